# Optimizing an MI355X kernel written in HIP

```python
import math
import jax
import jax.numpy as jnp
from jax import lax
import numpy as np


D_MODEL = 1024
BATCH = 16
SEQ = 2048
DEPTH = 4

CTX_LEN = 256
GRID_W = 64
N_MIXERS = 3
EPS = 1e-6

MLA_HEADS = 16
MLA_NOPE = 64
MLA_ROPE = 32
MLA_V = 64
MLA_Q_LORA = 384
MLA_KV_LORA = 256
ROPE_BASE = 10000.0
Q_BLOCK = 128

S5_GROUP = 16
S5_GROUPS = D_MODEL // S5_GROUP
S5_STATE = 64
S5_DT_MIN = 0.001
S5_DT_MAX = 0.1

GLA_HEADS = 4
GLA_KD = D_MODEL // 2
GLA_VD = D_MODEL
GLA_DK = GLA_KD // GLA_HEADS
GLA_DV = GLA_VD // GLA_HEADS
GLA_GATE_RANK = 16
GLA_GATE_NORM = 16.0
GLA_CHUNK = 64

PEER_HEADS = 8
PEER_NKEYS = 128
PEER_EXPERTS = PEER_NKEYS * PEER_NKEYS
PEER_DKEY = 128
PEER_TOPK = 16
PEER_CHUNK = 512

kernel_name = 'hybrid_mla_s5_gla_peer_dit'


def rmsnorm(x, g):
    xf = x.astype(jnp.float32)
    y = xf * lax.rsqrt(jnp.mean(xf * xf, axis=-1, keepdims=True) + EPS)
    return (y * g.astype(jnp.float32)).astype(x.dtype)


def modulate(h, shift, scale):
    return h * (1.0 + scale) + shift


def ada_params(cond, ada_w, ada_b):
    return jnp.split(jax.nn.silu(cond) @ ada_w + ada_b, 6, axis=-1)


def axial_angles(n):
    rows_n = n // GRID_W
    rows = jnp.repeat(jnp.arange(rows_n, dtype=jnp.float32), GRID_W)
    cols = jnp.tile(jnp.arange(GRID_W, dtype=jnp.float32), rows_n)
    half = MLA_ROPE // 2
    inv = ROPE_BASE ** (-jnp.arange(0, half, 2, dtype=jnp.float32) / half)
    return rows[:, None] * inv, cols[:, None] * inv


def rope_half(x, ang):
    m = x.shape[-1] // 2
    x1, x2 = x[..., :m], x[..., m:]
    cos, sin = jnp.cos(ang).astype(x.dtype), jnp.sin(ang).astype(x.dtype)
    return jnp.concatenate([x1 * cos - x2 * sin, x2 * cos + x1 * sin], axis=-1)


def axial_rope(x, ang_r, ang_c):
    h = x.shape[-1] // 2
    return jnp.concatenate([rope_half(x[..., :h], ang_r), rope_half(x[..., h:], ang_c)], axis=-1)


def mla_project(h, w_in, q_norm, w_uq, kv_norm, w_ukv):
    b, n, _ = h.shape
    a = h @ w_in
    cq, ckv, k_pe = jnp.split(a, [MLA_Q_LORA, MLA_Q_LORA + MLA_KV_LORA], axis=-1)
    q = (rmsnorm(cq, q_norm) @ w_uq).reshape(b, n, MLA_HEADS, MLA_NOPE + MLA_ROPE)
    kv = (rmsnorm(ckv, kv_norm) @ w_ukv).reshape(b, n, MLA_HEADS, MLA_NOPE + MLA_V)
    return q[..., :MLA_NOPE], q[..., MLA_NOPE:], kv[..., :MLA_NOPE], k_pe, kv[..., MLA_NOPE:]


def mla_attend(q_nope, q_pe, k_nope, k_pe, v):
    b, nq, h, _ = q_nope.shape
    nb = nq // Q_BLOCK
    scale = (MLA_NOPE + MLA_ROPE) ** -0.5

    def blk(args):
        qn, qp = args
        s = (jnp.einsum('bqhd,bkhd->bhqk', qn, k_nope)
             + jnp.einsum('bqhr,bkr->bhqk', qp, k_pe)).astype(jnp.float32) * scale
        p = jax.nn.softmax(s, axis=-1).astype(v.dtype)
        return jnp.einsum('bhqk,bkhd->bqhd', p, v)

    to_blocks = lambda t: jnp.moveaxis(t.reshape(b, nb, Q_BLOCK, *t.shape[2:]), 1, 0)
    o = lax.map(blk, (to_blocks(q_nope), to_blocks(q_pe)))
    return jnp.moveaxis(o, 0, 1).reshape(b, nq, h * MLA_V)


def mixer_mla(hc, hl, ctx_out, w_in, q_norm, w_uq, kv_norm, w_ukv, w_o):
    n_c = hc.shape[1]
    q_n, q_p, k_n, k_p, v = mla_project(jnp.concatenate([hc, hl], axis=1), w_in, q_norm, w_uq, kv_norm, w_ukv)
    ang_r, ang_c = axial_angles(hl.shape[1])
    lq_p = axial_rope(q_p[:, n_c:], ang_r[:, None], ang_c[:, None])
    k_p = jnp.concatenate([k_p[:, :n_c], axial_rope(k_p[:, n_c:], ang_r, ang_c)], axis=1)
    yl = mla_attend(q_n[:, n_c:], lq_p, k_n, k_p, v) @ w_o
    if not ctx_out:
        return None, yl
    yc = mla_attend(q_n[:, :n_c], q_p[:, :n_c], k_n[:, :n_c], k_p[:, :n_c], v[:, :n_c]) @ w_o
    return yc, yl


def s5_discretise(lam_re, lam_im, b_re, b_im, log_step):
    f32 = jnp.float32
    lr, li = lam_re.astype(f32), lam_im.astype(f32)
    dt = jnp.exp(log_step.astype(f32))[:, None]
    mag = jnp.exp(lr * dt)
    ar, ai = mag * jnp.cos(li * dt), mag * jnp.sin(li * dt)
    den = lr * lr + li * li
    fr = ((ar - 1.0) * lr + ai * li) / den
    fi = (ai * lr - (ar - 1.0) * li) / den
    br_, bi_ = b_re.astype(f32), b_im.astype(f32)
    br = fr[..., None] * br_ - fi[..., None] * bi_
    bi = fr[..., None] * bi_ + fi[..., None] * br_
    return ar, ai, br, bi


def s5_combine(e1, e2):
    a1r, a1i, b1r, b1i = e1
    a2r, a2i, b2r, b2i = e2
    return (a2r * a1r - a2i * a1i, a2r * a1i + a2i * a1r,
            a2r * b1r - a2i * b1i + b2r, a2r * b1i + a2i * b1r + b2i)


def s5_scan(u, h0r, h0i, disc, reverse):
    ar, ai, br, bi = disc
    bur = jnp.einsum('gpc,ngc->ngp', br, u)
    bui = jnp.einsum('gpc,ngc->ngp', bi, u)
    j = -1 if reverse else 0
    bur = bur.at[j].add(ar * h0r - ai * h0i)
    bui = bui.at[j].add(ar * h0i + ai * h0r)
    n = u.shape[0]
    a_r = jnp.broadcast_to(ar, (n,) + ar.shape)
    a_i = jnp.broadcast_to(ai, (n,) + ai.shape)
    _, _, xr, xi = lax.associative_scan(s5_combine, (a_r, a_i, bur, bui), reverse=reverse, axis=0)
    return xr, xi


def s5_readout(c_re, c_im, xr, xi):
    return (jnp.einsum('gcp,ngp->ngc', c_re.astype(jnp.float32), xr)
            - jnp.einsum('gcp,ngp->ngc', c_im.astype(jnp.float32), xi))


def s5_glu(y, u, d_skip, w_glu):
    z = jax.nn.gelu(y + d_skip * u) @ w_glu
    a, g = jnp.split(z, 2, axis=-1)
    return a * jax.nn.sigmoid(g)


def mixer_s5(hc, hl, ctx_out, lam_re, lam_im, b_re, b_im, c_re, c_im, log_step, d_skip, w_glu):
    f32 = jnp.float32
    n_c, n_l = hc.shape[1], hl.shape[1]
    disc = [s5_discretise(lam_re[d], lam_im[d], b_re[d], b_im[d], log_step[d]) for d in range(2)]

    def per_sample(args):
        uc, ul = args
        uc = uc.astype(f32).reshape(n_c, S5_GROUPS, S5_GROUP)
        ul = ul.astype(f32).reshape(n_l, S5_GROUPS, S5_GROUP)
        zero = jnp.zeros((S5_GROUPS, S5_STATE), f32)
        yl = jnp.zeros_like(ul)
        yc = jnp.zeros_like(uc) if ctx_out else None
        for d in range(2):
            rev = d == 1
            fin = 0 if rev else -1
            xcr, xci = s5_scan(uc, zero, zero, disc[d], rev)
            xlr, xli = s5_scan(ul, xcr[fin], xci[fin], disc[d], rev)
            yl = yl + s5_readout(c_re[d], c_im[d], xlr, xli)
            if ctx_out:
                yc = yc + s5_readout(c_re[d], c_im[d], xcr, xci)
        if ctx_out:
            return yc.reshape(n_c, D_MODEL), yl.reshape(n_l, D_MODEL)
        return yl.reshape(n_l, D_MODEL)

    res = lax.map(per_sample, (hc, hl))
    if not ctx_out:
        return None, s5_glu(res.astype(hl.dtype), hl, d_skip, w_glu)
    yc, yl = res
    return (s5_glu(yc.astype(hc.dtype), hc, d_skip, w_glu),
            s5_glu(yl.astype(hl.dtype), hl, d_skip, w_glu))


def gla_chunk_scan(q, k, v, lg, s0):
    b, h, n, _ = q.shape
    nc = n // GLA_CHUNK
    to_chunks = lambda t: jnp.moveaxis(t.reshape(b, h, nc, GLA_CHUNK, t.shape[-1]), 2, 0)
    mask = jnp.tril(jnp.ones((GLA_CHUNK, GLA_CHUNK), dtype=bool))

    def step(s, inp):
        qi, ki, vi, gi = inp
        bcum = jnp.cumsum(gi, axis=2)
        blast = bcum[:, :, -1:, :]
        qg = qi * jnp.exp(bcum)
        kg = ki * jnp.exp(-bcum)
        att = jnp.where(mask, jnp.einsum('bhik,bhjk->bhij', qg, kg), 0.0)
        o = jnp.einsum('bhij,bhjv->bhiv', att, vi) + jnp.einsum('bhik,bhkv->bhiv', qg, s)
        kdec = ki * jnp.exp(blast - bcum)
        s_new = jnp.exp(blast)[:, :, 0, :, None] * s + jnp.einsum('bhjk,bhjv->bhkv', kdec, vi)
        return s_new, o

    s_fin, o = lax.scan(step, s0, (to_chunks(q), to_chunks(k), to_chunks(v), to_chunks(lg)))
    return jnp.moveaxis(o, 0, 2).reshape(b, h, n, v.shape[-1]), s_fin


def mixer_gla(hc, hl, ctx_out, w_in, gk_w1, gk_w2, gk_b, o_norm, w_o):
    f32 = jnp.float32
    n_c = hc.shape[1]
    h = jnp.concatenate([hc, hl], axis=1)
    b, n, _ = h.shape
    q, k, v, g = jnp.split(h @ w_in, [GLA_KD, 2 * GLA_KD, 2 * GLA_KD + GLA_VD], axis=-1)
    heads = lambda t, dh: t.reshape(b, n, GLA_HEADS, dh).transpose(0, 2, 1, 3).astype(f32)
    q = heads(q, GLA_DK) * (GLA_DK ** -0.5)
    k = heads(k, GLA_DK)
    v = heads(v, GLA_DV)
    o_c, o_l = 0.0, 0.0
    for d in range(2):
        lg = jax.nn.log_sigmoid(heads((h @ gk_w1[d]) @ gk_w2[d] + gk_b[d], GLA_DK)) / GLA_GATE_NORM
        parts = (q, k, v, lg)
        ctx_p = [t[:, :, :n_c] for t in parts]
        lat_p = [t[:, :, n_c:] for t in parts]
        if d == 1:
            ctx_p = [jnp.flip(t, 2) for t in ctx_p]
            lat_p = [jnp.flip(t, 2) for t in lat_p]
        s0 = jnp.zeros((b, GLA_HEADS, GLA_DK, GLA_DV), f32)
        oc, sc = gla_chunk_scan(*ctx_p, s0)
        ol, _ = gla_chunk_scan(*lat_p, sc)
        if d == 1:
            oc, ol = jnp.flip(oc, 2), jnp.flip(ol, 2)
        o_c = o_c + oc
        o_l = o_l + ol

    def out(o, gt):
        m = o.shape[2]
        o = rmsnorm(o.transpose(0, 2, 1, 3).astype(h.dtype), o_norm)
        o = o * jax.nn.silu(gt.reshape(b, m, GLA_HEADS, GLA_DV))
        return o.reshape(b, m, GLA_VD) @ w_o

    yl = out(o_l, g[:, n_c:])
    yc = out(o_c, g[:, :n_c]) if ctx_out else None
    return yc, yl


def peer(h, w_q, sub_keys, u_tab, v_tab):
    t, d = h.shape
    pad = (-t) % PEER_CHUNK
    hp = jnp.pad(h, ((0, pad), (0, 0))).reshape(-1, PEER_CHUNK, d)
    kk = PEER_TOPK * PEER_TOPK

    def chunk(xc):
        q = (xc @ w_q).reshape(PEER_CHUNK, PEER_HEADS, 2, PEER_DKEY // 2)
        s = jnp.einsum('thpd,hpkd->thpk', q, sub_keys).astype(jnp.float32)
        sv, si = lax.top_k(s, PEER_TOPK)
        cand = (sv[:, :, 0, :, None] + sv[:, :, 1, None, :]).reshape(PEER_CHUNK, PEER_HEADS, kk)
        cid = (si[:, :, 0, :, None] * PEER_NKEYS + si[:, :, 1, None, :]).reshape(PEER_CHUNK, PEER_HEADS, kk)
        fv, fi = lax.top_k(cand, PEER_TOPK)
        eid = jnp.take_along_axis(cid, fi, axis=-1)
        gate = jax.nn.softmax(fv, axis=-1)
        act = jax.nn.gelu(jnp.einsum('thed,td->the', u_tab[eid], xc).astype(jnp.float32))
        w = (gate * act).astype(xc.dtype)
        return jnp.einsum('the,thed->td', w, v_tab[eid])

    return lax.map(chunk, hp).reshape(-1, d)[:t]


def setup_inputs(seed: int = 0) -> dict:
    key = jax.random.key(seed)
    ks = iter(jax.random.split(key, 40))
    nrm = lambda shape, s: jax.random.normal(next(ks), shape, jnp.float32) * s
    D = D_MODEL
    n_mla, n_s5, n_gla = (DEPTH + 2) // 3, (DEPTH + 1) // 3, DEPTH // 3
    n_idx = jnp.arange(S5_STATE, dtype=jnp.float32)
    return {
        'x': nrm((BATCH, SEQ, D), 1.0),
        'c': nrm((BATCH, D), 1.0),
        'ctx': nrm((BATCH, CTX_LEN, D), 1.0),
        'c_ctx': nrm((D,), 1.0),
        'norm_g': 1.0 + nrm((DEPTH, 2, D), 0.02),
        'ada_w': nrm((DEPTH, D, 6 * D), 0.5 * D ** -0.5),
        'ada_b': nrm((DEPTH, 6 * D), 0.01),
        'mla_w_in': nrm((n_mla, D, MLA_Q_LORA + MLA_KV_LORA + MLA_ROPE), D ** -0.5),
        'mla_q_norm': 1.0 + nrm((n_mla, MLA_Q_LORA), 0.02),
        'mla_w_uq': nrm((n_mla, MLA_Q_LORA, MLA_HEADS * (MLA_NOPE + MLA_ROPE)), MLA_Q_LORA ** -0.5),
        'mla_kv_norm': 1.0 + nrm((n_mla, MLA_KV_LORA), 0.02),
        'mla_w_ukv': nrm((n_mla, MLA_KV_LORA, MLA_HEADS * (MLA_NOPE + MLA_V)), MLA_KV_LORA ** -0.5),
        'mla_w_o': nrm((n_mla, MLA_HEADS * MLA_V, D), (MLA_HEADS * MLA_V) ** -0.5),
        's5_lam_re': -0.5 + nrm((n_s5, 2, S5_GROUPS, S5_STATE), 0.01),
        's5_lam_im': math.pi * n_idx + nrm((n_s5, 2, S5_GROUPS, S5_STATE), 0.01),
        's5_b_re': nrm((n_s5, 2, S5_GROUPS, S5_STATE, S5_GROUP), (2 * S5_GROUP) ** -0.5),
        's5_b_im': nrm((n_s5, 2, S5_GROUPS, S5_STATE, S5_GROUP), (2 * S5_GROUP) ** -0.5),
        's5_c_re': nrm((n_s5, 2, S5_GROUPS, S5_GROUP, S5_STATE), (2 * S5_STATE) ** -0.5),
        's5_c_im': nrm((n_s5, 2, S5_GROUPS, S5_GROUP, S5_STATE), (2 * S5_STATE) ** -0.5),
        's5_log_step': jax.random.uniform(next(ks), (n_s5, 2, S5_GROUPS), jnp.float32,
                                          math.log(S5_DT_MIN), math.log(S5_DT_MAX)),
        's5_d': nrm((n_s5, D), 1.0),
        's5_w_glu': nrm((n_s5, D, 2 * D), D ** -0.5),
        'gla_w_in': nrm((n_gla, D, 2 * GLA_KD + 2 * GLA_VD), D ** -0.5),
        'gla_gk_w1': nrm((n_gla, 2, D, GLA_GATE_RANK), D ** -0.5),
        'gla_gk_w2': nrm((n_gla, 2, GLA_GATE_RANK, GLA_KD), GLA_GATE_RANK ** -0.5),
        'gla_gk_b': nrm((n_gla, 2, GLA_KD), 0.1),
        'gla_o_norm': 1.0 + nrm((n_gla, GLA_DV), 0.02),
        'gla_w_o': nrm((n_gla, GLA_VD, D), GLA_VD ** -0.5),
        'peer_w_q': nrm((DEPTH, D, PEER_HEADS * PEER_DKEY), D ** -0.5),
        'peer_keys': nrm((DEPTH, PEER_HEADS, 2, PEER_NKEYS, PEER_DKEY // 2), (PEER_DKEY // 2) ** -0.5),
        'peer_u': nrm((DEPTH, PEER_EXPERTS, D), D ** -0.5),
        'peer_v': nrm((DEPTH, PEER_EXPERTS, D), 0.5),
        'final_g': 1.0 + nrm((D,), 0.02),
    }


def reference(x, c, ctx, c_ctx, norm_g, ada_w, ada_b,
              mla_w_in, mla_q_norm, mla_w_uq, mla_kv_norm, mla_w_ukv, mla_w_o,
              s5_lam_re, s5_lam_im, s5_b_re, s5_b_im, s5_c_re, s5_c_im, s5_log_step, s5_d, s5_w_glu,
              gla_w_in, gla_gk_w1, gla_gk_w2, gla_gk_b, gla_o_norm, gla_w_o,
              peer_w_q, peer_keys, peer_u, peer_v, final_g):
    xl, xc = x, ctx
    for i in range(DEPTH):
        kind, j = i % N_MIXERS, i // N_MIXERS
        last = i == DEPTH - 1
        sh1, sc1, g1, sh2, sc2, g2 = [t[:, None, :] for t in ada_params(c, ada_w[i], ada_b[i])]
        csh1, csc1, cg1, csh2, csc2, cg2 = ada_params(c_ctx, ada_w[i], ada_b[i])
        hl = modulate(rmsnorm(xl, norm_g[i, 0]), sh1, sc1)
        hc = modulate(rmsnorm(xc, norm_g[i, 0]), csh1, csc1)
        if kind == 0:
            yc, yl = mixer_mla(hc, hl, not last, mla_w_in[j], mla_q_norm[j], mla_w_uq[j],
                               mla_kv_norm[j], mla_w_ukv[j], mla_w_o[j])
        elif kind == 1:
            yc, yl = mixer_s5(hc, hl, not last, s5_lam_re[j], s5_lam_im[j], s5_b_re[j], s5_b_im[j],
                              s5_c_re[j], s5_c_im[j], s5_log_step[j], s5_d[j], s5_w_glu[j])
        else:
            yc, yl = mixer_gla(hc, hl, not last, gla_w_in[j], gla_gk_w1[j], gla_gk_w2[j],
                               gla_gk_b[j], gla_o_norm[j], gla_w_o[j])
        xl = xl + g1 * yl
        hl = modulate(rmsnorm(xl, norm_g[i, 1]), sh2, sc2)
        if last:
            f = peer(hl.reshape(-1, D_MODEL), peer_w_q[i], peer_keys[i], peer_u[i], peer_v[i])
            xl = xl + g2 * f.reshape(xl.shape)
        else:
            xc = xc + cg1 * yc
            hc = modulate(rmsnorm(xc, norm_g[i, 1]), csh2, csc2)
            h_all = jnp.concatenate([hc, hl], axis=1)
            f = peer(h_all.reshape(-1, D_MODEL), peer_w_q[i], peer_keys[i], peer_u[i], peer_v[i]).reshape(h_all.shape)
            n_c = hc.shape[1]
            xc = xc + cg2 * f[:, :n_c]
            xl = xl + g2 * f[:, n_c:]
    return rmsnorm(xl, final_g)
```

```cpp
#include <hip/hip_runtime.h>
#include <hip/hip_cooperative_groups.h>
#include <cstdio>
#include <cstdint>
namespace cg = cooperative_groups;

typedef unsigned short bf16_t;
#define DEV __device__ __forceinline__

DEV int tid_op() { int t = threadIdx.x; asm volatile("" : "+v"(t)); return t; }
DEV int bid_op() { int t = blockIdx.x; asm volatile("" : "+s"(t)); return t; }
#define TIDX tid_op()
#define BIDX bid_op()
constexpr int D = 1024, NB = 16, SEQ = 2048, CTX = 256, SP = 2304, T = NB * SP;
constexpr int NTHR = 512;

struct Params {
  const float *x, *c, *ctx, *c_ctx, *norm_g, *ada_w, *ada_b;
  const float *mla_w_in, *mla_q_norm, *mla_w_uq, *mla_kv_norm, *mla_w_ukv, *mla_w_o;
  const float *s5_lam_re, *s5_lam_im, *s5_b_re, *s5_b_im, *s5_c_re, *s5_c_im, *s5_log_step, *s5_d, *s5_w_glu;
  const float *gla_w_in, *gla_gk_w1, *gla_gk_w2, *gla_gk_b, *gla_o_norm, *gla_w_o;
  const float *peer_w_q, *peer_keys, *peer_u, *peer_v, *final_g;
  float* out;
  float *xc, *ada, *rope;
  bf16_t* h;
  bf16_t *w_mla_in, *w_uq, *w_ukv, *w_mla_o, *w_glu, *w_gla_in, *w_gla_o, *w_pq;
  float *s5_ar, *s5_ai, *s5_br, *s5_bi;
  char* scratch;
};

constexpr size_t MB = 1ull << 20;
constexpr size_t OFF_A1 = 0;
constexpr size_t OFF_CQN = 54 * MB;
constexpr size_t OFF_CKVN = 81 * MB;
constexpr size_t OFF_QF = 99 * MB;
constexpr size_t OFF_KF = 207 * MB;
constexpr size_t OFF_VF = 315 * MB;
constexpr size_t OFF_O = 387 * MB;
constexpr size_t OFF_Y = 0;
constexpr size_t OFF_GIN = 144 * MB;
constexpr size_t OFF_Z = 216 * MB;
constexpr size_t OFF_QKVG = 0;
constexpr size_t OFF_LG = 216 * MB;
constexpr size_t OFF_OD = 360 * MB;
constexpr size_t OFF_GO = 504 * MB;
constexpr size_t OFF_PQ = 0;
constexpr size_t OFF_SV = 144 * MB;
constexpr size_t OFF_SI = 180 * MB;
constexpr size_t OFF_EID = 216 * MB;
constexpr size_t OFF_GATE = 234 * MB;
constexpr size_t SCRATCH_BYTES = 576 * MB;

DEV float bf2f(bf16_t v) { return __uint_as_float(((unsigned)v) << 16); }
DEV bf16_t f2bf(float f) { unsigned u = __float_as_uint(f); u += 0x7fffu + ((u >> 16) & 1u); return (bf16_t)(u >> 16); }
DEV float wave_sum(float v) {
#pragma unroll
  for (int o = 32; o > 0; o >>= 1) v += __shfl_xor(v, o);
  return v;
}
DEV float gelu_tanh(float x) { float u = 0.7978845608028654f * (x + 0.044715f * x * x * x); return 0.5f * x * (1.f + tanhf(u)); }
DEV float sigm(float x) { return 1.f / (1.f + __expf(-x)); }
DEV float silu(float x) { return x * sigm(x); }

DEV float* xrow_ptr(const Params& p, int t) {
  int b = t / SP, s = t - b * SP;
  return s < CTX ? p.xc + ((size_t)(b * CTX + s)) * D : p.out + ((size_t)(b * SEQ + s - CTX)) * D;
}
DEV const float* ada_ptr(const Params& p, int layer, int t) {
  int b = t / SP, s = t - b * SP;
  return p.ada + ((size_t)(layer * 17 + (s < CTX ? 16 : b))) * 6144;
}

DEV void load_row_f32(const float* row, int lane, float (&v)[16]) {
#pragma unroll
  for (int j = 0; j < 4; ++j) { float4 t = *(const float4*)(row + j * 256 + lane * 4); v[j * 4] = t.x; v[j * 4 + 1] = t.y; v[j * 4 + 2] = t.z; v[j * 4 + 3] = t.w; }
}
DEV void store_row_f32(float* row, int lane, const float (&v)[16]) {
#pragma unroll
  for (int j = 0; j < 4; ++j) *(float4*)(row + j * 256 + lane * 4) = make_float4(v[j * 4], v[j * 4 + 1], v[j * 4 + 2], v[j * 4 + 3]);
}
DEV void norm_mod_store(const float (&v)[16], const float* g, const float* sc, const float* sh, bf16_t* hrow, int lane) {
  float ss = 0.f;
#pragma unroll
  for (int i = 0; i < 16; ++i) ss += v[i] * v[i];
  ss = wave_sum(ss);
  const float rstd = rsqrtf(ss * (1.0f / D) + 1e-6f);
#pragma unroll
  for (int j = 0; j < 4; ++j) {
    const int c0 = j * 256 + lane * 4;
    float4 gg = *(const float4*)(g + c0), s1 = *(const float4*)(sc + c0), s2 = *(const float4*)(sh + c0);
    float y0 = v[j * 4] * rstd * gg.x * (1.f + s1.x) + s2.x, y1 = v[j * 4 + 1] * rstd * gg.y * (1.f + s1.y) + s2.y;
    float y2 = v[j * 4 + 2] * rstd * gg.z * (1.f + s1.z) + s2.z, y3 = v[j * 4 + 3] * rstd * gg.w * (1.f + s1.w) + s2.w;
    uint2 w; w.x = (unsigned)f2bf(y0) | ((unsigned)f2bf(y1) << 16); w.y = (unsigned)f2bf(y2) | ((unsigned)f2bf(y3) << 16);
    *(uint2*)(hrow + c0) = w;
  }
}

DEV void convT(const float* src, bf16_t* dst, int K, int N, int Npad, int rot, float* lds) {
  const int tk = K / 64, tn = Npad / 64, nt = tk * tn, tid = TIDX;
  for (int tile = (BIDX + rot) % gridDim.x; tile < nt; tile += gridDim.x) {
    const int k0 = (tile % tk) * 64, n0 = (tile / tk) * 64;
    __syncthreads();
#pragma unroll
    for (int i = 0; i < 8; ++i) { int idx = tid + i * NTHR, kk = idx >> 6, nn = idx & 63;
      lds[kk * 65 + nn] = (n0 + nn < N) ? src[(size_t)(k0 + kk) * N + n0 + nn] : 0.f; }
    __syncthreads();
#pragma unroll
    for (int i = 0; i < 8; ++i) { int idx = tid + i * NTHR, nn = idx >> 6, kk = idx & 63;
      dst[(size_t)(n0 + nn) * K + k0 + kk] = f2bf(lds[kk * 65 + nn]); }
  }
}

DEV void phase_prologue(const Params& p, float* lds) {
  const int tid = TIDX, gtid = BIDX * NTHR + tid, gn = gridDim.x * NTHR;
  int rot = 0;
  for (int j = 0; j < 2; ++j) {
    convT(p.mla_w_in + (size_t)j * 1024 * 672, p.w_mla_in + (size_t)j * 768 * 1024, 1024, 672, 768, rot, lds); rot += 37;
    convT(p.mla_w_uq + (size_t)j * 384 * 1536, p.w_uq + (size_t)j * 1536 * 384, 384, 1536, 1536, rot, lds); rot += 37;
    convT(p.mla_w_ukv + (size_t)j * 256 * 2048, p.w_ukv + (size_t)j * 2048 * 256, 256, 2048, 2048, rot, lds); rot += 37;
    convT(p.mla_w_o + (size_t)j * 1024 * 1024, p.w_mla_o + (size_t)j * 1024 * 1024, 1024, 1024, 1024, rot, lds); rot += 37;
  }
  convT(p.s5_w_glu, p.w_glu, 1024, 2048, 2048, rot, lds); rot += 37;
  convT(p.gla_w_in, p.w_gla_in, 1024, 3072, 3072, rot, lds); rot += 37;
  convT(p.gla_w_o, p.w_gla_o, 1024, 1024, 1024, rot, lds); rot += 37;
  for (int i = 0; i < 4; ++i) { convT(p.peer_w_q + (size_t)i * 1024 * 1024, p.w_pq + (size_t)i * 1024 * 1024, 1024, 1024, 1024, rot, lds); rot += 37; }
  for (int idx = gtid; idx < 2 * 512 * 1024; idx += gn) {
    const int k = idx & 1023, n = (idx >> 10) & 511, d = idx >> 19;
    const float* w1 = p.gla_gk_w1 + ((size_t)d * 1024 + k) * 16; const float* w2 = p.gla_gk_w2 + (size_t)d * 16 * 512 + n;
    float s = 0.f;
#pragma unroll
    for (int r = 0; r < 16; ++r) s += w1[r] * w2[r * 512];
    p.w_gla_in[(size_t)(3072 + d * 512 + n) * 1024 + k] = f2bf(s);
  }
  for (int idx = gtid; idx < 2048 * 8; idx += gn) {
    const int pos = idx >> 3, i = idx & 7;
    const float inv = powf(10000.0f, -(float)i / 8.0f);
    const float ar = (float)(pos / 64) * inv, ac = (float)(pos % 64) * inv;
    float* r = p.rope + pos * 32;
    r[i] = cosf(ar); r[8 + i] = sinf(ar); r[16 + i] = cosf(ac); r[24 + i] = sinf(ac);
  }
  for (int idx = gtid; idx < 2 * 64 * 64; idx += gn) {
    const int g = (idx >> 6) & 63, d = idx >> 12;
    const float lr = p.s5_lam_re[idx], li = p.s5_lam_im[idx], dt = expf(p.s5_log_step[d * 64 + g]);
    const float mag = expf(lr * dt), ar = mag * cosf(li * dt), ai = mag * sinf(li * dt), den = lr * lr + li * li;
    const float fr = ((ar - 1.f) * lr + ai * li) / den, fi = (ai * lr - (ar - 1.f) * li) / den;
    p.s5_ar[idx] = ar; p.s5_ai[idx] = ai;
    for (int c = 0; c < 16; ++c) { const float bre = p.s5_b_re[idx * 16 + c], bim = p.s5_b_im[idx * 16 + c];
      p.s5_br[idx * 16 + c] = fr * bre - fi * bim; p.s5_bi[idx * 16 + c] = fr * bim + fi * bre; }
  }
  {
    float* s = lds;
    float* part = lds + 17 * 1024;
    __syncthreads();
    for (int idx = tid; idx < 17 * 1024; idx += NTHR) { const int r = idx >> 10, k = idx & 1023; const float cv = r < 16 ? p.c[r * 1024 + k] : p.c_ctx[k]; s[idx] = silu(cv); }
    __syncthreads();
    for (int cb = BIDX; cb < 4 * 64; cb += gridDim.x) {
      const int layer = cb >> 6, n0 = (cb & 63) * 96;
      if (tid < 384) {
        const int col = tid % 96, kq = tid / 96;
        float acc[17];
#pragma unroll
        for (int r = 0; r < 17; ++r) acc[r] = 0.f;
        const float* w = p.ada_w + (size_t)layer * 1024 * 6144 + n0 + col;
        for (int k = kq * 256; k < kq * 256 + 256; ++k) { const float wv = w[(size_t)k * 6144];
#pragma unroll
          for (int r = 0; r < 17; ++r) acc[r] += s[r * 1024 + k] * wv; }
#pragma unroll
        for (int r = 0; r < 17; ++r) part[(kq * 96 + col) * 17 + r] = acc[r];
      }
      __syncthreads();
      for (int idx = tid; idx < 96 * 17; idx += NTHR) { const int col = idx / 17, r = idx % 17;
        const float v = part[(0 * 96 + col) * 17 + r] + part[(1 * 96 + col) * 17 + r] + part[(2 * 96 + col) * 17 + r] + part[(3 * 96 + col) * 17 + r];
        p.ada[((size_t)(layer * 17 + r)) * 6144 + n0 + col] = v + p.ada_b[layer * 6144 + n0 + col]; }
      __syncthreads();
    }
  }
}

DEV void phase_norm1_first(const Params& p) {
  const int lane = TIDX & 63, gw = BIDX * (NTHR / 64) + (TIDX >> 6), nw = gridDim.x * (NTHR / 64);
  for (int t = gw; t < T; t += nw) {
    const int b = t / SP, s = t - b * SP;
    const float* src = s < CTX ? p.ctx + ((size_t)(b * CTX + s)) * D : p.x + ((size_t)(b * SEQ + s - CTX)) * D;
    float v[16]; load_row_f32(src, lane, v);
    store_row_f32(xrow_ptr(p, t), lane, v);
    const float* ad = ada_ptr(p, 0, t);
    norm_mod_store(v, p.norm_g, ad + 1024, ad, p.h + (size_t)t * D, lane);
  }
}
DEV void phase_norm2(const Params& p, int layer) {
  const int lane = TIDX & 63, gw = BIDX * (NTHR / 64) + (TIDX >> 6), nw = gridDim.x * (NTHR / 64);
  for (int t = gw; t < T; t += nw) {
    float v[16]; load_row_f32(xrow_ptr(p, t), lane, v);
    const float* ad = ada_ptr(p, layer, t);
    norm_mod_store(v, p.norm_g + (layer * 2 + 1) * D, ad + 4096, ad + 3072, p.h + (size_t)t * D, lane);
  }
}

template <class Epi>
DEV void gemm_naive(const bf16_t* A, int lda, const bf16_t* Bt, int ldb, int M, int N, int K, const Epi& epi, float* lds) {
  float* As = lds;
  float* Bs = lds + 16 * 132;
  const int tid = TIDX, ty = tid >> 5, tx = tid & 31, nM = M / 128, nN = N / 128;
  const int lrow = tid >> 2, lkq = tid & 3;
  for (int tile = BIDX; tile < nM * nN; tile += gridDim.x) {
    const int pm = tile / nN, pn = tile - pm * nN;
    float acc[8][4];
#pragma unroll
    for (int i = 0; i < 8; ++i)
#pragma unroll
      for (int j = 0; j < 4; ++j) acc[i][j] = 0.f;
    const bf16_t* ap = A + (size_t)(pm * 128 + lrow) * lda + lkq * 4;
    const bf16_t* bp = Bt + (size_t)(pn * 128 + lrow) * ldb + lkq * 4;
    for (int k0 = 0; k0 < K; k0 += 16) {
      const uint2 av = *(const uint2*)(ap + k0), bv = *(const uint2*)(bp + k0);
      __syncthreads();
      As[(lkq * 4 + 0) * 132 + lrow] = __uint_as_float(av.x << 16); As[(lkq * 4 + 1) * 132 + lrow] = __uint_as_float(av.x & 0xffff0000u);
      As[(lkq * 4 + 2) * 132 + lrow] = __uint_as_float(av.y << 16); As[(lkq * 4 + 3) * 132 + lrow] = __uint_as_float(av.y & 0xffff0000u);
      Bs[(lkq * 4 + 0) * 132 + lrow] = __uint_as_float(bv.x << 16); Bs[(lkq * 4 + 1) * 132 + lrow] = __uint_as_float(bv.x & 0xffff0000u);
      Bs[(lkq * 4 + 2) * 132 + lrow] = __uint_as_float(bv.y << 16); Bs[(lkq * 4 + 3) * 132 + lrow] = __uint_as_float(bv.y & 0xffff0000u);
      __syncthreads();
#pragma unroll 2
      for (int kk = 0; kk < 16; ++kk) {
        const float4 a0 = *(const float4*)(As + kk * 132 + ty * 8), a1 = *(const float4*)(As + kk * 132 + ty * 8 + 4), b0 = *(const float4*)(Bs + kk * 132 + tx * 4);
        const float a[8] = {a0.x, a0.y, a0.z, a0.w, a1.x, a1.y, a1.z, a1.w}, b[4] = {b0.x, b0.y, b0.z, b0.w};
#pragma unroll
        for (int i = 0; i < 8; ++i)
#pragma unroll
          for (int j = 0; j < 4; ++j) acc[i][j] += a[i] * b[j];
      }
    }
#pragma unroll
    for (int i = 0; i < 8; ++i)
#pragma unroll
      for (int j = 0; j < 4; ++j) epi(pm * 128 + ty * 8 + i, pn * 128 + tx * 4 + j, acc[i][j]);
  }
}

struct EpiStoreBf16 { bf16_t* C; int ldc; int ncols; DEV void operator()(int r, int c, float v) const { if (c < ncols) C[(size_t)r * ldc + c] = f2bf(v); } };
struct EpiStoreF32 { float* C; int ldc; DEV void operator()(int r, int c, float v) const { C[(size_t)r * ldc + c] = v; } };
struct EpiQ { bf16_t* QF; DEV void operator()(int r, int c, float v) const { int b = r / SP, s = r - b * SP, h = c / 96, d = c - h * 96; QF[((size_t)(b * 16 + h) * SP + s) * 96 + d] = f2bf(v); } };
struct EpiKV { bf16_t* KF; bf16_t* VF; DEV void operator()(int r, int c, float v) const { int b = r / SP, s = r - b * SP, h = c >> 7, d = c & 127;
    if (d < 64) KF[((size_t)(b * 16 + h) * SP + s) * 96 + d] = f2bf(v); else VF[((size_t)(b * 16 + h) * SP + s) * 64 + d - 64] = f2bf(v); } };
struct EpiRes { float* xc; float* out; const float* ada; int layer; int goff; bool last;
  DEV void operator()(int r, int c, float v) const { int b = r / SP, s = r - b * SP;
    if (s < CTX) { if (last) return; xc[((size_t)(b * CTX + s)) * D + c] += ada[((size_t)(layer * 17 + 16)) * 6144 + goff + c] * v; }
    else out[((size_t)(b * SEQ + s - CTX)) * D + c] += ada[((size_t)(layer * 17 + b)) * 6144 + goff + c] * v; } };
struct EpiGla { bf16_t* QKVG; float* LG; const float* gkb;
  DEV void operator()(int r, int c, float v) const {
    if (c < 3072) { if (c < 512) v *= 0.08838834764831845f; QKVG[(size_t)r * 3072 + c] = f2bf(v); }
    else { int d = (c - 3072) >> 9, n = (c - 3072) & 511; float z = v + gkb[d * 512 + n];
      float ls = fminf(z, 0.f) - log1pf(__expf(-fabsf(z)));
      LG[((size_t)d * T + r) * 512 + n] = ls * (1.0f / 16.0f); } } };

DEV void phase_mla_norm(const Params& p, int j) {
  const bf16_t* A1 = (const bf16_t*)(p.scratch + OFF_A1); bf16_t* CQN = (bf16_t*)(p.scratch + OFF_CQN); bf16_t* CKVN = (bf16_t*)(p.scratch + OFF_CKVN); bf16_t* KF = (bf16_t*)(p.scratch + OFF_KF);
  const int lane = TIDX & 63, gw = BIDX * (NTHR / 64) + (TIDX >> 6), nw = gridDim.x * (NTHR / 64);
  const float* qn = p.mla_q_norm + j * 384; const float* kn = p.mla_kv_norm + j * 256;
  for (int t = gw; t < T; t += nw) {
    const bf16_t* a = A1 + (size_t)t * 768;
    float v[6], ss = 0.f;
#pragma unroll
    for (int i = 0; i < 6; ++i) { v[i] = bf2f(a[lane + 64 * i]); ss += v[i] * v[i]; }
    ss = wave_sum(ss); float rstd = rsqrtf(ss * (1.0f / 384.0f) + 1e-6f);
#pragma unroll
    for (int i = 0; i < 6; ++i) CQN[(size_t)t * 384 + lane + 64 * i] = f2bf(v[i] * rstd * qn[lane + 64 * i]);
    float w[4]; ss = 0.f;
#pragma unroll
    for (int i = 0; i < 4; ++i) { w[i] = bf2f(a[384 + lane + 64 * i]); ss += w[i] * w[i]; }
    ss = wave_sum(ss); rstd = rsqrtf(ss * (1.0f / 256.0f) + 1e-6f);
#pragma unroll
    for (int i = 0; i < 4; ++i) CKVN[(size_t)t * 256 + lane + 64 * i] = f2bf(w[i] * rstd * kn[lane + 64 * i]);
    const int b = t / SP, s = t - b * SP;
    float val = bf2f(a[640 + (lane & 31)]);
    const float other = __shfl_xor(val, 8);
    if (s >= CTX) { const int pos = s - CTX, d = lane & 31, hb = d >> 4, dd = d & 15, i = dd & 7;
      const float cs = p.rope[pos * 32 + hb * 16 + i], sn = p.rope[pos * 32 + hb * 16 + 8 + i];
      val = dd < 8 ? val * cs - other * sn : val * cs + other * sn; }
    if (lane < 32) { const bf16_t o = f2bf(val);
      for (int hh = 0; hh < 16; ++hh) KF[((size_t)(b * 16 + hh) * SP + s) * 96 + 64 + lane] = o; }
  }
}

DEV void phase_attn_naive(const Params& p, bool last, float* lds) {
  const bf16_t* QF = (const bf16_t*)(p.scratch + OFF_QF); const bf16_t* KF = (const bf16_t*)(p.scratch + OFF_KF); const bf16_t* VF = (const bf16_t*)(p.scratch + OFF_VF);
  bf16_t* O = (bf16_t*)(p.scratch + OFF_O);
  float* Ks = lds;
  float* Vs = lds + 32 * 96;
  const int tid = TIDX;
  const int nitems = 1024 + (last ? 0 : 256);
  for (int item = BIDX; item < nitems; item += gridDim.x) {
    int b, hh, q0, nq, nkeys;
    if (item < 1024) { b = item >> 6; hh = (item >> 2) & 15; q0 = CTX + (item & 3) * 512; nq = 512; nkeys = SP; }
    else { const int it = item - 1024; b = it >> 4; hh = it & 15; q0 = 0; nq = 256; nkeys = CTX; }
    const size_t bh = (size_t)(b * 16 + hh) * SP;
    const bool active = tid < nq;
    const int sq = q0 + (active ? tid : 0);
    float q[96];
    { const bf16_t* qp = QF + (bh + sq) * 96;
#pragma unroll
      for (int i = 0; i < 96; i += 2) { const unsigned u = *(const unsigned*)(qp + i); q[i] = __uint_as_float(u << 16); q[i + 1] = __uint_as_float(u & 0xffff0000u); } }
    if (sq >= CTX) { const float* r = p.rope + (sq - CTX) * 32;
#pragma unroll
      for (int hb = 0; hb < 2; ++hb)
#pragma unroll
        for (int i = 0; i < 8; ++i) { const float cs = r[hb * 16 + i], sn = r[hb * 16 + 8 + i], x1 = q[64 + hb * 16 + i], x2 = q[64 + hb * 16 + 8 + i];
          q[64 + hb * 16 + i] = x1 * cs - x2 * sn; q[64 + hb * 16 + 8 + i] = x2 * cs + x1 * sn; } }
#pragma unroll
    for (int i = 0; i < 96; ++i) q[i] *= 0.10206207261596577f;
    float acc[64], m = -1e30f, l = 0.f;
#pragma unroll
    for (int i = 0; i < 64; ++i) acc[i] = 0.f;
    for (int k0 = 0; k0 < nkeys; k0 += 32) {
      __syncthreads();
      for (int idx = tid; idx < 32 * 96 / 2; idx += NTHR) { const unsigned u = *(const unsigned*)(KF + (bh + k0) * 96 + idx * 2); Ks[idx * 2] = __uint_as_float(u << 16); Ks[idx * 2 + 1] = __uint_as_float(u & 0xffff0000u); }
      for (int idx = tid; idx < 32 * 64 / 2; idx += NTHR) { const unsigned u = *(const unsigned*)(VF + (bh + k0) * 64 + idx * 2); Vs[idx * 2] = __uint_as_float(u << 16); Vs[idx * 2 + 1] = __uint_as_float(u & 0xffff0000u); }
      __syncthreads();
#pragma unroll 1
      for (int kk = 0; kk < 32; ++kk) {
        float s = 0.f;
#pragma unroll
        for (int i = 0; i < 96; i += 4) { const float4 kv = *(const float4*)(Ks + kk * 96 + i); s += q[i] * kv.x + q[i + 1] * kv.y + q[i + 2] * kv.z + q[i + 3] * kv.w; }
        if (s > m) { const float corr = __expf(m - s); l *= corr;
#pragma unroll
          for (int i = 0; i < 64; ++i) acc[i] *= corr;
          m = s; }
        const float pe = __expf(s - m); l += pe;
#pragma unroll
        for (int i = 0; i < 64; i += 4) { const float4 vv = *(const float4*)(Vs + kk * 64 + i); acc[i] += pe * vv.x; acc[i + 1] += pe * vv.y; acc[i + 2] += pe * vv.z; acc[i + 3] += pe * vv.w; }
      }
    }
    if (active) { const float inv = 1.f / l; bf16_t* op = O + ((size_t)(b * SP + sq)) * D + hh * 64;
#pragma unroll
      for (int i = 0; i < 64; i += 2) *(unsigned*)(op + i) = (unsigned)f2bf(acc[i] * inv) | ((unsigned)f2bf(acc[i + 1] * inv) << 16); }
  }
}

#define INSERT16(val, pay, tv, ti) { float s_ = (val); int i_ = (pay); _Pragma("unroll") for (int j_ = 0; j_ < 16; ++j_) { if (s_ > tv[j_]) { float t_ = tv[j_]; tv[j_] = s_; s_ = t_; int u_ = ti[j_]; ti[j_] = i_; i_ = u_; } } }

DEV void phase_peer_subtopk(const Params& p, int layer, float* lds) {
  const float* PQ = (const float*)(p.scratch + OFF_PQ); float* SV = (float*)(p.scratch + OFF_SV); int* SI = (int*)(p.scratch + OFF_SI);
  const int tid = TIDX;
  for (int item = BIDX; item < 16 * 72; item += gridDim.x) {
    const int hp = item / 72, tb = item - hp * 72, t = tb * 512 + tid;
    __syncthreads();
    const float* kp = p.peer_keys + ((size_t)(layer * 16 + hp)) * 128 * 64;
    for (int idx = tid; idx < 128 * 64 / 4; idx += NTHR) *(float4*)(lds + idx * 4) = *(const float4*)(kp + idx * 4);
    __syncthreads();
    float q[64];
#pragma unroll
    for (int i = 0; i < 64; i += 4) { const float4 v = *(const float4*)(PQ + (size_t)t * 1024 + hp * 64 + i); q[i] = v.x; q[i + 1] = v.y; q[i + 2] = v.z; q[i + 3] = v.w; }
    float tv[16]; int ti[16];
#pragma unroll
    for (int j = 0; j < 16; ++j) { tv[j] = -3.0e38f; ti[j] = 0; }
#pragma unroll 1
    for (int key = 0; key < 128; ++key) {
      float s = 0.f;
#pragma unroll
      for (int i = 0; i < 64; i += 4) { const float4 kv = *(const float4*)(lds + key * 64 + i); s += q[i] * kv.x + q[i + 1] * kv.y + q[i + 2] * kv.z + q[i + 3] * kv.w; }
      INSERT16(s, key, tv, ti);
    }
#pragma unroll
    for (int j = 0; j < 16; ++j) { SV[((size_t)t * 16 + hp) * 16 + j] = tv[j]; SI[((size_t)t * 16 + hp) * 16 + j] = ti[j]; }
  }
}

DEV void phase_peer_final_topk(const Params& p) {
  const float* SV = (const float*)(p.scratch + OFF_SV); const int* SI = (const int*)(p.scratch + OFF_SI);
  int* EID = (int*)(p.scratch + OFF_EID); float* GATE = (float*)(p.scratch + OFF_GATE);
  for (int idx = BIDX * NTHR + TIDX; idx < T * 8; idx += gridDim.x * NTHR) {
    float a[16], bq[16]; int ia[16], ib[16];
#pragma unroll
    for (int j = 0; j < 16; ++j) { a[j] = SV[(size_t)idx * 32 + j]; ia[j] = SI[(size_t)idx * 32 + j]; bq[j] = SV[(size_t)idx * 32 + 16 + j]; ib[j] = SI[(size_t)idx * 32 + 16 + j]; }
    float tv[16]; int ti[16];
#pragma unroll
    for (int j = 0; j < 16; ++j) { tv[j] = -3.0e38f; ti[j] = 0; }
#pragma unroll
    for (int i0 = 0; i0 < 16; ++i0)
#pragma unroll
      for (int i1 = 0; i1 < 16; ++i1)
        if ((i0 + 1) * (i1 + 1) <= 16) INSERT16(a[i0] + bq[i1], ia[i0] * 128 + ib[i1], tv, ti);
    float e[16], sum = 0.f;
#pragma unroll
    for (int j = 0; j < 16; ++j) { e[j] = __expf(tv[j] - tv[0]); sum += e[j]; }
    const float inv = 1.f / sum;
#pragma unroll
    for (int j = 0; j < 16; ++j) { EID[(size_t)idx * 16 + j] = ti[j]; GATE[(size_t)idx * 16 + j] = e[j] * inv; }
  }
}

DEV void phase_peer_gather(const Params& p, int layer) {
  const int* EID = (const int*)(p.scratch + OFF_EID); const float* GATE = (const float*)(p.scratch + OFF_GATE);
  const int lane = TIDX & 63, gw = BIDX * (NTHR / 64) + (TIDX >> 6), nw = gridDim.x * (NTHR / 64);
  const bool last = layer == 3;
  const float* U = p.peer_u + (size_t)layer * 16384 * 1024; const float* V = p.peer_v + (size_t)layer * 16384 * 1024;
  for (int t = gw; t < T; t += nw) {
    const int b = t / SP, s = t - b * SP;
    if (last && s < CTX) continue;
    float x[16];
    { const bf16_t* hr = p.h + (size_t)t * D;
#pragma unroll
      for (int j = 0; j < 4; ++j) { const uint2 w = *(const uint2*)(hr + j * 256 + lane * 4); x[j * 4] = __uint_as_float(w.x << 16); x[j * 4 + 1] = __uint_as_float(w.x & 0xffff0000u); x[j * 4 + 2] = __uint_as_float(w.y << 16); x[j * 4 + 3] = __uint_as_float(w.y & 0xffff0000u); } }
    float f[16];
#pragma unroll
    for (int i = 0; i < 16; ++i) f[i] = 0.f;
#pragma unroll 2
    for (int e = 0; e < 128; ++e) {
      const int eid = EID[(size_t)t * 128 + e]; const float gate = GATE[(size_t)t * 128 + e];
      const float* ur = U + (size_t)eid * 1024; const float* vr = V + (size_t)eid * 1024;
      float4 uu[4], vv[4];
#pragma unroll
      for (int j = 0; j < 4; ++j) { uu[j] = *(const float4*)(ur + j * 256 + lane * 4); vv[j] = *(const float4*)(vr + j * 256 + lane * 4); }
      float dsum = 0.f;
#pragma unroll
      for (int j = 0; j < 4; ++j) dsum += uu[j].x * x[j * 4] + uu[j].y * x[j * 4 + 1] + uu[j].z * x[j * 4 + 2] + uu[j].w * x[j * 4 + 3];
      dsum = wave_sum(dsum);
      const float w = gate * gelu_tanh(dsum);
#pragma unroll
      for (int j = 0; j < 4; ++j) { f[j * 4] += w * vv[j].x; f[j * 4 + 1] += w * vv[j].y; f[j * 4 + 2] += w * vv[j].z; f[j * 4 + 3] += w * vv[j].w; }
    }
    float* xr = xrow_ptr(p, t);
    float xv[16]; load_row_f32(xr, lane, xv);
    const float* ad = ada_ptr(p, layer, t);
#pragma unroll
    for (int j = 0; j < 4; ++j) { const float4 g2 = *(const float4*)(ad + 5120 + j * 256 + lane * 4);
      xv[j * 4] += g2.x * f[j * 4]; xv[j * 4 + 1] += g2.y * f[j * 4 + 1]; xv[j * 4 + 2] += g2.z * f[j * 4 + 2]; xv[j * 4 + 3] += g2.w * f[j * 4 + 3]; }
    if (!last) {
      store_row_f32(xr, lane, xv);
      const float* ad2 = ada_ptr(p, layer + 1, t);
      norm_mod_store(xv, p.norm_g + ((layer + 1) * 2) * D, ad2 + 1024, ad2, p.h + (size_t)t * D, lane);
    } else {
      float ss = 0.f;
#pragma unroll
      for (int i = 0; i < 16; ++i) ss += xv[i] * xv[i];
      ss = wave_sum(ss); const float rstd = rsqrtf(ss * (1.0f / D) + 1e-6f);
#pragma unroll
      for (int j = 0; j < 4; ++j) { const float4 g = *(const float4*)(p.final_g + j * 256 + lane * 4);
        xv[j * 4] *= rstd * g.x; xv[j * 4 + 1] *= rstd * g.y; xv[j * 4 + 2] *= rstd * g.z; xv[j * 4 + 3] *= rstd * g.w; }
      store_row_f32(xr, lane, xv);
    }
  }
}

DEV int seq_of_tau(int tau, int d) { return d == 0 ? tau : (tau < CTX ? CTX - 1 - tau : 2 * CTX + SEQ - 1 - tau); }

DEV void phase_s5_scan(const Params& p, float* lds) {
  float* Y = (float*)(p.scratch + OFF_Y); bf16_t* GIN = (bf16_t*)(p.scratch + OFF_GIN);
  const int tid = TIDX, wid = tid >> 6, lane = tid & 63;
  float* ub = lds + wid * 2048;
  float* yb = ub + 1024;
  for (int item0 = BIDX * 8; item0 < 1024; item0 += gridDim.x * 8) {
    const int item = item0 + wid, b = item >> 6, g = item & 63;
    for (int d = 0; d < 2; ++d) {
      const int sidx = (d * 64 + g) * 64 + lane;
      const float ar = p.s5_ar[sidx], ai = p.s5_ai[sidx];
      float br[16], bi[16], cr[16], ci[16];
#pragma unroll
      for (int c = 0; c < 16; ++c) { br[c] = p.s5_br[sidx * 16 + c]; bi[c] = p.s5_bi[sidx * 16 + c];
        cr[c] = p.s5_c_re[((size_t)(d * 64 + g) * 16 + c) * 64 + lane]; ci[c] = p.s5_c_im[((size_t)(d * 64 + g) * 16 + c) * 64 + lane]; }
      float xr = 0.f, xi = 0.f;
      for (int k = 0; k < 36; ++k) {
        const int trow = b * SP + seq_of_tau(k * 64 + lane, d);
        __syncthreads();
        { const bf16_t* hp = p.h + (size_t)trow * D + g * 16;
          const uint4 w0 = *(const uint4*)hp, w1 = *(const uint4*)(hp + 8);
          const unsigned ww[8] = {w0.x, w0.y, w0.z, w0.w, w1.x, w1.y, w1.z, w1.w};
#pragma unroll
          for (int i = 0; i < 8; ++i) { ub[lane * 16 + 2 * i] = __uint_as_float(ww[i] << 16); ub[lane * 16 + 2 * i + 1] = __uint_as_float(ww[i] & 0xffff0000u); } }
        __syncthreads();
#pragma unroll 1
        for (int j = 0; j < 64; ++j) {
          float u[16];
#pragma unroll
          for (int c = 0; c < 16; c += 4) { const float4 t4 = *(const float4*)(ub + j * 16 + c); u[c] = t4.x; u[c + 1] = t4.y; u[c + 2] = t4.z; u[c + 3] = t4.w; }
          float bur = 0.f, bui = 0.f;
#pragma unroll
          for (int c = 0; c < 16; ++c) { bur += br[c] * u[c]; bui += bi[c] * u[c]; }
          const float nxr = ar * xr - ai * xi + bur, nxi = ar * xi + ai * xr + bui;
          xr = nxr; xi = nxi;
          float v[16];
#pragma unroll
          for (int c = 0; c < 16; ++c) v[c] = cr[c] * xr - ci[c] * xi;
#pragma unroll
          for (int i = 0; i < 8; ++i) { const bool hi = lane & 32; const float send = hi ? v[i] : v[i + 8], keep = hi ? v[i + 8] : v[i]; v[i] = keep + __shfl_xor(send, 32); }
#pragma unroll
          for (int i = 0; i < 4; ++i) { const bool hi = lane & 16; const float send = hi ? v[i] : v[i + 4], keep = hi ? v[i + 4] : v[i]; v[i] = keep + __shfl_xor(send, 16); }
#pragma unroll
          for (int i = 0; i < 2; ++i) { const bool hi = lane & 8; const float send = hi ? v[i] : v[i + 2], keep = hi ? v[i + 2] : v[i]; v[i] = keep + __shfl_xor(send, 8); }
          { const bool hi = lane & 4; const float send = hi ? v[0] : v[1], keep = hi ? v[1] : v[0]; v[0] = keep + __shfl_xor(send, 4); }
          v[0] += __shfl_xor(v[0], 2); v[0] += __shfl_xor(v[0], 1);
          if ((lane & 3) == 0) yb[j * 16 + (lane >> 2)] = v[0];
        }
        __syncthreads();
        if (d == 0) {
#pragma unroll
          for (int c = 0; c < 16; c += 4) *(float4*)(Y + (size_t)trow * D + g * 16 + c) = *(const float4*)(yb + lane * 16 + c);
        } else {
          unsigned ow[8];
#pragma unroll
          for (int c = 0; c < 16; c += 2) {
            const float y0 = Y[(size_t)trow * D + g * 16 + c] + yb[lane * 16 + c] + p.s5_d[g * 16 + c] * ub[lane * 16 + c];
            const float y1 = Y[(size_t)trow * D + g * 16 + c + 1] + yb[lane * 16 + c + 1] + p.s5_d[g * 16 + c + 1] * ub[lane * 16 + c + 1];
            ow[c >> 1] = (unsigned)f2bf(gelu_tanh(y0)) | ((unsigned)f2bf(gelu_tanh(y1)) << 16);
          }
          *(uint4*)(GIN + (size_t)trow * D + g * 16) = make_uint4(ow[0], ow[1], ow[2], ow[3]);
          *(uint4*)(GIN + (size_t)trow * D + g * 16 + 8) = make_uint4(ow[4], ow[5], ow[6], ow[7]);
        }
      }
    }
  }
}

DEV void phase_s5_out(const Params& p, int layer) {
  const bf16_t* Z = (const bf16_t*)(p.scratch + OFF_Z);
  const int lane = TIDX & 63, gw = BIDX * (NTHR / 64) + (TIDX >> 6), nw = gridDim.x * (NTHR / 64);
  for (int t = gw; t < T; t += nw) {
    float* xr = xrow_ptr(p, t); float xv[16]; load_row_f32(xr, lane, xv);
    const float* ad = ada_ptr(p, layer, t);
#pragma unroll
    for (int j = 0; j < 4; ++j) { const int c0 = j * 256 + lane * 4;
      const uint2 za = *(const uint2*)(Z + (size_t)t * 2048 + c0), zg = *(const uint2*)(Z + (size_t)t * 2048 + 1024 + c0);
      const float a[4] = {__uint_as_float(za.x << 16), __uint_as_float(za.x & 0xffff0000u), __uint_as_float(za.y << 16), __uint_as_float(za.y & 0xffff0000u)};
      const float gg[4] = {__uint_as_float(zg.x << 16), __uint_as_float(zg.x & 0xffff0000u), __uint_as_float(zg.y << 16), __uint_as_float(zg.y & 0xffff0000u)};
      const float4 g1 = *(const float4*)(ad + 2048 + c0); const float g1a[4] = {g1.x, g1.y, g1.z, g1.w};
#pragma unroll
      for (int e = 0; e < 4; ++e) xv[j * 4 + e] += g1a[e] * a[e] * sigm(gg[e]); }
    store_row_f32(xr, lane, xv);
    norm_mod_store(xv, p.norm_g + (layer * 2 + 1) * D, ad + 4096, ad + 3072, p.h + (size_t)t * D, lane);
  }
}

DEV void phase_gla_scan(const Params& p, float* lds) {
  const bf16_t* QKVG = (const bf16_t*)(p.scratch + OFF_QKVG); const float* LG = (const float*)(p.scratch + OFF_LG); bf16_t* OD = (bf16_t*)(p.scratch + OFF_OD);
  float* qs = lds; float* ks = lds + 16 * 128; float* es = lds + 32 * 128; float* vs = lds + 48 * 128; float* op = vs + 16 * 256;
  const int tid = TIDX, col = tid & 255, kh = tid >> 8;
  for (int item = BIDX; item < 128; item += gridDim.x) {
    const int b = item >> 3, hd = (item >> 1) & 3, d = item & 1;
    float S[64];
#pragma unroll
    for (int i = 0; i < 64; ++i) S[i] = 0.f;
    for (int st = 0; st < SP / 16; ++st) {
      __syncthreads();
      for (int idx = tid; idx < 16 * 128; idx += NTHR) { const int j = idx >> 7, k = idx & 127; const size_t trow = (size_t)b * SP + seq_of_tau(st * 16 + j, d);
        qs[idx] = bf2f(QKVG[trow * 3072 + hd * 128 + k]); ks[idx] = bf2f(QKVG[trow * 3072 + 512 + hd * 128 + k]); es[idx] = __expf(LG[((size_t)d * T + trow) * 512 + hd * 128 + k]); }
      for (int idx = tid; idx < 16 * 256; idx += NTHR) { const int j = idx >> 8, c = idx & 255; const size_t trow = (size_t)b * SP + seq_of_tau(st * 16 + j, d);
        vs[idx] = bf2f(QKVG[trow * 3072 + 1024 + hd * 256 + c]); }
      __syncthreads();
#pragma unroll 1
      for (int j = 0; j < 16; ++j) {
        const float vv = vs[j * 256 + col]; float acc = 0.f;
#pragma unroll
        for (int kk = 0; kk < 64; kk += 4) {
          const float4 e4 = *(const float4*)(es + j * 128 + kh * 64 + kk), k4 = *(const float4*)(ks + j * 128 + kh * 64 + kk), q4 = *(const float4*)(qs + j * 128 + kh * 64 + kk);
          S[kk] = e4.x * S[kk] + k4.x * vv; acc += q4.x * S[kk];
          S[kk + 1] = e4.y * S[kk + 1] + k4.y * vv; acc += q4.y * S[kk + 1];
          S[kk + 2] = e4.z * S[kk + 2] + k4.z * vv; acc += q4.z * S[kk + 2];
          S[kk + 3] = e4.w * S[kk + 3] + k4.w * vv; acc += q4.w * S[kk + 3];
        }
        op[kh * 16 * 256 + j * 256 + col] = acc;
      }
      __syncthreads();
      for (int idx = tid; idx < 16 * 256; idx += NTHR) { const int j = idx >> 8, c = idx & 255; const size_t trow = (size_t)b * SP + seq_of_tau(st * 16 + j, d);
        OD[((size_t)d * T + trow) * D + hd * 256 + c] = f2bf(op[idx] + op[16 * 256 + idx]); }
    }
  }
}

DEV void phase_gla_out(const Params& p) {
  const bf16_t* QKVG = (const bf16_t*)(p.scratch + OFF_QKVG); const bf16_t* OD = (const bf16_t*)(p.scratch + OFF_OD); bf16_t* GO = (bf16_t*)(p.scratch + OFF_GO);
  const int lane = TIDX & 63, gw = BIDX * (NTHR / 64) + (TIDX >> 6), nw = gridDim.x * (NTHR / 64);
  for (int t = gw; t < T; t += nw) {
#pragma unroll
    for (int hd = 0; hd < 4; ++hd) {
      const int c0 = hd * 256 + lane * 4;
      const uint2 a = *(const uint2*)(OD + (size_t)t * D + c0), bq = *(const uint2*)(OD + ((size_t)T + t) * D + c0), gg = *(const uint2*)(QKVG + (size_t)t * 3072 + 2048 + c0);
      float o[4] = {__uint_as_float(a.x << 16) + __uint_as_float(bq.x << 16), __uint_as_float(a.x & 0xffff0000u) + __uint_as_float(bq.x & 0xffff0000u),
                    __uint_as_float(a.y << 16) + __uint_as_float(bq.y << 16), __uint_as_float(a.y & 0xffff0000u) + __uint_as_float(bq.y & 0xffff0000u)};
      const float gv[4] = {__uint_as_float(gg.x << 16), __uint_as_float(gg.x & 0xffff0000u), __uint_as_float(gg.y << 16), __uint_as_float(gg.y & 0xffff0000u)};
      float ss = o[0] * o[0] + o[1] * o[1] + o[2] * o[2] + o[3] * o[3];
      ss = wave_sum(ss); const float rstd = rsqrtf(ss * (1.0f / 256.0f) + 1e-6f);
      const float4 on = *(const float4*)(p.gla_o_norm + lane * 4); const float ona[4] = {on.x, on.y, on.z, on.w};
      unsigned w[2];
#pragma unroll
      for (int e = 0; e < 4; e += 2) w[e >> 1] = (unsigned)f2bf(o[e] * rstd * ona[e] * silu(gv[e])) | ((unsigned)f2bf(o[e + 1] * rstd * ona[e + 1] * silu(gv[e + 1])) << 16);
      *(uint2*)(GO + (size_t)t * D + c0) = make_uint2(w[0], w[1]);
    }
  }
}

__global__ void __launch_bounds__(NTHR) fwd_megakernel(Params p) {
  cg::grid_group grid = cg::this_grid();
  __shared__ __attribute__((aligned(16))) float lds[24 * 1024];
  phase_prologue(p, lds);
  grid.sync();
  phase_norm1_first(p);
  grid.sync();
  for (int layer = 0; layer < 4; ++layer) {
    const int kind = layer % 3, j = layer / 3; const bool last = layer == 3;
    if (kind == 0) {
      gemm_naive(p.h, D, p.w_mla_in + (size_t)j * 768 * 1024, 1024, T, 768, 1024, EpiStoreBf16{(bf16_t*)(p.scratch + OFF_A1), 768, 672}, lds);
      grid.sync();
      phase_mla_norm(p, j);
      grid.sync();
      gemm_naive((const bf16_t*)(p.scratch + OFF_CQN), 384, p.w_uq + (size_t)j * 1536 * 384, 384, T, 1536, 384, EpiQ{(bf16_t*)(p.scratch + OFF_QF)}, lds);
      gemm_naive((const bf16_t*)(p.scratch + OFF_CKVN), 256, p.w_ukv + (size_t)j * 2048 * 256, 256, T, 2048, 256, EpiKV{(bf16_t*)(p.scratch + OFF_KF), (bf16_t*)(p.scratch + OFF_VF)}, lds);
      grid.sync();
      phase_attn_naive(p, last, lds);
      grid.sync();
      gemm_naive((const bf16_t*)(p.scratch + OFF_O), D, p.w_mla_o + (size_t)j * 1024 * 1024, 1024, T, 1024, 1024, EpiRes{p.xc, p.out, p.ada, layer, 2048, last}, lds);
      grid.sync();
      phase_norm2(p, layer);
      grid.sync();
    } else if (kind == 1) {
      phase_s5_scan(p, lds);
      grid.sync();
      gemm_naive((const bf16_t*)(p.scratch + OFF_GIN), D, p.w_glu, 1024, T, 2048, 1024, EpiStoreBf16{(bf16_t*)(p.scratch + OFF_Z), 2048, 2048}, lds);
      grid.sync();
      phase_s5_out(p, layer);
      grid.sync();
    } else {
      gemm_naive(p.h, D, p.w_gla_in, 1024, T, 4096, 1024, EpiGla{(bf16_t*)(p.scratch + OFF_QKVG), (float*)(p.scratch + OFF_LG), p.gla_gk_b}, lds);
      grid.sync();
      phase_gla_scan(p, lds);
      grid.sync();
      phase_gla_out(p);
      grid.sync();
      gemm_naive((const bf16_t*)(p.scratch + OFF_GO), D, p.w_gla_o, 1024, T, 1024, 1024, EpiRes{p.xc, p.out, p.ada, layer, 2048, false}, lds);
      grid.sync();
      phase_norm2(p, layer);
      grid.sync();
    }
    gemm_naive(p.h, D, p.w_pq + (size_t)layer * 1024 * 1024, 1024, T, 1024, 1024, EpiStoreF32{(float*)(p.scratch + OFF_PQ), 1024}, lds);
    grid.sync();
    phase_peer_subtopk(p, layer, lds);
    grid.sync();
    phase_peer_final_topk(p);
    grid.sync();
    phase_peer_gather(p, layer);
    if (layer < 3) grid.sync();
  }
}

extern "C" void kernel_launch(void* const* d_in, const int* in_sizes, int n_in, void* d_out,
                              int out_size, void* d_ws, size_t ws_size, hipStream_t stream) {
  static int grid_blocks = 0;
  if (!grid_blocks) {
    int dev = 0, cus = 0, per_cu = 0;
    (void)hipGetDevice(&dev);
    (void)hipDeviceGetAttribute(&cus, hipDeviceAttributeMultiprocessorCount, dev);
    (void)hipOccupancyMaxActiveBlocksPerMultiprocessor(&per_cu, fwd_megakernel, NTHR, 0);
    if (per_cu > 1) per_cu = 1;
    grid_blocks = cus * per_cu;
  }
  Params p{};
  const float* const* in = (const float* const*)d_in;
  p.x = in[0]; p.c = in[1]; p.ctx = in[2]; p.c_ctx = in[3]; p.norm_g = in[4]; p.ada_w = in[5]; p.ada_b = in[6];
  p.mla_w_in = in[7]; p.mla_q_norm = in[8]; p.mla_w_uq = in[9]; p.mla_kv_norm = in[10]; p.mla_w_ukv = in[11]; p.mla_w_o = in[12];
  p.s5_lam_re = in[13]; p.s5_lam_im = in[14]; p.s5_b_re = in[15]; p.s5_b_im = in[16]; p.s5_c_re = in[17]; p.s5_c_im = in[18]; p.s5_log_step = in[19]; p.s5_d = in[20]; p.s5_w_glu = in[21];
  p.gla_w_in = in[22]; p.gla_gk_w1 = in[23]; p.gla_gk_w2 = in[24]; p.gla_gk_b = in[25]; p.gla_o_norm = in[26]; p.gla_w_o = in[27];
  p.peer_w_q = in[28]; p.peer_keys = in[29]; p.peer_u = in[30]; p.peer_v = in[31]; p.final_g = in[32];
  p.out = (float*)d_out;
  char* w = (char*)d_ws; size_t off = 0;
  auto take = [&](size_t bytes) { char* r = w + off; off += (bytes + 255) & ~(size_t)255; return r; };
  p.xc = (float*)take((size_t)NB * CTX * D * 4);
  p.ada = (float*)take((size_t)4 * 17 * 6144 * 4);
  p.rope = (float*)take((size_t)2048 * 32 * 4);
  p.h = (bf16_t*)take((size_t)T * D * 2);
  p.w_mla_in = (bf16_t*)take((size_t)2 * 768 * 1024 * 2);
  p.w_uq = (bf16_t*)take((size_t)2 * 1536 * 384 * 2);
  p.w_ukv = (bf16_t*)take((size_t)2 * 2048 * 256 * 2);
  p.w_mla_o = (bf16_t*)take((size_t)2 * 1024 * 1024 * 2);
  p.w_glu = (bf16_t*)take((size_t)2048 * 1024 * 2);
  p.w_gla_in = (bf16_t*)take((size_t)4096 * 1024 * 2);
  p.w_gla_o = (bf16_t*)take((size_t)1024 * 1024 * 2);
  p.w_pq = (bf16_t*)take((size_t)4 * 1024 * 1024 * 2);
  p.s5_ar = (float*)take(2 * 64 * 64 * 4); p.s5_ai = (float*)take(2 * 64 * 64 * 4);
  p.s5_br = (float*)take(2 * 64 * 64 * 16 * 4); p.s5_bi = (float*)take(2 * 64 * 64 * 16 * 4);
  p.scratch = take(SCRATCH_BYTES);
  if (off > ws_size) { fprintf(stderr, "workspace too small: need %zu have %zu\n", off, ws_size); return; }
  void* args[] = {&p};
  hipError_t e = hipLaunchCooperativeKernel((void*)fwd_megakernel, dim3(grid_blocks), dim3(NTHR), args, 0, stream);
  if (e != hipSuccess) fprintf(stderr, "cooperative launch failed: %s (grid %d)\n", hipGetErrorString(e), grid_blocks);
}
```

```cpp
#include <hip/hip_runtime.h>
#include <hip/hip_cooperative_groups.h>
#include <cstdio>
#include <cstdint>
namespace cg = cooperative_groups;

typedef unsigned short bf16_t;
#define DEV __device__ __forceinline__

DEV int tid_op() { int t = threadIdx.x; asm volatile("" : "+v"(t)); return t; }
DEV int bid_op() { int t = blockIdx.x; asm volatile("" : "+s"(t)); return t; }
#define TIDX tid_op()
#define BIDX bid_op()
constexpr int D = 1024, NB = 16, SEQ = 2048, CTX = 256, SP = 2304, T = NB * SP;
constexpr int NTHR = 512;

struct Params {
  const float *x, *c, *ctx, *c_ctx, *norm_g, *ada_w, *ada_b;
  const float *mla_w_in, *mla_q_norm, *mla_w_uq, *mla_kv_norm, *mla_w_ukv, *mla_w_o;
  const float *s5_lam_re, *s5_lam_im, *s5_b_re, *s5_b_im, *s5_c_re, *s5_c_im, *s5_log_step, *s5_d, *s5_w_glu;
  const float *gla_w_in, *gla_gk_w1, *gla_gk_w2, *gla_gk_b, *gla_o_norm, *gla_w_o;
  const float *peer_w_q, *peer_keys, *peer_u, *peer_v, *final_g;
  float* out;
  float *xc, *ada, *rope;
  bf16_t* h;
  bf16_t *w_mla_in, *w_uq, *w_ukv, *w_mla_o, *w_glu, *w_gla_in, *w_gla_o, *w_pq;
  float *s5_ar, *s5_ai, *s5_br, *s5_bi;
  char* scratch;
};

constexpr size_t MB = 1ull << 20;
constexpr size_t OFF_A1 = 0;
constexpr size_t OFF_CQN = 54 * MB;
constexpr size_t OFF_CKVN = 81 * MB;
constexpr size_t OFF_QF = 99 * MB;
constexpr size_t OFF_KF = 207 * MB;
constexpr size_t OFF_VF = 315 * MB;
constexpr size_t OFF_O = 387 * MB;
constexpr size_t OFF_Y = 0;
constexpr size_t OFF_GIN = 144 * MB;
constexpr size_t OFF_Z = 216 * MB;
constexpr size_t OFF_QKVG = 0;
constexpr size_t OFF_LG = 216 * MB;
constexpr size_t OFF_OD = 360 * MB;
constexpr size_t OFF_GO = 504 * MB;
constexpr size_t OFF_PQ = 0;
constexpr size_t OFF_SV = 144 * MB;
constexpr size_t OFF_SI = 180 * MB;
constexpr size_t OFF_EID = 216 * MB;
constexpr size_t OFF_GATE = 234 * MB;
constexpr size_t SCRATCH_BYTES = 576 * MB;

DEV float bf2f(bf16_t v) { return __uint_as_float(((unsigned)v) << 16); }
DEV bf16_t f2bf(float f) { unsigned u = __float_as_uint(f); u += 0x7fffu + ((u >> 16) & 1u); return (bf16_t)(u >> 16); }
DEV float wave_sum(float v) {
#pragma unroll
  for (int o = 32; o > 0; o >>= 1) v += __shfl_xor(v, o);
  return v;
}
DEV float gelu_tanh(float x) { float u = 0.7978845608028654f * (x + 0.044715f * x * x * x); return 0.5f * x * (1.f + tanhf(u)); }
DEV float sigm(float x) { return 1.f / (1.f + __expf(-x)); }
DEV float silu(float x) { return x * sigm(x); }

DEV float* xrow_ptr(const Params& p, int t) {
  int b = t / SP, s = t - b * SP;
  return s < CTX ? p.xc + ((size_t)(b * CTX + s)) * D : p.out + ((size_t)(b * SEQ + s - CTX)) * D;
}
DEV const float* ada_ptr(const Params& p, int layer, int t) {
  int b = t / SP, s = t - b * SP;
  return p.ada + ((size_t)(layer * 17 + (s < CTX ? 16 : b))) * 6144;
}

DEV void load_row_f32(const float* row, int lane, float (&v)[16]) {
#pragma unroll
  for (int j = 0; j < 4; ++j) { float4 t = *(const float4*)(row + j * 256 + lane * 4); v[j * 4] = t.x; v[j * 4 + 1] = t.y; v[j * 4 + 2] = t.z; v[j * 4 + 3] = t.w; }
}
DEV void store_row_f32(float* row, int lane, const float (&v)[16]) {
#pragma unroll
  for (int j = 0; j < 4; ++j) *(float4*)(row + j * 256 + lane * 4) = make_float4(v[j * 4], v[j * 4 + 1], v[j * 4 + 2], v[j * 4 + 3]);
}
DEV void norm_mod_store(const float (&v)[16], const float* g, const float* sc, const float* sh, bf16_t* hrow, int lane) {
  float ss = 0.f;
#pragma unroll
  for (int i = 0; i < 16; ++i) ss += v[i] * v[i];
  ss = wave_sum(ss);
  const float rstd = rsqrtf(ss * (1.0f / D) + 1e-6f);
#pragma unroll
  for (int j = 0; j < 4; ++j) {
    const int c0 = j * 256 + lane * 4;
    float4 gg = *(const float4*)(g + c0), s1 = *(const float4*)(sc + c0), s2 = *(const float4*)(sh + c0);
    float y0 = v[j * 4] * rstd * gg.x * (1.f + s1.x) + s2.x, y1 = v[j * 4 + 1] * rstd * gg.y * (1.f + s1.y) + s2.y;
    float y2 = v[j * 4 + 2] * rstd * gg.z * (1.f + s1.z) + s2.z, y3 = v[j * 4 + 3] * rstd * gg.w * (1.f + s1.w) + s2.w;
    uint2 w; w.x = (unsigned)f2bf(y0) | ((unsigned)f2bf(y1) << 16); w.y = (unsigned)f2bf(y2) | ((unsigned)f2bf(y3) << 16);
    *(uint2*)(hrow + c0) = w;
  }
}

DEV void convT(const float* src, bf16_t* dst, int K, int N, int Npad, int rot, float* lds) {
  const int tk = K / 64, tn = Npad / 64, nt = tk * tn, tid = TIDX;
  for (int tile = (BIDX + rot) % gridDim.x; tile < nt; tile += gridDim.x) {
    const int k0 = (tile % tk) * 64, n0 = (tile / tk) * 64;
    __syncthreads();
#pragma unroll
    for (int i = 0; i < 8; ++i) { int idx = tid + i * NTHR, kk = idx >> 6, nn = idx & 63;
      lds[kk * 65 + nn] = (n0 + nn < N) ? src[(size_t)(k0 + kk) * N + n0 + nn] : 0.f; }
    __syncthreads();
#pragma unroll
    for (int i = 0; i < 8; ++i) { int idx = tid + i * NTHR, nn = idx >> 6, kk = idx & 63;
      dst[(size_t)(n0 + nn) * K + k0 + kk] = f2bf(lds[kk * 65 + nn]); }
  }
}

DEV void phase_prologue(const Params& p, float* lds) {
  const int tid = TIDX, gtid = BIDX * NTHR + tid, gn = gridDim.x * NTHR;
  int rot = 0;
  for (int j = 0; j < 2; ++j) {
    convT(p.mla_w_in + (size_t)j * 1024 * 672, p.w_mla_in + (size_t)j * 768 * 1024, 1024, 672, 768, rot, lds); rot += 37;
    convT(p.mla_w_uq + (size_t)j * 384 * 1536, p.w_uq + (size_t)j * 1536 * 384, 384, 1536, 1536, rot, lds); rot += 37;
    convT(p.mla_w_ukv + (size_t)j * 256 * 2048, p.w_ukv + (size_t)j * 2048 * 256, 256, 2048, 2048, rot, lds); rot += 37;
    convT(p.mla_w_o + (size_t)j * 1024 * 1024, p.w_mla_o + (size_t)j * 1024 * 1024, 1024, 1024, 1024, rot, lds); rot += 37;
  }
  convT(p.s5_w_glu, p.w_glu, 1024, 2048, 2048, rot, lds); rot += 37;
  convT(p.gla_w_in, p.w_gla_in, 1024, 3072, 3072, rot, lds); rot += 37;
  convT(p.gla_w_o, p.w_gla_o, 1024, 1024, 1024, rot, lds); rot += 37;
  for (int i = 0; i < 4; ++i) { convT(p.peer_w_q + (size_t)i * 1024 * 1024, p.w_pq + (size_t)i * 1024 * 1024, 1024, 1024, 1024, rot, lds); rot += 37; }
  for (int idx = gtid; idx < 2 * 512 * 1024; idx += gn) {
    const int k = idx & 1023, n = (idx >> 10) & 511, d = idx >> 19;
    const float* w1 = p.gla_gk_w1 + ((size_t)d * 1024 + k) * 16; const float* w2 = p.gla_gk_w2 + (size_t)d * 16 * 512 + n;
    float s = 0.f;
#pragma unroll
    for (int r = 0; r < 16; ++r) s += w1[r] * w2[r * 512];
    p.w_gla_in[(size_t)(3072 + d * 512 + n) * 1024 + k] = f2bf(s);
  }
  for (int idx = gtid; idx < 2048 * 8; idx += gn) {
    const int pos = idx >> 3, i = idx & 7;
    const float inv = powf(10000.0f, -(float)i / 8.0f);
    const float ar = (float)(pos / 64) * inv, ac = (float)(pos % 64) * inv;
    float* r = p.rope + pos * 32;
    r[i] = cosf(ar); r[8 + i] = sinf(ar); r[16 + i] = cosf(ac); r[24 + i] = sinf(ac);
  }
  for (int idx = gtid; idx < 2 * 64 * 64; idx += gn) {
    const int g = (idx >> 6) & 63, d = idx >> 12;
    const float lr = p.s5_lam_re[idx], li = p.s5_lam_im[idx], dt = expf(p.s5_log_step[d * 64 + g]);
    const float mag = expf(lr * dt), ar = mag * cosf(li * dt), ai = mag * sinf(li * dt), den = lr * lr + li * li;
    const float fr = ((ar - 1.f) * lr + ai * li) / den, fi = (ai * lr - (ar - 1.f) * li) / den;
    p.s5_ar[idx] = ar; p.s5_ai[idx] = ai;
    for (int c = 0; c < 16; ++c) { const float bre = p.s5_b_re[idx * 16 + c], bim = p.s5_b_im[idx * 16 + c];
      p.s5_br[idx * 16 + c] = fr * bre - fi * bim; p.s5_bi[idx * 16 + c] = fr * bim + fi * bre; }
  }
  {
    float* s = lds;
    float* part = lds + 17 * 1024;
    __syncthreads();
    for (int idx = tid; idx < 17 * 1024; idx += NTHR) { const int r = idx >> 10, k = idx & 1023; const float cv = r < 16 ? p.c[r * 1024 + k] : p.c_ctx[k]; s[idx] = silu(cv); }
    __syncthreads();
    for (int cb = BIDX; cb < 4 * 64; cb += gridDim.x) {
      const int layer = cb >> 6, n0 = (cb & 63) * 96;
      if (tid < 384) {
        const int col = tid % 96, kq = tid / 96;
        float acc[17];
#pragma unroll
        for (int r = 0; r < 17; ++r) acc[r] = 0.f;
        const float* w = p.ada_w + (size_t)layer * 1024 * 6144 + n0 + col;
        for (int k = kq * 256; k < kq * 256 + 256; ++k) { const float wv = w[(size_t)k * 6144];
#pragma unroll
          for (int r = 0; r < 17; ++r) acc[r] += s[r * 1024 + k] * wv; }
#pragma unroll
        for (int r = 0; r < 17; ++r) part[(kq * 96 + col) * 17 + r] = acc[r];
      }
      __syncthreads();
      for (int idx = tid; idx < 96 * 17; idx += NTHR) { const int col = idx / 17, r = idx % 17;
        const float v = part[(0 * 96 + col) * 17 + r] + part[(1 * 96 + col) * 17 + r] + part[(2 * 96 + col) * 17 + r] + part[(3 * 96 + col) * 17 + r];
        p.ada[((size_t)(layer * 17 + r)) * 6144 + n0 + col] = v + p.ada_b[layer * 6144 + n0 + col]; }
      __syncthreads();
    }
  }
}

DEV void phase_norm1_first(const Params& p) {
  const int lane = TIDX & 63, gw = BIDX * (NTHR / 64) + (TIDX >> 6), nw = gridDim.x * (NTHR / 64);
  for (int t = gw; t < T; t += nw) {
    const int b = t / SP, s = t - b * SP;
    const float* src = s < CTX ? p.ctx + ((size_t)(b * CTX + s)) * D : p.x + ((size_t)(b * SEQ + s - CTX)) * D;
    float v[16]; load_row_f32(src, lane, v);
    store_row_f32(xrow_ptr(p, t), lane, v);
    const float* ad = ada_ptr(p, 0, t);
    norm_mod_store(v, p.norm_g, ad + 1024, ad, p.h + (size_t)t * D, lane);
  }
}
DEV void phase_norm2(const Params& p, int layer) {
  const int lane = TIDX & 63, gw = BIDX * (NTHR / 64) + (TIDX >> 6), nw = gridDim.x * (NTHR / 64);
  for (int t = gw; t < T; t += nw) {
    float v[16]; load_row_f32(xrow_ptr(p, t), lane, v);
    const float* ad = ada_ptr(p, layer, t);
    norm_mod_store(v, p.norm_g + (layer * 2 + 1) * D, ad + 4096, ad + 3072, p.h + (size_t)t * D, lane);
  }
}

template <class Epi>
DEV void gemm_naive(const bf16_t* A, int lda, const bf16_t* Bt, int ldb, int M, int N, int K, const Epi& epi, float* lds) {
  float* As = lds;
  float* Bs = lds + 16 * 132;
  const int tid = TIDX, ty = tid >> 5, tx = tid & 31, nM = M / 128, nN = N / 128;
  const int lrow = tid >> 2, lkq = tid & 3;
  for (int tile = BIDX; tile < nM * nN; tile += gridDim.x) {
    const int pm = tile / nN, pn = tile - pm * nN;
    float acc[8][4];
#pragma unroll
    for (int i = 0; i < 8; ++i)
#pragma unroll
      for (int j = 0; j < 4; ++j) acc[i][j] = 0.f;
    const bf16_t* ap = A + (size_t)(pm * 128 + lrow) * lda + lkq * 4;
    const bf16_t* bp = Bt + (size_t)(pn * 128 + lrow) * ldb + lkq * 4;
    for (int k0 = 0; k0 < K; k0 += 16) {
      const uint2 av = *(const uint2*)(ap + k0), bv = *(const uint2*)(bp + k0);
      __syncthreads();
      As[(lkq * 4 + 0) * 132 + lrow] = __uint_as_float(av.x << 16); As[(lkq * 4 + 1) * 132 + lrow] = __uint_as_float(av.x & 0xffff0000u);
      As[(lkq * 4 + 2) * 132 + lrow] = __uint_as_float(av.y << 16); As[(lkq * 4 + 3) * 132 + lrow] = __uint_as_float(av.y & 0xffff0000u);
      Bs[(lkq * 4 + 0) * 132 + lrow] = __uint_as_float(bv.x << 16); Bs[(lkq * 4 + 1) * 132 + lrow] = __uint_as_float(bv.x & 0xffff0000u);
      Bs[(lkq * 4 + 2) * 132 + lrow] = __uint_as_float(bv.y << 16); Bs[(lkq * 4 + 3) * 132 + lrow] = __uint_as_float(bv.y & 0xffff0000u);
      __syncthreads();
#pragma unroll 2
      for (int kk = 0; kk < 16; ++kk) {
        const float4 a0 = *(const float4*)(As + kk * 132 + ty * 8), a1 = *(const float4*)(As + kk * 132 + ty * 8 + 4), b0 = *(const float4*)(Bs + kk * 132 + tx * 4);
        const float a[8] = {a0.x, a0.y, a0.z, a0.w, a1.x, a1.y, a1.z, a1.w}, b[4] = {b0.x, b0.y, b0.z, b0.w};
#pragma unroll
        for (int i = 0; i < 8; ++i)
#pragma unroll
          for (int j = 0; j < 4; ++j) acc[i][j] += a[i] * b[j];
      }
    }
#pragma unroll
    for (int i = 0; i < 8; ++i)
#pragma unroll
      for (int j = 0; j < 4; ++j) epi(pm * 128 + ty * 8 + i, pn * 128 + tx * 4 + j, acc[i][j]);
  }
}


#define LAS __attribute__((address_space(3)))
typedef short bf16x8 __attribute__((ext_vector_type(8)));
typedef float f32x4 __attribute__((ext_vector_type(4)));
DEV int lds_byte2(int r, int c) { const int st = (r >> 4) * 2 + (c >> 5), ob = (r & 15) * 64 + (c & 31) * 2; return st * 1024 + (ob ^ (((ob >> 9) & 1) << 5)); }
DEV void stage_rc2(int b, int& R, int& C) { const int st = b >> 10, sb = b & 1023, swz = sb ^ (((sb >> 9) & 1) << 5); R = (st >> 1) * 16 + (swz >> 6); C = (st & 1) * 32 + ((swz & 63) >> 1); }

template <int BM, class Epi>
DEV void gemm_mfma(const bf16_t* A, int lda, const bf16_t* Bt, int ldb, int M, int N, int K, const Epi& epi, LAS char* shm) {
  constexpr int MF = BM / 32, TA = BM * 128, TB = 256 * 128, STG = TA + TB, GA = TA / 8192, GB = TB / 8192;
  const int tid = TIDX, wid = __builtin_amdgcn_readfirstlane(tid >> 6), lane = tid & 63, wr = wid >> 2, wc = wid & 3, fr = lane & 15, fq = lane >> 4;
  int offA[GB], offB[GB];
#pragma unroll
  for (int i = 0; i < GB; ++i) { int R, C; stage_rc2(wid * 1024 + i * 8192 + lane * 16, R, C); offA[i] = R * lda + C; offB[i] = R * ldb + C; }
  const int nM = M / BM, nN = N / 256, ntile = nM * nN, nt = K / 64;
  const int G = gridDim.x, bid = BIDX, vb = (bid & 7) * (G >> 3) + (bid >> 3);
  int aoff[MF], boff[4];
#pragma unroll
  for (int m = 0; m < MF; ++m) aoff[m] = lds_byte2(wr * (BM / 2) + m * 16 + fr, fq * 8);
#pragma unroll
  for (int n = 0; n < 4; ++n) boff[n] = TA + lds_byte2(wc * 64 + n * 16 + fr, fq * 8);
  for (int tile = vb; tile < ntile; tile += G) {
    const int pm = tile / nN, pn = tile - pm * nN;
    const bf16_t* Ab = A + (size_t)pm * BM * lda; const bf16_t* Bb = Bt + (size_t)pn * 256 * ldb;
    f32x4 acc[MF][4];
#pragma unroll
    for (int m = 0; m < MF; ++m)
#pragma unroll
      for (int n = 0; n < 4; ++n) acc[m][n] = (f32x4){0.f, 0.f, 0.f, 0.f};
#define GSTAGE(buf, kt) do { _Pragma("unroll") for (int i = 0; i < GB; ++i) { \
      if (i < GA) __builtin_amdgcn_global_load_lds((const unsigned*)(Ab + offA[i] + (kt) * 64), (LAS unsigned*)(shm + (buf) * STG + wid * 1024 + i * 8192), 16, 0, 0); \
      __builtin_amdgcn_global_load_lds((const unsigned*)(Bb + offB[i] + (kt) * 64), (LAS unsigned*)(shm + (buf) * STG + TA + wid * 1024 + i * 8192), 16, 0, 0); } } while (0)
    GSTAGE(0, 0);
    asm volatile("s_waitcnt vmcnt(0)" ::: "memory"); __syncthreads();
    for (int t = 0; t < nt; ++t) {
      const int cur = t & 1;
      if (t + 1 < nt) GSTAGE(cur ^ 1, t + 1);
#pragma unroll
      for (int ks = 0; ks < 2; ++ks) {
        bf16x8 At[MF], Bf[4];
#pragma unroll
        for (int m = 0; m < MF; ++m) At[m] = *(const LAS bf16x8*)(shm + cur * STG + (aoff[m] ^ 0) + ks * 1024);
#pragma unroll
        for (int n = 0; n < 4; ++n) Bf[n] = *(const LAS bf16x8*)(shm + cur * STG + boff[n] + ks * 1024);
#pragma unroll
        for (int m = 0; m < MF; ++m)
#pragma unroll
          for (int n = 0; n < 4; ++n) acc[m][n] = __builtin_amdgcn_mfma_f32_16x16x32_bf16(At[m], Bf[n], acc[m][n], 0, 0, 0);
      }
      asm volatile("s_waitcnt vmcnt(0)" ::: "memory"); __syncthreads();
    }
#undef GSTAGE
    const int row0 = pm * BM + wr * (BM / 2) + fq * 4, col0 = pn * 256 + wc * 64 + fr;
#pragma unroll
    for (int m = 0; m < MF; ++m)
#pragma unroll
      for (int n = 0; n < 4; ++n)
#pragma unroll
        for (int j = 0; j < 4; ++j) epi(row0 + m * 16 + j, col0 + n * 16, acc[m][n][j]);
  }
}

struct EpiStoreBf16 { bf16_t* C; int ldc; int ncols; DEV void operator()(int r, int c, float v) const { if (c < ncols) C[(size_t)r * ldc + c] = f2bf(v); } };
struct EpiStoreF32 { float* C; int ldc; DEV void operator()(int r, int c, float v) const { C[(size_t)r * ldc + c] = v; } };
struct EpiQ { bf16_t* QF; DEV void operator()(int r, int c, float v) const { int b = r / SP, s = r - b * SP, h = c / 96, d = c - h * 96; QF[((size_t)(b * 16 + h) * SP + s) * 96 + d] = f2bf(v); } };
struct EpiKV { bf16_t* KF; bf16_t* VF; DEV void operator()(int r, int c, float v) const { int b = r / SP, s = r - b * SP, h = c >> 7, d = c & 127;
    if (d < 64) KF[((size_t)(b * 16 + h) * SP + s) * 96 + d] = f2bf(v); else VF[((size_t)(b * 16 + h) * SP + s) * 64 + d - 64] = f2bf(v); } };
struct EpiRes { float* xc; float* out; const float* ada; int layer; int goff; bool last;
  DEV void operator()(int r, int c, float v) const { int b = r / SP, s = r - b * SP;
    if (s < CTX) { if (last) return; xc[((size_t)(b * CTX + s)) * D + c] += ada[((size_t)(layer * 17 + 16)) * 6144 + goff + c] * v; }
    else out[((size_t)(b * SEQ + s - CTX)) * D + c] += ada[((size_t)(layer * 17 + b)) * 6144 + goff + c] * v; } };
struct EpiGla { bf16_t* QKVG; float* LG; const float* gkb;
  DEV void operator()(int r, int c, float v) const {
    if (c < 3072) { if (c < 512) v *= 0.08838834764831845f; QKVG[(size_t)r * 3072 + c] = f2bf(v); }
    else { int d = (c - 3072) >> 9, n = (c - 3072) & 511; float z = v + gkb[d * 512 + n];
      float ls = fminf(z, 0.f) - log1pf(__expf(-fabsf(z)));
      LG[((size_t)d * T + r) * 512 + n] = ls * (1.0f / 16.0f); } } };

DEV void phase_mla_norm(const Params& p, int j) {
  const bf16_t* A1 = (const bf16_t*)(p.scratch + OFF_A1); bf16_t* CQN = (bf16_t*)(p.scratch + OFF_CQN); bf16_t* CKVN = (bf16_t*)(p.scratch + OFF_CKVN); bf16_t* KF = (bf16_t*)(p.scratch + OFF_KF);
  const int lane = TIDX & 63, gw = BIDX * (NTHR / 64) + (TIDX >> 6), nw = gridDim.x * (NTHR / 64);
  const float* qn = p.mla_q_norm + j * 384; const float* kn = p.mla_kv_norm + j * 256;
  for (int t = gw; t < T; t += nw) {
    const bf16_t* a = A1 + (size_t)t * 768;
    float v[6], ss = 0.f;
#pragma unroll
    for (int i = 0; i < 6; ++i) { v[i] = bf2f(a[lane + 64 * i]); ss += v[i] * v[i]; }
    ss = wave_sum(ss); float rstd = rsqrtf(ss * (1.0f / 384.0f) + 1e-6f);
#pragma unroll
    for (int i = 0; i < 6; ++i) CQN[(size_t)t * 384 + lane + 64 * i] = f2bf(v[i] * rstd * qn[lane + 64 * i]);
    float w[4]; ss = 0.f;
#pragma unroll
    for (int i = 0; i < 4; ++i) { w[i] = bf2f(a[384 + lane + 64 * i]); ss += w[i] * w[i]; }
    ss = wave_sum(ss); rstd = rsqrtf(ss * (1.0f / 256.0f) + 1e-6f);
#pragma unroll
    for (int i = 0; i < 4; ++i) CKVN[(size_t)t * 256 + lane + 64 * i] = f2bf(w[i] * rstd * kn[lane + 64 * i]);
    const int b = t / SP, s = t - b * SP;
    float val = bf2f(a[640 + (lane & 31)]);
    const float other = __shfl_xor(val, 8);
    if (s >= CTX) { const int pos = s - CTX, d = lane & 31, hb = d >> 4, dd = d & 15, i = dd & 7;
      const float cs = p.rope[pos * 32 + hb * 16 + i], sn = p.rope[pos * 32 + hb * 16 + 8 + i];
      val = dd < 8 ? val * cs - other * sn : val * cs + other * sn; }
    if (lane < 32) { const bf16_t o = f2bf(val);
      for (int hh = 0; hh < 16; ++hh) KF[((size_t)(b * 16 + hh) * SP + s) * 96 + 64 + lane] = o; }
  }
}

DEV void phase_attn_naive(const Params& p, bool last, float* lds) {
  const bf16_t* QF = (const bf16_t*)(p.scratch + OFF_QF); const bf16_t* KF = (const bf16_t*)(p.scratch + OFF_KF); const bf16_t* VF = (const bf16_t*)(p.scratch + OFF_VF);
  bf16_t* O = (bf16_t*)(p.scratch + OFF_O);
  float* Ks = lds;
  float* Vs = lds + 32 * 96;
  const int tid = TIDX;
  const int nitems = 1024 + (last ? 0 : 256);
  for (int item = BIDX; item < nitems; item += gridDim.x) {
    int b, hh, q0, nq, nkeys;
    if (item < 1024) { b = item >> 6; hh = (item >> 2) & 15; q0 = CTX + (item & 3) * 512; nq = 512; nkeys = SP; }
    else { const int it = item - 1024; b = it >> 4; hh = it & 15; q0 = 0; nq = 256; nkeys = CTX; }
    const size_t bh = (size_t)(b * 16 + hh) * SP;
    const bool active = tid < nq;
    const int sq = q0 + (active ? tid : 0);
    float q[96];
    { const bf16_t* qp = QF + (bh + sq) * 96;
#pragma unroll
      for (int i = 0; i < 96; i += 2) { const unsigned u = *(const unsigned*)(qp + i); q[i] = __uint_as_float(u << 16); q[i + 1] = __uint_as_float(u & 0xffff0000u); } }
    if (sq >= CTX) { const float* r = p.rope + (sq - CTX) * 32;
#pragma unroll
      for (int hb = 0; hb < 2; ++hb)
#pragma unroll
        for (int i = 0; i < 8; ++i) { const float cs = r[hb * 16 + i], sn = r[hb * 16 + 8 + i], x1 = q[64 + hb * 16 + i], x2 = q[64 + hb * 16 + 8 + i];
          q[64 + hb * 16 + i] = x1 * cs - x2 * sn; q[64 + hb * 16 + 8 + i] = x2 * cs + x1 * sn; } }
#pragma unroll
    for (int i = 0; i < 96; ++i) q[i] *= 0.10206207261596577f;
    float acc[64], m = -1e30f, l = 0.f;
#pragma unroll
    for (int i = 0; i < 64; ++i) acc[i] = 0.f;
    for (int k0 = 0; k0 < nkeys; k0 += 32) {
      __syncthreads();
      for (int idx = tid; idx < 32 * 96 / 2; idx += NTHR) { const unsigned u = *(const unsigned*)(KF + (bh + k0) * 96 + idx * 2); Ks[idx * 2] = __uint_as_float(u << 16); Ks[idx * 2 + 1] = __uint_as_float(u & 0xffff0000u); }
      for (int idx = tid; idx < 32 * 64 / 2; idx += NTHR) { const unsigned u = *(const unsigned*)(VF + (bh + k0) * 64 + idx * 2); Vs[idx * 2] = __uint_as_float(u << 16); Vs[idx * 2 + 1] = __uint_as_float(u & 0xffff0000u); }
      __syncthreads();
#pragma unroll 1
      for (int kk = 0; kk < 32; ++kk) {
        float s = 0.f;
#pragma unroll
        for (int i = 0; i < 96; i += 4) { const float4 kv = *(const float4*)(Ks + kk * 96 + i); s += q[i] * kv.x + q[i + 1] * kv.y + q[i + 2] * kv.z + q[i + 3] * kv.w; }
        if (s > m) { const float corr = __expf(m - s); l *= corr;
#pragma unroll
          for (int i = 0; i < 64; ++i) acc[i] *= corr;
          m = s; }
        const float pe = __expf(s - m); l += pe;
#pragma unroll
        for (int i = 0; i < 64; i += 4) { const float4 vv = *(const float4*)(Vs + kk * 64 + i); acc[i] += pe * vv.x; acc[i + 1] += pe * vv.y; acc[i + 2] += pe * vv.z; acc[i + 3] += pe * vv.w; }
      }
    }
    if (active) { const float inv = 1.f / l; bf16_t* op = O + ((size_t)(b * SP + sq)) * D + hh * 64;
#pragma unroll
      for (int i = 0; i < 64; i += 2) *(unsigned*)(op + i) = (unsigned)f2bf(acc[i] * inv) | ((unsigned)f2bf(acc[i + 1] * inv) << 16); }
  }
}

#define INSERT16(val, pay, tv, ti) { float s_ = (val); int i_ = (pay); _Pragma("unroll") for (int j_ = 0; j_ < 16; ++j_) { if (s_ > tv[j_]) { float t_ = tv[j_]; tv[j_] = s_; s_ = t_; int u_ = ti[j_]; ti[j_] = i_; i_ = u_; } } }

DEV void phase_peer_subtopk(const Params& p, int layer, float* lds) {
  const float* PQ = (const float*)(p.scratch + OFF_PQ); float* SV = (float*)(p.scratch + OFF_SV); int* SI = (int*)(p.scratch + OFF_SI);
  const int tid = TIDX;
  for (int item = BIDX; item < 16 * 72; item += gridDim.x) {
    const int hp = item / 72, tb = item - hp * 72, t = tb * 512 + tid;
    __syncthreads();
    const float* kp = p.peer_keys + ((size_t)(layer * 16 + hp)) * 128 * 64;
    for (int idx = tid; idx < 128 * 64 / 4; idx += NTHR) *(float4*)(lds + idx * 4) = *(const float4*)(kp + idx * 4);
    __syncthreads();
    float q[64];
#pragma unroll
    for (int i = 0; i < 64; i += 4) { const float4 v = *(const float4*)(PQ + (size_t)t * 1024 + hp * 64 + i); q[i] = v.x; q[i + 1] = v.y; q[i + 2] = v.z; q[i + 3] = v.w; }
    float tv[16]; int ti[16];
#pragma unroll
    for (int j = 0; j < 16; ++j) { tv[j] = -3.0e38f; ti[j] = 0; }
#pragma unroll 1
    for (int key = 0; key < 128; ++key) {
      float s = 0.f;
#pragma unroll
      for (int i = 0; i < 64; i += 4) { const float4 kv = *(const float4*)(lds + key * 64 + i); s += q[i] * kv.x + q[i + 1] * kv.y + q[i + 2] * kv.z + q[i + 3] * kv.w; }
      INSERT16(s, key, tv, ti);
    }
#pragma unroll
    for (int j = 0; j < 16; ++j) { SV[((size_t)t * 16 + hp) * 16 + j] = tv[j]; SI[((size_t)t * 16 + hp) * 16 + j] = ti[j]; }
  }
}

DEV void phase_peer_final_topk(const Params& p) {
  const float* SV = (const float*)(p.scratch + OFF_SV); const int* SI = (const int*)(p.scratch + OFF_SI);
  int* EID = (int*)(p.scratch + OFF_EID); float* GATE = (float*)(p.scratch + OFF_GATE);
  for (int idx = BIDX * NTHR + TIDX; idx < T * 8; idx += gridDim.x * NTHR) {
    float a[16], bq[16]; int ia[16], ib[16];
#pragma unroll
    for (int j = 0; j < 16; ++j) { a[j] = SV[(size_t)idx * 32 + j]; ia[j] = SI[(size_t)idx * 32 + j]; bq[j] = SV[(size_t)idx * 32 + 16 + j]; ib[j] = SI[(size_t)idx * 32 + 16 + j]; }
    float tv[16]; int ti[16];
#pragma unroll
    for (int j = 0; j < 16; ++j) { tv[j] = -3.0e38f; ti[j] = 0; }
#pragma unroll
    for (int i0 = 0; i0 < 16; ++i0)
#pragma unroll
      for (int i1 = 0; i1 < 16; ++i1)
        if ((i0 + 1) * (i1 + 1) <= 16) INSERT16(a[i0] + bq[i1], ia[i0] * 128 + ib[i1], tv, ti);
    float e[16], sum = 0.f;
#pragma unroll
    for (int j = 0; j < 16; ++j) { e[j] = __expf(tv[j] - tv[0]); sum += e[j]; }
    const float inv = 1.f / sum;
#pragma unroll
    for (int j = 0; j < 16; ++j) { EID[(size_t)idx * 16 + j] = ti[j]; GATE[(size_t)idx * 16 + j] = e[j] * inv; }
  }
}

DEV void phase_peer_gather(const Params& p, int layer) {
  const int* EID = (const int*)(p.scratch + OFF_EID); const float* GATE = (const float*)(p.scratch + OFF_GATE);
  const int lane = TIDX & 63, gw = BIDX * (NTHR / 64) + (TIDX >> 6), nw = gridDim.x * (NTHR / 64);
  const bool last = layer == 3;
  const float* U = p.peer_u + (size_t)layer * 16384 * 1024; const float* V = p.peer_v + (size_t)layer * 16384 * 1024;
  for (int t = gw; t < T; t += nw) {
    const int b = t / SP, s = t - b * SP;
    if (last && s < CTX) continue;
    float x[16];
    { const bf16_t* hr = p.h + (size_t)t * D;
#pragma unroll
      for (int j = 0; j < 4; ++j) { const uint2 w = *(const uint2*)(hr + j * 256 + lane * 4); x[j * 4] = __uint_as_float(w.x << 16); x[j * 4 + 1] = __uint_as_float(w.x & 0xffff0000u); x[j * 4 + 2] = __uint_as_float(w.y << 16); x[j * 4 + 3] = __uint_as_float(w.y & 0xffff0000u); } }
    float f[16];
#pragma unroll
    for (int i = 0; i < 16; ++i) f[i] = 0.f;
#pragma unroll 2
    for (int e = 0; e < 128; ++e) {
      const int eid = EID[(size_t)t * 128 + e]; const float gate = GATE[(size_t)t * 128 + e];
      const float* ur = U + (size_t)eid * 1024; const float* vr = V + (size_t)eid * 1024;
      float4 uu[4], vv[4];
#pragma unroll
      for (int j = 0; j < 4; ++j) { uu[j] = *(const float4*)(ur + j * 256 + lane * 4); vv[j] = *(const float4*)(vr + j * 256 + lane * 4); }
      float dsum = 0.f;
#pragma unroll
      for (int j = 0; j < 4; ++j) dsum += uu[j].x * x[j * 4] + uu[j].y * x[j * 4 + 1] + uu[j].z * x[j * 4 + 2] + uu[j].w * x[j * 4 + 3];
      dsum = wave_sum(dsum);
      const float w = gate * gelu_tanh(dsum);
#pragma unroll
      for (int j = 0; j < 4; ++j) { f[j * 4] += w * vv[j].x; f[j * 4 + 1] += w * vv[j].y; f[j * 4 + 2] += w * vv[j].z; f[j * 4 + 3] += w * vv[j].w; }
    }
    float* xr = xrow_ptr(p, t);
    float xv[16]; load_row_f32(xr, lane, xv);
    const float* ad = ada_ptr(p, layer, t);
#pragma unroll
    for (int j = 0; j < 4; ++j) { const float4 g2 = *(const float4*)(ad + 5120 + j * 256 + lane * 4);
      xv[j * 4] += g2.x * f[j * 4]; xv[j * 4 + 1] += g2.y * f[j * 4 + 1]; xv[j * 4 + 2] += g2.z * f[j * 4 + 2]; xv[j * 4 + 3] += g2.w * f[j * 4 + 3]; }
    if (!last) {
      store_row_f32(xr, lane, xv);
      const float* ad2 = ada_ptr(p, layer + 1, t);
      norm_mod_store(xv, p.norm_g + ((layer + 1) * 2) * D, ad2 + 1024, ad2, p.h + (size_t)t * D, lane);
    } else {
      float ss = 0.f;
#pragma unroll
      for (int i = 0; i < 16; ++i) ss += xv[i] * xv[i];
      ss = wave_sum(ss); const float rstd = rsqrtf(ss * (1.0f / D) + 1e-6f);
#pragma unroll
      for (int j = 0; j < 4; ++j) { const float4 g = *(const float4*)(p.final_g + j * 256 + lane * 4);
        xv[j * 4] *= rstd * g.x; xv[j * 4 + 1] *= rstd * g.y; xv[j * 4 + 2] *= rstd * g.z; xv[j * 4 + 3] *= rstd * g.w; }
      store_row_f32(xr, lane, xv);
    }
  }
}

DEV int seq_of_tau(int tau, int d) { return d == 0 ? tau : (tau < CTX ? CTX - 1 - tau : 2 * CTX + SEQ - 1 - tau); }

DEV void phase_s5_scan(const Params& p, float* lds) {
  float* Y = (float*)(p.scratch + OFF_Y); bf16_t* GIN = (bf16_t*)(p.scratch + OFF_GIN);
  const int tid = TIDX, wid = tid >> 6, lane = tid & 63;
  float* ub = lds + wid * 2048;
  float* yb = ub + 1024;
  for (int item0 = BIDX * 8; item0 < 1024; item0 += gridDim.x * 8) {
    const int item = item0 + wid, b = item >> 6, g = item & 63;
    for (int d = 0; d < 2; ++d) {
      const int sidx = (d * 64 + g) * 64 + lane;
      const float ar = p.s5_ar[sidx], ai = p.s5_ai[sidx];
      float br[16], bi[16], cr[16], ci[16];
#pragma unroll
      for (int c = 0; c < 16; ++c) { br[c] = p.s5_br[sidx * 16 + c]; bi[c] = p.s5_bi[sidx * 16 + c];
        cr[c] = p.s5_c_re[((size_t)(d * 64 + g) * 16 + c) * 64 + lane]; ci[c] = p.s5_c_im[((size_t)(d * 64 + g) * 16 + c) * 64 + lane]; }
      float xr = 0.f, xi = 0.f;
      for (int k = 0; k < 36; ++k) {
        const int trow = b * SP + seq_of_tau(k * 64 + lane, d);
        __syncthreads();
        { const bf16_t* hp = p.h + (size_t)trow * D + g * 16;
          const uint4 w0 = *(const uint4*)hp, w1 = *(const uint4*)(hp + 8);
          const unsigned ww[8] = {w0.x, w0.y, w0.z, w0.w, w1.x, w1.y, w1.z, w1.w};
#pragma unroll
          for (int i = 0; i < 8; ++i) { ub[lane * 16 + 2 * i] = __uint_as_float(ww[i] << 16); ub[lane * 16 + 2 * i + 1] = __uint_as_float(ww[i] & 0xffff0000u); } }
        __syncthreads();
#pragma unroll 1
        for (int j = 0; j < 64; ++j) {
          float u[16];
#pragma unroll
          for (int c = 0; c < 16; c += 4) { const float4 t4 = *(const float4*)(ub + j * 16 + c); u[c] = t4.x; u[c + 1] = t4.y; u[c + 2] = t4.z; u[c + 3] = t4.w; }
          float bur = 0.f, bui = 0.f;
#pragma unroll
          for (int c = 0; c < 16; ++c) { bur += br[c] * u[c]; bui += bi[c] * u[c]; }
          const float nxr = ar * xr - ai * xi + bur, nxi = ar * xi + ai * xr + bui;
          xr = nxr; xi = nxi;
          float v[16];
#pragma unroll
          for (int c = 0; c < 16; ++c) v[c] = cr[c] * xr - ci[c] * xi;
#pragma unroll
          for (int i = 0; i < 8; ++i) { const bool hi = lane & 32; const float send = hi ? v[i] : v[i + 8], keep = hi ? v[i + 8] : v[i]; v[i] = keep + __shfl_xor(send, 32); }
#pragma unroll
          for (int i = 0; i < 4; ++i) { const bool hi = lane & 16; const float send = hi ? v[i] : v[i + 4], keep = hi ? v[i + 4] : v[i]; v[i] = keep + __shfl_xor(send, 16); }
#pragma unroll
          for (int i = 0; i < 2; ++i) { const bool hi = lane & 8; const float send = hi ? v[i] : v[i + 2], keep = hi ? v[i + 2] : v[i]; v[i] = keep + __shfl_xor(send, 8); }
          { const bool hi = lane & 4; const float send = hi ? v[0] : v[1], keep = hi ? v[1] : v[0]; v[0] = keep + __shfl_xor(send, 4); }
          v[0] += __shfl_xor(v[0], 2); v[0] += __shfl_xor(v[0], 1);
          if ((lane & 3) == 0) yb[j * 16 + (lane >> 2)] = v[0];
        }
        __syncthreads();
        if (d == 0) {
#pragma unroll
          for (int c = 0; c < 16; c += 4) *(float4*)(Y + (size_t)trow * D + g * 16 + c) = *(const float4*)(yb + lane * 16 + c);
        } else {
          unsigned ow[8];
#pragma unroll
          for (int c = 0; c < 16; c += 2) {
            const float y0 = Y[(size_t)trow * D + g * 16 + c] + yb[lane * 16 + c] + p.s5_d[g * 16 + c] * ub[lane * 16 + c];
            const float y1 = Y[(size_t)trow * D + g * 16 + c + 1] + yb[lane * 16 + c + 1] + p.s5_d[g * 16 + c + 1] * ub[lane * 16 + c + 1];
            ow[c >> 1] = (unsigned)f2bf(gelu_tanh(y0)) | ((unsigned)f2bf(gelu_tanh(y1)) << 16);
          }
          *(uint4*)(GIN + (size_t)trow * D + g * 16) = make_uint4(ow[0], ow[1], ow[2], ow[3]);
          *(uint4*)(GIN + (size_t)trow * D + g * 16 + 8) = make_uint4(ow[4], ow[5], ow[6], ow[7]);
        }
      }
    }
  }
}

DEV void phase_s5_out(const Params& p, int layer) {
  const bf16_t* Z = (const bf16_t*)(p.scratch + OFF_Z);
  const int lane = TIDX & 63, gw = BIDX * (NTHR / 64) + (TIDX >> 6), nw = gridDim.x * (NTHR / 64);
  for (int t = gw; t < T; t += nw) {
    float* xr = xrow_ptr(p, t); float xv[16]; load_row_f32(xr, lane, xv);
    const float* ad = ada_ptr(p, layer, t);
#pragma unroll
    for (int j = 0; j < 4; ++j) { const int c0 = j * 256 + lane * 4;
      const uint2 za = *(const uint2*)(Z + (size_t)t * 2048 + c0), zg = *(const uint2*)(Z + (size_t)t * 2048 + 1024 + c0);
      const float a[4] = {__uint_as_float(za.x << 16), __uint_as_float(za.x & 0xffff0000u), __uint_as_float(za.y << 16), __uint_as_float(za.y & 0xffff0000u)};
      const float gg[4] = {__uint_as_float(zg.x << 16), __uint_as_float(zg.x & 0xffff0000u), __uint_as_float(zg.y << 16), __uint_as_float(zg.y & 0xffff0000u)};
      const float4 g1 = *(const float4*)(ad + 2048 + c0); const float g1a[4] = {g1.x, g1.y, g1.z, g1.w};
#pragma unroll
      for (int e = 0; e < 4; ++e) xv[j * 4 + e] += g1a[e] * a[e] * sigm(gg[e]); }
    store_row_f32(xr, lane, xv);
    norm_mod_store(xv, p.norm_g + (layer * 2 + 1) * D, ad + 4096, ad + 3072, p.h + (size_t)t * D, lane);
  }
}

DEV void phase_gla_scan(const Params& p, float* lds) {
  const bf16_t* QKVG = (const bf16_t*)(p.scratch + OFF_QKVG); const float* LG = (const float*)(p.scratch + OFF_LG); bf16_t* OD = (bf16_t*)(p.scratch + OFF_OD);
  float* qs = lds; float* ks = lds + 16 * 128; float* es = lds + 32 * 128; float* vs = lds + 48 * 128; float* op = vs + 16 * 256;
  const int tid = TIDX, col = tid & 255, kh = tid >> 8;
  for (int item = BIDX; item < 128; item += gridDim.x) {
    const int b = item >> 3, hd = (item >> 1) & 3, d = item & 1;
    float S[64];
#pragma unroll
    for (int i = 0; i < 64; ++i) S[i] = 0.f;
    for (int st = 0; st < SP / 16; ++st) {
      __syncthreads();
      for (int idx = tid; idx < 16 * 128; idx += NTHR) { const int j = idx >> 7, k = idx & 127; const size_t trow = (size_t)b * SP + seq_of_tau(st * 16 + j, d);
        qs[idx] = bf2f(QKVG[trow * 3072 + hd * 128 + k]); ks[idx] = bf2f(QKVG[trow * 3072 + 512 + hd * 128 + k]); es[idx] = __expf(LG[((size_t)d * T + trow) * 512 + hd * 128 + k]); }
      for (int idx = tid; idx < 16 * 256; idx += NTHR) { const int j = idx >> 8, c = idx & 255; const size_t trow = (size_t)b * SP + seq_of_tau(st * 16 + j, d);
        vs[idx] = bf2f(QKVG[trow * 3072 + 1024 + hd * 256 + c]); }
      __syncthreads();
#pragma unroll 1
      for (int j = 0; j < 16; ++j) {
        const float vv = vs[j * 256 + col]; float acc = 0.f;
#pragma unroll
        for (int kk = 0; kk < 64; kk += 4) {
          const float4 e4 = *(const float4*)(es + j * 128 + kh * 64 + kk), k4 = *(const float4*)(ks + j * 128 + kh * 64 + kk), q4 = *(const float4*)(qs + j * 128 + kh * 64 + kk);
          S[kk] = e4.x * S[kk] + k4.x * vv; acc += q4.x * S[kk];
          S[kk + 1] = e4.y * S[kk + 1] + k4.y * vv; acc += q4.y * S[kk + 1];
          S[kk + 2] = e4.z * S[kk + 2] + k4.z * vv; acc += q4.z * S[kk + 2];
          S[kk + 3] = e4.w * S[kk + 3] + k4.w * vv; acc += q4.w * S[kk + 3];
        }
        op[kh * 16 * 256 + j * 256 + col] = acc;
      }
      __syncthreads();
      for (int idx = tid; idx < 16 * 256; idx += NTHR) { const int j = idx >> 8, c = idx & 255; const size_t trow = (size_t)b * SP + seq_of_tau(st * 16 + j, d);
        OD[((size_t)d * T + trow) * D + hd * 256 + c] = f2bf(op[idx] + op[16 * 256 + idx]); }
    }
  }
}

DEV void phase_gla_out(const Params& p) {
  const bf16_t* QKVG = (const bf16_t*)(p.scratch + OFF_QKVG); const bf16_t* OD = (const bf16_t*)(p.scratch + OFF_OD); bf16_t* GO = (bf16_t*)(p.scratch + OFF_GO);
  const int lane = TIDX & 63, gw = BIDX * (NTHR / 64) + (TIDX >> 6), nw = gridDim.x * (NTHR / 64);
  for (int t = gw; t < T; t += nw) {
#pragma unroll
    for (int hd = 0; hd < 4; ++hd) {
      const int c0 = hd * 256 + lane * 4;
      const uint2 a = *(const uint2*)(OD + (size_t)t * D + c0), bq = *(const uint2*)(OD + ((size_t)T + t) * D + c0), gg = *(const uint2*)(QKVG + (size_t)t * 3072 + 2048 + c0);
      float o[4] = {__uint_as_float(a.x << 16) + __uint_as_float(bq.x << 16), __uint_as_float(a.x & 0xffff0000u) + __uint_as_float(bq.x & 0xffff0000u),
                    __uint_as_float(a.y << 16) + __uint_as_float(bq.y << 16), __uint_as_float(a.y & 0xffff0000u) + __uint_as_float(bq.y & 0xffff0000u)};
      const float gv[4] = {__uint_as_float(gg.x << 16), __uint_as_float(gg.x & 0xffff0000u), __uint_as_float(gg.y << 16), __uint_as_float(gg.y & 0xffff0000u)};
      float ss = o[0] * o[0] + o[1] * o[1] + o[2] * o[2] + o[3] * o[3];
      ss = wave_sum(ss); const float rstd = rsqrtf(ss * (1.0f / 256.0f) + 1e-6f);
      const float4 on = *(const float4*)(p.gla_o_norm + lane * 4); const float ona[4] = {on.x, on.y, on.z, on.w};
      unsigned w[2];
#pragma unroll
      for (int e = 0; e < 4; e += 2) w[e >> 1] = (unsigned)f2bf(o[e] * rstd * ona[e] * silu(gv[e])) | ((unsigned)f2bf(o[e + 1] * rstd * ona[e + 1] * silu(gv[e + 1])) << 16);
      *(uint2*)(GO + (size_t)t * D + c0) = make_uint2(w[0], w[1]);
    }
  }
}

__global__ void __launch_bounds__(NTHR) fwd_megakernel(Params p) {
  cg::grid_group grid = cg::this_grid();
  __shared__ __attribute__((aligned(1024))) char shm_raw[128 * 1024];
  float* lds = (float*)shm_raw; LAS char* shm = (LAS char*)shm_raw;
  phase_prologue(p, lds);
  grid.sync();
  phase_norm1_first(p);
  grid.sync();
  for (int layer = 0; layer < 4; ++layer) {
    const int kind = layer % 3, j = layer / 3; const bool last = layer == 3;
    if (kind == 0) {
      gemm_mfma<128>(p.h, D, p.w_mla_in + (size_t)j * 768 * 1024, 1024, T, 768, 1024, EpiStoreBf16{(bf16_t*)(p.scratch + OFF_A1), 768, 672}, shm);
      grid.sync();
      phase_mla_norm(p, j);
      grid.sync();
      gemm_mfma<128>((const bf16_t*)(p.scratch + OFF_CQN), 384, p.w_uq + (size_t)j * 1536 * 384, 384, T, 1536, 384, EpiQ{(bf16_t*)(p.scratch + OFF_QF)}, shm);
      gemm_mfma<128>((const bf16_t*)(p.scratch + OFF_CKVN), 256, p.w_ukv + (size_t)j * 2048 * 256, 256, T, 2048, 256, EpiKV{(bf16_t*)(p.scratch + OFF_KF), (bf16_t*)(p.scratch + OFF_VF)}, shm);
      grid.sync();
      phase_attn_naive(p, last, lds);
      grid.sync();
      gemm_mfma<128>((const bf16_t*)(p.scratch + OFF_O), D, p.w_mla_o + (size_t)j * 1024 * 1024, 1024, T, 1024, 1024, EpiRes{p.xc, p.out, p.ada, layer, 2048, last}, shm);
      grid.sync();
      phase_norm2(p, layer);
      grid.sync();
    } else if (kind == 1) {
      phase_s5_scan(p, lds);
      grid.sync();
      gemm_mfma<128>((const bf16_t*)(p.scratch + OFF_GIN), D, p.w_glu, 1024, T, 2048, 1024, EpiStoreBf16{(bf16_t*)(p.scratch + OFF_Z), 2048, 2048}, shm);
      grid.sync();
      phase_s5_out(p, layer);
      grid.sync();
    } else {
      gemm_mfma<128>(p.h, D, p.w_gla_in, 1024, T, 4096, 1024, EpiGla{(bf16_t*)(p.scratch + OFF_QKVG), (float*)(p.scratch + OFF_LG), p.gla_gk_b}, shm);
      grid.sync();
      phase_gla_scan(p, lds);
      grid.sync();
      phase_gla_out(p);
      grid.sync();
      gemm_mfma<128>((const bf16_t*)(p.scratch + OFF_GO), D, p.w_gla_o, 1024, T, 1024, 1024, EpiRes{p.xc, p.out, p.ada, layer, 2048, false}, shm);
      grid.sync();
      phase_norm2(p, layer);
      grid.sync();
    }
    gemm_mfma<128>(p.h, D, p.w_pq + (size_t)layer * 1024 * 1024, 1024, T, 1024, 1024, EpiStoreF32{(float*)(p.scratch + OFF_PQ), 1024}, shm);
    grid.sync();
    phase_peer_subtopk(p, layer, lds);
    grid.sync();
    phase_peer_final_topk(p);
    grid.sync();
    phase_peer_gather(p, layer);
    if (layer < 3) grid.sync();
  }
}

extern "C" void kernel_launch(void* const* d_in, const int* in_sizes, int n_in, void* d_out,
                              int out_size, void* d_ws, size_t ws_size, hipStream_t stream) {
  static int grid_blocks = 0;
  if (!grid_blocks) {
    int dev = 0, cus = 0, per_cu = 0;
    (void)hipGetDevice(&dev);
    (void)hipDeviceGetAttribute(&cus, hipDeviceAttributeMultiprocessorCount, dev);
    (void)hipOccupancyMaxActiveBlocksPerMultiprocessor(&per_cu, fwd_megakernel, NTHR, 0);
    if (per_cu > 1) per_cu = 1;
    grid_blocks = cus * per_cu;
  }
  Params p{};
  const float* const* in = (const float* const*)d_in;
  p.x = in[0]; p.c = in[1]; p.ctx = in[2]; p.c_ctx = in[3]; p.norm_g = in[4]; p.ada_w = in[5]; p.ada_b = in[6];
  p.mla_w_in = in[7]; p.mla_q_norm = in[8]; p.mla_w_uq = in[9]; p.mla_kv_norm = in[10]; p.mla_w_ukv = in[11]; p.mla_w_o = in[12];
  p.s5_lam_re = in[13]; p.s5_lam_im = in[14]; p.s5_b_re = in[15]; p.s5_b_im = in[16]; p.s5_c_re = in[17]; p.s5_c_im = in[18]; p.s5_log_step = in[19]; p.s5_d = in[20]; p.s5_w_glu = in[21];
  p.gla_w_in = in[22]; p.gla_gk_w1 = in[23]; p.gla_gk_w2 = in[24]; p.gla_gk_b = in[25]; p.gla_o_norm = in[26]; p.gla_w_o = in[27];
  p.peer_w_q = in[28]; p.peer_keys = in[29]; p.peer_u = in[30]; p.peer_v = in[31]; p.final_g = in[32];
  p.out = (float*)d_out;
  char* w = (char*)d_ws; size_t off = 0;
  auto take = [&](size_t bytes) { char* r = w + off; off += (bytes + 255) & ~(size_t)255; return r; };
  p.xc = (float*)take((size_t)NB * CTX * D * 4);
  p.ada = (float*)take((size_t)4 * 17 * 6144 * 4);
  p.rope = (float*)take((size_t)2048 * 32 * 4);
  p.h = (bf16_t*)take((size_t)T * D * 2);
  p.w_mla_in = (bf16_t*)take((size_t)2 * 768 * 1024 * 2);
  p.w_uq = (bf16_t*)take((size_t)2 * 1536 * 384 * 2);
  p.w_ukv = (bf16_t*)take((size_t)2 * 2048 * 256 * 2);
  p.w_mla_o = (bf16_t*)take((size_t)2 * 1024 * 1024 * 2);
  p.w_glu = (bf16_t*)take((size_t)2048 * 1024 * 2);
  p.w_gla_in = (bf16_t*)take((size_t)4096 * 1024 * 2);
  p.w_gla_o = (bf16_t*)take((size_t)1024 * 1024 * 2);
  p.w_pq = (bf16_t*)take((size_t)4 * 1024 * 1024 * 2);
  p.s5_ar = (float*)take(2 * 64 * 64 * 4); p.s5_ai = (float*)take(2 * 64 * 64 * 4);
  p.s5_br = (float*)take(2 * 64 * 64 * 16 * 4); p.s5_bi = (float*)take(2 * 64 * 64 * 16 * 4);
  p.scratch = take(SCRATCH_BYTES);
  if (off > ws_size) { fprintf(stderr, "workspace too small: need %zu have %zu\n", off, ws_size); return; }
  void* args[] = {&p};
  hipError_t e = hipLaunchCooperativeKernel((void*)fwd_megakernel, dim3(grid_blocks), dim3(NTHR), args, 0, stream);
  if (e != hipSuccess) fprintf(stderr, "cooperative launch failed: %s (grid %d)\n", hipGetErrorString(e), grid_blocks);
}
```

```cpp
#include <hip/hip_runtime.h>
#include <hip/hip_cooperative_groups.h>
#include <cstdio>
#include <cstdint>
namespace cg = cooperative_groups;

typedef unsigned short bf16_t;
#define DEV __device__ __forceinline__

DEV int tid_op() { int t = threadIdx.x; asm volatile("" : "+v"(t)); return t; }
DEV int bid_op() { int t = blockIdx.x; asm volatile("" : "+s"(t)); return t; }
#define TIDX tid_op()
#define BIDX bid_op()
constexpr int D = 1024, NB = 16, SEQ = 2048, CTX = 256, SP = 2304, T = NB * SP;
constexpr int NTHR = 512;

struct Params {
  const float *x, *c, *ctx, *c_ctx, *norm_g, *ada_w, *ada_b;
  const float *mla_w_in, *mla_q_norm, *mla_w_uq, *mla_kv_norm, *mla_w_ukv, *mla_w_o;
  const float *s5_lam_re, *s5_lam_im, *s5_b_re, *s5_b_im, *s5_c_re, *s5_c_im, *s5_log_step, *s5_d, *s5_w_glu;
  const float *gla_w_in, *gla_gk_w1, *gla_gk_w2, *gla_gk_b, *gla_o_norm, *gla_w_o;
  const float *peer_w_q, *peer_keys, *peer_u, *peer_v, *final_g;
  float* out;
  float *xc, *ada, *rope;
  bf16_t* h;
  bf16_t *w_mla_in, *w_uq, *w_ukv, *w_mla_o, *w_glu, *w_gla_in, *w_gla_o, *w_pq;
  float *s5_ar, *s5_ai, *s5_br, *s5_bi;
  char* scratch;
};

constexpr size_t MB = 1ull << 20;
constexpr size_t OFF_A1 = 0;
constexpr size_t OFF_CQN = 54 * MB;
constexpr size_t OFF_CKVN = 81 * MB;
constexpr size_t OFF_QF = 99 * MB;
constexpr size_t OFF_KF = 207 * MB;
constexpr size_t OFF_VF = 315 * MB;
constexpr size_t OFF_O = 387 * MB;
constexpr size_t OFF_Y = 0;
constexpr size_t OFF_GIN = 144 * MB;
constexpr size_t OFF_Z = 216 * MB;
constexpr size_t OFF_QKVG = 0;
constexpr size_t OFF_LG = 216 * MB;
constexpr size_t OFF_OD = 360 * MB;
constexpr size_t OFF_GO = 504 * MB;
constexpr size_t OFF_PQ = 0;
constexpr size_t OFF_SV = 144 * MB;
constexpr size_t OFF_SI = 180 * MB;
constexpr size_t OFF_EID = 216 * MB;
constexpr size_t OFF_GATE = 234 * MB;
constexpr size_t OFF_U8 = 256 * MB;
constexpr size_t OFF_V8 = 272 * MB;
constexpr size_t SCRATCH_BYTES = 576 * MB;

DEV float bf2f(bf16_t v) { return __uint_as_float(((unsigned)v) << 16); }
DEV bf16_t f2bf(float f) { unsigned u = __float_as_uint(f); u += 0x7fffu + ((u >> 16) & 1u); return (bf16_t)(u >> 16); }
DEV float wave_sum(float v) {
#pragma unroll
  for (int o = 32; o > 0; o >>= 1) v += __shfl_xor(v, o);
  return v;
}
DEV float gelu_tanh(float x) { float u = 0.7978845608028654f * (x + 0.044715f * x * x * x); return 0.5f * x * (1.f + tanhf(u)); }
DEV float sigm(float x) { return 1.f / (1.f + __expf(-x)); }
DEV float silu(float x) { return x * sigm(x); }

DEV float* xrow_ptr(const Params& p, int t) {
  int b = t / SP, s = t - b * SP;
  return s < CTX ? p.xc + ((size_t)(b * CTX + s)) * D : p.out + ((size_t)(b * SEQ + s - CTX)) * D;
}
DEV const float* ada_ptr(const Params& p, int layer, int t) {
  int b = t / SP, s = t - b * SP;
  return p.ada + ((size_t)(layer * 17 + (s < CTX ? 16 : b))) * 6144;
}

DEV void load_row_f32(const float* row, int lane, float (&v)[16]) {
#pragma unroll
  for (int j = 0; j < 4; ++j) { float4 t = *(const float4*)(row + j * 256 + lane * 4); v[j * 4] = t.x; v[j * 4 + 1] = t.y; v[j * 4 + 2] = t.z; v[j * 4 + 3] = t.w; }
}
DEV void store_row_f32(float* row, int lane, const float (&v)[16]) {
#pragma unroll
  for (int j = 0; j < 4; ++j) *(float4*)(row + j * 256 + lane * 4) = make_float4(v[j * 4], v[j * 4 + 1], v[j * 4 + 2], v[j * 4 + 3]);
}
DEV void norm_mod_store(const float (&v)[16], const float* g, const float* sc, const float* sh, bf16_t* hrow, int lane) {
  float ss = 0.f;
#pragma unroll
  for (int i = 0; i < 16; ++i) ss += v[i] * v[i];
  ss = wave_sum(ss);
  const float rstd = rsqrtf(ss * (1.0f / D) + 1e-6f);
#pragma unroll
  for (int j = 0; j < 4; ++j) {
    const int c0 = j * 256 + lane * 4;
    float4 gg = *(const float4*)(g + c0), s1 = *(const float4*)(sc + c0), s2 = *(const float4*)(sh + c0);
    float y0 = v[j * 4] * rstd * gg.x * (1.f + s1.x) + s2.x, y1 = v[j * 4 + 1] * rstd * gg.y * (1.f + s1.y) + s2.y;
    float y2 = v[j * 4 + 2] * rstd * gg.z * (1.f + s1.z) + s2.z, y3 = v[j * 4 + 3] * rstd * gg.w * (1.f + s1.w) + s2.w;
    uint2 w; w.x = (unsigned)f2bf(y0) | ((unsigned)f2bf(y1) << 16); w.y = (unsigned)f2bf(y2) | ((unsigned)f2bf(y3) << 16);
    *(uint2*)(hrow + c0) = w;
  }
}

DEV void convT(const float* src, bf16_t* dst, int K, int N, int Npad, int rot, float* lds) {
  const int tk = K / 64, tn = Npad / 64, nt = tk * tn, tid = TIDX;
  for (int tile = (BIDX + rot) % gridDim.x; tile < nt; tile += gridDim.x) {
    const int k0 = (tile % tk) * 64, n0 = (tile / tk) * 64;
    __syncthreads();
#pragma unroll
    for (int i = 0; i < 8; ++i) { int idx = tid + i * NTHR, kk = idx >> 6, nn = idx & 63;
      lds[kk * 65 + nn] = (n0 + nn < N) ? src[(size_t)(k0 + kk) * N + n0 + nn] : 0.f; }
    __syncthreads();
#pragma unroll
    for (int i = 0; i < 8; ++i) { int idx = tid + i * NTHR, nn = idx >> 6, kk = idx & 63;
      dst[(size_t)(n0 + nn) * K + k0 + kk] = f2bf(lds[kk * 65 + nn]); }
  }
}

DEV void phase_prologue(const Params& p, float* lds) {
  const int tid = TIDX, gtid = BIDX * NTHR + tid, gn = gridDim.x * NTHR;
  int rot = 0;
  for (int j = 0; j < 2; ++j) {
    convT(p.mla_w_in + (size_t)j * 1024 * 672, p.w_mla_in + (size_t)j * 768 * 1024, 1024, 672, 768, rot, lds); rot += 37;
    convT(p.mla_w_uq + (size_t)j * 384 * 1536, p.w_uq + (size_t)j * 1536 * 384, 384, 1536, 1536, rot, lds); rot += 37;
    convT(p.mla_w_ukv + (size_t)j * 256 * 2048, p.w_ukv + (size_t)j * 2048 * 256, 256, 2048, 2048, rot, lds); rot += 37;
    convT(p.mla_w_o + (size_t)j * 1024 * 1024, p.w_mla_o + (size_t)j * 1024 * 1024, 1024, 1024, 1024, rot, lds); rot += 37;
  }
  convT(p.s5_w_glu, p.w_glu, 1024, 2048, 2048, rot, lds); rot += 37;
  convT(p.gla_w_in, p.w_gla_in, 1024, 3072, 3072, rot, lds); rot += 37;
  convT(p.gla_w_o, p.w_gla_o, 1024, 1024, 1024, rot, lds); rot += 37;
  for (int i = 0; i < 4; ++i) { convT(p.peer_w_q + (size_t)i * 1024 * 1024, p.w_pq + (size_t)i * 1024 * 1024, 1024, 1024, 1024, rot, lds); rot += 37; }
  for (int idx = gtid; idx < 2 * 512 * 1024; idx += gn) {
    const int k = idx & 1023, n = (idx >> 10) & 511, d = idx >> 19;
    const float* w1 = p.gla_gk_w1 + ((size_t)d * 1024 + k) * 16; const float* w2 = p.gla_gk_w2 + (size_t)d * 16 * 512 + n;
    float s = 0.f;
#pragma unroll
    for (int r = 0; r < 16; ++r) s += w1[r] * w2[r * 512];
    p.w_gla_in[(size_t)(3072 + d * 512 + n) * 1024 + k] = f2bf(s);
  }
  for (int idx = gtid; idx < 2048 * 8; idx += gn) {
    const int pos = idx >> 3, i = idx & 7;
    const float inv = powf(10000.0f, -(float)i / 8.0f);
    const float ar = (float)(pos / 64) * inv, ac = (float)(pos % 64) * inv;
    float* r = p.rope + pos * 32;
    r[i] = cosf(ar); r[8 + i] = sinf(ar); r[16 + i] = cosf(ac); r[24 + i] = sinf(ac);
  }
  for (int idx = gtid; idx < 2 * 64 * 64; idx += gn) {
    const int g = (idx >> 6) & 63, d = idx >> 12;
    const float lr = p.s5_lam_re[idx], li = p.s5_lam_im[idx], dt = expf(p.s5_log_step[d * 64 + g]);
    const float mag = expf(lr * dt), ar = mag * cosf(li * dt), ai = mag * sinf(li * dt), den = lr * lr + li * li;
    const float fr = ((ar - 1.f) * lr + ai * li) / den, fi = (ai * lr - (ar - 1.f) * li) / den;
    p.s5_ar[idx] = ar; p.s5_ai[idx] = ai;
    for (int c = 0; c < 16; ++c) { const float bre = p.s5_b_re[idx * 16 + c], bim = p.s5_b_im[idx * 16 + c];
      p.s5_br[idx * 16 + c] = fr * bre - fi * bim; p.s5_bi[idx * 16 + c] = fr * bim + fi * bre; }
  }
  {
    float* s = lds;
    float* part = lds + 17 * 1024;
    __syncthreads();
    for (int idx = tid; idx < 17 * 1024; idx += NTHR) { const int r = idx >> 10, k = idx & 1023; const float cv = r < 16 ? p.c[r * 1024 + k] : p.c_ctx[k]; s[idx] = silu(cv); }
    __syncthreads();
    for (int cb = BIDX; cb < 4 * 64; cb += gridDim.x) {
      const int layer = cb >> 6, n0 = (cb & 63) * 96;
      if (tid < 384) {
        const int col = tid % 96, kq = tid / 96;
        float acc[17];
#pragma unroll
        for (int r = 0; r < 17; ++r) acc[r] = 0.f;
        const float* w = p.ada_w + (size_t)layer * 1024 * 6144 + n0 + col;
        for (int k = kq * 256; k < kq * 256 + 256; ++k) { const float wv = w[(size_t)k * 6144];
#pragma unroll
          for (int r = 0; r < 17; ++r) acc[r] += s[r * 1024 + k] * wv; }
#pragma unroll
        for (int r = 0; r < 17; ++r) part[(kq * 96 + col) * 17 + r] = acc[r];
      }
      __syncthreads();
      for (int idx = tid; idx < 96 * 17; idx += NTHR) { const int col = idx / 17, r = idx % 17;
        const float v = part[(0 * 96 + col) * 17 + r] + part[(1 * 96 + col) * 17 + r] + part[(2 * 96 + col) * 17 + r] + part[(3 * 96 + col) * 17 + r];
        p.ada[((size_t)(layer * 17 + r)) * 6144 + n0 + col] = v + p.ada_b[layer * 6144 + n0 + col]; }
      __syncthreads();
    }
  }
}

DEV void phase_norm1_first(const Params& p) {
  const int lane = TIDX & 63, gw = BIDX * (NTHR / 64) + (TIDX >> 6), nw = gridDim.x * (NTHR / 64);
  for (int t = gw; t < T; t += nw) {
    const int b = t / SP, s = t - b * SP;
    const float* src = s < CTX ? p.ctx + ((size_t)(b * CTX + s)) * D : p.x + ((size_t)(b * SEQ + s - CTX)) * D;
    float v[16]; load_row_f32(src, lane, v);
    store_row_f32(xrow_ptr(p, t), lane, v);
    const float* ad = ada_ptr(p, 0, t);
    norm_mod_store(v, p.norm_g, ad + 1024, ad, p.h + (size_t)t * D, lane);
  }
}
DEV void phase_norm2(const Params& p, int layer) {
  const int lane = TIDX & 63, gw = BIDX * (NTHR / 64) + (TIDX >> 6), nw = gridDim.x * (NTHR / 64);
  for (int t = gw; t < T; t += nw) {
    float v[16]; load_row_f32(xrow_ptr(p, t), lane, v);
    const float* ad = ada_ptr(p, layer, t);
    norm_mod_store(v, p.norm_g + (layer * 2 + 1) * D, ad + 4096, ad + 3072, p.h + (size_t)t * D, lane);
  }
}

template <class Epi>
DEV void gemm_naive(const bf16_t* A, int lda, const bf16_t* Bt, int ldb, int M, int N, int K, const Epi& epi, float* lds) {
  float* As = lds;
  float* Bs = lds + 16 * 132;
  const int tid = TIDX, ty = tid >> 5, tx = tid & 31, nM = M / 128, nN = N / 128;
  const int lrow = tid >> 2, lkq = tid & 3;
  for (int tile = BIDX; tile < nM * nN; tile += gridDim.x) {
    const int pm = tile / nN, pn = tile - pm * nN;
    float acc[8][4];
#pragma unroll
    for (int i = 0; i < 8; ++i)
#pragma unroll
      for (int j = 0; j < 4; ++j) acc[i][j] = 0.f;
    const bf16_t* ap = A + (size_t)(pm * 128 + lrow) * lda + lkq * 4;
    const bf16_t* bp = Bt + (size_t)(pn * 128 + lrow) * ldb + lkq * 4;
    for (int k0 = 0; k0 < K; k0 += 16) {
      const uint2 av = *(const uint2*)(ap + k0), bv = *(const uint2*)(bp + k0);
      __syncthreads();
      As[(lkq * 4 + 0) * 132 + lrow] = __uint_as_float(av.x << 16); As[(lkq * 4 + 1) * 132 + lrow] = __uint_as_float(av.x & 0xffff0000u);
      As[(lkq * 4 + 2) * 132 + lrow] = __uint_as_float(av.y << 16); As[(lkq * 4 + 3) * 132 + lrow] = __uint_as_float(av.y & 0xffff0000u);
      Bs[(lkq * 4 + 0) * 132 + lrow] = __uint_as_float(bv.x << 16); Bs[(lkq * 4 + 1) * 132 + lrow] = __uint_as_float(bv.x & 0xffff0000u);
      Bs[(lkq * 4 + 2) * 132 + lrow] = __uint_as_float(bv.y << 16); Bs[(lkq * 4 + 3) * 132 + lrow] = __uint_as_float(bv.y & 0xffff0000u);
      __syncthreads();
#pragma unroll 2
      for (int kk = 0; kk < 16; ++kk) {
        const float4 a0 = *(const float4*)(As + kk * 132 + ty * 8), a1 = *(const float4*)(As + kk * 132 + ty * 8 + 4), b0 = *(const float4*)(Bs + kk * 132 + tx * 4);
        const float a[8] = {a0.x, a0.y, a0.z, a0.w, a1.x, a1.y, a1.z, a1.w}, b[4] = {b0.x, b0.y, b0.z, b0.w};
#pragma unroll
        for (int i = 0; i < 8; ++i)
#pragma unroll
          for (int j = 0; j < 4; ++j) acc[i][j] += a[i] * b[j];
      }
    }
#pragma unroll
    for (int i = 0; i < 8; ++i)
#pragma unroll
      for (int j = 0; j < 4; ++j) epi(pm * 128 + ty * 8 + i, pn * 128 + tx * 4 + j, acc[i][j]);
  }
}


#define LAS __attribute__((address_space(3)))
typedef short bf16x8 __attribute__((ext_vector_type(8)));
typedef float f32x4 __attribute__((ext_vector_type(4)));
DEV int lds_byte2(int r, int c) { const int st = (r >> 4) * 2 + (c >> 5), ob = (r & 15) * 64 + (c & 31) * 2; return st * 1024 + (ob ^ (((ob >> 9) & 1) << 5)); }
DEV void stage_rc2(int b, int& R, int& C) { const int st = b >> 10, sb = b & 1023, swz = sb ^ (((sb >> 9) & 1) << 5); R = (st >> 1) * 16 + (swz >> 6); C = (st & 1) * 32 + ((swz & 63) >> 1); }

template <int BM, class Epi>
DEV void gemm_mfma(const bf16_t* A, int lda, const bf16_t* Bt, int ldb, int M, int N, int K, const Epi& epi, LAS char* shm) {
  constexpr int MF = BM / 32, TA = BM * 128, TB = 256 * 128, STG = TA + TB, GA = TA / 8192, GB = TB / 8192;
  const int tid = TIDX, wid = __builtin_amdgcn_readfirstlane(tid >> 6), lane = tid & 63, wr = wid >> 2, wc = wid & 3, fr = lane & 15, fq = lane >> 4;
  int offA[GB], offB[GB];
#pragma unroll
  for (int i = 0; i < GB; ++i) { int R, C; stage_rc2(wid * 1024 + i * 8192 + lane * 16, R, C); offA[i] = R * lda + C; offB[i] = R * ldb + C; }
  const int nM = M / BM, nN = N / 256, ntile = nM * nN, nt = K / 64;
  const int G = gridDim.x, bid = BIDX, vb = (bid & 7) * (G >> 3) + (bid >> 3);
  int aoff[MF], boff[4];
#pragma unroll
  for (int m = 0; m < MF; ++m) aoff[m] = lds_byte2(wr * (BM / 2) + m * 16 + fr, fq * 8);
#pragma unroll
  for (int n = 0; n < 4; ++n) boff[n] = TA + lds_byte2(wc * 64 + n * 16 + fr, fq * 8);
  for (int tile = vb; tile < ntile; tile += G) {
    const int pm = tile / nN, pn = tile - pm * nN;
    const bf16_t* Ab = A + (size_t)pm * BM * lda; const bf16_t* Bb = Bt + (size_t)pn * 256 * ldb;
    f32x4 acc[MF][4];
#pragma unroll
    for (int m = 0; m < MF; ++m)
#pragma unroll
      for (int n = 0; n < 4; ++n) acc[m][n] = (f32x4){0.f, 0.f, 0.f, 0.f};
#define GSTAGE(buf, kt) do { _Pragma("unroll") for (int i = 0; i < GB; ++i) { \
      if (i < GA) __builtin_amdgcn_global_load_lds((const unsigned*)(Ab + offA[i] + (kt) * 64), (LAS unsigned*)(shm + (buf) * STG + wid * 1024 + i * 8192), 16, 0, 0); \
      __builtin_amdgcn_global_load_lds((const unsigned*)(Bb + offB[i] + (kt) * 64), (LAS unsigned*)(shm + (buf) * STG + TA + wid * 1024 + i * 8192), 16, 0, 0); } } while (0)
    GSTAGE(0, 0);
    asm volatile("s_waitcnt vmcnt(0)" ::: "memory"); __syncthreads();
    for (int t = 0; t < nt; ++t) {
      const int cur = t & 1;
      if (t + 1 < nt) GSTAGE(cur ^ 1, t + 1);
#pragma unroll
      for (int ks = 0; ks < 2; ++ks) {
        bf16x8 At[MF], Bf[4];
#pragma unroll
        for (int m = 0; m < MF; ++m) At[m] = *(const LAS bf16x8*)(shm + cur * STG + (aoff[m] ^ 0) + ks * 1024);
#pragma unroll
        for (int n = 0; n < 4; ++n) Bf[n] = *(const LAS bf16x8*)(shm + cur * STG + boff[n] + ks * 1024);
#pragma unroll
        for (int m = 0; m < MF; ++m)
#pragma unroll
          for (int n = 0; n < 4; ++n) acc[m][n] = __builtin_amdgcn_mfma_f32_16x16x32_bf16(At[m], Bf[n], acc[m][n], 0, 0, 0);
      }
      asm volatile("s_waitcnt vmcnt(0)" ::: "memory"); __syncthreads();
    }
#undef GSTAGE
    const int row0 = pm * BM + wr * (BM / 2) + fq * 4, col0 = pn * 256 + wc * 64 + fr;
#pragma unroll
    for (int m = 0; m < MF; ++m)
#pragma unroll
      for (int n = 0; n < 4; ++n)
#pragma unroll
        for (int j = 0; j < 4; ++j) epi(row0 + m * 16 + j, col0 + n * 16, acc[m][n][j]);
  }
}

struct EpiStoreBf16 { bf16_t* C; int ldc; int ncols; DEV void operator()(int r, int c, float v) const { if (c < ncols) C[(size_t)r * ldc + c] = f2bf(v); } };
struct EpiStoreF32 { float* C; int ldc; DEV void operator()(int r, int c, float v) const { C[(size_t)r * ldc + c] = v; } };
struct EpiQ { bf16_t* QF; DEV void operator()(int r, int c, float v) const { int b = r / SP, s = r - b * SP, h = c / 96, d = c - h * 96; QF[((size_t)(b * 16 + h) * SP + s) * 96 + d] = f2bf(v); } };
struct EpiKV { bf16_t* KF; bf16_t* VF; DEV void operator()(int r, int c, float v) const { int b = r / SP, s = r - b * SP, h = c >> 7, d = c & 127;
    if (d < 64) KF[((size_t)(b * 16 + h) * SP + s) * 96 + d] = f2bf(v); else VF[((size_t)(b * 16 + h) * SP + s) * 64 + d - 64] = f2bf(v); } };
struct EpiRes { float* xc; float* out; const float* ada; int layer; int goff; bool last;
  DEV void operator()(int r, int c, float v) const { int b = r / SP, s = r - b * SP;
    if (s < CTX) { if (last) return; xc[((size_t)(b * CTX + s)) * D + c] += ada[((size_t)(layer * 17 + 16)) * 6144 + goff + c] * v; }
    else out[((size_t)(b * SEQ + s - CTX)) * D + c] += ada[((size_t)(layer * 17 + b)) * 6144 + goff + c] * v; } };
struct EpiGla { bf16_t* QKVG; float* LG; const float* gkb;
  DEV void operator()(int r, int c, float v) const {
    if (c < 3072) { if (c < 512) v *= 0.08838834764831845f; QKVG[(size_t)r * 3072 + c] = f2bf(v); }
    else { int d = (c - 3072) >> 9, n = (c - 3072) & 511; float z = v + gkb[d * 512 + n];
      float ls = fminf(z, 0.f) - log1pf(__expf(-fabsf(z)));
      LG[((size_t)d * T + r) * 512 + n] = ls * (1.0f / 16.0f); } } };

DEV void phase_mla_norm(const Params& p, int j) {
  const bf16_t* A1 = (const bf16_t*)(p.scratch + OFF_A1); bf16_t* CQN = (bf16_t*)(p.scratch + OFF_CQN); bf16_t* CKVN = (bf16_t*)(p.scratch + OFF_CKVN); bf16_t* KF = (bf16_t*)(p.scratch + OFF_KF);
  const int lane = TIDX & 63, gw = BIDX * (NTHR / 64) + (TIDX >> 6), nw = gridDim.x * (NTHR / 64);
  const float* qn = p.mla_q_norm + j * 384; const float* kn = p.mla_kv_norm + j * 256;
  for (int t = gw; t < T; t += nw) {
    const bf16_t* a = A1 + (size_t)t * 768;
    float v[6], ss = 0.f;
#pragma unroll
    for (int i = 0; i < 6; ++i) { v[i] = bf2f(a[lane + 64 * i]); ss += v[i] * v[i]; }
    ss = wave_sum(ss); float rstd = rsqrtf(ss * (1.0f / 384.0f) + 1e-6f);
#pragma unroll
    for (int i = 0; i < 6; ++i) CQN[(size_t)t * 384 + lane + 64 * i] = f2bf(v[i] * rstd * qn[lane + 64 * i]);
    float w[4]; ss = 0.f;
#pragma unroll
    for (int i = 0; i < 4; ++i) { w[i] = bf2f(a[384 + lane + 64 * i]); ss += w[i] * w[i]; }
    ss = wave_sum(ss); rstd = rsqrtf(ss * (1.0f / 256.0f) + 1e-6f);
#pragma unroll
    for (int i = 0; i < 4; ++i) CKVN[(size_t)t * 256 + lane + 64 * i] = f2bf(w[i] * rstd * kn[lane + 64 * i]);
    const int b = t / SP, s = t - b * SP;
    float val = bf2f(a[640 + (lane & 31)]);
    const float other = __shfl_xor(val, 8);
    if (s >= CTX) { const int pos = s - CTX, d = lane & 31, hb = d >> 4, dd = d & 15, i = dd & 7;
      const float cs = p.rope[pos * 32 + hb * 16 + i], sn = p.rope[pos * 32 + hb * 16 + 8 + i];
      val = dd < 8 ? val * cs - other * sn : val * cs + other * sn; }
    if (lane < 32) { const bf16_t o = f2bf(val);
      for (int hh = 0; hh < 16; ++hh) KF[((size_t)(b * 16 + hh) * SP + s) * 96 + 64 + lane] = o; }
  }
}

DEV void phase_attn_naive(const Params& p, bool last, float* lds) {
  const bf16_t* QF = (const bf16_t*)(p.scratch + OFF_QF); const bf16_t* KF = (const bf16_t*)(p.scratch + OFF_KF); const bf16_t* VF = (const bf16_t*)(p.scratch + OFF_VF);
  bf16_t* O = (bf16_t*)(p.scratch + OFF_O);
  float* Ks = lds;
  float* Vs = lds + 32 * 96;
  const int tid = TIDX;
  const int nitems = 1024 + (last ? 0 : 256);
  for (int item = BIDX; item < nitems; item += gridDim.x) {
    int b, hh, q0, nq, nkeys;
    if (item < 1024) { b = item >> 6; hh = (item >> 2) & 15; q0 = CTX + (item & 3) * 512; nq = 512; nkeys = SP; }
    else { const int it = item - 1024; b = it >> 4; hh = it & 15; q0 = 0; nq = 256; nkeys = CTX; }
    const size_t bh = (size_t)(b * 16 + hh) * SP;
    const bool active = tid < nq;
    const int sq = q0 + (active ? tid : 0);
    float q[96];
    { const bf16_t* qp = QF + (bh + sq) * 96;
#pragma unroll
      for (int i = 0; i < 96; i += 2) { const unsigned u = *(const unsigned*)(qp + i); q[i] = __uint_as_float(u << 16); q[i + 1] = __uint_as_float(u & 0xffff0000u); } }
    if (sq >= CTX) { const float* r = p.rope + (sq - CTX) * 32;
#pragma unroll
      for (int hb = 0; hb < 2; ++hb)
#pragma unroll
        for (int i = 0; i < 8; ++i) { const float cs = r[hb * 16 + i], sn = r[hb * 16 + 8 + i], x1 = q[64 + hb * 16 + i], x2 = q[64 + hb * 16 + 8 + i];
          q[64 + hb * 16 + i] = x1 * cs - x2 * sn; q[64 + hb * 16 + 8 + i] = x2 * cs + x1 * sn; } }
#pragma unroll
    for (int i = 0; i < 96; ++i) q[i] *= 0.10206207261596577f;
    float acc[64], m = -1e30f, l = 0.f;
#pragma unroll
    for (int i = 0; i < 64; ++i) acc[i] = 0.f;
    for (int k0 = 0; k0 < nkeys; k0 += 32) {
      __syncthreads();
      for (int idx = tid; idx < 32 * 96 / 2; idx += NTHR) { const unsigned u = *(const unsigned*)(KF + (bh + k0) * 96 + idx * 2); Ks[idx * 2] = __uint_as_float(u << 16); Ks[idx * 2 + 1] = __uint_as_float(u & 0xffff0000u); }
      for (int idx = tid; idx < 32 * 64 / 2; idx += NTHR) { const unsigned u = *(const unsigned*)(VF + (bh + k0) * 64 + idx * 2); Vs[idx * 2] = __uint_as_float(u << 16); Vs[idx * 2 + 1] = __uint_as_float(u & 0xffff0000u); }
      __syncthreads();
#pragma unroll 1
      for (int kk = 0; kk < 32; ++kk) {
        float s = 0.f;
#pragma unroll
        for (int i = 0; i < 96; i += 4) { const float4 kv = *(const float4*)(Ks + kk * 96 + i); s += q[i] * kv.x + q[i + 1] * kv.y + q[i + 2] * kv.z + q[i + 3] * kv.w; }
        if (s > m) { const float corr = __expf(m - s); l *= corr;
#pragma unroll
          for (int i = 0; i < 64; ++i) acc[i] *= corr;
          m = s; }
        const float pe = __expf(s - m); l += pe;
#pragma unroll
        for (int i = 0; i < 64; i += 4) { const float4 vv = *(const float4*)(Vs + kk * 64 + i); acc[i] += pe * vv.x; acc[i + 1] += pe * vv.y; acc[i + 2] += pe * vv.z; acc[i + 3] += pe * vv.w; }
      }
    }
    if (active) { const float inv = 1.f / l; bf16_t* op = O + ((size_t)(b * SP + sq)) * D + hh * 64;
#pragma unroll
      for (int i = 0; i < 64; i += 2) *(unsigned*)(op + i) = (unsigned)f2bf(acc[i] * inv) | ((unsigned)f2bf(acc[i + 1] * inv) << 16); }
  }
}

#define INSERT16(val, pay, tv, ti) { float s_ = (val); int i_ = (pay); _Pragma("unroll") for (int j_ = 0; j_ < 16; ++j_) { if (s_ > tv[j_]) { float t_ = tv[j_]; tv[j_] = s_; s_ = t_; int u_ = ti[j_]; ti[j_] = i_; i_ = u_; } } }

DEV void phase_peer_subtopk(const Params& p, int layer, float* lds) {
  const float* PQ = (const float*)(p.scratch + OFF_PQ); float* SV = (float*)(p.scratch + OFF_SV); int* SI = (int*)(p.scratch + OFF_SI);
  const int tid = TIDX;
  for (int item = BIDX; item < 16 * 72; item += gridDim.x) {
    const int hp = item / 72, tb = item - hp * 72, t = tb * 512 + tid;
    __syncthreads();
    const float* kp = p.peer_keys + ((size_t)(layer * 16 + hp)) * 128 * 64;
    for (int idx = tid; idx < 128 * 64 / 4; idx += NTHR) *(float4*)(lds + idx * 4) = *(const float4*)(kp + idx * 4);
    __syncthreads();
    float q[64];
#pragma unroll
    for (int i = 0; i < 64; i += 4) { const float4 v = *(const float4*)(PQ + (size_t)t * 1024 + hp * 64 + i); q[i] = v.x; q[i + 1] = v.y; q[i + 2] = v.z; q[i + 3] = v.w; }
    float tv[16]; int ti[16];
#pragma unroll
    for (int j = 0; j < 16; ++j) { tv[j] = -3.0e38f; ti[j] = 0; }
#pragma unroll 1
    for (int key = 0; key < 128; ++key) {
      float s = 0.f;
#pragma unroll
      for (int i = 0; i < 64; i += 4) { const float4 kv = *(const float4*)(lds + key * 64 + i); s += q[i] * kv.x + q[i + 1] * kv.y + q[i + 2] * kv.z + q[i + 3] * kv.w; }
      INSERT16(s, key, tv, ti);
    }
#pragma unroll
    for (int j = 0; j < 16; ++j) { SV[((size_t)t * 16 + hp) * 16 + j] = tv[j]; SI[((size_t)t * 16 + hp) * 16 + j] = ti[j]; }
  }
}

DEV void phase_peer_final_topk(const Params& p) {
  const float* SV = (const float*)(p.scratch + OFF_SV); const int* SI = (const int*)(p.scratch + OFF_SI);
  int* EID = (int*)(p.scratch + OFF_EID); float* GATE = (float*)(p.scratch + OFF_GATE);
  for (int idx = BIDX * NTHR + TIDX; idx < T * 8; idx += gridDim.x * NTHR) {
    float a[16], bq[16]; int ia[16], ib[16];
#pragma unroll
    for (int j = 0; j < 16; ++j) { a[j] = SV[(size_t)idx * 32 + j]; ia[j] = SI[(size_t)idx * 32 + j]; bq[j] = SV[(size_t)idx * 32 + 16 + j]; ib[j] = SI[(size_t)idx * 32 + 16 + j]; }
    float tv[16]; int ti[16];
#pragma unroll
    for (int j = 0; j < 16; ++j) { tv[j] = -3.0e38f; ti[j] = 0; }
#pragma unroll
    for (int i0 = 0; i0 < 16; ++i0)
#pragma unroll
      for (int i1 = 0; i1 < 16; ++i1)
        if ((i0 + 1) * (i1 + 1) <= 16) INSERT16(a[i0] + bq[i1], ia[i0] * 128 + ib[i1], tv, ti);
    float e[16], sum = 0.f;
#pragma unroll
    for (int j = 0; j < 16; ++j) { e[j] = __expf(tv[j] - tv[0]); sum += e[j]; }
    const float inv = 1.f / sum;
#pragma unroll
    for (int j = 0; j < 16; ++j) { EID[(size_t)idx * 16 + j] = ti[j]; GATE[(size_t)idx * 16 + j] = e[j] * inv; }
  }
}

DEV void phase_peer_gather(const Params& p, int layer) {
  const int* EID = (const int*)(p.scratch + OFF_EID); const float* GATE = (const float*)(p.scratch + OFF_GATE);
  const int lane = TIDX & 63, gw = BIDX * (NTHR / 64) + (TIDX >> 6), nw = gridDim.x * (NTHR / 64);
  const bool last = layer == 3;
  const float* U = p.peer_u + (size_t)layer * 16384 * 1024; const float* V = p.peer_v + (size_t)layer * 16384 * 1024;
  for (int t = gw; t < T; t += nw) {
    const int b = t / SP, s = t - b * SP;
    if (last && s < CTX) continue;
    float x[16];
    { const bf16_t* hr = p.h + (size_t)t * D;
#pragma unroll
      for (int j = 0; j < 4; ++j) { const uint2 w = *(const uint2*)(hr + j * 256 + lane * 4); x[j * 4] = __uint_as_float(w.x << 16); x[j * 4 + 1] = __uint_as_float(w.x & 0xffff0000u); x[j * 4 + 2] = __uint_as_float(w.y << 16); x[j * 4 + 3] = __uint_as_float(w.y & 0xffff0000u); } }
    float f[16];
#pragma unroll
    for (int i = 0; i < 16; ++i) f[i] = 0.f;
#pragma unroll 2
    for (int e = 0; e < 128; ++e) {
      const int eid = EID[(size_t)t * 128 + e]; const float gate = GATE[(size_t)t * 128 + e];
      const float* ur = U + (size_t)eid * 1024; const float* vr = V + (size_t)eid * 1024;
      float4 uu[4], vv[4];
#pragma unroll
      for (int j = 0; j < 4; ++j) { uu[j] = *(const float4*)(ur + j * 256 + lane * 4); vv[j] = *(const float4*)(vr + j * 256 + lane * 4); }
      float dsum = 0.f;
#pragma unroll
      for (int j = 0; j < 4; ++j) dsum += uu[j].x * x[j * 4] + uu[j].y * x[j * 4 + 1] + uu[j].z * x[j * 4 + 2] + uu[j].w * x[j * 4 + 3];
      dsum = wave_sum(dsum);
      const float w = gate * gelu_tanh(dsum);
#pragma unroll
      for (int j = 0; j < 4; ++j) { f[j * 4] += w * vv[j].x; f[j * 4 + 1] += w * vv[j].y; f[j * 4 + 2] += w * vv[j].z; f[j * 4 + 3] += w * vv[j].w; }
    }
    float* xr = xrow_ptr(p, t);
    float xv[16]; load_row_f32(xr, lane, xv);
    const float* ad = ada_ptr(p, layer, t);
#pragma unroll
    for (int j = 0; j < 4; ++j) { const float4 g2 = *(const float4*)(ad + 5120 + j * 256 + lane * 4);
      xv[j * 4] += g2.x * f[j * 4]; xv[j * 4 + 1] += g2.y * f[j * 4 + 1]; xv[j * 4 + 2] += g2.z * f[j * 4 + 2]; xv[j * 4 + 3] += g2.w * f[j * 4 + 3]; }
    if (!last) {
      store_row_f32(xr, lane, xv);
      const float* ad2 = ada_ptr(p, layer + 1, t);
      norm_mod_store(xv, p.norm_g + ((layer + 1) * 2) * D, ad2 + 1024, ad2, p.h + (size_t)t * D, lane);
    } else {
      float ss = 0.f;
#pragma unroll
      for (int i = 0; i < 16; ++i) ss += xv[i] * xv[i];
      ss = wave_sum(ss); const float rstd = rsqrtf(ss * (1.0f / D) + 1e-6f);
#pragma unroll
      for (int j = 0; j < 4; ++j) { const float4 g = *(const float4*)(p.final_g + j * 256 + lane * 4);
        xv[j * 4] *= rstd * g.x; xv[j * 4 + 1] *= rstd * g.y; xv[j * 4 + 2] *= rstd * g.z; xv[j * 4 + 3] *= rstd * g.w; }
      store_row_f32(xr, lane, xv);
    }
  }
}


typedef float f32x2 __attribute__((ext_vector_type(2)));
constexpr float U8_SCALE = 1024.0f, V8_SCALE = 64.0f;
DEV unsigned pack4_fp8(float a, float b, float c, float d, float sc) {
  a = fminf(fmaxf(a * sc, -448.f), 448.f); b = fminf(fmaxf(b * sc, -448.f), 448.f); c = fminf(fmaxf(c * sc, -448.f), 448.f); d = fminf(fmaxf(d * sc, -448.f), 448.f);
  int w = 0; w = __builtin_amdgcn_cvt_pk_fp8_f32(a, b, w, false); w = __builtin_amdgcn_cvt_pk_fp8_f32(c, d, w, true); return (unsigned)w;
}
DEV void phase_peer_tables(const Params& p, int layer) {
  uint4* U8 = (uint4*)(p.scratch + OFF_U8); uint4* V8 = (uint4*)(p.scratch + OFF_V8);
  const float4* U = (const float4*)(p.peer_u + (size_t)layer * 16384 * 1024); const float4* V = (const float4*)(p.peer_v + (size_t)layer * 16384 * 1024);
  const int n16 = 16384 * 1024 / 16;
  for (int i = BIDX * NTHR + TIDX; i < n16; i += gridDim.x * NTHR) {
    { const float4 a = U[(size_t)i * 4], b = U[(size_t)i * 4 + 1], c = U[(size_t)i * 4 + 2], d = U[(size_t)i * 4 + 3];
      U8[i] = make_uint4(pack4_fp8(a.x, a.y, a.z, a.w, U8_SCALE), pack4_fp8(b.x, b.y, b.z, b.w, U8_SCALE), pack4_fp8(c.x, c.y, c.z, c.w, U8_SCALE), pack4_fp8(d.x, d.y, d.z, d.w, U8_SCALE)); }
    { const float4 a = V[(size_t)i * 4], b = V[(size_t)i * 4 + 1], c = V[(size_t)i * 4 + 2], d = V[(size_t)i * 4 + 3];
      V8[i] = make_uint4(pack4_fp8(a.x, a.y, a.z, a.w, V8_SCALE), pack4_fp8(b.x, b.y, b.z, b.w, V8_SCALE), pack4_fp8(c.x, c.y, c.z, c.w, V8_SCALE), pack4_fp8(d.x, d.y, d.z, d.w, V8_SCALE)); }
  }
}
DEV float rdlane_f(float v, int l) { return __builtin_bit_cast(float, __builtin_amdgcn_readlane(__builtin_bit_cast(int, v), l)); }

DEV void phase_peer_gather8(const Params& p, int layer) {
  const int* EID = (const int*)(p.scratch + OFF_EID); const float* GATE = (const float*)(p.scratch + OFF_GATE);
  const uint4* U8 = (const uint4*)(p.scratch + OFF_U8); const uint4* V8 = (const uint4*)(p.scratch + OFF_V8);
  const int lane = TIDX & 63, gw = BIDX * (NTHR / 64) + (TIDX >> 6), nw = gridDim.x * (NTHR / 64);
  const bool last = layer == 3;
  for (int t = gw; t < T; t += nw) {
    const int b = t / SP, s = t - b * SP;
    if (last && s < CTX) continue;
    f32x2 x[8];
    { const bf16_t* hr = p.h + (size_t)t * D + lane * 16; const uint4 h0 = *(const uint4*)hr, h1 = *(const uint4*)(hr + 8);
      const unsigned hw[8] = {h0.x, h0.y, h0.z, h0.w, h1.x, h1.y, h1.z, h1.w};
#pragma unroll
      for (int i = 0; i < 8; ++i) { x[i].x = __uint_as_float(hw[i] << 16); x[i].y = __uint_as_float(hw[i] & 0xffff0000u); } }
    f32x2 f[8];
#pragma unroll
    for (int i = 0; i < 8; ++i) f[i] = (f32x2){0.f, 0.f};
#pragma unroll 1
    for (int grp = 0; grp < 16; ++grp) {
      const int eidv = EID[(size_t)t * 128 + grp * 8 + (lane & 7)];
      const float gv = GATE[(size_t)t * 128 + grp * 8 + ((lane >> 3) & 7)];
      uint4 uu[8], vv[8];
#pragma unroll
      for (int r = 0; r < 8; ++r) { const int e = __builtin_amdgcn_readlane(eidv, r); uu[r] = U8[(size_t)e * 64 + lane]; vv[r] = V8[(size_t)e * 64 + lane]; }
      float d[8];
#pragma unroll
      for (int r = 0; r < 8; ++r) {
        const unsigned uw[4] = {uu[r].x, uu[r].y, uu[r].z, uu[r].w};
        f32x2 acc = (f32x2){0.f, 0.f};
#pragma unroll
        for (int q = 0; q < 4; ++q) { acc += x[2 * q] * __builtin_amdgcn_cvt_pk_f32_fp8((int)uw[q], false); acc += x[2 * q + 1] * __builtin_amdgcn_cvt_pk_f32_fp8((int)uw[q], true); }
        d[r] = acc.x + acc.y;
      }
#pragma unroll
      for (int i = 0; i < 4; ++i) { const bool hi = lane & 32; const float send = hi ? d[i] : d[i + 4], keep = hi ? d[i + 4] : d[i]; d[i] = keep + __shfl_xor(send, 32); }
#pragma unroll
      for (int i = 0; i < 2; ++i) { const bool hi = lane & 16; const float send = hi ? d[i] : d[i + 2], keep = hi ? d[i + 2] : d[i]; d[i] = keep + __shfl_xor(send, 16); }
      { const bool hi = lane & 8; const float send = hi ? d[0] : d[1], keep = hi ? d[1] : d[0]; d[0] = keep + __shfl_xor(send, 8); }
      d[0] += __shfl_xor(d[0], 4); d[0] += __shfl_xor(d[0], 2); d[0] += __shfl_xor(d[0], 1);
      const float w = gv * gelu_tanh(d[0] * (1.0f / U8_SCALE));
#pragma unroll
      for (int r = 0; r < 8; ++r) {
        const float wr = rdlane_f(w, r * 8);
        const unsigned vw[4] = {vv[r].x, vv[r].y, vv[r].z, vv[r].w};
#pragma unroll
        for (int q = 0; q < 4; ++q) { f[2 * q] += wr * __builtin_amdgcn_cvt_pk_f32_fp8((int)vw[q], false); f[2 * q + 1] += wr * __builtin_amdgcn_cvt_pk_f32_fp8((int)vw[q], true); }
      }
    }
    float* xr = xrow_ptr(p, t) + lane * 16;
    const float* ad = ada_ptr(p, layer, t);
    float xv[16];
#pragma unroll
    for (int j = 0; j < 4; ++j) { const float4 xx = *(const float4*)(xr + j * 4), g2 = *(const float4*)(ad + 5120 + lane * 16 + j * 4);
      xv[j * 4] = xx.x + g2.x * f[2 * j].x * (1.0f / V8_SCALE); xv[j * 4 + 1] = xx.y + g2.y * f[2 * j].y * (1.0f / V8_SCALE);
      xv[j * 4 + 2] = xx.z + g2.z * f[2 * j + 1].x * (1.0f / V8_SCALE); xv[j * 4 + 3] = xx.w + g2.w * f[2 * j + 1].y * (1.0f / V8_SCALE); }
    float ss = 0.f;
#pragma unroll
    for (int i = 0; i < 16; ++i) ss += xv[i] * xv[i];
    ss = wave_sum(ss); const float rstd = rsqrtf(ss * (1.0f / D) + 1e-6f);
    if (!last) {
#pragma unroll
      for (int j = 0; j < 4; ++j) *(float4*)(xr + j * 4) = make_float4(xv[j * 4], xv[j * 4 + 1], xv[j * 4 + 2], xv[j * 4 + 3]);
      const float* ad2 = ada_ptr(p, layer + 1, t); const float* g = p.norm_g + ((layer + 1) * 2) * D;
      unsigned ow[8];
#pragma unroll
      for (int j = 0; j < 4; ++j) { const int c0 = lane * 16 + j * 4; const float4 gg = *(const float4*)(g + c0), s1 = *(const float4*)(ad2 + 1024 + c0), s2 = *(const float4*)(ad2 + c0);
        const float y0 = xv[j * 4] * rstd * gg.x * (1.f + s1.x) + s2.x, y1 = xv[j * 4 + 1] * rstd * gg.y * (1.f + s1.y) + s2.y;
        const float y2 = xv[j * 4 + 2] * rstd * gg.z * (1.f + s1.z) + s2.z, y3 = xv[j * 4 + 3] * rstd * gg.w * (1.f + s1.w) + s2.w;
        ow[j * 2] = (unsigned)f2bf(y0) | ((unsigned)f2bf(y1) << 16); ow[j * 2 + 1] = (unsigned)f2bf(y2) | ((unsigned)f2bf(y3) << 16); }
      bf16_t* hw = p.h + (size_t)t * D + lane * 16;
      *(uint4*)hw = make_uint4(ow[0], ow[1], ow[2], ow[3]); *(uint4*)(hw + 8) = make_uint4(ow[4], ow[5], ow[6], ow[7]);
    } else {
#pragma unroll
      for (int j = 0; j < 4; ++j) { const float4 g = *(const float4*)(p.final_g + lane * 16 + j * 4);
        *(float4*)(xr + j * 4) = make_float4(xv[j * 4] * rstd * g.x, xv[j * 4 + 1] * rstd * g.y, xv[j * 4 + 2] * rstd * g.z, xv[j * 4 + 3] * rstd * g.w); }
    }
  }
}

DEV int seq_of_tau(int tau, int d) { return d == 0 ? tau : (tau < CTX ? CTX - 1 - tau : 2 * CTX + SEQ - 1 - tau); }

DEV void phase_s5_scan(const Params& p, float* lds) {
  float* Y = (float*)(p.scratch + OFF_Y); bf16_t* GIN = (bf16_t*)(p.scratch + OFF_GIN);
  const int tid = TIDX, wid = tid >> 6, lane = tid & 63;
  float* ub = lds + wid * 2048;
  float* yb = ub + 1024;
  for (int item0 = BIDX * 8; item0 < 1024; item0 += gridDim.x * 8) {
    const int item = item0 + wid, b = item >> 6, g = item & 63;
    for (int d = 0; d < 2; ++d) {
      const int sidx = (d * 64 + g) * 64 + lane;
      const float ar = p.s5_ar[sidx], ai = p.s5_ai[sidx];
      float br[16], bi[16], cr[16], ci[16];
#pragma unroll
      for (int c = 0; c < 16; ++c) { br[c] = p.s5_br[sidx * 16 + c]; bi[c] = p.s5_bi[sidx * 16 + c];
        cr[c] = p.s5_c_re[((size_t)(d * 64 + g) * 16 + c) * 64 + lane]; ci[c] = p.s5_c_im[((size_t)(d * 64 + g) * 16 + c) * 64 + lane]; }
      float xr = 0.f, xi = 0.f;
      for (int k = 0; k < 36; ++k) {
        const int trow = b * SP + seq_of_tau(k * 64 + lane, d);
        __syncthreads();
        { const bf16_t* hp = p.h + (size_t)trow * D + g * 16;
          const uint4 w0 = *(const uint4*)hp, w1 = *(const uint4*)(hp + 8);
          const unsigned ww[8] = {w0.x, w0.y, w0.z, w0.w, w1.x, w1.y, w1.z, w1.w};
#pragma unroll
          for (int i = 0; i < 8; ++i) { ub[lane * 16 + 2 * i] = __uint_as_float(ww[i] << 16); ub[lane * 16 + 2 * i + 1] = __uint_as_float(ww[i] & 0xffff0000u); } }
        __syncthreads();
#pragma unroll 1
        for (int j = 0; j < 64; ++j) {
          float u[16];
#pragma unroll
          for (int c = 0; c < 16; c += 4) { const float4 t4 = *(const float4*)(ub + j * 16 + c); u[c] = t4.x; u[c + 1] = t4.y; u[c + 2] = t4.z; u[c + 3] = t4.w; }
          float bur = 0.f, bui = 0.f;
#pragma unroll
          for (int c = 0; c < 16; ++c) { bur += br[c] * u[c]; bui += bi[c] * u[c]; }
          const float nxr = ar * xr - ai * xi + bur, nxi = ar * xi + ai * xr + bui;
          xr = nxr; xi = nxi;
          float v[16];
#pragma unroll
          for (int c = 0; c < 16; ++c) v[c] = cr[c] * xr - ci[c] * xi;
#pragma unroll
          for (int i = 0; i < 8; ++i) { const bool hi = lane & 32; const float send = hi ? v[i] : v[i + 8], keep = hi ? v[i + 8] : v[i]; v[i] = keep + __shfl_xor(send, 32); }
#pragma unroll
          for (int i = 0; i < 4; ++i) { const bool hi = lane & 16; const float send = hi ? v[i] : v[i + 4], keep = hi ? v[i + 4] : v[i]; v[i] = keep + __shfl_xor(send, 16); }
#pragma unroll
          for (int i = 0; i < 2; ++i) { const bool hi = lane & 8; const float send = hi ? v[i] : v[i + 2], keep = hi ? v[i + 2] : v[i]; v[i] = keep + __shfl_xor(send, 8); }
          { const bool hi = lane & 4; const float send = hi ? v[0] : v[1], keep = hi ? v[1] : v[0]; v[0] = keep + __shfl_xor(send, 4); }
          v[0] += __shfl_xor(v[0], 2); v[0] += __shfl_xor(v[0], 1);
          if ((lane & 3) == 0) yb[j * 16 + (lane >> 2)] = v[0];
        }
        __syncthreads();
        if (d == 0) {
#pragma unroll
          for (int c = 0; c < 16; c += 4) *(float4*)(Y + (size_t)trow * D + g * 16 + c) = *(const float4*)(yb + lane * 16 + c);
        } else {
          unsigned ow[8];
#pragma unroll
          for (int c = 0; c < 16; c += 2) {
            const float y0 = Y[(size_t)trow * D + g * 16 + c] + yb[lane * 16 + c] + p.s5_d[g * 16 + c] * ub[lane * 16 + c];
            const float y1 = Y[(size_t)trow * D + g * 16 + c + 1] + yb[lane * 16 + c + 1] + p.s5_d[g * 16 + c + 1] * ub[lane * 16 + c + 1];
            ow[c >> 1] = (unsigned)f2bf(gelu_tanh(y0)) | ((unsigned)f2bf(gelu_tanh(y1)) << 16);
          }
          *(uint4*)(GIN + (size_t)trow * D + g * 16) = make_uint4(ow[0], ow[1], ow[2], ow[3]);
          *(uint4*)(GIN + (size_t)trow * D + g * 16 + 8) = make_uint4(ow[4], ow[5], ow[6], ow[7]);
        }
      }
    }
  }
}

DEV void phase_s5_out(const Params& p, int layer) {
  const bf16_t* Z = (const bf16_t*)(p.scratch + OFF_Z);
  const int lane = TIDX & 63, gw = BIDX * (NTHR / 64) + (TIDX >> 6), nw = gridDim.x * (NTHR / 64);
  for (int t = gw; t < T; t += nw) {
    float* xr = xrow_ptr(p, t); float xv[16]; load_row_f32(xr, lane, xv);
    const float* ad = ada_ptr(p, layer, t);
#pragma unroll
    for (int j = 0; j < 4; ++j) { const int c0 = j * 256 + lane * 4;
      const uint2 za = *(const uint2*)(Z + (size_t)t * 2048 + c0), zg = *(const uint2*)(Z + (size_t)t * 2048 + 1024 + c0);
      const float a[4] = {__uint_as_float(za.x << 16), __uint_as_float(za.x & 0xffff0000u), __uint_as_float(za.y << 16), __uint_as_float(za.y & 0xffff0000u)};
      const float gg[4] = {__uint_as_float(zg.x << 16), __uint_as_float(zg.x & 0xffff0000u), __uint_as_float(zg.y << 16), __uint_as_float(zg.y & 0xffff0000u)};
      const float4 g1 = *(const float4*)(ad + 2048 + c0); const float g1a[4] = {g1.x, g1.y, g1.z, g1.w};
#pragma unroll
      for (int e = 0; e < 4; ++e) xv[j * 4 + e] += g1a[e] * a[e] * sigm(gg[e]); }
    store_row_f32(xr, lane, xv);
    norm_mod_store(xv, p.norm_g + (layer * 2 + 1) * D, ad + 4096, ad + 3072, p.h + (size_t)t * D, lane);
  }
}

DEV void phase_gla_scan(const Params& p, float* lds) {
  const bf16_t* QKVG = (const bf16_t*)(p.scratch + OFF_QKVG); const float* LG = (const float*)(p.scratch + OFF_LG); bf16_t* OD = (bf16_t*)(p.scratch + OFF_OD);
  float* qs = lds; float* ks = lds + 16 * 128; float* es = lds + 32 * 128; float* vs = lds + 48 * 128; float* op = vs + 16 * 256;
  const int tid = TIDX, col = tid & 255, kh = tid >> 8;
  for (int item = BIDX; item < 128; item += gridDim.x) {
    const int b = item >> 3, hd = (item >> 1) & 3, d = item & 1;
    float S[64];
#pragma unroll
    for (int i = 0; i < 64; ++i) S[i] = 0.f;
    for (int st = 0; st < SP / 16; ++st) {
      __syncthreads();
      for (int idx = tid; idx < 16 * 128; idx += NTHR) { const int j = idx >> 7, k = idx & 127; const size_t trow = (size_t)b * SP + seq_of_tau(st * 16 + j, d);
        qs[idx] = bf2f(QKVG[trow * 3072 + hd * 128 + k]); ks[idx] = bf2f(QKVG[trow * 3072 + 512 + hd * 128 + k]); es[idx] = __expf(LG[((size_t)d * T + trow) * 512 + hd * 128 + k]); }
      for (int idx = tid; idx < 16 * 256; idx += NTHR) { const int j = idx >> 8, c = idx & 255; const size_t trow = (size_t)b * SP + seq_of_tau(st * 16 + j, d);
        vs[idx] = bf2f(QKVG[trow * 3072 + 1024 + hd * 256 + c]); }
      __syncthreads();
#pragma unroll 1
      for (int j = 0; j < 16; ++j) {
        const float vv = vs[j * 256 + col]; float acc = 0.f;
#pragma unroll
        for (int kk = 0; kk < 64; kk += 4) {
          const float4 e4 = *(const float4*)(es + j * 128 + kh * 64 + kk), k4 = *(const float4*)(ks + j * 128 + kh * 64 + kk), q4 = *(const float4*)(qs + j * 128 + kh * 64 + kk);
          S[kk] = e4.x * S[kk] + k4.x * vv; acc += q4.x * S[kk];
          S[kk + 1] = e4.y * S[kk + 1] + k4.y * vv; acc += q4.y * S[kk + 1];
          S[kk + 2] = e4.z * S[kk + 2] + k4.z * vv; acc += q4.z * S[kk + 2];
          S[kk + 3] = e4.w * S[kk + 3] + k4.w * vv; acc += q4.w * S[kk + 3];
        }
        op[kh * 16 * 256 + j * 256 + col] = acc;
      }
      __syncthreads();
      for (int idx = tid; idx < 16 * 256; idx += NTHR) { const int j = idx >> 8, c = idx & 255; const size_t trow = (size_t)b * SP + seq_of_tau(st * 16 + j, d);
        OD[((size_t)d * T + trow) * D + hd * 256 + c] = f2bf(op[idx] + op[16 * 256 + idx]); }
    }
  }
}

DEV void phase_gla_out(const Params& p) {
  const bf16_t* QKVG = (const bf16_t*)(p.scratch + OFF_QKVG); const bf16_t* OD = (const bf16_t*)(p.scratch + OFF_OD); bf16_t* GO = (bf16_t*)(p.scratch + OFF_GO);
  const int lane = TIDX & 63, gw = BIDX * (NTHR / 64) + (TIDX >> 6), nw = gridDim.x * (NTHR / 64);
  for (int t = gw; t < T; t += nw) {
#pragma unroll
    for (int hd = 0; hd < 4; ++hd) {
      const int c0 = hd * 256 + lane * 4;
      const uint2 a = *(const uint2*)(OD + (size_t)t * D + c0), bq = *(const uint2*)(OD + ((size_t)T + t) * D + c0), gg = *(const uint2*)(QKVG + (size_t)t * 3072 + 2048 + c0);
      float o[4] = {__uint_as_float(a.x << 16) + __uint_as_float(bq.x << 16), __uint_as_float(a.x & 0xffff0000u) + __uint_as_float(bq.x & 0xffff0000u),
                    __uint_as_float(a.y << 16) + __uint_as_float(bq.y << 16), __uint_as_float(a.y & 0xffff0000u) + __uint_as_float(bq.y & 0xffff0000u)};
      const float gv[4] = {__uint_as_float(gg.x << 16), __uint_as_float(gg.x & 0xffff0000u), __uint_as_float(gg.y << 16), __uint_as_float(gg.y & 0xffff0000u)};
      float ss = o[0] * o[0] + o[1] * o[1] + o[2] * o[2] + o[3] * o[3];
      ss = wave_sum(ss); const float rstd = rsqrtf(ss * (1.0f / 256.0f) + 1e-6f);
      const float4 on = *(const float4*)(p.gla_o_norm + lane * 4); const float ona[4] = {on.x, on.y, on.z, on.w};
      unsigned w[2];
#pragma unroll
      for (int e = 0; e < 4; e += 2) w[e >> 1] = (unsigned)f2bf(o[e] * rstd * ona[e] * silu(gv[e])) | ((unsigned)f2bf(o[e + 1] * rstd * ona[e + 1] * silu(gv[e + 1])) << 16);
      *(uint2*)(GO + (size_t)t * D + c0) = make_uint2(w[0], w[1]);
    }
  }
}

__global__ void __launch_bounds__(NTHR) fwd_megakernel(Params p) {
  cg::grid_group grid = cg::this_grid();
  __shared__ __attribute__((aligned(1024))) char shm_raw[128 * 1024];
  float* lds = (float*)shm_raw; LAS char* shm = (LAS char*)shm_raw;
  phase_prologue(p, lds);
  grid.sync();
  phase_norm1_first(p);
  grid.sync();
  for (int layer = 0; layer < 4; ++layer) {
    const int kind = layer % 3, j = layer / 3; const bool last = layer == 3;
    if (kind == 0) {
      gemm_mfma<128>(p.h, D, p.w_mla_in + (size_t)j * 768 * 1024, 1024, T, 768, 1024, EpiStoreBf16{(bf16_t*)(p.scratch + OFF_A1), 768, 672}, shm);
      grid.sync();
      phase_mla_norm(p, j);
      grid.sync();
      gemm_mfma<128>((const bf16_t*)(p.scratch + OFF_CQN), 384, p.w_uq + (size_t)j * 1536 * 384, 384, T, 1536, 384, EpiQ{(bf16_t*)(p.scratch + OFF_QF)}, shm);
      gemm_mfma<128>((const bf16_t*)(p.scratch + OFF_CKVN), 256, p.w_ukv + (size_t)j * 2048 * 256, 256, T, 2048, 256, EpiKV{(bf16_t*)(p.scratch + OFF_KF), (bf16_t*)(p.scratch + OFF_VF)}, shm);
      grid.sync();
      phase_attn_naive(p, last, lds);
      grid.sync();
      gemm_mfma<128>((const bf16_t*)(p.scratch + OFF_O), D, p.w_mla_o + (size_t)j * 1024 * 1024, 1024, T, 1024, 1024, EpiRes{p.xc, p.out, p.ada, layer, 2048, last}, shm);
      grid.sync();
      phase_norm2(p, layer);
      grid.sync();
    } else if (kind == 1) {
      phase_s5_scan(p, lds);
      grid.sync();
      gemm_mfma<128>((const bf16_t*)(p.scratch + OFF_GIN), D, p.w_glu, 1024, T, 2048, 1024, EpiStoreBf16{(bf16_t*)(p.scratch + OFF_Z), 2048, 2048}, shm);
      grid.sync();
      phase_s5_out(p, layer);
      grid.sync();
    } else {
      gemm_mfma<128>(p.h, D, p.w_gla_in, 1024, T, 4096, 1024, EpiGla{(bf16_t*)(p.scratch + OFF_QKVG), (float*)(p.scratch + OFF_LG), p.gla_gk_b}, shm);
      grid.sync();
      phase_gla_scan(p, lds);
      grid.sync();
      phase_gla_out(p);
      grid.sync();
      gemm_mfma<128>((const bf16_t*)(p.scratch + OFF_GO), D, p.w_gla_o, 1024, T, 1024, 1024, EpiRes{p.xc, p.out, p.ada, layer, 2048, false}, shm);
      grid.sync();
      phase_norm2(p, layer);
      grid.sync();
    }
    gemm_mfma<128>(p.h, D, p.w_pq + (size_t)layer * 1024 * 1024, 1024, T, 1024, 1024, EpiStoreF32{(float*)(p.scratch + OFF_PQ), 1024}, shm);
    phase_peer_tables(p, layer);
    grid.sync();
    phase_peer_subtopk(p, layer, lds);
    grid.sync();
    phase_peer_final_topk(p);
    grid.sync();
    phase_peer_gather8(p, layer);
    if (layer < 3) grid.sync();
  }
}

extern "C" void kernel_launch(void* const* d_in, const int* in_sizes, int n_in, void* d_out,
                              int out_size, void* d_ws, size_t ws_size, hipStream_t stream) {
  static int grid_blocks = 0;
  if (!grid_blocks) {
    int dev = 0, cus = 0, per_cu = 0;
    (void)hipGetDevice(&dev);
    (void)hipDeviceGetAttribute(&cus, hipDeviceAttributeMultiprocessorCount, dev);
    (void)hipOccupancyMaxActiveBlocksPerMultiprocessor(&per_cu, fwd_megakernel, NTHR, 0);
    if (per_cu > 1) per_cu = 1;
    grid_blocks = cus * per_cu;
  }
  Params p{};
  const float* const* in = (const float* const*)d_in;
  p.x = in[0]; p.c = in[1]; p.ctx = in[2]; p.c_ctx = in[3]; p.norm_g = in[4]; p.ada_w = in[5]; p.ada_b = in[6];
  p.mla_w_in = in[7]; p.mla_q_norm = in[8]; p.mla_w_uq = in[9]; p.mla_kv_norm = in[10]; p.mla_w_ukv = in[11]; p.mla_w_o = in[12];
  p.s5_lam_re = in[13]; p.s5_lam_im = in[14]; p.s5_b_re = in[15]; p.s5_b_im = in[16]; p.s5_c_re = in[17]; p.s5_c_im = in[18]; p.s5_log_step = in[19]; p.s5_d = in[20]; p.s5_w_glu = in[21];
  p.gla_w_in = in[22]; p.gla_gk_w1 = in[23]; p.gla_gk_w2 = in[24]; p.gla_gk_b = in[25]; p.gla_o_norm = in[26]; p.gla_w_o = in[27];
  p.peer_w_q = in[28]; p.peer_keys = in[29]; p.peer_u = in[30]; p.peer_v = in[31]; p.final_g = in[32];
  p.out = (float*)d_out;
  char* w = (char*)d_ws; size_t off = 0;
  auto take = [&](size_t bytes) { char* r = w + off; off += (bytes + 255) & ~(size_t)255; return r; };
  p.xc = (float*)take((size_t)NB * CTX * D * 4);
  p.ada = (float*)take((size_t)4 * 17 * 6144 * 4);
  p.rope = (float*)take((size_t)2048 * 32 * 4);
  p.h = (bf16_t*)take((size_t)T * D * 2);
  p.w_mla_in = (bf16_t*)take((size_t)2 * 768 * 1024 * 2);
  p.w_uq = (bf16_t*)take((size_t)2 * 1536 * 384 * 2);
  p.w_ukv = (bf16_t*)take((size_t)2 * 2048 * 256 * 2);
  p.w_mla_o = (bf16_t*)take((size_t)2 * 1024 * 1024 * 2);
  p.w_glu = (bf16_t*)take((size_t)2048 * 1024 * 2);
  p.w_gla_in = (bf16_t*)take((size_t)4096 * 1024 * 2);
  p.w_gla_o = (bf16_t*)take((size_t)1024 * 1024 * 2);
  p.w_pq = (bf16_t*)take((size_t)4 * 1024 * 1024 * 2);
  p.s5_ar = (float*)take(2 * 64 * 64 * 4); p.s5_ai = (float*)take(2 * 64 * 64 * 4);
  p.s5_br = (float*)take(2 * 64 * 64 * 16 * 4); p.s5_bi = (float*)take(2 * 64 * 64 * 16 * 4);
  p.scratch = take(SCRATCH_BYTES);
  if (off > ws_size) { fprintf(stderr, "workspace too small: need %zu have %zu\n", off, ws_size); return; }
  void* args[] = {&p};
  hipError_t e = hipLaunchCooperativeKernel((void*)fwd_megakernel, dim3(grid_blocks), dim3(NTHR), args, 0, stream);
  if (e != hipSuccess) fprintf(stderr, "cooperative launch failed: %s (grid %d)\n", hipGetErrorString(e), grid_blocks);
}
```

```cpp
#include <hip/hip_runtime.h>
#include <hip/hip_cooperative_groups.h>
#include <cstdio>
#include <cstdint>
namespace cg = cooperative_groups;

typedef unsigned short bf16_t;
#define DEV __device__ __forceinline__

DEV int tid_op() { int t = threadIdx.x; asm volatile("" : "+v"(t)); return t; }
DEV int bid_op() { int t = blockIdx.x; asm volatile("" : "+s"(t)); return t; }
#define TIDX tid_op()
#define BIDX bid_op()
constexpr int D = 1024, NB = 16, SEQ = 2048, CTX = 256, SP = 2304, T = NB * SP;
constexpr int NTHR = 512;

struct Params {
  const float *x, *c, *ctx, *c_ctx, *norm_g, *ada_w, *ada_b;
  const float *mla_w_in, *mla_q_norm, *mla_w_uq, *mla_kv_norm, *mla_w_ukv, *mla_w_o;
  const float *s5_lam_re, *s5_lam_im, *s5_b_re, *s5_b_im, *s5_c_re, *s5_c_im, *s5_log_step, *s5_d, *s5_w_glu;
  const float *gla_w_in, *gla_gk_w1, *gla_gk_w2, *gla_gk_b, *gla_o_norm, *gla_w_o;
  const float *peer_w_q, *peer_keys, *peer_u, *peer_v, *final_g;
  float* out;
  float *xc, *ada, *rope;
  bf16_t* h;
  bf16_t *w_mla_in, *w_uq, *w_ukv, *w_mla_o, *w_glu, *w_gla_in, *w_gla_o, *w_pq;
  float *s5_ar, *s5_ai, *s5_br, *s5_bi;
  char* scratch;
};

constexpr size_t MB = 1ull << 20;
constexpr size_t OFF_A1 = 0;
constexpr size_t OFF_CQN = 54 * MB;
constexpr size_t OFF_CKVN = 81 * MB;
constexpr size_t OFF_QF = 99 * MB;
constexpr size_t OFF_KF = 207 * MB;
constexpr size_t OFF_VF = 315 * MB;
constexpr size_t OFF_O = 387 * MB;
constexpr size_t OFF_Y = 0;
constexpr size_t OFF_GIN = 144 * MB;
constexpr size_t OFF_Z = 216 * MB;
constexpr size_t OFF_QKVG = 0;
constexpr size_t OFF_LG = 216 * MB;
constexpr size_t OFF_OD = 360 * MB;
constexpr size_t OFF_GO = 504 * MB;
constexpr size_t OFF_PQ = 0;
constexpr size_t OFF_SV = 144 * MB;
constexpr size_t OFF_SI = 180 * MB;
constexpr size_t OFF_EID = 216 * MB;
constexpr size_t OFF_GATE = 234 * MB;
constexpr size_t OFF_U8 = 256 * MB;
constexpr size_t OFF_V8 = 272 * MB;
constexpr size_t SCRATCH_BYTES = 576 * MB;

DEV float bf2f(bf16_t v) { return __uint_as_float(((unsigned)v) << 16); }
DEV bf16_t f2bf(float f) { unsigned u = __float_as_uint(f); u += 0x7fffu + ((u >> 16) & 1u); return (bf16_t)(u >> 16); }
DEV float wave_sum(float v) {
#pragma unroll
  for (int o = 32; o > 0; o >>= 1) v += __shfl_xor(v, o);
  return v;
}
DEV float gelu_tanh(float x) { float u = 0.7978845608028654f * (x + 0.044715f * x * x * x); return 0.5f * x * (1.f + tanhf(u)); }
DEV float sigm(float x) { return 1.f / (1.f + __expf(-x)); }
DEV float silu(float x) { return x * sigm(x); }

DEV float* xrow_ptr(const Params& p, int t) {
  int b = t / SP, s = t - b * SP;
  return s < CTX ? p.xc + ((size_t)(b * CTX + s)) * D : p.out + ((size_t)(b * SEQ + s - CTX)) * D;
}
DEV const float* ada_ptr(const Params& p, int layer, int t) {
  int b = t / SP, s = t - b * SP;
  return p.ada + ((size_t)(layer * 17 + (s < CTX ? 16 : b))) * 6144;
}

DEV void load_row_f32(const float* row, int lane, float (&v)[16]) {
#pragma unroll
  for (int j = 0; j < 4; ++j) { float4 t = *(const float4*)(row + j * 256 + lane * 4); v[j * 4] = t.x; v[j * 4 + 1] = t.y; v[j * 4 + 2] = t.z; v[j * 4 + 3] = t.w; }
}
DEV void store_row_f32(float* row, int lane, const float (&v)[16]) {
#pragma unroll
  for (int j = 0; j < 4; ++j) *(float4*)(row + j * 256 + lane * 4) = make_float4(v[j * 4], v[j * 4 + 1], v[j * 4 + 2], v[j * 4 + 3]);
}
DEV void norm_mod_store(const float (&v)[16], const float* g, const float* sc, const float* sh, bf16_t* hrow, int lane) {
  float ss = 0.f;
#pragma unroll
  for (int i = 0; i < 16; ++i) ss += v[i] * v[i];
  ss = wave_sum(ss);
  const float rstd = rsqrtf(ss * (1.0f / D) + 1e-6f);
#pragma unroll
  for (int j = 0; j < 4; ++j) {
    const int c0 = j * 256 + lane * 4;
    float4 gg = *(const float4*)(g + c0), s1 = *(const float4*)(sc + c0), s2 = *(const float4*)(sh + c0);
    float y0 = v[j * 4] * rstd * gg.x * (1.f + s1.x) + s2.x, y1 = v[j * 4 + 1] * rstd * gg.y * (1.f + s1.y) + s2.y;
    float y2 = v[j * 4 + 2] * rstd * gg.z * (1.f + s1.z) + s2.z, y3 = v[j * 4 + 3] * rstd * gg.w * (1.f + s1.w) + s2.w;
    uint2 w; w.x = (unsigned)f2bf(y0) | ((unsigned)f2bf(y1) << 16); w.y = (unsigned)f2bf(y2) | ((unsigned)f2bf(y3) << 16);
    *(uint2*)(hrow + c0) = w;
  }
}

DEV void convT(const float* src, bf16_t* dst, int K, int N, int Npad, int rot, float* lds) {
  const int tk = K / 64, tn = Npad / 64, nt = tk * tn, tid = TIDX;
  for (int tile = (BIDX + rot) % gridDim.x; tile < nt; tile += gridDim.x) {
    const int k0 = (tile % tk) * 64, n0 = (tile / tk) * 64;
    __syncthreads();
#pragma unroll
    for (int i = 0; i < 8; ++i) { int idx = tid + i * NTHR, kk = idx >> 6, nn = idx & 63;
      lds[kk * 65 + nn] = (n0 + nn < N) ? src[(size_t)(k0 + kk) * N + n0 + nn] : 0.f; }
    __syncthreads();
#pragma unroll
    for (int i = 0; i < 8; ++i) { int idx = tid + i * NTHR, nn = idx >> 6, kk = idx & 63;
      dst[(size_t)(n0 + nn) * K + k0 + kk] = f2bf(lds[kk * 65 + nn]); }
  }
}

DEV void phase_prologue(const Params& p, float* lds) {
  const int tid = TIDX, gtid = BIDX * NTHR + tid, gn = gridDim.x * NTHR;
  int rot = 0;
  for (int j = 0; j < 2; ++j) {
    convT(p.mla_w_in + (size_t)j * 1024 * 672, p.w_mla_in + (size_t)j * 768 * 1024, 1024, 672, 768, rot, lds); rot += 37;
    convT(p.mla_w_uq + (size_t)j * 384 * 1536, p.w_uq + (size_t)j * 1536 * 384, 384, 1536, 1536, rot, lds); rot += 37;
    convT(p.mla_w_ukv + (size_t)j * 256 * 2048, p.w_ukv + (size_t)j * 2048 * 256, 256, 2048, 2048, rot, lds); rot += 37;
    convT(p.mla_w_o + (size_t)j * 1024 * 1024, p.w_mla_o + (size_t)j * 1024 * 1024, 1024, 1024, 1024, rot, lds); rot += 37;
  }
  convT(p.s5_w_glu, p.w_glu, 1024, 2048, 2048, rot, lds); rot += 37;
  convT(p.gla_w_in, p.w_gla_in, 1024, 3072, 3072, rot, lds); rot += 37;
  convT(p.gla_w_o, p.w_gla_o, 1024, 1024, 1024, rot, lds); rot += 37;
  for (int i = 0; i < 4; ++i) { convT(p.peer_w_q + (size_t)i * 1024 * 1024, p.w_pq + (size_t)i * 1024 * 1024, 1024, 1024, 1024, rot, lds); rot += 37; }
  for (int idx = gtid; idx < 2 * 512 * 1024; idx += gn) {
    const int k = idx & 1023, n = (idx >> 10) & 511, d = idx >> 19;
    const float* w1 = p.gla_gk_w1 + ((size_t)d * 1024 + k) * 16; const float* w2 = p.gla_gk_w2 + (size_t)d * 16 * 512 + n;
    float s = 0.f;
#pragma unroll
    for (int r = 0; r < 16; ++r) s += w1[r] * w2[r * 512];
    p.w_gla_in[(size_t)(3072 + d * 512 + n) * 1024 + k] = f2bf(s);
  }
  for (int idx = gtid; idx < 2048 * 8; idx += gn) {
    const int pos = idx >> 3, i = idx & 7;
    const float inv = powf(10000.0f, -(float)i / 8.0f);
    const float ar = (float)(pos / 64) * inv, ac = (float)(pos % 64) * inv;
    float* r = p.rope + pos * 32;
    r[i] = cosf(ar); r[8 + i] = sinf(ar); r[16 + i] = cosf(ac); r[24 + i] = sinf(ac);
  }
  for (int idx = gtid; idx < 2 * 64 * 64; idx += gn) {
    const int g = (idx >> 6) & 63, d = idx >> 12;
    const float lr = p.s5_lam_re[idx], li = p.s5_lam_im[idx], dt = expf(p.s5_log_step[d * 64 + g]);
    const float mag = expf(lr * dt), ar = mag * cosf(li * dt), ai = mag * sinf(li * dt), den = lr * lr + li * li;
    const float fr = ((ar - 1.f) * lr + ai * li) / den, fi = (ai * lr - (ar - 1.f) * li) / den;
    p.s5_ar[idx] = ar; p.s5_ai[idx] = ai;
    for (int c = 0; c < 16; ++c) { const float bre = p.s5_b_re[idx * 16 + c], bim = p.s5_b_im[idx * 16 + c];
      p.s5_br[idx * 16 + c] = fr * bre - fi * bim; p.s5_bi[idx * 16 + c] = fr * bim + fi * bre; }
  }
  {
    float* s = lds;
    float* part = lds + 17 * 1024;
    __syncthreads();
    for (int idx = tid; idx < 17 * 1024; idx += NTHR) { const int r = idx >> 10, k = idx & 1023; const float cv = r < 16 ? p.c[r * 1024 + k] : p.c_ctx[k]; s[idx] = silu(cv); }
    __syncthreads();
    for (int cb = BIDX; cb < 4 * 64; cb += gridDim.x) {
      const int layer = cb >> 6, n0 = (cb & 63) * 96;
      if (tid < 384) {
        const int col = tid % 96, kq = tid / 96;
        float acc[17];
#pragma unroll
        for (int r = 0; r < 17; ++r) acc[r] = 0.f;
        const float* w = p.ada_w + (size_t)layer * 1024 * 6144 + n0 + col;
        for (int k = kq * 256; k < kq * 256 + 256; ++k) { const float wv = w[(size_t)k * 6144];
#pragma unroll
          for (int r = 0; r < 17; ++r) acc[r] += s[r * 1024 + k] * wv; }
#pragma unroll
        for (int r = 0; r < 17; ++r) part[(kq * 96 + col) * 17 + r] = acc[r];
      }
      __syncthreads();
      for (int idx = tid; idx < 96 * 17; idx += NTHR) { const int col = idx / 17, r = idx % 17;
        const float v = part[(0 * 96 + col) * 17 + r] + part[(1 * 96 + col) * 17 + r] + part[(2 * 96 + col) * 17 + r] + part[(3 * 96 + col) * 17 + r];
        p.ada[((size_t)(layer * 17 + r)) * 6144 + n0 + col] = v + p.ada_b[layer * 6144 + n0 + col]; }
      __syncthreads();
    }
  }
}

DEV void phase_norm1_first(const Params& p) {
  const int lane = TIDX & 63, gw = BIDX * (NTHR / 64) + (TIDX >> 6), nw = gridDim.x * (NTHR / 64);
  for (int t = gw; t < T; t += nw) {
    const int b = t / SP, s = t - b * SP;
    const float* src = s < CTX ? p.ctx + ((size_t)(b * CTX + s)) * D : p.x + ((size_t)(b * SEQ + s - CTX)) * D;
    float v[16]; load_row_f32(src, lane, v);
    store_row_f32(xrow_ptr(p, t), lane, v);
    const float* ad = ada_ptr(p, 0, t);
    norm_mod_store(v, p.norm_g, ad + 1024, ad, p.h + (size_t)t * D, lane);
  }
}
DEV void phase_norm2(const Params& p, int layer) {
  const int lane = TIDX & 63, gw = BIDX * (NTHR / 64) + (TIDX >> 6), nw = gridDim.x * (NTHR / 64);
  for (int t = gw; t < T; t += nw) {
    float v[16]; load_row_f32(xrow_ptr(p, t), lane, v);
    const float* ad = ada_ptr(p, layer, t);
    norm_mod_store(v, p.norm_g + (layer * 2 + 1) * D, ad + 4096, ad + 3072, p.h + (size_t)t * D, lane);
  }
}

template <class Epi>
DEV void gemm_naive(const bf16_t* A, int lda, const bf16_t* Bt, int ldb, int M, int N, int K, const Epi& epi, float* lds) {
  float* As = lds;
  float* Bs = lds + 16 * 132;
  const int tid = TIDX, ty = tid >> 5, tx = tid & 31, nM = M / 128, nN = N / 128;
  const int lrow = tid >> 2, lkq = tid & 3;
  for (int tile = BIDX; tile < nM * nN; tile += gridDim.x) {
    const int pm = tile / nN, pn = tile - pm * nN;
    float acc[8][4];
#pragma unroll
    for (int i = 0; i < 8; ++i)
#pragma unroll
      for (int j = 0; j < 4; ++j) acc[i][j] = 0.f;
    const bf16_t* ap = A + (size_t)(pm * 128 + lrow) * lda + lkq * 4;
    const bf16_t* bp = Bt + (size_t)(pn * 128 + lrow) * ldb + lkq * 4;
    for (int k0 = 0; k0 < K; k0 += 16) {
      const uint2 av = *(const uint2*)(ap + k0), bv = *(const uint2*)(bp + k0);
      __syncthreads();
      As[(lkq * 4 + 0) * 132 + lrow] = __uint_as_float(av.x << 16); As[(lkq * 4 + 1) * 132 + lrow] = __uint_as_float(av.x & 0xffff0000u);
      As[(lkq * 4 + 2) * 132 + lrow] = __uint_as_float(av.y << 16); As[(lkq * 4 + 3) * 132 + lrow] = __uint_as_float(av.y & 0xffff0000u);
      Bs[(lkq * 4 + 0) * 132 + lrow] = __uint_as_float(bv.x << 16); Bs[(lkq * 4 + 1) * 132 + lrow] = __uint_as_float(bv.x & 0xffff0000u);
      Bs[(lkq * 4 + 2) * 132 + lrow] = __uint_as_float(bv.y << 16); Bs[(lkq * 4 + 3) * 132 + lrow] = __uint_as_float(bv.y & 0xffff0000u);
      __syncthreads();
#pragma unroll 2
      for (int kk = 0; kk < 16; ++kk) {
        const float4 a0 = *(const float4*)(As + kk * 132 + ty * 8), a1 = *(const float4*)(As + kk * 132 + ty * 8 + 4), b0 = *(const float4*)(Bs + kk * 132 + tx * 4);
        const float a[8] = {a0.x, a0.y, a0.z, a0.w, a1.x, a1.y, a1.z, a1.w}, b[4] = {b0.x, b0.y, b0.z, b0.w};
#pragma unroll
        for (int i = 0; i < 8; ++i)
#pragma unroll
          for (int j = 0; j < 4; ++j) acc[i][j] += a[i] * b[j];
      }
    }
#pragma unroll
    for (int i = 0; i < 8; ++i)
#pragma unroll
      for (int j = 0; j < 4; ++j) epi(pm * 128 + ty * 8 + i, pn * 128 + tx * 4 + j, acc[i][j]);
  }
}


#define LAS __attribute__((address_space(3)))
typedef short bf16x8 __attribute__((ext_vector_type(8)));
typedef float f32x4 __attribute__((ext_vector_type(4)));
DEV int lds_byte2(int r, int c) { const int st = (r >> 4) * 2 + (c >> 5), ob = (r & 15) * 64 + (c & 31) * 2; return st * 1024 + (ob ^ (((ob >> 9) & 1) << 5)); }
DEV void stage_rc2(int b, int& R, int& C) { const int st = b >> 10, sb = b & 1023, swz = sb ^ (((sb >> 9) & 1) << 5); R = (st >> 1) * 16 + (swz >> 6); C = (st & 1) * 32 + ((swz & 63) >> 1); }

template <int BM, class Epi>
DEV void gemm_mfma(const bf16_t* A, int lda, const bf16_t* Bt, int ldb, int M, int N, int K, const Epi& epi, LAS char* shm) {
  constexpr int MF = BM / 32, TA = BM * 128, TB = 256 * 128, STG = TA + TB, GA = TA / 8192, GB = TB / 8192;
  const int tid = TIDX, wid = __builtin_amdgcn_readfirstlane(tid >> 6), lane = tid & 63, wr = wid >> 2, wc = wid & 3, fr = lane & 15, fq = lane >> 4;
  int offA[GB], offB[GB];
#pragma unroll
  for (int i = 0; i < GB; ++i) { int R, C; stage_rc2(wid * 1024 + i * 8192 + lane * 16, R, C); offA[i] = R * lda + C; offB[i] = R * ldb + C; }
  const int nM = M / BM, nN = N / 256, ntile = nM * nN, nt = K / 64;
  const int G = gridDim.x, bid = BIDX, vb = (bid & 7) * (G >> 3) + (bid >> 3);
  int aoff[MF], boff[4];
#pragma unroll
  for (int m = 0; m < MF; ++m) aoff[m] = lds_byte2(wr * (BM / 2) + m * 16 + fr, fq * 8);
#pragma unroll
  for (int n = 0; n < 4; ++n) boff[n] = TA + lds_byte2(wc * 64 + n * 16 + fr, fq * 8);
  for (int tile = vb; tile < ntile; tile += G) {
    const int pm = tile / nN, pn = tile - pm * nN;
    const bf16_t* Ab = A + (size_t)pm * BM * lda; const bf16_t* Bb = Bt + (size_t)pn * 256 * ldb;
    f32x4 acc[MF][4];
#pragma unroll
    for (int m = 0; m < MF; ++m)
#pragma unroll
      for (int n = 0; n < 4; ++n) acc[m][n] = (f32x4){0.f, 0.f, 0.f, 0.f};
#define GSTAGE(buf, kt) do { _Pragma("unroll") for (int i = 0; i < GB; ++i) { \
      if (i < GA) __builtin_amdgcn_global_load_lds((const unsigned*)(Ab + offA[i] + (kt) * 64), (LAS unsigned*)(shm + (buf) * STG + wid * 1024 + i * 8192), 16, 0, 0); \
      __builtin_amdgcn_global_load_lds((const unsigned*)(Bb + offB[i] + (kt) * 64), (LAS unsigned*)(shm + (buf) * STG + TA + wid * 1024 + i * 8192), 16, 0, 0); } } while (0)
    GSTAGE(0, 0);
    asm volatile("s_waitcnt vmcnt(0)" ::: "memory"); __syncthreads();
    for (int t = 0; t < nt; ++t) {
      const int cur = t & 1;
      if (t + 1 < nt) GSTAGE(cur ^ 1, t + 1);
#pragma unroll
      for (int ks = 0; ks < 2; ++ks) {
        bf16x8 At[MF], Bf[4];
#pragma unroll
        for (int m = 0; m < MF; ++m) At[m] = *(const LAS bf16x8*)(shm + cur * STG + (aoff[m] ^ 0) + ks * 1024);
#pragma unroll
        for (int n = 0; n < 4; ++n) Bf[n] = *(const LAS bf16x8*)(shm + cur * STG + boff[n] + ks * 1024);
#pragma unroll
        for (int m = 0; m < MF; ++m)
#pragma unroll
          for (int n = 0; n < 4; ++n) acc[m][n] = __builtin_amdgcn_mfma_f32_16x16x32_bf16(At[m], Bf[n], acc[m][n], 0, 0, 0);
      }
      asm volatile("s_waitcnt vmcnt(0)" ::: "memory"); __syncthreads();
    }
#undef GSTAGE
    const int row0 = pm * BM + wr * (BM / 2) + fq * 4, col0 = pn * 256 + wc * 64 + fr;
#pragma unroll
    for (int m = 0; m < MF; ++m)
#pragma unroll
      for (int n = 0; n < 4; ++n)
        epi(row0 + m * 16, col0 + n * 16, acc[m][n]);
  }
}

struct EpiStoreBf16 { bf16_t* C; int ldc; int ncols; DEV void operator()(int r, int c, f32x4 v) const { if (c < ncols) {
#pragma unroll
    for (int j = 0; j < 4; ++j) C[(size_t)(r + j) * ldc + c] = f2bf(v[j]); } } };
struct EpiStoreF32 { float* C; int ldc; DEV void operator()(int r, int c, f32x4 v) const {
#pragma unroll
    for (int j = 0; j < 4; ++j) C[(size_t)(r + j) * ldc + c] = v[j]; } };
struct EpiQ { bf16_t* QF; DEV void operator()(int r, int c, f32x4 v) const { const int b = r / SP, s = r - b * SP, h = c / 96, d = c - h * 96;
#pragma unroll
    for (int j = 0; j < 4; ++j) QF[((size_t)(b * 16 + h) * SP + s + j) * 96 + d] = f2bf(v[j]); } };
struct EpiKV { bf16_t* KF; bf16_t* VT; DEV void operator()(int r, int c, f32x4 v) const { const int b = r / SP, s = r - b * SP, h = c >> 7, d = c & 127;
    if (d < 64) {
#pragma unroll
      for (int j = 0; j < 4; ++j) KF[((size_t)(b * 16 + h) * SP + s + j) * 96 + d] = f2bf(v[j]);
    } else { uint2 w; w.x = (unsigned)f2bf(v[0]) | ((unsigned)f2bf(v[1]) << 16); w.y = (unsigned)f2bf(v[2]) | ((unsigned)f2bf(v[3]) << 16);
      *(uint2*)(VT + ((size_t)(b * 16 + h) * 64 + d - 64) * SP + s) = w; } } };
struct EpiRes { float* xc; float* out; const float* ada; int layer; int goff; bool last;
  DEV void operator()(int r, int c, f32x4 v) const { const int b = r / SP, s = r - b * SP;
    if (s < CTX) { if (last) return; const float g = ada[((size_t)(layer * 17 + 16)) * 6144 + goff + c];
#pragma unroll
      for (int j = 0; j < 4; ++j) xc[((size_t)(b * CTX + s + j)) * D + c] += g * v[j]; }
    else { const float g = ada[((size_t)(layer * 17 + b)) * 6144 + goff + c];
#pragma unroll
      for (int j = 0; j < 4; ++j) out[((size_t)(b * SEQ + s - CTX + j)) * D + c] += g * v[j]; } } };
struct EpiGla { bf16_t* QKVG; float* LG; const float* gkb;
  DEV void operator()(int r, int c, f32x4 v) const {
    if (c < 3072) { const float sc = c < 512 ? 0.08838834764831845f : 1.0f;
#pragma unroll
      for (int j = 0; j < 4; ++j) QKVG[(size_t)(r + j) * 3072 + c] = f2bf(v[j] * sc); }
    else { const int d = (c - 3072) >> 9, n = (c - 3072) & 511; const float bias = gkb[d * 512 + n];
#pragma unroll
      for (int j = 0; j < 4; ++j) { const float z = v[j] + bias; const float ls = fminf(z, 0.f) - log1pf(__expf(-fabsf(z)));
        LG[((size_t)d * T + r + j) * 512 + n] = ls * (1.0f / 16.0f); } } } };

DEV void phase_mla_norm(const Params& p, int j) {
  const bf16_t* A1 = (const bf16_t*)(p.scratch + OFF_A1); bf16_t* CQN = (bf16_t*)(p.scratch + OFF_CQN); bf16_t* CKVN = (bf16_t*)(p.scratch + OFF_CKVN); bf16_t* KF = (bf16_t*)(p.scratch + OFF_KF);
  const int lane = TIDX & 63, gw = BIDX * (NTHR / 64) + (TIDX >> 6), nw = gridDim.x * (NTHR / 64);
  const float* qn = p.mla_q_norm + j * 384; const float* kn = p.mla_kv_norm + j * 256;
  for (int t = gw; t < T; t += nw) {
    const bf16_t* a = A1 + (size_t)t * 768;
    float v[6], ss = 0.f;
#pragma unroll
    for (int i = 0; i < 6; ++i) { v[i] = bf2f(a[lane + 64 * i]); ss += v[i] * v[i]; }
    ss = wave_sum(ss); float rstd = rsqrtf(ss * (1.0f / 384.0f) + 1e-6f);
#pragma unroll
    for (int i = 0; i < 6; ++i) CQN[(size_t)t * 384 + lane + 64 * i] = f2bf(v[i] * rstd * qn[lane + 64 * i]);
    float w[4]; ss = 0.f;
#pragma unroll
    for (int i = 0; i < 4; ++i) { w[i] = bf2f(a[384 + lane + 64 * i]); ss += w[i] * w[i]; }
    ss = wave_sum(ss); rstd = rsqrtf(ss * (1.0f / 256.0f) + 1e-6f);
#pragma unroll
    for (int i = 0; i < 4; ++i) CKVN[(size_t)t * 256 + lane + 64 * i] = f2bf(w[i] * rstd * kn[lane + 64 * i]);
    const int b = t / SP, s = t - b * SP;
    float val = bf2f(a[640 + (lane & 31)]);
    const float other = __shfl_xor(val, 8);
    if (s >= CTX) { const int pos = s - CTX, d = lane & 31, hb = d >> 4, dd = d & 15, i = dd & 7;
      const float cs = p.rope[pos * 32 + hb * 16 + i], sn = p.rope[pos * 32 + hb * 16 + 8 + i];
      val = dd < 8 ? val * cs - other * sn : val * cs + other * sn; }
    if (lane < 32) { const bf16_t o = f2bf(val);
      for (int hh = 0; hh < 16; ++hh) KF[((size_t)(b * 16 + hh) * SP + s) * 96 + 64 + lane] = o; }
  }
}

DEV void phase_attn_naive(const Params& p, bool last, float* lds) {
  const bf16_t* QF = (const bf16_t*)(p.scratch + OFF_QF); const bf16_t* KF = (const bf16_t*)(p.scratch + OFF_KF); const bf16_t* VF = (const bf16_t*)(p.scratch + OFF_VF);
  bf16_t* O = (bf16_t*)(p.scratch + OFF_O);
  float* Ks = lds;
  float* Vs = lds + 32 * 96;
  const int tid = TIDX;
  const int nitems = 1024 + (last ? 0 : 256);
  for (int item = BIDX; item < nitems; item += gridDim.x) {
    int b, hh, q0, nq, nkeys;
    if (item < 1024) { b = item >> 6; hh = (item >> 2) & 15; q0 = CTX + (item & 3) * 512; nq = 512; nkeys = SP; }
    else { const int it = item - 1024; b = it >> 4; hh = it & 15; q0 = 0; nq = 256; nkeys = CTX; }
    const size_t bh = (size_t)(b * 16 + hh) * SP;
    const bool active = tid < nq;
    const int sq = q0 + (active ? tid : 0);
    float q[96];
    { const bf16_t* qp = QF + (bh + sq) * 96;
#pragma unroll
      for (int i = 0; i < 96; i += 2) { const unsigned u = *(const unsigned*)(qp + i); q[i] = __uint_as_float(u << 16); q[i + 1] = __uint_as_float(u & 0xffff0000u); } }
    if (sq >= CTX) { const float* r = p.rope + (sq - CTX) * 32;
#pragma unroll
      for (int hb = 0; hb < 2; ++hb)
#pragma unroll
        for (int i = 0; i < 8; ++i) { const float cs = r[hb * 16 + i], sn = r[hb * 16 + 8 + i], x1 = q[64 + hb * 16 + i], x2 = q[64 + hb * 16 + 8 + i];
          q[64 + hb * 16 + i] = x1 * cs - x2 * sn; q[64 + hb * 16 + 8 + i] = x2 * cs + x1 * sn; } }
#pragma unroll
    for (int i = 0; i < 96; ++i) q[i] *= 0.10206207261596577f;
    float acc[64], m = -1e30f, l = 0.f;
#pragma unroll
    for (int i = 0; i < 64; ++i) acc[i] = 0.f;
    for (int k0 = 0; k0 < nkeys; k0 += 32) {
      __syncthreads();
      for (int idx = tid; idx < 32 * 96 / 2; idx += NTHR) { const unsigned u = *(const unsigned*)(KF + (bh + k0) * 96 + idx * 2); Ks[idx * 2] = __uint_as_float(u << 16); Ks[idx * 2 + 1] = __uint_as_float(u & 0xffff0000u); }
      for (int idx = tid; idx < 32 * 64 / 2; idx += NTHR) { const unsigned u = *(const unsigned*)(VF + (bh + k0) * 64 + idx * 2); Vs[idx * 2] = __uint_as_float(u << 16); Vs[idx * 2 + 1] = __uint_as_float(u & 0xffff0000u); }
      __syncthreads();
#pragma unroll 1
      for (int kk = 0; kk < 32; ++kk) {
        float s = 0.f;
#pragma unroll
        for (int i = 0; i < 96; i += 4) { const float4 kv = *(const float4*)(Ks + kk * 96 + i); s += q[i] * kv.x + q[i + 1] * kv.y + q[i + 2] * kv.z + q[i + 3] * kv.w; }
        if (s > m) { const float corr = __expf(m - s); l *= corr;
#pragma unroll
          for (int i = 0; i < 64; ++i) acc[i] *= corr;
          m = s; }
        const float pe = __expf(s - m); l += pe;
#pragma unroll
        for (int i = 0; i < 64; i += 4) { const float4 vv = *(const float4*)(Vs + kk * 64 + i); acc[i] += pe * vv.x; acc[i + 1] += pe * vv.y; acc[i + 2] += pe * vv.z; acc[i + 3] += pe * vv.w; }
      }
    }
    if (active) { const float inv = 1.f / l; bf16_t* op = O + ((size_t)(b * SP + sq)) * D + hh * 64;
#pragma unroll
      for (int i = 0; i < 64; i += 2) *(unsigned*)(op + i) = (unsigned)f2bf(acc[i] * inv) | ((unsigned)f2bf(acc[i + 1] * inv) << 16); }
  }
}


typedef float f32x16 __attribute__((ext_vector_type(16)));
typedef unsigned u32x4 __attribute__((ext_vector_type(4)));
typedef unsigned u32x2 __attribute__((ext_vector_type(2)));
DEV unsigned cvt_pk_bf16(float lo, float hi) { unsigned r; asm("v_cvt_pk_bf16_f32 %0, %1, %2" : "=v"(r) : "v"(lo), "v"(hi)); return r; }
DEV void phase_attn_mfma(const Params& p, bool last, LAS char* shm) {
  const bf16_t* QF = (const bf16_t*)(p.scratch + OFF_QF); const bf16_t* KF = (const bf16_t*)(p.scratch + OFF_KF); const bf16_t* VT = (const bf16_t*)(p.scratch + OFF_VF);
  bf16_t* O = (bf16_t*)(p.scratch + OFF_O);
  constexpr int KSTR = 208, VSTR = 136, KBYTES = 64 * KSTR, STAGE = 22528;
  const int tid = TIDX, wid = tid >> 6, lane = tid & 63, ql = lane & 31, hh = lane >> 5;
  const int nitems = 2048 + (last ? 0 : 256), G = gridDim.x;
  const int k_idx0 = tid, k_idx1 = tid + 512;
  const int vd = tid >> 3, vpart = tid & 7;
  for (int item = BIDX; item < nitems; item += G) {
    int b, h, q0, nk;
    if (item < 2048) { b = item >> 7; h = (item >> 3) & 15; q0 = CTX + (item & 7) * 256; nk = SP; }
    else { const int it = item - 2048; b = it >> 4; h = it & 15; q0 = 0; nk = CTX; }
    const size_t bh = (size_t)(b * 16 + h);
    const int sq = q0 + wid * 32 + ql;
    bf16x8 qf[6];
    { const bf16_t* qp = QF + (bh * SP + sq) * 96 + 8 * hh;
      const float qs = 0.10206207261596577f * 1.4426950408889634f;
#pragma unroll
      for (int s = 0; s < 6; ++s) {
        const uint4 w = *(const uint4*)(qp + 16 * s); const unsigned ww[4] = {w.x, w.y, w.z, w.w};
        float v[8];
#pragma unroll
        for (int i = 0; i < 4; ++i) { v[2 * i] = __uint_as_float(ww[i] << 16); v[2 * i + 1] = __uint_as_float(ww[i] & 0xffff0000u); }
        if (s >= 4 && sq >= CTX) { const float* r = p.rope + (sq - CTX) * 32 + (s - 4) * 16;
#pragma unroll
          for (int j = 0; j < 8; ++j) { const float pv = __shfl_xor(v[j], 32), cs = r[j], sn = r[8 + j]; v[j] = hh ? v[j] * cs + pv * sn : v[j] * cs - pv * sn; } }
        unsigned o[4];
#pragma unroll
        for (int i = 0; i < 4; ++i) o[i] = cvt_pk_bf16(v[2 * i] * qs, v[2 * i + 1] * qs);
        qf[s] = __builtin_bit_cast(bf16x8, make_uint4(o[0], o[1], o[2], o[3]));
      } }
    f32x16 oacc[2];
#pragma unroll
    for (int dt = 0; dt < 2; ++dt)
#pragma unroll
      for (int r = 0; r < 16; ++r) oacc[dt][r] = 0.f;
    float m = -1e30f, l = 0.f;
    const int ntile = nk >> 6;
    uint4 kr0, kr1, vr;
    const bf16_t* kbase = KF + bh * SP * 96; const bf16_t* vbase = VT + (bh * 64 + vd) * SP + vpart * 8;
#define ATT_LOAD(t_) do { const int k0_ = (t_) * 64; kr0 = *(const uint4*)(kbase + (size_t)(k0_ + k_idx0 / 12) * 96 + (k_idx0 % 12) * 8); \
      if (k_idx1 < 768) kr1 = *(const uint4*)(kbase + (size_t)(k0_ + k_idx1 / 12) * 96 + (k_idx1 % 12) * 8); vr = *(const uint4*)(vbase + k0_); } while (0)
#define ATT_WRITE(buf_) do { LAS char* kb_ = shm + (buf_) * STAGE; *(LAS u32x4*)(kb_ + (k_idx0 / 12) * KSTR + (k_idx0 % 12) * 16) = (u32x4){kr0.x, kr0.y, kr0.z, kr0.w}; \
      if (k_idx1 < 768) *(LAS u32x4*)(kb_ + (k_idx1 / 12) * KSTR + (k_idx1 % 12) * 16) = (u32x4){kr1.x, kr1.y, kr1.z, kr1.w}; \
      LAS char* vb_ = kb_ + KBYTES + vd * VSTR + vpart * 16; *(LAS u32x2*)vb_ = (u32x2){vr.x, vr.y}; *(LAS u32x2*)(vb_ + 8) = (u32x2){vr.z, vr.w}; } while (0)
    __syncthreads();
    ATT_LOAD(0); ATT_WRITE(0);
    __syncthreads();
    for (int t = 0; t < ntile; ++t) {
      if (t + 1 < ntile) ATT_LOAD(t + 1);
      LAS char* kb = shm + (t & 1) * STAGE; LAS char* vb = kb + KBYTES;
      f32x16 st[2];
#pragma unroll
      for (int kk = 0; kk < 2; ++kk) {
        f32x16 a;
#pragma unroll
        for (int r = 0; r < 16; ++r) a[r] = 0.f;
#pragma unroll
        for (int s = 0; s < 6; ++s) { const bf16x8 kf = *(const LAS bf16x8*)(kb + (kk * 32 + ql) * KSTR + (16 * s + 8 * hh) * 2); a = __builtin_amdgcn_mfma_f32_32x32x16_bf16(kf, qf[s], a, 0, 0, 0); }
        st[kk] = a;
      }
      float mx = st[0][0];
#pragma unroll
      for (int r = 1; r < 16; ++r) mx = fmaxf(mx, st[0][r]);
#pragma unroll
      for (int r = 0; r < 16; ++r) mx = fmaxf(mx, st[1][r]);
      mx = fmaxf(mx, __shfl_xor(mx, 32));
      const float mn = fmaxf(m, mx), corr = __builtin_amdgcn_exp2f(m - mn);
      m = mn; l *= corr;
#pragma unroll
      for (int dt = 0; dt < 2; ++dt)
#pragma unroll
        for (int r = 0; r < 16; ++r) oacc[dt][r] *= corr;
      bf16x8 pf[2][2];
#pragma unroll
      for (int kk = 0; kk < 2; ++kk) {
        float e[16];
#pragma unroll
        for (int r = 0; r < 16; ++r) { e[r] = __builtin_amdgcn_exp2f(st[kk][r] - mn); l += e[r]; }
#pragma unroll
        for (int s2 = 0; s2 < 2; ++s2) pf[kk][s2] = __builtin_bit_cast(bf16x8, make_uint4(cvt_pk_bf16(e[8 * s2], e[8 * s2 + 1]), cvt_pk_bf16(e[8 * s2 + 2], e[8 * s2 + 3]), cvt_pk_bf16(e[8 * s2 + 4], e[8 * s2 + 5]), cvt_pk_bf16(e[8 * s2 + 6], e[8 * s2 + 7])));
      }
#pragma unroll
      for (int dt = 0; dt < 2; ++dt)
#pragma unroll
        for (int kk = 0; kk < 2; ++kk)
#pragma unroll
          for (int s2 = 0; s2 < 2; ++s2) {
            const LAS char* vp = vb + (dt * 32 + ql) * VSTR + (kk * 32 + 16 * s2 + 4 * hh) * 2;
            const u32x2 v0 = *(const LAS u32x2*)vp, v1 = *(const LAS u32x2*)(vp + 16);
            const bf16x8 vf = __builtin_bit_cast(bf16x8, (u32x4){v0.x, v0.y, v1.x, v1.y});
            oacc[dt] = __builtin_amdgcn_mfma_f32_32x32x16_bf16(vf, pf[kk][s2], oacc[dt], 0, 0, 0);
          }
      if (t + 1 < ntile) ATT_WRITE((t + 1) & 1);
      __syncthreads();
    }
#undef ATT_LOAD
#undef ATT_WRITE
    l += __shfl_xor(l, 32);
    const float inv = 1.f / l;
    bf16_t* op = O + ((size_t)(b * SP + sq)) * D + h * 64 + 4 * hh;
#pragma unroll
    for (int dt = 0; dt < 2; ++dt)
#pragma unroll
      for (int g = 0; g < 4; ++g) { uint2 w; w.x = cvt_pk_bf16(oacc[dt][4 * g] * inv, oacc[dt][4 * g + 1] * inv); w.y = cvt_pk_bf16(oacc[dt][4 * g + 2] * inv, oacc[dt][4 * g + 3] * inv);
        *(uint2*)(op + dt * 32 + 8 * g) = w; }
  }
}

#define INSERT16(val, pay, tv, ti) { float s_ = (val); int i_ = (pay); _Pragma("unroll") for (int j_ = 0; j_ < 16; ++j_) { if (s_ > tv[j_]) { float t_ = tv[j_]; tv[j_] = s_; s_ = t_; int u_ = ti[j_]; ti[j_] = i_; i_ = u_; } } }

DEV void phase_peer_subtopk(const Params& p, int layer, float* lds) {
  const float* PQ = (const float*)(p.scratch + OFF_PQ); float* SV = (float*)(p.scratch + OFF_SV); int* SI = (int*)(p.scratch + OFF_SI);
  const int tid = TIDX;
  for (int item = BIDX; item < 16 * 72; item += gridDim.x) {
    const int hp = item / 72, tb = item - hp * 72, t = tb * 512 + tid;
    __syncthreads();
    const float* kp = p.peer_keys + ((size_t)(layer * 16 + hp)) * 128 * 64;
    for (int idx = tid; idx < 128 * 64 / 4; idx += NTHR) *(float4*)(lds + idx * 4) = *(const float4*)(kp + idx * 4);
    __syncthreads();
    float q[64];
#pragma unroll
    for (int i = 0; i < 64; i += 4) { const float4 v = *(const float4*)(PQ + (size_t)t * 1024 + hp * 64 + i); q[i] = v.x; q[i + 1] = v.y; q[i + 2] = v.z; q[i + 3] = v.w; }
    float tv[16]; int ti[16];
#pragma unroll
    for (int j = 0; j < 16; ++j) { tv[j] = -3.0e38f; ti[j] = 0; }
#pragma unroll 1
    for (int key = 0; key < 128; ++key) {
      float s = 0.f;
#pragma unroll
      for (int i = 0; i < 64; i += 4) { const float4 kv = *(const float4*)(lds + key * 64 + i); s += q[i] * kv.x + q[i + 1] * kv.y + q[i + 2] * kv.z + q[i + 3] * kv.w; }
      INSERT16(s, key, tv, ti);
    }
#pragma unroll
    for (int j = 0; j < 16; ++j) { SV[((size_t)t * 16 + hp) * 16 + j] = tv[j]; SI[((size_t)t * 16 + hp) * 16 + j] = ti[j]; }
  }
}

DEV void phase_peer_final_topk(const Params& p) {
  const float* SV = (const float*)(p.scratch + OFF_SV); const int* SI = (const int*)(p.scratch + OFF_SI);
  int* EID = (int*)(p.scratch + OFF_EID); float* GATE = (float*)(p.scratch + OFF_GATE);
  for (int idx = BIDX * NTHR + TIDX; idx < T * 8; idx += gridDim.x * NTHR) {
    float a[16], bq[16]; int ia[16], ib[16];
#pragma unroll
    for (int j = 0; j < 16; ++j) { a[j] = SV[(size_t)idx * 32 + j]; ia[j] = SI[(size_t)idx * 32 + j]; bq[j] = SV[(size_t)idx * 32 + 16 + j]; ib[j] = SI[(size_t)idx * 32 + 16 + j]; }
    float tv[16]; int ti[16];
#pragma unroll
    for (int j = 0; j < 16; ++j) { tv[j] = -3.0e38f; ti[j] = 0; }
#pragma unroll
    for (int i0 = 0; i0 < 16; ++i0)
#pragma unroll
      for (int i1 = 0; i1 < 16; ++i1)
        if ((i0 + 1) * (i1 + 1) <= 16) INSERT16(a[i0] + bq[i1], ia[i0] * 128 + ib[i1], tv, ti);
    float e[16], sum = 0.f;
#pragma unroll
    for (int j = 0; j < 16; ++j) { e[j] = __expf(tv[j] - tv[0]); sum += e[j]; }
    const float inv = 1.f / sum;
#pragma unroll
    for (int j = 0; j < 16; ++j) { EID[(size_t)idx * 16 + j] = ti[j]; GATE[(size_t)idx * 16 + j] = e[j] * inv; }
  }
}

DEV void phase_peer_gather(const Params& p, int layer) {
  const int* EID = (const int*)(p.scratch + OFF_EID); const float* GATE = (const float*)(p.scratch + OFF_GATE);
  const int lane = TIDX & 63, gw = BIDX * (NTHR / 64) + (TIDX >> 6), nw = gridDim.x * (NTHR / 64);
  const bool last = layer == 3;
  const float* U = p.peer_u + (size_t)layer * 16384 * 1024; const float* V = p.peer_v + (size_t)layer * 16384 * 1024;
  for (int t = gw; t < T; t += nw) {
    const int b = t / SP, s = t - b * SP;
    if (last && s < CTX) continue;
    float x[16];
    { const bf16_t* hr = p.h + (size_t)t * D;
#pragma unroll
      for (int j = 0; j < 4; ++j) { const uint2 w = *(const uint2*)(hr + j * 256 + lane * 4); x[j * 4] = __uint_as_float(w.x << 16); x[j * 4 + 1] = __uint_as_float(w.x & 0xffff0000u); x[j * 4 + 2] = __uint_as_float(w.y << 16); x[j * 4 + 3] = __uint_as_float(w.y & 0xffff0000u); } }
    float f[16];
#pragma unroll
    for (int i = 0; i < 16; ++i) f[i] = 0.f;
#pragma unroll 2
    for (int e = 0; e < 128; ++e) {
      const int eid = EID[(size_t)t * 128 + e]; const float gate = GATE[(size_t)t * 128 + e];
      const float* ur = U + (size_t)eid * 1024; const float* vr = V + (size_t)eid * 1024;
      float4 uu[4], vv[4];
#pragma unroll
      for (int j = 0; j < 4; ++j) { uu[j] = *(const float4*)(ur + j * 256 + lane * 4); vv[j] = *(const float4*)(vr + j * 256 + lane * 4); }
      float dsum = 0.f;
#pragma unroll
      for (int j = 0; j < 4; ++j) dsum += uu[j].x * x[j * 4] + uu[j].y * x[j * 4 + 1] + uu[j].z * x[j * 4 + 2] + uu[j].w * x[j * 4 + 3];
      dsum = wave_sum(dsum);
      const float w = gate * gelu_tanh(dsum);
#pragma unroll
      for (int j = 0; j < 4; ++j) { f[j * 4] += w * vv[j].x; f[j * 4 + 1] += w * vv[j].y; f[j * 4 + 2] += w * vv[j].z; f[j * 4 + 3] += w * vv[j].w; }
    }
    float* xr = xrow_ptr(p, t);
    float xv[16]; load_row_f32(xr, lane, xv);
    const float* ad = ada_ptr(p, layer, t);
#pragma unroll
    for (int j = 0; j < 4; ++j) { const float4 g2 = *(const float4*)(ad + 5120 + j * 256 + lane * 4);
      xv[j * 4] += g2.x * f[j * 4]; xv[j * 4 + 1] += g2.y * f[j * 4 + 1]; xv[j * 4 + 2] += g2.z * f[j * 4 + 2]; xv[j * 4 + 3] += g2.w * f[j * 4 + 3]; }
    if (!last) {
      store_row_f32(xr, lane, xv);
      const float* ad2 = ada_ptr(p, layer + 1, t);
      norm_mod_store(xv, p.norm_g + ((layer + 1) * 2) * D, ad2 + 1024, ad2, p.h + (size_t)t * D, lane);
    } else {
      float ss = 0.f;
#pragma unroll
      for (int i = 0; i < 16; ++i) ss += xv[i] * xv[i];
      ss = wave_sum(ss); const float rstd = rsqrtf(ss * (1.0f / D) + 1e-6f);
#pragma unroll
      for (int j = 0; j < 4; ++j) { const float4 g = *(const float4*)(p.final_g + j * 256 + lane * 4);
        xv[j * 4] *= rstd * g.x; xv[j * 4 + 1] *= rstd * g.y; xv[j * 4 + 2] *= rstd * g.z; xv[j * 4 + 3] *= rstd * g.w; }
      store_row_f32(xr, lane, xv);
    }
  }
}


typedef float f32x2 __attribute__((ext_vector_type(2)));
constexpr float U8_SCALE = 1024.0f, V8_SCALE = 64.0f;
DEV unsigned pack4_fp8(float a, float b, float c, float d, float sc) {
  a = fminf(fmaxf(a * sc, -448.f), 448.f); b = fminf(fmaxf(b * sc, -448.f), 448.f); c = fminf(fmaxf(c * sc, -448.f), 448.f); d = fminf(fmaxf(d * sc, -448.f), 448.f);
  int w = 0; w = __builtin_amdgcn_cvt_pk_fp8_f32(a, b, w, false); w = __builtin_amdgcn_cvt_pk_fp8_f32(c, d, w, true); return (unsigned)w;
}
DEV void phase_peer_tables(const Params& p, int layer) {
  uint4* U8 = (uint4*)(p.scratch + OFF_U8); uint4* V8 = (uint4*)(p.scratch + OFF_V8);
  const float4* U = (const float4*)(p.peer_u + (size_t)layer * 16384 * 1024); const float4* V = (const float4*)(p.peer_v + (size_t)layer * 16384 * 1024);
  const int n16 = 16384 * 1024 / 16;
  for (int i = BIDX * NTHR + TIDX; i < n16; i += gridDim.x * NTHR) {
    { const float4 a = U[(size_t)i * 4], b = U[(size_t)i * 4 + 1], c = U[(size_t)i * 4 + 2], d = U[(size_t)i * 4 + 3];
      U8[i] = make_uint4(pack4_fp8(a.x, a.y, a.z, a.w, U8_SCALE), pack4_fp8(b.x, b.y, b.z, b.w, U8_SCALE), pack4_fp8(c.x, c.y, c.z, c.w, U8_SCALE), pack4_fp8(d.x, d.y, d.z, d.w, U8_SCALE)); }
    { const float4 a = V[(size_t)i * 4], b = V[(size_t)i * 4 + 1], c = V[(size_t)i * 4 + 2], d = V[(size_t)i * 4 + 3];
      V8[i] = make_uint4(pack4_fp8(a.x, a.y, a.z, a.w, V8_SCALE), pack4_fp8(b.x, b.y, b.z, b.w, V8_SCALE), pack4_fp8(c.x, c.y, c.z, c.w, V8_SCALE), pack4_fp8(d.x, d.y, d.z, d.w, V8_SCALE)); }
  }
}
DEV float rdlane_f(float v, int l) { return __builtin_bit_cast(float, __builtin_amdgcn_readlane(__builtin_bit_cast(int, v), l)); }

DEV void phase_peer_gather8(const Params& p, int layer) {
  const int* EID = (const int*)(p.scratch + OFF_EID); const float* GATE = (const float*)(p.scratch + OFF_GATE);
  const uint4* U8 = (const uint4*)(p.scratch + OFF_U8); const uint4* V8 = (const uint4*)(p.scratch + OFF_V8);
  const int lane = TIDX & 63, gw = BIDX * (NTHR / 64) + (TIDX >> 6), nw = gridDim.x * (NTHR / 64);
  const bool last = layer == 3;
  for (int t = gw; t < T; t += nw) {
    const int b = t / SP, s = t - b * SP;
    if (last && s < CTX) continue;
    f32x2 x[8];
    { const bf16_t* hr = p.h + (size_t)t * D + lane * 16; const uint4 h0 = *(const uint4*)hr, h1 = *(const uint4*)(hr + 8);
      const unsigned hw[8] = {h0.x, h0.y, h0.z, h0.w, h1.x, h1.y, h1.z, h1.w};
#pragma unroll
      for (int i = 0; i < 8; ++i) { x[i].x = __uint_as_float(hw[i] << 16); x[i].y = __uint_as_float(hw[i] & 0xffff0000u); } }
    f32x2 f[8];
#pragma unroll
    for (int i = 0; i < 8; ++i) f[i] = (f32x2){0.f, 0.f};
#pragma unroll 1
    for (int grp = 0; grp < 16; ++grp) {
      const int eidv = EID[(size_t)t * 128 + grp * 8 + (lane & 7)];
      const float gv = GATE[(size_t)t * 128 + grp * 8 + ((lane >> 3) & 7)];
      uint4 uu[8], vv[8];
#pragma unroll
      for (int r = 0; r < 8; ++r) { const int e = __builtin_amdgcn_readlane(eidv, r); uu[r] = U8[(size_t)e * 64 + lane]; vv[r] = V8[(size_t)e * 64 + lane]; }
      float d[8];
#pragma unroll
      for (int r = 0; r < 8; ++r) {
        const unsigned uw[4] = {uu[r].x, uu[r].y, uu[r].z, uu[r].w};
        f32x2 acc = (f32x2){0.f, 0.f};
#pragma unroll
        for (int q = 0; q < 4; ++q) { acc += x[2 * q] * __builtin_amdgcn_cvt_pk_f32_fp8((int)uw[q], false); acc += x[2 * q + 1] * __builtin_amdgcn_cvt_pk_f32_fp8((int)uw[q], true); }
        d[r] = acc.x + acc.y;
      }
#pragma unroll
      for (int i = 0; i < 4; ++i) { const bool hi = lane & 32; const float send = hi ? d[i] : d[i + 4], keep = hi ? d[i + 4] : d[i]; d[i] = keep + __shfl_xor(send, 32); }
#pragma unroll
      for (int i = 0; i < 2; ++i) { const bool hi = lane & 16; const float send = hi ? d[i] : d[i + 2], keep = hi ? d[i + 2] : d[i]; d[i] = keep + __shfl_xor(send, 16); }
      { const bool hi = lane & 8; const float send = hi ? d[0] : d[1], keep = hi ? d[1] : d[0]; d[0] = keep + __shfl_xor(send, 8); }
      d[0] += __shfl_xor(d[0], 4); d[0] += __shfl_xor(d[0], 2); d[0] += __shfl_xor(d[0], 1);
      const float w = gv * gelu_tanh(d[0] * (1.0f / U8_SCALE));
#pragma unroll
      for (int r = 0; r < 8; ++r) {
        const float wr = rdlane_f(w, r * 8);
        const unsigned vw[4] = {vv[r].x, vv[r].y, vv[r].z, vv[r].w};
#pragma unroll
        for (int q = 0; q < 4; ++q) { f[2 * q] += wr * __builtin_amdgcn_cvt_pk_f32_fp8((int)vw[q], false); f[2 * q + 1] += wr * __builtin_amdgcn_cvt_pk_f32_fp8((int)vw[q], true); }
      }
    }
    float* xr = xrow_ptr(p, t) + lane * 16;
    const float* ad = ada_ptr(p, layer, t);
    float xv[16];
#pragma unroll
    for (int j = 0; j < 4; ++j) { const float4 xx = *(const float4*)(xr + j * 4), g2 = *(const float4*)(ad + 5120 + lane * 16 + j * 4);
      xv[j * 4] = xx.x + g2.x * f[2 * j].x * (1.0f / V8_SCALE); xv[j * 4 + 1] = xx.y + g2.y * f[2 * j].y * (1.0f / V8_SCALE);
      xv[j * 4 + 2] = xx.z + g2.z * f[2 * j + 1].x * (1.0f / V8_SCALE); xv[j * 4 + 3] = xx.w + g2.w * f[2 * j + 1].y * (1.0f / V8_SCALE); }
    float ss = 0.f;
#pragma unroll
    for (int i = 0; i < 16; ++i) ss += xv[i] * xv[i];
    ss = wave_sum(ss); const float rstd = rsqrtf(ss * (1.0f / D) + 1e-6f);
    if (!last) {
#pragma unroll
      for (int j = 0; j < 4; ++j) *(float4*)(xr + j * 4) = make_float4(xv[j * 4], xv[j * 4 + 1], xv[j * 4 + 2], xv[j * 4 + 3]);
      const float* ad2 = ada_ptr(p, layer + 1, t); const float* g = p.norm_g + ((layer + 1) * 2) * D;
      unsigned ow[8];
#pragma unroll
      for (int j = 0; j < 4; ++j) { const int c0 = lane * 16 + j * 4; const float4 gg = *(const float4*)(g + c0), s1 = *(const float4*)(ad2 + 1024 + c0), s2 = *(const float4*)(ad2 + c0);
        const float y0 = xv[j * 4] * rstd * gg.x * (1.f + s1.x) + s2.x, y1 = xv[j * 4 + 1] * rstd * gg.y * (1.f + s1.y) + s2.y;
        const float y2 = xv[j * 4 + 2] * rstd * gg.z * (1.f + s1.z) + s2.z, y3 = xv[j * 4 + 3] * rstd * gg.w * (1.f + s1.w) + s2.w;
        ow[j * 2] = (unsigned)f2bf(y0) | ((unsigned)f2bf(y1) << 16); ow[j * 2 + 1] = (unsigned)f2bf(y2) | ((unsigned)f2bf(y3) << 16); }
      bf16_t* hw = p.h + (size_t)t * D + lane * 16;
      *(uint4*)hw = make_uint4(ow[0], ow[1], ow[2], ow[3]); *(uint4*)(hw + 8) = make_uint4(ow[4], ow[5], ow[6], ow[7]);
    } else {
#pragma unroll
      for (int j = 0; j < 4; ++j) { const float4 g = *(const float4*)(p.final_g + lane * 16 + j * 4);
        *(float4*)(xr + j * 4) = make_float4(xv[j * 4] * rstd * g.x, xv[j * 4 + 1] * rstd * g.y, xv[j * 4 + 2] * rstd * g.z, xv[j * 4 + 3] * rstd * g.w); }
    }
  }
}

DEV int seq_of_tau(int tau, int d) { return d == 0 ? tau : (tau < CTX ? CTX - 1 - tau : 2 * CTX + SEQ - 1 - tau); }

DEV void phase_s5_scan(const Params& p, float* lds) {
  float* Y = (float*)(p.scratch + OFF_Y); bf16_t* GIN = (bf16_t*)(p.scratch + OFF_GIN);
  const int tid = TIDX, wid = tid >> 6, lane = tid & 63;
  float* ub = lds + wid * 2048;
  float* yb = ub + 1024;
  for (int item0 = BIDX * 8; item0 < 1024; item0 += gridDim.x * 8) {
    const int item = item0 + wid, b = item >> 6, g = item & 63;
    for (int d = 0; d < 2; ++d) {
      const int sidx = (d * 64 + g) * 64 + lane;
      const float ar = p.s5_ar[sidx], ai = p.s5_ai[sidx];
      float br[16], bi[16], cr[16], ci[16];
#pragma unroll
      for (int c = 0; c < 16; ++c) { br[c] = p.s5_br[sidx * 16 + c]; bi[c] = p.s5_bi[sidx * 16 + c];
        cr[c] = p.s5_c_re[((size_t)(d * 64 + g) * 16 + c) * 64 + lane]; ci[c] = p.s5_c_im[((size_t)(d * 64 + g) * 16 + c) * 64 + lane]; }
      float xr = 0.f, xi = 0.f;
      for (int k = 0; k < 36; ++k) {
        const int trow = b * SP + seq_of_tau(k * 64 + lane, d);
        __syncthreads();
        { const bf16_t* hp = p.h + (size_t)trow * D + g * 16;
          const uint4 w0 = *(const uint4*)hp, w1 = *(const uint4*)(hp + 8);
          const unsigned ww[8] = {w0.x, w0.y, w0.z, w0.w, w1.x, w1.y, w1.z, w1.w};
#pragma unroll
          for (int i = 0; i < 8; ++i) { ub[lane * 16 + 2 * i] = __uint_as_float(ww[i] << 16); ub[lane * 16 + 2 * i + 1] = __uint_as_float(ww[i] & 0xffff0000u); } }
        __syncthreads();
#pragma unroll 1
        for (int j = 0; j < 64; ++j) {
          float u[16];
#pragma unroll
          for (int c = 0; c < 16; c += 4) { const float4 t4 = *(const float4*)(ub + j * 16 + c); u[c] = t4.x; u[c + 1] = t4.y; u[c + 2] = t4.z; u[c + 3] = t4.w; }
          float bur = 0.f, bui = 0.f;
#pragma unroll
          for (int c = 0; c < 16; ++c) { bur += br[c] * u[c]; bui += bi[c] * u[c]; }
          const float nxr = ar * xr - ai * xi + bur, nxi = ar * xi + ai * xr + bui;
          xr = nxr; xi = nxi;
          float v[16];
#pragma unroll
          for (int c = 0; c < 16; ++c) v[c] = cr[c] * xr - ci[c] * xi;
#pragma unroll
          for (int i = 0; i < 8; ++i) { const bool hi = lane & 32; const float send = hi ? v[i] : v[i + 8], keep = hi ? v[i + 8] : v[i]; v[i] = keep + __shfl_xor(send, 32); }
#pragma unroll
          for (int i = 0; i < 4; ++i) { const bool hi = lane & 16; const float send = hi ? v[i] : v[i + 4], keep = hi ? v[i + 4] : v[i]; v[i] = keep + __shfl_xor(send, 16); }
#pragma unroll
          for (int i = 0; i < 2; ++i) { const bool hi = lane & 8; const float send = hi ? v[i] : v[i + 2], keep = hi ? v[i + 2] : v[i]; v[i] = keep + __shfl_xor(send, 8); }
          { const bool hi = lane & 4; const float send = hi ? v[0] : v[1], keep = hi ? v[1] : v[0]; v[0] = keep + __shfl_xor(send, 4); }
          v[0] += __shfl_xor(v[0], 2); v[0] += __shfl_xor(v[0], 1);
          if ((lane & 3) == 0) yb[j * 16 + (lane >> 2)] = v[0];
        }
        __syncthreads();
        if (d == 0) {
#pragma unroll
          for (int c = 0; c < 16; c += 4) *(float4*)(Y + (size_t)trow * D + g * 16 + c) = *(const float4*)(yb + lane * 16 + c);
        } else {
          unsigned ow[8];
#pragma unroll
          for (int c = 0; c < 16; c += 2) {
            const float y0 = Y[(size_t)trow * D + g * 16 + c] + yb[lane * 16 + c] + p.s5_d[g * 16 + c] * ub[lane * 16 + c];
            const float y1 = Y[(size_t)trow * D + g * 16 + c + 1] + yb[lane * 16 + c + 1] + p.s5_d[g * 16 + c + 1] * ub[lane * 16 + c + 1];
            ow[c >> 1] = (unsigned)f2bf(gelu_tanh(y0)) | ((unsigned)f2bf(gelu_tanh(y1)) << 16);
          }
          *(uint4*)(GIN + (size_t)trow * D + g * 16) = make_uint4(ow[0], ow[1], ow[2], ow[3]);
          *(uint4*)(GIN + (size_t)trow * D + g * 16 + 8) = make_uint4(ow[4], ow[5], ow[6], ow[7]);
        }
      }
    }
  }
}

DEV void phase_s5_out(const Params& p, int layer) {
  const bf16_t* Z = (const bf16_t*)(p.scratch + OFF_Z);
  const int lane = TIDX & 63, gw = BIDX * (NTHR / 64) + (TIDX >> 6), nw = gridDim.x * (NTHR / 64);
  for (int t = gw; t < T; t += nw) {
    float* xr = xrow_ptr(p, t); float xv[16]; load_row_f32(xr, lane, xv);
    const float* ad = ada_ptr(p, layer, t);
#pragma unroll
    for (int j = 0; j < 4; ++j) { const int c0 = j * 256 + lane * 4;
      const uint2 za = *(const uint2*)(Z + (size_t)t * 2048 + c0), zg = *(const uint2*)(Z + (size_t)t * 2048 + 1024 + c0);
      const float a[4] = {__uint_as_float(za.x << 16), __uint_as_float(za.x & 0xffff0000u), __uint_as_float(za.y << 16), __uint_as_float(za.y & 0xffff0000u)};
      const float gg[4] = {__uint_as_float(zg.x << 16), __uint_as_float(zg.x & 0xffff0000u), __uint_as_float(zg.y << 16), __uint_as_float(zg.y & 0xffff0000u)};
      const float4 g1 = *(const float4*)(ad + 2048 + c0); const float g1a[4] = {g1.x, g1.y, g1.z, g1.w};
#pragma unroll
      for (int e = 0; e < 4; ++e) xv[j * 4 + e] += g1a[e] * a[e] * sigm(gg[e]); }
    store_row_f32(xr, lane, xv);
    norm_mod_store(xv, p.norm_g + (layer * 2 + 1) * D, ad + 4096, ad + 3072, p.h + (size_t)t * D, lane);
  }
}

DEV void phase_gla_scan(const Params& p, float* lds) {
  const bf16_t* QKVG = (const bf16_t*)(p.scratch + OFF_QKVG); const float* LG = (const float*)(p.scratch + OFF_LG); bf16_t* OD = (bf16_t*)(p.scratch + OFF_OD);
  float* qs = lds; float* ks = lds + 16 * 128; float* es = lds + 32 * 128; float* vs = lds + 48 * 128; float* op = vs + 16 * 256;
  const int tid = TIDX, col = tid & 255, kh = tid >> 8;
  for (int item = BIDX; item < 128; item += gridDim.x) {
    const int b = item >> 3, hd = (item >> 1) & 3, d = item & 1;
    float S[64];
#pragma unroll
    for (int i = 0; i < 64; ++i) S[i] = 0.f;
    for (int st = 0; st < SP / 16; ++st) {
      __syncthreads();
      for (int idx = tid; idx < 16 * 128; idx += NTHR) { const int j = idx >> 7, k = idx & 127; const size_t trow = (size_t)b * SP + seq_of_tau(st * 16 + j, d);
        qs[idx] = bf2f(QKVG[trow * 3072 + hd * 128 + k]); ks[idx] = bf2f(QKVG[trow * 3072 + 512 + hd * 128 + k]); es[idx] = __expf(LG[((size_t)d * T + trow) * 512 + hd * 128 + k]); }
      for (int idx = tid; idx < 16 * 256; idx += NTHR) { const int j = idx >> 8, c = idx & 255; const size_t trow = (size_t)b * SP + seq_of_tau(st * 16 + j, d);
        vs[idx] = bf2f(QKVG[trow * 3072 + 1024 + hd * 256 + c]); }
      __syncthreads();
#pragma unroll 1
      for (int j = 0; j < 16; ++j) {
        const float vv = vs[j * 256 + col]; float acc = 0.f;
#pragma unroll
        for (int kk = 0; kk < 64; kk += 4) {
          const float4 e4 = *(const float4*)(es + j * 128 + kh * 64 + kk), k4 = *(const float4*)(ks + j * 128 + kh * 64 + kk), q4 = *(const float4*)(qs + j * 128 + kh * 64 + kk);
          S[kk] = e4.x * S[kk] + k4.x * vv; acc += q4.x * S[kk];
          S[kk + 1] = e4.y * S[kk + 1] + k4.y * vv; acc += q4.y * S[kk + 1];
          S[kk + 2] = e4.z * S[kk + 2] + k4.z * vv; acc += q4.z * S[kk + 2];
          S[kk + 3] = e4.w * S[kk + 3] + k4.w * vv; acc += q4.w * S[kk + 3];
        }
        op[kh * 16 * 256 + j * 256 + col] = acc;
      }
      __syncthreads();
      for (int idx = tid; idx < 16 * 256; idx += NTHR) { const int j = idx >> 8, c = idx & 255; const size_t trow = (size_t)b * SP + seq_of_tau(st * 16 + j, d);
        OD[((size_t)d * T + trow) * D + hd * 256 + c] = f2bf(op[idx] + op[16 * 256 + idx]); }
    }
  }
}

DEV void phase_gla_out(const Params& p) {
  const bf16_t* QKVG = (const bf16_t*)(p.scratch + OFF_QKVG); const bf16_t* OD = (const bf16_t*)(p.scratch + OFF_OD); bf16_t* GO = (bf16_t*)(p.scratch + OFF_GO);
  const int lane = TIDX & 63, gw = BIDX * (NTHR / 64) + (TIDX >> 6), nw = gridDim.x * (NTHR / 64);
  for (int t = gw; t < T; t += nw) {
#pragma unroll
    for (int hd = 0; hd < 4; ++hd) {
      const int c0 = hd * 256 + lane * 4;
      const uint2 a = *(const uint2*)(OD + (size_t)t * D + c0), bq = *(const uint2*)(OD + ((size_t)T + t) * D + c0), gg = *(const uint2*)(QKVG + (size_t)t * 3072 + 2048 + c0);
      float o[4] = {__uint_as_float(a.x << 16) + __uint_as_float(bq.x << 16), __uint_as_float(a.x & 0xffff0000u) + __uint_as_float(bq.x & 0xffff0000u),
                    __uint_as_float(a.y << 16) + __uint_as_float(bq.y << 16), __uint_as_float(a.y & 0xffff0000u) + __uint_as_float(bq.y & 0xffff0000u)};
      const float gv[4] = {__uint_as_float(gg.x << 16), __uint_as_float(gg.x & 0xffff0000u), __uint_as_float(gg.y << 16), __uint_as_float(gg.y & 0xffff0000u)};
      float ss = o[0] * o[0] + o[1] * o[1] + o[2] * o[2] + o[3] * o[3];
      ss = wave_sum(ss); const float rstd = rsqrtf(ss * (1.0f / 256.0f) + 1e-6f);
      const float4 on = *(const float4*)(p.gla_o_norm + lane * 4); const float ona[4] = {on.x, on.y, on.z, on.w};
      unsigned w[2];
#pragma unroll
      for (int e = 0; e < 4; e += 2) w[e >> 1] = (unsigned)f2bf(o[e] * rstd * ona[e] * silu(gv[e])) | ((unsigned)f2bf(o[e + 1] * rstd * ona[e + 1] * silu(gv[e + 1])) << 16);
      *(uint2*)(GO + (size_t)t * D + c0) = make_uint2(w[0], w[1]);
    }
  }
}

__global__ void __launch_bounds__(NTHR) fwd_megakernel(Params p) {
  cg::grid_group grid = cg::this_grid();
  __shared__ __attribute__((aligned(1024))) char shm_raw[128 * 1024];
  float* lds = (float*)shm_raw; LAS char* shm = (LAS char*)shm_raw;
  phase_prologue(p, lds);
  grid.sync();
  phase_norm1_first(p);
  grid.sync();
  for (int layer = 0; layer < 4; ++layer) {
    const int kind = layer % 3, j = layer / 3; const bool last = layer == 3;
    if (kind == 0) {
      gemm_mfma<128>(p.h, D, p.w_mla_in + (size_t)j * 768 * 1024, 1024, T, 768, 1024, EpiStoreBf16{(bf16_t*)(p.scratch + OFF_A1), 768, 672}, shm);
      grid.sync();
      phase_mla_norm(p, j);
      grid.sync();
      gemm_mfma<128>((const bf16_t*)(p.scratch + OFF_CQN), 384, p.w_uq + (size_t)j * 1536 * 384, 384, T, 1536, 384, EpiQ{(bf16_t*)(p.scratch + OFF_QF)}, shm);
      gemm_mfma<128>((const bf16_t*)(p.scratch + OFF_CKVN), 256, p.w_ukv + (size_t)j * 2048 * 256, 256, T, 2048, 256, EpiKV{(bf16_t*)(p.scratch + OFF_KF), (bf16_t*)(p.scratch + OFF_VF)}, shm);
      grid.sync();
      phase_attn_mfma(p, last, shm);
      grid.sync();
      gemm_mfma<128>((const bf16_t*)(p.scratch + OFF_O), D, p.w_mla_o + (size_t)j * 1024 * 1024, 1024, T, 1024, 1024, EpiRes{p.xc, p.out, p.ada, layer, 2048, last}, shm);
      grid.sync();
      phase_norm2(p, layer);
      grid.sync();
    } else if (kind == 1) {
      phase_s5_scan(p, lds);
      grid.sync();
      gemm_mfma<128>((const bf16_t*)(p.scratch + OFF_GIN), D, p.w_glu, 1024, T, 2048, 1024, EpiStoreBf16{(bf16_t*)(p.scratch + OFF_Z), 2048, 2048}, shm);
      grid.sync();
      phase_s5_out(p, layer);
      grid.sync();
    } else {
      gemm_mfma<128>(p.h, D, p.w_gla_in, 1024, T, 4096, 1024, EpiGla{(bf16_t*)(p.scratch + OFF_QKVG), (float*)(p.scratch + OFF_LG), p.gla_gk_b}, shm);
      grid.sync();
      phase_gla_scan(p, lds);
      grid.sync();
      phase_gla_out(p);
      grid.sync();
      gemm_mfma<128>((const bf16_t*)(p.scratch + OFF_GO), D, p.w_gla_o, 1024, T, 1024, 1024, EpiRes{p.xc, p.out, p.ada, layer, 2048, false}, shm);
      grid.sync();
      phase_norm2(p, layer);
      grid.sync();
    }
    gemm_mfma<128>(p.h, D, p.w_pq + (size_t)layer * 1024 * 1024, 1024, T, 1024, 1024, EpiStoreF32{(float*)(p.scratch + OFF_PQ), 1024}, shm);
    phase_peer_tables(p, layer);
    grid.sync();
    phase_peer_subtopk(p, layer, lds);
    grid.sync();
    phase_peer_final_topk(p);
    grid.sync();
    phase_peer_gather8(p, layer);
    if (layer < 3) grid.sync();
  }
}

extern "C" void kernel_launch(void* const* d_in, const int* in_sizes, int n_in, void* d_out,
                              int out_size, void* d_ws, size_t ws_size, hipStream_t stream) {
  static int grid_blocks = 0;
  if (!grid_blocks) {
    int dev = 0, cus = 0, per_cu = 0;
    (void)hipGetDevice(&dev);
    (void)hipDeviceGetAttribute(&cus, hipDeviceAttributeMultiprocessorCount, dev);
    (void)hipOccupancyMaxActiveBlocksPerMultiprocessor(&per_cu, fwd_megakernel, NTHR, 0);
    if (per_cu > 1) per_cu = 1;
    grid_blocks = cus * per_cu;
  }
  Params p{};
  const float* const* in = (const float* const*)d_in;
  p.x = in[0]; p.c = in[1]; p.ctx = in[2]; p.c_ctx = in[3]; p.norm_g = in[4]; p.ada_w = in[5]; p.ada_b = in[6];
  p.mla_w_in = in[7]; p.mla_q_norm = in[8]; p.mla_w_uq = in[9]; p.mla_kv_norm = in[10]; p.mla_w_ukv = in[11]; p.mla_w_o = in[12];
  p.s5_lam_re = in[13]; p.s5_lam_im = in[14]; p.s5_b_re = in[15]; p.s5_b_im = in[16]; p.s5_c_re = in[17]; p.s5_c_im = in[18]; p.s5_log_step = in[19]; p.s5_d = in[20]; p.s5_w_glu = in[21];
  p.gla_w_in = in[22]; p.gla_gk_w1 = in[23]; p.gla_gk_w2 = in[24]; p.gla_gk_b = in[25]; p.gla_o_norm = in[26]; p.gla_w_o = in[27];
  p.peer_w_q = in[28]; p.peer_keys = in[29]; p.peer_u = in[30]; p.peer_v = in[31]; p.final_g = in[32];
  p.out = (float*)d_out;
  char* w = (char*)d_ws; size_t off = 0;
  auto take = [&](size_t bytes) { char* r = w + off; off += (bytes + 255) & ~(size_t)255; return r; };
  p.xc = (float*)take((size_t)NB * CTX * D * 4);
  p.ada = (float*)take((size_t)4 * 17 * 6144 * 4);
  p.rope = (float*)take((size_t)2048 * 32 * 4);
  p.h = (bf16_t*)take((size_t)T * D * 2);
  p.w_mla_in = (bf16_t*)take((size_t)2 * 768 * 1024 * 2);
  p.w_uq = (bf16_t*)take((size_t)2 * 1536 * 384 * 2);
  p.w_ukv = (bf16_t*)take((size_t)2 * 2048 * 256 * 2);
  p.w_mla_o = (bf16_t*)take((size_t)2 * 1024 * 1024 * 2);
  p.w_glu = (bf16_t*)take((size_t)2048 * 1024 * 2);
  p.w_gla_in = (bf16_t*)take((size_t)4096 * 1024 * 2);
  p.w_gla_o = (bf16_t*)take((size_t)1024 * 1024 * 2);
  p.w_pq = (bf16_t*)take((size_t)4 * 1024 * 1024 * 2);
  p.s5_ar = (float*)take(2 * 64 * 64 * 4); p.s5_ai = (float*)take(2 * 64 * 64 * 4);
  p.s5_br = (float*)take(2 * 64 * 64 * 16 * 4); p.s5_bi = (float*)take(2 * 64 * 64 * 16 * 4);
  p.scratch = take(SCRATCH_BYTES);
  if (off > ws_size) { fprintf(stderr, "workspace too small: need %zu have %zu\n", off, ws_size); return; }
  void* args[] = {&p};
  hipError_t e = hipLaunchCooperativeKernel((void*)fwd_megakernel, dim3(grid_blocks), dim3(NTHR), args, 0, stream);
  if (e != hipSuccess) fprintf(stderr, "cooperative launch failed: %s (grid %d)\n", hipGetErrorString(e), grid_blocks);
}
```

```cpp
#include <hip/hip_runtime.h>
#include <hip/hip_cooperative_groups.h>
#include <cstdio>
#include <cstdint>
namespace cg = cooperative_groups;

typedef unsigned short bf16_t;
#define DEV __device__ __forceinline__

DEV int tid_op() { int t = threadIdx.x; asm volatile("" : "+v"(t)); return t; }
DEV int bid_op() { int t = blockIdx.x; asm volatile("" : "+s"(t)); return t; }
#define TIDX tid_op()
#define BIDX bid_op()
constexpr int D = 1024, NB = 16, SEQ = 2048, CTX = 256, SP = 2304, T = NB * SP;
constexpr int NTHR = 512;

struct Params {
  const float *x, *c, *ctx, *c_ctx, *norm_g, *ada_w, *ada_b;
  const float *mla_w_in, *mla_q_norm, *mla_w_uq, *mla_kv_norm, *mla_w_ukv, *mla_w_o;
  const float *s5_lam_re, *s5_lam_im, *s5_b_re, *s5_b_im, *s5_c_re, *s5_c_im, *s5_log_step, *s5_d, *s5_w_glu;
  const float *gla_w_in, *gla_gk_w1, *gla_gk_w2, *gla_gk_b, *gla_o_norm, *gla_w_o;
  const float *peer_w_q, *peer_keys, *peer_u, *peer_v, *final_g;
  float* out;
  bf16_t *xl, *xc;
  float *ada, *rope;
  bf16_t* h;
  bf16_t *w_mla_in, *w_uq, *w_ukv, *w_mla_o, *w_glu, *w_gla_in, *w_gla_o, *w_pq;
  float *s5_ar, *s5_ai, *s5_br, *s5_bi;
  char* scratch;
  unsigned* bar;
};
typedef const __attribute__((address_space(4))) Params& CP;
__device__ __forceinline__ const __attribute__((address_space(4))) Params* params_now() {
  unsigned long long kp = (unsigned long long)__builtin_amdgcn_kernarg_segment_ptr();
  asm volatile("" : "+s"(kp));
  return (const __attribute__((address_space(4))) Params*)kp;
}

constexpr size_t MB = 1ull << 20;
constexpr size_t OFF_A1 = 0;
constexpr size_t OFF_CQN = 54 * MB;
constexpr size_t OFF_CKVN = 81 * MB;
constexpr size_t OFF_QF = 99 * MB;
constexpr size_t OFF_KF = 207 * MB;
constexpr size_t OFF_VF = 315 * MB;
constexpr size_t OFF_O = 387 * MB;
constexpr size_t OFF_KPE = 459 * MB;
constexpr size_t OFF_Y = 0;
constexpr size_t OFF_GIN = 144 * MB;
constexpr size_t OFF_Z = 216 * MB;
constexpr size_t OFF_KT = 360 * MB;
constexpr size_t OFF_W4 = 364 * MB;
constexpr size_t OFF_XIN = 384 * MB;
constexpr size_t OFF_QKVG = 0;
constexpr size_t OFF_LG = 216 * MB;
constexpr size_t OFF_OD = 360 * MB;
constexpr size_t OFF_GO = 504 * MB;
constexpr size_t OFF_PQ = 0;
constexpr size_t OFF_SV = 144 * MB;
constexpr size_t OFF_SI = 180 * MB;
constexpr size_t OFF_EID = 216 * MB;
constexpr size_t OFF_GATE = 234 * MB;
constexpr size_t OFF_U8 = 256 * MB;
constexpr size_t OFF_V8 = 272 * MB;
constexpr size_t OFF_VTG = 576 * MB;
constexpr size_t SCRATCH_BYTES = 648 * MB;

DEV float bf2f(bf16_t v) { return __uint_as_float(((unsigned)v) << 16); }
DEV bf16_t f2bf(float f) { unsigned u = __float_as_uint(f); u += 0x7fffu + ((u >> 16) & 1u); return (bf16_t)(u >> 16); }
DEV float wave_sum(float v) {
#pragma unroll
  for (int o = 32; o > 0; o >>= 1) v += __shfl_xor(v, o);
  return v;
}
DEV float gelu_tanh(float x) { const float u2 = 1.5957691216057308f * (x + 0.044715f * x * x * x); return x / (1.f + __expf(-u2)); }
DEV float sigm(float x) { return 1.f / (1.f + __expf(-x)); }
DEV float silu(float x) { return x * sigm(x); }

DEV bf16_t* xrow_ptr(CP p, int t) {
  int b = t / SP, s = t - b * SP;
  return s < CTX ? p.xc + ((size_t)(b * CTX + s)) * D : p.xl + ((size_t)(b * SEQ + s - CTX)) * D;
}
DEV const float* ada_ptr(CP p, int layer, int t) {
  int b = t / SP, s = t - b * SP;
  return p.ada + ((size_t)(layer * 17 + (s < CTX ? 16 : b))) * 6144;
}

DEV void load_row_f32(const float* row, int lane, float (&v)[16]) {
#pragma unroll
  for (int j = 0; j < 4; ++j) { float4 t = *(const float4*)(row + j * 256 + lane * 4); v[j * 4] = t.x; v[j * 4 + 1] = t.y; v[j * 4 + 2] = t.z; v[j * 4 + 3] = t.w; }
}
DEV void load_row_bf(const bf16_t* row, int lane, float (&v)[16]) {
#pragma unroll
  for (int j = 0; j < 4; ++j) { const uint2 w = *(const uint2*)(row + j * 256 + lane * 4); v[j * 4] = __uint_as_float(w.x << 16); v[j * 4 + 1] = __uint_as_float(w.x & 0xffff0000u); v[j * 4 + 2] = __uint_as_float(w.y << 16); v[j * 4 + 3] = __uint_as_float(w.y & 0xffff0000u); }
}
DEV void store_row_bf(bf16_t* row, int lane, const float (&v)[16]) {
#pragma unroll
  for (int j = 0; j < 4; ++j) { uint2 w; w.x = (unsigned)f2bf(v[j * 4]) | ((unsigned)f2bf(v[j * 4 + 1]) << 16); w.y = (unsigned)f2bf(v[j * 4 + 2]) | ((unsigned)f2bf(v[j * 4 + 3]) << 16); *(uint2*)(row + j * 256 + lane * 4) = w; }
}
DEV void store_row_f32(float* row, int lane, const float (&v)[16]) {
#pragma unroll
  for (int j = 0; j < 4; ++j) *(float4*)(row + j * 256 + lane * 4) = make_float4(v[j * 4], v[j * 4 + 1], v[j * 4 + 2], v[j * 4 + 3]);
}
DEV void norm_mod_store(const float (&v)[16], const float* g, const float* sc, const float* sh, bf16_t* hrow, int lane) {
  float ss = 0.f;
#pragma unroll
  for (int i = 0; i < 16; ++i) ss += v[i] * v[i];
  ss = wave_sum(ss);
  const float rstd = rsqrtf(ss * (1.0f / D) + 1e-6f);
#pragma unroll
  for (int j = 0; j < 4; ++j) {
    const int c0 = j * 256 + lane * 4;
    float4 gg = *(const float4*)(g + c0), s1 = *(const float4*)(sc + c0), s2 = *(const float4*)(sh + c0);
    float y0 = v[j * 4] * rstd * gg.x * (1.f + s1.x) + s2.x, y1 = v[j * 4 + 1] * rstd * gg.y * (1.f + s1.y) + s2.y;
    float y2 = v[j * 4 + 2] * rstd * gg.z * (1.f + s1.z) + s2.z, y3 = v[j * 4 + 3] * rstd * gg.w * (1.f + s1.w) + s2.w;
    uint2 w; w.x = (unsigned)f2bf(y0) | ((unsigned)f2bf(y1) << 16); w.y = (unsigned)f2bf(y2) | ((unsigned)f2bf(y3) << 16);
    *(uint2*)(hrow + c0) = w;
  }
}

DEV void conv_weights(CP p, float* lds) {
  const int tid = TIDX;
  constexpr int NT = 2000;
  float r[16];
  const float* src = nullptr; bf16_t* dst = nullptr; int K = 0, N = 0, k0 = 0, n0 = 0; bool glu = false;
  auto decode = [&](int g) {
    int base, Np; glu = false;
    if (g < 192) { const int j = g >= 96; base = j * 96; src = p.mla_w_in + (size_t)j * 1024 * 672; dst = p.w_mla_in + (size_t)j * 768 * 1024; K = 1024; N = 672; Np = 768; }
    else if (g < 336) { const int j = g >= 264; base = 192 + j * 72; src = p.mla_w_uq + (size_t)j * 384 * 1536; dst = p.w_uq + (size_t)j * 1536 * 384; K = 384; N = Np = 1536; }
    else if (g < 464) { const int j = g >= 400; base = 336 + j * 64; src = p.mla_w_ukv + (size_t)j * 256 * 2048; dst = p.w_ukv + (size_t)j * 2048 * 256; K = 256; N = Np = 2048; }
    else if (g < 720) { const int j = g >= 592; base = 464 + j * 128; src = p.mla_w_o + (size_t)j * 1024 * 1024; dst = p.w_mla_o + (size_t)j * 1024 * 1024; K = 1024; N = Np = 1024; }
    else if (g < 976) { base = 720; src = p.s5_w_glu; dst = p.w_glu; K = 1024; N = Np = 2048; glu = true; }
    else if (g < 1360) { base = 976; src = p.gla_w_in; dst = p.w_gla_in; K = 1024; N = Np = 3072; }
    else if (g < 1488) { base = 1360; src = p.gla_w_o; dst = p.w_gla_o; K = 1024; N = Np = 1024; }
    else { const int i = (g - 1488) >> 7; base = 1488 + i * 128; src = p.peer_w_q + (size_t)i * 1024 * 1024; dst = p.w_pq + (size_t)i * 1024 * 1024; K = 1024; N = Np = 1024; }
    const int local = g - base, tk = K >> 6;
    k0 = (local % tk) * 64; n0 = (local / tk) * 128; (void)Np;
  };
  auto loadt = [&]() {
#pragma unroll
    for (int i = 0; i < 16; ++i) { const int idx = tid + i * NTHR, kk = idx >> 7, nn = idx & 127;
      r[i] = (n0 + nn < N) ? src[(size_t)(k0 + kk) * N + n0 + nn] : 0.f; }
  };
  int g = BIDX;
  if (g < NT) { decode(g); loadt(); }
  while (g < NT) {
    __syncthreads();
#pragma unroll
    for (int i = 0; i < 16; ++i) { const int idx = tid + i * NTHR, kk = idx >> 7, nn = idx & 127; lds[kk * 129 + nn] = r[i]; }
    bf16_t* d0 = dst + k0; const int Kc = K, n0c = n0; const bool gluc = glu;
    const int gn = g + gridDim.x;
    if (gn < NT) { decode(gn); loadt(); }
    __syncthreads();
#pragma unroll
    for (int i = 0; i < 4; ++i) { const int idx = tid + i * NTHR, nn = idx >> 4, kq = idx & 15;
      const float* l = lds + (kq * 4) * 129 + nn;
      uint2 w; w.x = (unsigned)f2bf(l[0]) | ((unsigned)f2bf(l[129]) << 16); w.y = (unsigned)f2bf(l[258]) | ((unsigned)f2bf(l[387]) << 16);
      const int nrow = n0c + nn, orow = gluc ? (nrow < 1024 ? 2 * nrow : 2 * (nrow - 1024) + 1) : nrow;
      *(uint2*)(d0 + (size_t)orow * Kc + kq * 4) = w; }
    g = gn;
  }
}

DEV void ada_load(float (&W)[8][3], const float* w, int kb) {
#pragma unroll
  for (int i = 0; i < 8; ++i) { const float* wp = w + (size_t)(kb + i) * 6144; W[i][0] = wp[0]; W[i][1] = wp[1]; W[i][2] = wp[2]; }
}
DEV void ada_fma(float (&acc)[17][3], const float (&W)[8][3], const float* sp, int kb) {
#pragma unroll
  for (int i = 0; i < 8; ++i) {
    const float* sr = sp + (kb + i) * 20;
    const float4 s0 = *(const float4*)sr, s1 = *(const float4*)(sr + 4), s2 = *(const float4*)(sr + 8), s3 = *(const float4*)(sr + 12); const float s16 = sr[16];
    const float sv[17] = {s0.x, s0.y, s0.z, s0.w, s1.x, s1.y, s1.z, s1.w, s2.x, s2.y, s2.z, s2.w, s3.x, s3.y, s3.z, s3.w, s16};
#pragma unroll
    for (int r = 0; r < 17; ++r) { acc[r][0] += sv[r] * W[i][0]; acc[r][1] += sv[r] * W[i][1]; acc[r][2] += sv[r] * W[i][2]; }
  }
}

DEV void phase_prologue(CP p, float* lds) {
  const int tid = TIDX, gtid = BIDX * NTHR + tid, gn = gridDim.x * NTHR;
  conv_weights(p, lds);
  for (int idx = gtid; idx < 2 * 64 * 1024; idx += gn) {
    const int k = idx & 1023, ns = (idx >> 10) & 63, d = idx >> 16;
    const float4* w1 = (const float4*)(p.gla_gk_w1 + ((size_t)d * 1024 + k) * 16); const float* w2 = p.gla_gk_w2 + (size_t)d * 16 * 512 + ns * 8;
    const float4 a0 = w1[0], a1 = w1[1], a2 = w1[2], a3 = w1[3];
    const float a[16] = {a0.x, a0.y, a0.z, a0.w, a1.x, a1.y, a1.z, a1.w, a2.x, a2.y, a2.z, a2.w, a3.x, a3.y, a3.z, a3.w};
#pragma unroll
    for (int i = 0; i < 8; ++i) {
      float sacc = 0.f;
#pragma unroll
      for (int r = 0; r < 16; ++r) sacc += a[r] * w2[r * 512 + i];
      p.w_gla_in[(size_t)(3072 + d * 512 + ns * 8 + i) * 1024 + k] = f2bf(sacc);
    }
  }
  for (int idx = gtid; idx < 2048 * 8; idx += gn) {
    const int pos = idx >> 3, i = idx & 7;
    const float inv = powf(10000.0f, -(float)i / 8.0f);
    const float ar = (float)(pos / 64) * inv, ac = (float)(pos % 64) * inv;
    float* r = p.rope + pos * 32;
    r[i] = cosf(ar); r[8 + i] = sinf(ar); r[16 + i] = cosf(ac); r[24 + i] = sinf(ac);
  }
  for (int idx = gtid; idx < 2 * 64 * 64; idx += gn) {
    const int g = (idx >> 6) & 63, d = idx >> 12;
    const float lr = p.s5_lam_re[idx], li = p.s5_lam_im[idx], dt = expf(p.s5_log_step[d * 64 + g]);
    const float mag = expf(lr * dt), ar = mag * cosf(li * dt), ai = mag * sinf(li * dt), den = lr * lr + li * li;
    const float fr = ((ar - 1.f) * lr + ai * li) / den, fi = (ai * lr - (ar - 1.f) * li) / den;
    p.s5_ar[idx] = ar; p.s5_ai[idx] = ai;
    for (int c = 0; c < 16; ++c) { const float bre = p.s5_b_re[idx * 16 + c], bim = p.s5_b_im[idx * 16 + c];
      p.s5_br[idx * 16 + c] = fr * bre - fi * bim; p.s5_bi[idx * 16 + c] = fr * bim + fi * bre; }
  }
  {
    float* st = lds;
    for (int cb = BIDX; cb < 4 * 64; cb += gridDim.x) {
      const int layer = cb >> 6, n0 = (cb & 63) * 96;
      __syncthreads();
      for (int idx = tid; idx < 17 * 1024; idx += NTHR) { const int r = idx >> 10, k = idx & 1023; const float cv = r < 16 ? p.c[r * 1024 + k] : p.c_ctx[k]; st[k * 20 + (k >> 6) * 4 + r] = silu(cv); }
      __syncthreads();
      const int ct = tid & 31, kg = tid >> 5;
      const float* w = p.ada_w + ((size_t)layer * 1024 + kg * 64) * 6144 + n0 + ct * 3;
      const float* sp = st + kg * 64 * 20 + kg * 4;
      float acc[17][3];
#pragma unroll
      for (int r = 0; r < 17; ++r) { acc[r][0] = 0.f; acc[r][1] = 0.f; acc[r][2] = 0.f; }
      float wa[8][3], wb[8][3];
      ada_load(wa, w, 0);
#pragma unroll 1
      for (int kb = 0; kb < 64; kb += 16) {
        ada_load(wb, w, kb + 8);
        ada_fma(acc, wa, sp, kb);
        ada_load(wa, w, kb + 16 < 64 ? kb + 16 : 56);
        ada_fma(acc, wb, sp, kb + 8);
      }
      __syncthreads();
      float* part = lds;
#pragma unroll
      for (int r = 0; r < 17; ++r) { float* pp = part + (kg * 17 + r) * 96 + ct * 3; pp[0] = acc[r][0]; pp[1] = acc[r][1]; pp[2] = acc[r][2]; }
      __syncthreads();
      for (int idx = tid; idx < 96 * 17; idx += NTHR) { const int r = idx / 96, col = idx - r * 96;
        float v = 0.f;
#pragma unroll
        for (int q = 0; q < 16; ++q) v += part[(q * 17 + r) * 96 + col];
        p.ada[((size_t)(layer * 17 + r)) * 6144 + n0 + col] = v + p.ada_b[layer * 6144 + n0 + col]; }
    }
    __syncthreads();
  }
}

DEV void phase_norm1_first(CP p) {
  const int lane = TIDX & 63, gw = BIDX * (NTHR / 64) + (TIDX >> 6), nw = gridDim.x * (NTHR / 64);
  for (int t = gw; t < T; t += nw) {
    const int b = t / SP, s = t - b * SP;
    const float* src = s < CTX ? p.ctx + ((size_t)(b * CTX + s)) * D : p.x + ((size_t)(b * SEQ + s - CTX)) * D;
    float v[16]; load_row_f32(src, lane, v);
    store_row_bf(xrow_ptr(p, t), lane, v);
    const float* ad = ada_ptr(p, 0, t);
    norm_mod_store(v, p.norm_g, ad + 1024, ad, p.h + (size_t)t * D, lane);
  }
}
DEV void phase_norm2(CP p, int layer) {
  const int lane = TIDX & 63, gw = BIDX * (NTHR / 64) + (TIDX >> 6), nw = gridDim.x * (NTHR / 64);
  for (int t = gw; t < T; t += 3 * nw) {
    float v[3][16];
#pragma unroll
    for (int u = 0; u < 3; ++u) { const int tt = t + u * nw; if (tt < T) load_row_bf(xrow_ptr(p, tt), lane, v[u]); }
#pragma unroll
    for (int u = 0; u < 3; ++u) { const int tt = t + u * nw; if (tt < T) {
      const float* ad = ada_ptr(p, layer, tt);
      norm_mod_store(v[u], p.norm_g + (layer * 2 + 1) * D, ad + 4096, ad + 3072, p.h + (size_t)tt * D, lane); } }
  }
}

template <class Epi>
DEV void gemm_naive(const bf16_t* A, int lda, const bf16_t* Bt, int ldb, int M, int N, int K, const Epi& epi, float* lds) {
  float* As = lds;
  float* Bs = lds + 16 * 132;
  const int tid = TIDX, ty = tid >> 5, tx = tid & 31, nM = M / 128, nN = N / 128;
  const int lrow = tid >> 2, lkq = tid & 3;
  for (int tile = BIDX; tile < nM * nN; tile += gridDim.x) {
    const int pm = tile / nN, pn = tile - pm * nN;
    float acc[8][4];
#pragma unroll
    for (int i = 0; i < 8; ++i)
#pragma unroll
      for (int j = 0; j < 4; ++j) acc[i][j] = 0.f;
    const bf16_t* ap = A + (size_t)(pm * 128 + lrow) * lda + lkq * 4;
    const bf16_t* bp = Bt + (size_t)(pn * 128 + lrow) * ldb + lkq * 4;
    for (int k0 = 0; k0 < K; k0 += 16) {
      const uint2 av = *(const uint2*)(ap + k0), bv = *(const uint2*)(bp + k0);
      __syncthreads();
      As[(lkq * 4 + 0) * 132 + lrow] = __uint_as_float(av.x << 16); As[(lkq * 4 + 1) * 132 + lrow] = __uint_as_float(av.x & 0xffff0000u);
      As[(lkq * 4 + 2) * 132 + lrow] = __uint_as_float(av.y << 16); As[(lkq * 4 + 3) * 132 + lrow] = __uint_as_float(av.y & 0xffff0000u);
      Bs[(lkq * 4 + 0) * 132 + lrow] = __uint_as_float(bv.x << 16); Bs[(lkq * 4 + 1) * 132 + lrow] = __uint_as_float(bv.x & 0xffff0000u);
      Bs[(lkq * 4 + 2) * 132 + lrow] = __uint_as_float(bv.y << 16); Bs[(lkq * 4 + 3) * 132 + lrow] = __uint_as_float(bv.y & 0xffff0000u);
      __syncthreads();
#pragma unroll 2
      for (int kk = 0; kk < 16; ++kk) {
        const float4 a0 = *(const float4*)(As + kk * 132 + ty * 8), a1 = *(const float4*)(As + kk * 132 + ty * 8 + 4), b0 = *(const float4*)(Bs + kk * 132 + tx * 4);
        const float a[8] = {a0.x, a0.y, a0.z, a0.w, a1.x, a1.y, a1.z, a1.w}, b[4] = {b0.x, b0.y, b0.z, b0.w};
#pragma unroll
        for (int i = 0; i < 8; ++i)
#pragma unroll
          for (int j = 0; j < 4; ++j) acc[i][j] += a[i] * b[j];
      }
    }
#pragma unroll
    for (int i = 0; i < 8; ++i)
#pragma unroll
      for (int j = 0; j < 4; ++j) epi(pm * 128 + ty * 8 + i, pn * 128 + tx * 4 + j, acc[i][j]);
  }
}


#define LAS __attribute__((address_space(3)))
typedef short bf16x8 __attribute__((ext_vector_type(8)));
typedef float f32x4 __attribute__((ext_vector_type(4)));
typedef float f32x16 __attribute__((ext_vector_type(16)));
typedef unsigned u32x4 __attribute__((ext_vector_type(4)));
typedef unsigned u32x2 __attribute__((ext_vector_type(2)));
DEV bf16x8 ld_frag_lds(const LAS char* p) { return *(const LAS bf16x8*)p; }
typedef __bf16 hwbf16x2 __attribute__((ext_vector_type(2)));
typedef float f32pair __attribute__((ext_vector_type(2)));
DEV unsigned cvt_pk_bf16(float lo, float hi) { const f32pair v = {lo, hi}; return __builtin_bit_cast(unsigned, __builtin_convertvector(v, hwbf16x2)); }
DEV int lds_byte2(int r, int c) { const int st = (r >> 4) * 2 + (c >> 5), ob = (r & 15) * 64 + (c & 31) * 2; return st * 1024 + (ob ^ (((ob >> 9) & 1) << 5)); }
DEV void stage_rc2(int b, int& R, int& C) { const int st = b >> 10, sb = b & 1023, swz = sb ^ (((sb >> 9) & 1) << 5); R = (st >> 1) * 16 + (swz >> 6); C = (st & 1) * 32 + ((swz & 63) >> 1); }

template <int BM, class Epi>
DEV void gemm_mfma(const bf16_t* A, int lda, const bf16_t* Bt, int ldb, int M, int N, int K, const Epi& epi, LAS char* shm) {
  constexpr int MF = BM / 32, TA = BM * 128, TB = 256 * 128, STG = TA + TB, GA = TA / 8192, GB = TB / 8192;
  const int tid = TIDX, wid = __builtin_amdgcn_readfirstlane(tid >> 6), lane = tid & 63, wr = wid >> 2, wc = wid & 3, fr = lane & 15, fq = lane >> 4;
  int offA0, offB0;
  { int R, C; stage_rc2(wid * 1024 + lane * 16, R, C); offA0 = R * lda + C; offB0 = R * ldb + C; }
  const int nM = M / BM, nN = N / 256, ntile = nM * nN, nt = K / 64;
  const int G = gridDim.x, bid = BIDX, vb = (G & 7) ? bid : (bid & 7) * (G >> 3) + (bid >> 3);
  const int aoff0 = lds_byte2(wr * (BM / 2) + fr, fq * 8), boff0 = TA + lds_byte2(wc * 64 + fr, fq * 8);
  for (int tile = vb; tile < ntile; tile += G) {
    const int Wn = (nN > 4 && (nN & 3) == 0) ? 4 : ((nN > 3 && nN % 3 == 0) ? 3 : nN), tpg = nM * Wn, gn = tile / tpg, rem = tile - gn * tpg;
    const int pm = rem / Wn, pn = gn * Wn + (rem - pm * Wn);
    const bf16_t* Ab = A + (size_t)pm * BM * lda; const bf16_t* Bb = Bt + (size_t)pn * 256 * ldb;
    f32x4 acc[MF][4];
#pragma unroll
    for (int m = 0; m < MF; ++m)
#pragma unroll
      for (int n = 0; n < 4; ++n) acc[m][n] = (f32x4){0.f, 0.f, 0.f, 0.f};
#define GSTAGE(buf, kt) do { _Pragma("unroll") for (int i = 0; i < GB; ++i) { \
      if (i < GA) __builtin_amdgcn_global_load_lds((const unsigned*)(Ab + offA0 + i * 64 * lda + (kt) * 64), (LAS unsigned*)(shm + (buf) * STG + wid * 1024 + i * 8192), 16, 0, 0); \
      __builtin_amdgcn_global_load_lds((const unsigned*)(Bb + offB0 + i * 64 * ldb + (kt) * 64), (LAS unsigned*)(shm + (buf) * STG + TA + wid * 1024 + i * 8192), 16, 0, 0); } } while (0)
#define GWAIT_V(n_) asm volatile("s_waitcnt vmcnt(%0)" ::"n"(n_) : "memory")
#define GRAW_BARRIER() do { asm volatile("s_waitcnt lgkmcnt(0)" ::: "memory"); __builtin_amdgcn_s_barrier(); } while (0)
    constexpr int GL = GA + GB;
    if constexpr (BM == 256) {
      GWAIT_V(0); GRAW_BARRIER();
      GSTAGE(0, 0);
      int cur = 0;
      for (int t = 0; t < nt; ++t) {
        GWAIT_V(0); GRAW_BARRIER();
        if (t + 1 < nt) GSTAGE(cur ^ 1, t + 1);
#pragma unroll
        for (int ks = 0; ks < 2; ++ks) {
          bf16x8 At[MF], Bf[4];
#pragma unroll
          for (int m = 0; m < MF; ++m) At[m] = *(const LAS bf16x8*)(shm + cur * STG + aoff0 + m * 2048 + ks * 1024);
#pragma unroll
          for (int n = 0; n < 4; ++n) Bf[n] = *(const LAS bf16x8*)(shm + cur * STG + boff0 + n * 2048 + ks * 1024);
          __builtin_amdgcn_s_setprio(1);
#pragma unroll
          for (int m = 0; m < MF; ++m)
#pragma unroll
            for (int n = 0; n < 4; ++n) acc[m][n] = __builtin_amdgcn_mfma_f32_16x16x32_bf16(At[m], Bf[n], acc[m][n], 0, 0, 0);
          __builtin_amdgcn_s_setprio(0);
        }
        cur ^= 1;
      }
      GRAW_BARRIER();
    } else {
    GWAIT_V(0); GRAW_BARRIER();
    GSTAGE(0, 0);
    if (nt > 1) { GSTAGE(1, 1); GWAIT_V(GL); } else GWAIT_V(0);
    GRAW_BARRIER();
    int cur = 0;
    for (int t = 0; t < nt; ++t) {
      if (t + 2 < nt) { const int nb = cur >= 1 ? cur - 1 : 2; GSTAGE(nb, t + 2); }
#pragma unroll
      for (int ks = 0; ks < 2; ++ks) {
        bf16x8 At[MF], Bf[4];
#pragma unroll
        for (int m = 0; m < MF; ++m) At[m] = *(const LAS bf16x8*)(shm + cur * STG + aoff0 + m * 2048 + ks * 1024);
#pragma unroll
        for (int n = 0; n < 4; ++n) Bf[n] = *(const LAS bf16x8*)(shm + cur * STG + boff0 + n * 2048 + ks * 1024);
#pragma unroll
        for (int m = 0; m < MF; ++m)
#pragma unroll
          for (int n = 0; n < 4; ++n) acc[m][n] = __builtin_amdgcn_mfma_f32_16x16x32_bf16(At[m], Bf[n], acc[m][n], 0, 0, 0);
      }
      if (t + 2 < nt) GWAIT_V(GL); else GWAIT_V(0);
      GRAW_BARRIER();
      cur = cur == 2 ? 0 : cur + 1;
    }
    }
#undef GSTAGE
    const int row0 = pm * BM + wr * (BM / 2) + fq * 4, col0 = pn * 256 + wc * 64 + fr;
    if constexpr (Epi::PRELOAD) {
      f32x4 xin[MF][4];
#pragma unroll
      for (int m = 0; m < MF; ++m)
#pragma unroll
        for (int n = 0; n < 4; ++n) xin[m][n] = epi.load(row0 + m * 16, col0 + n * 16);
#pragma unroll
      for (int m = 0; m < MF; ++m)
#pragma unroll
        for (int n = 0; n < 4; ++n) epi.store(row0 + m * 16, col0 + n * 16, acc[m][n], xin[m][n]);
    } else {
#pragma unroll
    for (int m = 0; m < MF; ++m) {
#pragma unroll
      for (int n = 0; n < 4; ++n)
        epi(row0 + m * 16, col0 + n * 16, acc[m][n]);
      if (BM == 256) asm volatile("" ::: "memory");
    }
    }
  }
}


template <int BM, class Epi>
DEV void gemm256s_t(const bf16_t* A, int lda, const bf16_t* Bt, int ldb, int M, int N, int K, const Epi& epi, LAS char* shm, bool rev = false, bool seqonly = false) {
  constexpr int MF = BM / 32, TA = 256 * 128, STG = 2 * TA;
  const int tid = TIDX, wid = __builtin_amdgcn_readfirstlane(tid >> 6), lane = tid & 63, wr = wid >> 2, wc = wid & 3, fr = lane & 15, fq = lane >> 4;
  int offA0, offB0;
  { int R, C; stage_rc2(wid * 1024 + lane * 16, R, C); offA0 = R * lda + C; offB0 = R * ldb + C; }
  const int nM = seqonly ? NB * (SEQ / 256) : M / BM, nN = N / 256, ntile = nM * nN, nt = K / 64;
  const int G = gridDim.x, bid = BIDX, vb0 = (G & 7) ? bid : (bid & 7) * (G >> 3) + (bid >> 3), vb = rev ? G - 1 - vb0 : vb0;
  if (vb >= ntile) return;
  const int cnt = (ntile - vb + G - 1) / G, J = cnt * nt;
  const int aoff0 = lds_byte2(wr * (BM / 2) + fr, fq * 8), boff0 = TA + lds_byte2(wc * 64 + fr, fq * 8);
  const int Wn = (nN > 4 && (nN & 3) == 0) ? 4 : ((nN > 3 && nN % 3 == 0) ? 3 : nN), tpg = nM * Wn;
#define G2_ROW0(pm_) (seqonly ? ((pm_) >> 3) * SP + CTX + ((pm_) & 7) * 256 : (pm_) * BM)
#define G2_PMPN(tile_, pm_, pn_) do { const int gn_ = (tile_) / tpg, rem_ = (tile_) - gn_ * tpg; pm_ = rem_ / Wn; pn_ = gn_ * Wn + (rem_ - pm_ * Wn); } while (0)
#define G2_STAGE(j_) do { if ((j_) < J) { const int i_ = (j_) / nt, kt_ = (j_) - i_ * nt; int pm_, pn_; G2_PMPN(vb + i_ * G, pm_, pn_); \
      const bf16_t* Ab_ = A + (size_t)G2_ROW0(pm_) * lda + kt_ * 64; const bf16_t* Bb_ = Bt + (size_t)pn_ * 256 * ldb + kt_ * 64; LAS char* db_ = shm + ((j_) & 1) * STG + wid * 1024; \
      _Pragma("unroll") for (int q_ = 0; q_ < 4; ++q_) { \
        if (q_ < BM / 64) __builtin_amdgcn_global_load_lds((const unsigned*)(Ab_ + offA0 + q_ * 64 * lda), (LAS unsigned*)(db_ + q_ * 8192), 16, 0, 0); \
        __builtin_amdgcn_global_load_lds((const unsigned*)(Bb_ + offB0 + q_ * 64 * ldb), (LAS unsigned*)(db_ + TA + q_ * 8192), 16, 0, 0); } } } while (0)
#define G2_BAR() do { asm volatile("s_waitcnt lgkmcnt(0)" ::: "memory"); __builtin_amdgcn_sched_barrier(0); __builtin_amdgcn_s_barrier(); __builtin_amdgcn_sched_barrier(0); } while (0)
#define G2_WAITV() asm volatile("s_waitcnt vmcnt(0)" ::: "memory")
#define G2_LOADF(buf_, ks_) do { _Pragma("unroll") for (int m = 0; m < MF; ++m) At[m] = *(const LAS bf16x8*)(shm + (buf_) * STG + aoff0 + m * 2048 + (ks_) * 1024); \
      _Pragma("unroll") for (int n = 0; n < 4; ++n) Bf[n] = *(const LAS bf16x8*)(shm + (buf_) * STG + boff0 + n * 2048 + (ks_) * 1024); } while (0)
#define G2_MMA() do { __builtin_amdgcn_s_setprio(1); _Pragma("unroll") for (int m = 0; m < MF; ++m) _Pragma("unroll") for (int n = 0; n < 4; ++n) \
      acc[m][n] = Epi::ROWVEC ? __builtin_amdgcn_mfma_f32_16x16x32_bf16(Bf[n], At[m], acc[m][n], 0, 0, 0) : __builtin_amdgcn_mfma_f32_16x16x32_bf16(At[m], Bf[n], acc[m][n], 0, 0, 0); __builtin_amdgcn_s_setprio(0); } while (0)
  f32x4 acc[MF][4];
#pragma unroll
  for (int m = 0; m < MF; ++m)
#pragma unroll
    for (int n = 0; n < 4; ++n) acc[m][n] = (f32x4){0.f, 0.f, 0.f, 0.f};
  bf16x8 At[MF], Bf[4];
  G2_WAITV(); G2_BAR();
  G2_STAGE(0);
  G2_WAITV(); G2_BAR();
  if (wr == 1) { G2_STAGE(1); G2_BAR(); }
  int kt = 0, ti = 0;
  for (int j = 0; j < J; ++j) {
    const int buf = j & 1;
    const bool tile_end = (kt == nt - 1);
    if (wr == 0) G2_STAGE(j + 1);
    G2_LOADF(buf, 0); G2_BAR();
    G2_MMA(); G2_BAR();
    G2_LOADF(buf, 1); if (wr == 1) G2_WAITV(); G2_BAR();
    if (wr == 1) G2_STAGE(j + 2);
    G2_MMA();
    if (wr == 0) G2_WAITV();
    if (wr == 0 || j + 1 < J) G2_BAR();
    if (tile_end) {
      int pm, pn; G2_PMPN(vb + ti * G, pm, pn);
      if constexpr (Epi::ROWVEC) {
        LAS char* stg = shm + 2 * STG + wid * 2048;
        const int rr = lane >> 3, ch = lane & 7, rbase = G2_ROW0(pm) + wr * (BM / 2) + rr, cbase = pn * 256 + wc * 64 + ch * 8;
        uint4 xin[3][2];
        if constexpr (Epi::PRELOAD) {
#pragma unroll
          for (int m = 0; m < 2; ++m) { xin[m][0] = epi.load8(rbase + m * 16, cbase); xin[m][1] = epi.load8(rbase + m * 16 + 8, cbase); }
        }
#pragma unroll
        for (int m = 0; m < MF; ++m) {
          if constexpr (Epi::PRELOAD) { if (m + 2 < MF) { xin[(m + 2) % 3][0] = epi.load8(rbase + (m + 2) * 16, cbase); xin[(m + 2) % 3][1] = epi.load8(rbase + (m + 2) * 16 + 8, cbase); } }
#pragma unroll
          for (int n = 0; n < 4; ++n) {
            if constexpr (Epi::HAS_PRE) epi.pre(pn * 256 + wc * 64 + n * 16 + 4 * fq, acc[m][n]);
            const u32x2 w = (u32x2){cvt_pk_bf16(acc[m][n][0], acc[m][n][1]), cvt_pk_bf16(acc[m][n][2], acc[m][n][3])};
            *(LAS u32x2*)(stg + fr * 128 + (((n * 2 + (fq >> 1)) ^ (fr & 7)) << 4) + (fq & 1) * 8) = w;
            acc[m][n] = (f32x4){0.f, 0.f, 0.f, 0.f};
          }
          bool tr = false;
          if constexpr (Epi::HAS_T) tr = epi.transposed(pn * 256 + wc * 64);
          if (tr) {
            if constexpr (Epi::HAS_T) {
              unsigned w[8];
#pragma unroll
              for (int k = 0; k < 8; ++k) {
                const unsigned lo = *(const LAS unsigned short*)(stg + (2 * k) * 128 + ((((lane >> 3) ^ ((2 * k) & 7))) << 4) + (lane & 7) * 2);
                const unsigned hi = *(const LAS unsigned short*)(stg + (2 * k + 1) * 128 + ((((lane >> 3) ^ ((2 * k + 1) & 7))) << 4) + (lane & 7) * 2);
                w[k] = lo | (hi << 16);
              }
              epi.col16(G2_ROW0(pm) + wr * (BM / 2) + m * 16, pn * 256 + wc * 64 + lane, w);
            }
          } else {
#pragma unroll
          for (int i = 0; i < 2; ++i) {
            const int row = rr + 8 * i;
            const u32x4 v = *(const LAS u32x4*)(stg + row * 128 + ((ch ^ (row & 7)) << 4));
            if constexpr (Epi::PRELOAD) epi.row8(rbase + m * 16 + 8 * i, cbase, v, xin[m % 3][i]); else epi.row8(rbase + m * 16 + 8 * i, cbase, v);
          }
          }
          asm volatile("" ::: "memory");
        }
      } else {
      const int row0 = G2_ROW0(pm) + wr * (BM / 2) + fq * 4, col0 = pn * 256 + wc * 64 + fr;
#pragma unroll
      for (int m = 0; m < MF; ++m) {
#pragma unroll
        for (int n = 0; n < 4; ++n) { epi(row0 + m * 16, col0 + n * 16, acc[m][n]); acc[m][n] = (f32x4){0.f, 0.f, 0.f, 0.f}; }
        asm volatile("" ::: "memory");
      }
      }
      kt = 0; ++ti;
    } else ++kt;
  }
#undef G2_PMPN
#undef G2_ROW0
#undef G2_STAGE
#undef G2_BAR
#undef G2_WAITV
#undef G2_LOADF
#undef G2_MMA
}
template <class Epi>
DEV void gemm256s(const bf16_t* A, int lda, const bf16_t* Bt, int ldb, int M, int N, int K, const Epi& epi, LAS char* shm, bool rev = false, bool seqonly = false) { gemm256s_t<256, Epi>(A, lda, Bt, ldb, M, N, K, epi, shm, rev, seqonly); }


DEV int pg_perm32(int rho) { const int n = rho >> 4, i = rho & 15; return 8 * (i >> 2) + 4 * n + (i & 3); }
struct PgUnit { int pm, pn; };
DEV bool pg_next(int nM, int nN, int G, int c, int i, PgUnit& u) {
  const int nwg = nM * nN; const long L = (long)i * G + c; if (L >= nwg) return false;
  int wgid = (int)L; { const int q = nwg / 8, r = nwg % 8, xcd = wgid % 8, off = wgid / 8; wgid = (xcd < r ? xcd * (q + 1) : r * (q + 1) + (xcd - r) * q) + off; }
  const int nig = 8 * nN, gid = wgid / nig, fm = gid * 8, gsz = (nM - fm) < 8 ? (nM - fm) : 8;
  u.pm = fm + ((wgid % nig) % gsz); u.pn = (wgid % nig) / gsz; return true;
}
template <class Epi>
DEV void pg_epilogue(const Epi& E, f32x4 (&acc)[2][2][4][2], const PgUnit& u, int wr, int wc, int fr, int fq, LAS char* stg, int lane) {
  const int row0 = u.pm * 256 + wr * 64 + fr, col0 = u.pn * 256 + wc * 32 + 8 * fq;
  bool tr = false;
  if constexpr (Epi::HAS_T) tr = E.transposed(u.pn * 256 + wc * 32);
  if (tr) {
    if constexpr (Epi::HAS_T) {
#pragma unroll
      for (int ai = 0; ai < 2; ++ai)
#pragma unroll
        for (int m = 0; m < 4; ++m)
#pragma unroll
          for (int bj = 0; bj < 2; ++bj) {
            const f32x4 v0 = acc[ai][bj][m][0], v1 = acc[ai][bj][m][1];
            *(LAS u32x4*)(stg + fr * 64 + ((fq ^ ((fr >> 1) & 3)) << 4)) = (u32x4){cvt_pk_bf16(v0[0], v0[1]), cvt_pk_bf16(v0[2], v0[3]), cvt_pk_bf16(v1[0], v1[1]), cvt_pk_bf16(v1[2], v1[3])};
            const int col = lane & 31, hf = lane >> 5;
            unsigned w[4];
#pragma unroll
            for (int k = 0; k < 4; ++k) {
              const int r0 = 8 * hf + 2 * k, r1 = r0 + 1;
              const unsigned lo = *(const LAS unsigned short*)(stg + r0 * 64 + (((col >> 3) ^ ((r0 >> 1) & 3)) << 4) + (col & 7) * 2);
              const unsigned hi = *(const LAS unsigned short*)(stg + r1 * 64 + (((col >> 3) ^ ((r1 >> 1) & 3)) << 4) + (col & 7) * 2);
              w[k] = lo | (hi << 16);
            }
            E.col8(u.pm * 256 + ai * 128 + wr * 64 + m * 16 + 8 * hf, u.pn * 256 + bj * 128 + wc * 32 + col, (u32x4){w[0], w[1], w[2], w[3]});
            asm volatile("" ::: "memory");
          }
    }
  } else {
    uint4 xin[3];
#define PG_RC(i_, r_, c_) const int r_ = row0 + ((i_) >> 3) * 128 + (((i_) >> 1) & 3) * 16, c_ = col0 + ((i_) & 1) * 128
    if constexpr (Epi::PRELOAD) { { PG_RC(0, r, c); xin[0] = E.load8(r, c); } { PG_RC(1, r, c); xin[1] = E.load8(r, c); } }
#pragma unroll
    for (int i = 0; i < 16; ++i) {
      if constexpr (Epi::PRELOAD) { if (i + 2 < 16) { PG_RC(i + 2, r2, c2); xin[(i + 2) % 3] = E.load8(r2, c2); } }
      PG_RC(i, r, c);
      f32x4 v0 = acc[i >> 3][i & 1][(i >> 1) & 3][0], v1 = acc[i >> 3][i & 1][(i >> 1) & 3][1];
      if constexpr (Epi::HAS_PRE) { E.pre(c, v0); E.pre(c + 4, v1); }
      const u32x4 w = (u32x4){cvt_pk_bf16(v0[0], v0[1]), cvt_pk_bf16(v0[2], v0[3]), cvt_pk_bf16(v1[0], v1[1]), cvt_pk_bf16(v1[2], v1[3])};
      if constexpr (Epi::PRELOAD) E.row8(r, c, w, xin[i % 3]); else E.row8(r, c, w);
      asm volatile("" ::: "memory");
    }
#undef PG_RC
  }
}
template <class Epi>
DEV void gemm_pg8(const bf16_t* A, const bf16_t* Bt, int M, int N, int K, const Epi& E, LAS char* lds, bool rev = false, bool seqonly = false) {
  constexpr int HALF = 128, HTB = HALF * 64 * 2;
  const int tid = TIDX, wid = __builtin_amdgcn_readfirstlane(tid >> 6), lane = tid & 63, wr = wid >> 2, wc = wid & 3, fr = lane & 15, fq = lane >> 4;
  const int nt = K / 64, nM = seqonly ? NB * (SEQ / 256) : M / 256, nN = N / 256, G = gridDim.x, cidx = rev ? (int)gridDim.x - 1 - BIDX : BIDX;
  unsigned voffA[2], voffB[2];
#pragma unroll
  for (int i = 0; i < 2; ++i) { int R, C; stage_rc2(tid * 16 + i * 8192, R, C); const int Rb = (R & ~31) + pg_perm32(R & 31);
    voffA[i] = (unsigned)(R * K + C) * 2u; voffB[i] = (unsigned)(Rb * K + C) * 2u; }
  const size_t kstep = (size_t)(64 * 2), hstep = (size_t)HALF * K * 2, tstep = 2 * hstep;
  const unsigned ldsw = (unsigned)wid * 1024u;
  const int aoff = lds_byte2(wr * 64 + fr, fq * 8), boff = lds_byte2(wc * 32 + fr, fq * 8);
#define PG8_SA(b, h) (((b) * 2 + (h)) * HTB)
#define PG8_SB(b, h) ((4 + (b) * 2 + (h)) * HTB)
#define PG8_STAGE(bufoff, gbase, voff) do { _Pragma("unroll") for (int _i = 0; _i < 2; ++_i) \
    __builtin_amdgcn_global_load_lds((const unsigned*)((const char*)(gbase) + (voff)[_i]), (LAS unsigned*)(lds + (bufoff) + ldsw + _i * 8192), 16, 0, 0); } while (0)
#define PG8_LDA(dst, b, h) do { _Pragma("unroll") for (int m = 0; m < 4; ++m) _Pragma("unroll") for (int k = 0; k < 2; ++k) dst[m][k] = *(const LAS bf16x8*)(lds + PG8_SA(b, h) + aoff + m * 2048 + k * 1024); } while (0)
#define PG8_LDB(dst, b, h) do { _Pragma("unroll") for (int n = 0; n < 2; ++n) _Pragma("unroll") for (int k = 0; k < 2; ++k) dst[n][k] = *(const LAS bf16x8*)(lds + PG8_SB(b, h) + boff + n * 2048 + k * 1024); } while (0)
#define PG8_MMA(ai, bj, At_, Bt_) do { __builtin_amdgcn_s_setprio(1); _Pragma("unroll") for (int m = 0; m < 4; ++m) _Pragma("unroll") for (int n = 0; n < 2; ++n) _Pragma("unroll") for (int k = 0; k < 2; ++k) \
    acc[ai][bj][m][n] = __builtin_amdgcn_mfma_f32_16x16x32_bf16(Bt_[n][k], At_[m][k], acc[ai][bj][m][n], 0, 0, 0); __builtin_amdgcn_s_setprio(0); } while (0)
#define PG8_WAIT_V(n) asm volatile("s_waitcnt vmcnt(" #n ")" ::: "memory")
#define PG8_WAIT_L(n) asm volatile("s_waitcnt lgkmcnt(" #n ")" ::: "memory")
#define PG8_BAR __builtin_amdgcn_s_barrier()
#define PG8_SCHED __builtin_amdgcn_sched_barrier(0)
  PgUnit cur, nxt; int ui = 0;
  PG8_WAIT_V(0); PG8_WAIT_L(0); PG8_BAR;
#define PG_SEQ(u_) do { if (seqonly) (u_).pm = ((u_).pm >> 3) * 9 + 1 + ((u_).pm & 7); } while (0)
  if (!pg_next(nM, nN, G, cidx, 0, cur)) return;
  PG_SEQ(cur);
  f32x4 acc[2][2][4][2];
#pragma unroll
  for (int a = 0; a < 2; ++a)
#pragma unroll
    for (int b = 0; b < 2; ++b)
#pragma unroll
      for (int m = 0; m < 4; ++m)
#pragma unroll
        for (int n = 0; n < 2; ++n) acc[a][b][m][n] = (f32x4){0.f, 0.f, 0.f, 0.f};
  bf16x8 At[4][2], B0[2][2], B1[2][2];
  const char* cA = (const char*)A + (size_t)cur.pm * tstep; const char* cB = (const char*)Bt + (size_t)cur.pn * tstep;
  PG8_STAGE(PG8_SB(0, 0), cB, voffB); PG8_STAGE(PG8_SA(0, 0), cA, voffA); PG8_STAGE(PG8_SB(0, 1), cB + hstep, voffB); PG8_STAGE(PG8_SA(0, 1), cA + hstep, voffA);
  if (wr == 1) PG8_BAR;
  PG8_WAIT_V(4); PG8_BAR;
  PG8_STAGE(PG8_SB(1, 0), cB + kstep, voffB); PG8_STAGE(PG8_SA(1, 0), cA + kstep, voffA); PG8_STAGE(PG8_SB(1, 1), cB + hstep + kstep, voffB);
  PG8_WAIT_V(6); PG8_BAR;
  for (;;) {
    const bool has_next = pg_next(nM, nN, G, cidx, ui + 1, nxt); if (has_next) PG_SEQ(nxt);
    const char* nA = has_next ? (const char*)A + (size_t)nxt.pm * tstep : cA; const char* nB = has_next ? (const char*)Bt + (size_t)nxt.pn * tstep : cB;
    for (int t = 0; t < nt; t += 2) {
      const bool last = (t == nt - 2);
      const char* a1 = cA + (size_t)(t + 1) * kstep;
      const char* a2 = last ? nA : cA + (size_t)(t + 2) * kstep; const char* b2 = last ? nB : cB + (size_t)(t + 2) * kstep;
      const char* a3 = a2 + kstep; const char* b3 = b2 + kstep;
      PG8_LDB(B0, 0, 0); PG8_SCHED; PG8_LDA(At, 0, 0); PG8_STAGE(PG8_SA(1, 1), a1 + hstep, voffA);
      PG8_WAIT_L(8); PG8_BAR; PG8_WAIT_L(0); PG8_MMA(0, 0, At, B0); PG8_BAR; PG8_SCHED;
      PG8_LDB(B1, 0, 1); PG8_STAGE(PG8_SB(0, 0), b2, voffB);
      PG8_BAR; PG8_WAIT_L(0); PG8_MMA(0, 1, At, B1); PG8_BAR;
      PG8_LDA(At, 0, 1); PG8_STAGE(PG8_SA(0, 0), a2, voffA);
      PG8_BAR; PG8_WAIT_L(0); PG8_MMA(1, 0, At, B0); PG8_BAR; PG8_SCHED;
      PG8_STAGE(PG8_SB(0, 1), b2 + hstep, voffB);
      PG8_WAIT_V(6); PG8_BAR; PG8_MMA(1, 1, At, B1); PG8_BAR;
      PG8_LDB(B0, 1, 0); PG8_SCHED; PG8_LDA(At, 1, 0); PG8_STAGE(PG8_SA(0, 1), a2 + hstep, voffA);
      PG8_WAIT_L(8); PG8_BAR; PG8_WAIT_L(0); PG8_MMA(0, 0, At, B0); PG8_BAR; PG8_SCHED;
      PG8_LDB(B1, 1, 1); PG8_STAGE(PG8_SB(1, 0), b3, voffB);
      PG8_BAR; PG8_WAIT_L(0); PG8_MMA(0, 1, At, B1); PG8_BAR;
      PG8_LDA(At, 1, 1); PG8_STAGE(PG8_SA(1, 0), a3, voffA);
      PG8_BAR; PG8_WAIT_L(0); PG8_MMA(1, 0, At, B0); PG8_BAR; PG8_SCHED;
      PG8_STAGE(PG8_SB(1, 1), b3 + hstep, voffB);
      PG8_WAIT_V(6); PG8_BAR; PG8_MMA(1, 1, At, B1); PG8_BAR;
    }
    pg_epilogue(E, acc, cur, wr, wc, fr, fq, lds + 131072 + wid * 2048, lane);
    if (!has_next) break;
#pragma unroll
    for (int a = 0; a < 2; ++a)
#pragma unroll
      for (int b = 0; b < 2; ++b)
#pragma unroll
        for (int m = 0; m < 4; ++m)
#pragma unroll
          for (int n = 0; n < 2; ++n) acc[a][b][m][n] = (f32x4){0.f, 0.f, 0.f, 0.f};
    cur = nxt; cA = nA; cB = nB; ++ui;
  }
  PG8_WAIT_V(0);
  if (wr == 0) PG8_BAR;
  PG8_BAR;
#undef PG_SEQ
#undef PG8_SA
#undef PG8_SB
#undef PG8_STAGE
#undef PG8_LDA
#undef PG8_LDB
#undef PG8_MMA
#undef PG8_WAIT_V
#undef PG8_WAIT_L
#undef PG8_BAR
#undef PG8_SCHED
}

struct EpiStoreBf16 { static constexpr bool ROWVEC = false; static constexpr bool HAS_PRE = false; static constexpr bool HAS_T = false; static constexpr bool PRELOAD = false; bf16_t* C; int ldc; int ncols; DEV void operator()(int r, int c, f32x4 v) const { if (c < ncols) {
#pragma unroll
    for (int j = 0; j < 4; ++j) C[(size_t)(r + j) * ldc + c] = f2bf(v[j]); } } };
struct EpiStoreF32 { static constexpr bool ROWVEC = false; static constexpr bool HAS_PRE = false; static constexpr bool HAS_T = false; static constexpr bool PRELOAD = false; float* C; int ldc; DEV void operator()(int r, int c, f32x4 v) const {
#pragma unroll
    for (int j = 0; j < 4; ++j) C[(size_t)(r + j) * ldc + c] = v[j]; } };
struct EpiQ { static constexpr bool ROWVEC = false; static constexpr bool HAS_PRE = false; static constexpr bool HAS_T = false; static constexpr bool PRELOAD = false; bf16_t* QF; DEV void operator()(int r, int c, f32x4 v) const { const int b = r / SP, s = r - b * SP, h = c / 96, d = c - h * 96;
#pragma unroll
    for (int j = 0; j < 4; ++j) QF[((size_t)(b * 16 + h) * SP + s + j) * 96 + d] = f2bf(v[j]); } };
struct EpiKV { static constexpr bool ROWVEC = false; static constexpr bool HAS_PRE = false; static constexpr bool HAS_T = false; static constexpr bool PRELOAD = false; bf16_t* KF; bf16_t* VT; DEV void operator()(int r, int c, f32x4 v) const { const int b = r / SP, s = r - b * SP, h = c >> 7, d = c & 127;
    if (d < 64) {
#pragma unroll
      for (int j = 0; j < 4; ++j) KF[((size_t)(b * 16 + h) * SP + s + j) * 64 + d] = f2bf(v[j]);
    } else { uint2 w; w.x = (unsigned)f2bf(v[0]) | ((unsigned)f2bf(v[1]) << 16); w.y = (unsigned)f2bf(v[2]) | ((unsigned)f2bf(v[3]) << 16);
      *(uint2*)(VT + ((size_t)(b * 16 + h) * 64 + d - 64) * SP + s) = w; } } };
struct EpiRes { static constexpr bool ROWVEC = false; static constexpr bool HAS_PRE = false; static constexpr bool HAS_T = false; static constexpr bool PRELOAD = true; bf16_t* xc; bf16_t* xl; const float* ada; int layer; int goff; bool last;
  DEV bf16_t* xptr(int r, int c) const { const int b = r / SP, s = r - b * SP; return s < CTX ? (last ? nullptr : xc + ((size_t)(b * CTX + s)) * D + c) : xl + ((size_t)(b * SEQ + s - CTX)) * D + c; }
  DEV f32x4 load(int r, int c) const { const bf16_t* xp = xptr(r, c); f32x4 x = (f32x4){0.f, 0.f, 0.f, 0.f};
    if (xp) { x[0] = bf2f(xp[0]); x[1] = bf2f(xp[D]); x[2] = bf2f(xp[2 * D]); x[3] = bf2f(xp[3 * D]); } return x; }
  DEV void store(int r, int c, f32x4 v, f32x4 x) const { bf16_t* xp = xptr(r, c); if (!xp) return;
    const int b = r / SP, s = r - b * SP; const float g = ada[((size_t)(layer * 17 + (s < CTX ? 16 : b))) * 6144 + goff + c];
    xp[0] = f2bf(x[0] + g * v[0]); xp[D] = f2bf(x[1] + g * v[1]); xp[2 * D] = f2bf(x[2] + g * v[2]); xp[3 * D] = f2bf(x[3] + g * v[3]); } };
struct EpiStoreBf16R { static constexpr bool ROWVEC = true; static constexpr bool PRELOAD = false; static constexpr bool HAS_PRE = false; static constexpr bool HAS_T = false; bf16_t* C; int ldc; int ncols;
  DEV void row8(int r, int c, u32x4 v) const { if (c < ncols) *(uint4*)(C + (size_t)r * ldc + c) = make_uint4(v[0], v[1], v[2], v[3]); } };
struct EpiResR { static constexpr bool ROWVEC = true; static constexpr bool PRELOAD = true; static constexpr bool HAS_PRE = false; static constexpr bool HAS_T = false; bf16_t* xc; bf16_t* xl; const float* ada; int layer; int goff; bool last;
  DEV bf16_t* xptr(int r, int c) const { const int b = r / SP, s = r - b * SP; return s < CTX ? (last ? nullptr : xc + ((size_t)(b * CTX + s)) * D + c) : xl + ((size_t)(b * SEQ + s - CTX)) * D + c; }
  DEV uint4 load8(int r, int c) const { const bf16_t* xp = xptr(r, c); return xp ? *(const uint4*)xp : make_uint4(0u, 0u, 0u, 0u); }
  DEV void row8(int r, int c, u32x4 v, uint4 x) const { bf16_t* xp = xptr(r, c); if (!xp) return;
    const int b = r / SP, s = r - b * SP; const float* gp = ada + ((size_t)(layer * 17 + (s < CTX ? 16 : b))) * 6144 + goff + c;
    const float4 g0 = *(const float4*)gp, g1 = *(const float4*)(gp + 4);
    const unsigned xv[4] = {x.x, x.y, x.z, x.w}; const float g[8] = {g0.x, g0.y, g0.z, g0.w, g1.x, g1.y, g1.z, g1.w};
    unsigned o[4];
#pragma unroll
    for (int i = 0; i < 4; ++i) {
      const float lo = __uint_as_float(xv[i] << 16) + g[2 * i] * __uint_as_float(v[i] << 16), hi = __uint_as_float(xv[i] & 0xffff0000u) + g[2 * i + 1] * __uint_as_float(v[i] & 0xffff0000u);
      o[i] = cvt_pk_bf16(lo, hi); }
    *(uint4*)xp = make_uint4(o[0], o[1], o[2], o[3]); } };
struct EpiGla { static constexpr bool ROWVEC = false; static constexpr bool HAS_PRE = false; static constexpr bool HAS_T = false; static constexpr bool PRELOAD = false; bf16_t* QKVG; bf16_t* LG; const float* gkb; bf16_t* VTG;
  DEV void operator()(int r, int c, f32x4 v) const {
    if (c >= 1024 && c < 2048) { const int b = r / SP, s = r - b * SP; uint2 w; w.x = (unsigned)f2bf(v[0]) | ((unsigned)f2bf(v[1]) << 16); w.y = (unsigned)f2bf(v[2]) | ((unsigned)f2bf(v[3]) << 16);
      *(uint2*)(VTG + ((size_t)b * 1024 + c - 1024) * SP + s) = w; }
    else if (c < 3072) { const float sc = c < 512 ? 0.08838834764831845f : 1.0f;
#pragma unroll
      for (int j = 0; j < 4; ++j) QKVG[(size_t)(r + j) * 3072 + c] = f2bf(v[j] * sc); }
    else { const int d = (c - 3072) >> 9, n = (c - 3072) & 511; const float bias = gkb[d * 512 + n];
#pragma unroll
      for (int j = 0; j < 4; ++j) { const float z = v[j] + bias; const float ls = fminf(z, 0.f) - __logf(1.f + __expf(-fabsf(z)));
        LG[((size_t)d * T + r + j) * 512 + n] = f2bf(ls * (1.0f / 16.0f)); } } } };

struct EpiQR { static constexpr bool ROWVEC = true; static constexpr bool PRELOAD = false; static constexpr bool HAS_PRE = false; static constexpr bool HAS_T = false; bf16_t* QF;
  DEV void row8(int r, int c, u32x4 v) const { const int b = r / SP, s = r - b * SP, h = c / 96, d = c - h * 96;
    *(uint4*)(QF + ((size_t)(b * 16 + h) * SP + s) * 96 + d) = make_uint4(v[0], v[1], v[2], v[3]); } };
struct EpiKVR { static constexpr bool ROWVEC = true; static constexpr bool PRELOAD = false; static constexpr bool HAS_PRE = false; static constexpr bool HAS_T = true; bf16_t* KF; bf16_t* VT;
  DEV bool transposed(int c) const { return (c & 64) != 0; }
  DEV void row8(int r, int c, u32x4 v) const { const int b = r / SP, s = r - b * SP, h = c >> 7, d = c & 127;
    *(uint4*)(KF + ((size_t)(b * 16 + h) * SP + s) * 64 + d) = make_uint4(v[0], v[1], v[2], v[3]); }
  DEV void col16(int r, int c, const unsigned (&w)[8]) const { const int b = r / SP, s = r - b * SP, h = c >> 7, d = c & 127;
    bf16_t* vp = VT + ((size_t)(b * 16 + h) * 64 + d - 64) * SP + s;
    *(uint4*)vp = make_uint4(w[0], w[1], w[2], w[3]); *(uint4*)(vp + 8) = make_uint4(w[4], w[5], w[6], w[7]); }
  DEV void col8(int r, int c, u32x4 w) const { const int b = r / SP, s = r - b * SP, h = c >> 7, d = c & 127;
    *(uint4*)(VT + ((size_t)(b * 16 + h) * 64 + d - 64) * SP + s) = make_uint4(w[0], w[1], w[2], w[3]); } };
struct EpiGluResR { static constexpr bool ROWVEC = true; static constexpr bool PRELOAD = true; static constexpr bool HAS_PRE = false; static constexpr bool HAS_T = false; bf16_t* xc; bf16_t* xl; const float* ada; int layer;
  DEV bf16_t* xptr(int r, int c) const { const int b = r / SP, s = r - b * SP; return s < CTX ? xc + ((size_t)(b * CTX + s)) * D + c : xl + ((size_t)(b * SEQ + s - CTX)) * D + c; }
  DEV uint4 load8(int r, int c) const { const uint2 x = *(const uint2*)xptr(r, c >> 1); return make_uint4(x.x, x.y, 0u, 0u); }
  DEV void row8(int r, int c, u32x4 v, uint4 x) const { const int oc = c >> 1; bf16_t* xp = xptr(r, oc);
    const int b = r / SP, s = r - b * SP; const float4 g1 = *(const float4*)(ada + ((size_t)(layer * 17 + (s < CTX ? 16 : b))) * 6144 + 2048 + oc);
    const float g[4] = {g1.x, g1.y, g1.z, g1.w}; const unsigned xv[2] = {x.x, x.y};
    float o[4];
#pragma unroll
    for (int i = 0; i < 4; ++i) { const float a = __uint_as_float(v[i] << 16), gt = __uint_as_float(v[i] & 0xffff0000u);
      const float xo = (i & 1) ? __uint_as_float(xv[i >> 1] & 0xffff0000u) : __uint_as_float(xv[i >> 1] << 16);
      o[i] = xo + g[i] * a * sigm(gt); }
    *(uint2*)xp = make_uint2(cvt_pk_bf16(o[0], o[1]), cvt_pk_bf16(o[2], o[3])); } };
struct EpiGlaR { static constexpr bool ROWVEC = true; static constexpr bool PRELOAD = false; static constexpr bool HAS_PRE = true; static constexpr bool HAS_T = true; bf16_t* QKVG; bf16_t* LG; const float* gkb; bf16_t* VTG;
  DEV void pre(int c, f32x4& v) const {
    if (c < 512) { v[0] *= 0.08838834764831845f; v[1] *= 0.08838834764831845f; v[2] *= 0.08838834764831845f; v[3] *= 0.08838834764831845f; }
    else if (c >= 3072) { const float4 bias = *(const float4*)(gkb + c - 3072); const float bb[4] = {bias.x, bias.y, bias.z, bias.w};
#pragma unroll
      for (int j = 0; j < 4; ++j) { const float z = v[j] + bb[j]; v[j] = (fminf(z, 0.f) - __logf(1.f + __expf(-fabsf(z)))) * (1.0f / 16.0f); } } }
  DEV bool transposed(int c) const { return c >= 1024 && c < 2048; }
  DEV void row8(int r, int c, u32x4 v) const {
    if (c < 3072) *(uint4*)(QKVG + (size_t)r * 3072 + c) = make_uint4(v[0], v[1], v[2], v[3]);
    else { const int d = (c - 3072) >> 9, n = (c - 3072) & 511; *(uint4*)(LG + ((size_t)d * T + r) * 512 + n) = make_uint4(v[0], v[1], v[2], v[3]); } }
  DEV void col16(int r, int c, const unsigned (&w)[8]) const { const int b = r / SP, s = r - b * SP;
    bf16_t* vp = VTG + ((size_t)b * 1024 + c - 1024) * SP + s;
    *(uint4*)vp = make_uint4(w[0], w[1], w[2], w[3]); *(uint4*)(vp + 8) = make_uint4(w[4], w[5], w[6], w[7]); }
  DEV void col8(int r, int c, u32x4 w) const { const int b = r / SP, s = r - b * SP;
    *(uint4*)(VTG + ((size_t)b * 1024 + c - 1024) * SP + s) = make_uint4(w[0], w[1], w[2], w[3]); } };
DEV void phase_mla_norm(CP p, int j) {
  const bf16_t* A1 = (const bf16_t*)(p.scratch + OFF_A1); bf16_t* CQN = (bf16_t*)(p.scratch + OFF_CQN); bf16_t* CKVN = (bf16_t*)(p.scratch + OFF_CKVN); bf16_t* KPE = (bf16_t*)(p.scratch + OFF_KPE);
  const int lane = TIDX & 63, gw = BIDX * (NTHR / 64) + (TIDX >> 6), nw = gridDim.x * (NTHR / 64);
  const float* qn = p.mla_q_norm + j * 384; const float* kn = p.mla_kv_norm + j * 256;
  for (int t0 = gw; t0 < T; t0 += 2 * nw) {
    float v[2][6], w[2][4], val[2];
#pragma unroll
    for (int u = 0; u < 2; ++u) { const int t = t0 + u * nw; if (t < T) { const bf16_t* a = A1 + (size_t)t * 768;
#pragma unroll
      for (int i = 0; i < 6; ++i) v[u][i] = bf2f(a[lane + 64 * i]);
#pragma unroll
      for (int i = 0; i < 4; ++i) w[u][i] = bf2f(a[384 + lane + 64 * i]);
      val[u] = bf2f(a[640 + (lane & 31)]); } }
#pragma unroll
    for (int u = 0; u < 2; ++u) { const int t = t0 + u * nw; if (t < T) {
      float ss = 0.f;
#pragma unroll
      for (int i = 0; i < 6; ++i) ss += v[u][i] * v[u][i];
      ss = wave_sum(ss); float rstd = rsqrtf(ss * (1.0f / 384.0f) + 1e-6f);
#pragma unroll
      for (int i = 0; i < 6; ++i) CQN[(size_t)t * 384 + lane + 64 * i] = f2bf(v[u][i] * rstd * qn[lane + 64 * i]);
      ss = 0.f;
#pragma unroll
      for (int i = 0; i < 4; ++i) ss += w[u][i] * w[u][i];
      ss = wave_sum(ss); rstd = rsqrtf(ss * (1.0f / 256.0f) + 1e-6f);
#pragma unroll
      for (int i = 0; i < 4; ++i) CKVN[(size_t)t * 256 + lane + 64 * i] = f2bf(w[u][i] * rstd * kn[lane + 64 * i]);
      const int b = t / SP, s = t - b * SP;
      float vl = val[u];
      const float other = __shfl_xor(vl, 8);
      if (s >= CTX) { const int pos = s - CTX, d = lane & 31, hb = d >> 4, dd = d & 15, i = dd & 7;
        const float cs = p.rope[pos * 32 + hb * 16 + i], sn = p.rope[pos * 32 + hb * 16 + 8 + i];
        vl = dd < 8 ? vl * cs - other * sn : vl * cs + other * sn; }
      if (lane < 32) KPE[(size_t)t * 32 + lane] = f2bf(vl);
    } }
  }
}

DEV void phase_attn_naive(CP p, bool last, float* lds) {
  const bf16_t* QF = (const bf16_t*)(p.scratch + OFF_QF); const bf16_t* KF = (const bf16_t*)(p.scratch + OFF_KF); const bf16_t* VF = (const bf16_t*)(p.scratch + OFF_VF);
  bf16_t* O = (bf16_t*)(p.scratch + OFF_O);
  float* Ks = lds;
  float* Vs = lds + 32 * 96;
  const int tid = TIDX;
  const int nitems = 1024 + (last ? 0 : 256);
  for (int item = BIDX; item < nitems; item += gridDim.x) {
    int b, hh, q0, nq, nkeys;
    if (item < 1024) { b = item >> 6; hh = (item >> 2) & 15; q0 = CTX + (item & 3) * 512; nq = 512; nkeys = SP; }
    else { const int it = item - 1024; b = it >> 4; hh = it & 15; q0 = 0; nq = 256; nkeys = CTX; }
    const size_t bh = (size_t)(b * 16 + hh) * SP;
    const bool active = tid < nq;
    const int sq = q0 + (active ? tid : 0);
    float q[96];
    { const bf16_t* qp = QF + (bh + sq) * 96;
#pragma unroll
      for (int i = 0; i < 96; i += 2) { const unsigned u = *(const unsigned*)(qp + i); q[i] = __uint_as_float(u << 16); q[i + 1] = __uint_as_float(u & 0xffff0000u); } }
    if (sq >= CTX) { const float* r = p.rope + (sq - CTX) * 32;
#pragma unroll
      for (int hb = 0; hb < 2; ++hb)
#pragma unroll
        for (int i = 0; i < 8; ++i) { const float cs = r[hb * 16 + i], sn = r[hb * 16 + 8 + i], x1 = q[64 + hb * 16 + i], x2 = q[64 + hb * 16 + 8 + i];
          q[64 + hb * 16 + i] = x1 * cs - x2 * sn; q[64 + hb * 16 + 8 + i] = x2 * cs + x1 * sn; } }
#pragma unroll
    for (int i = 0; i < 96; ++i) q[i] *= 0.10206207261596577f;
    float acc[64], m = -1e30f, l = 0.f;
#pragma unroll
    for (int i = 0; i < 64; ++i) acc[i] = 0.f;
    for (int k0 = 0; k0 < nkeys; k0 += 32) {
      __syncthreads();
      for (int idx = tid; idx < 32 * 96 / 2; idx += NTHR) { const unsigned u = *(const unsigned*)(KF + (bh + k0) * 96 + idx * 2); Ks[idx * 2] = __uint_as_float(u << 16); Ks[idx * 2 + 1] = __uint_as_float(u & 0xffff0000u); }
      for (int idx = tid; idx < 32 * 64 / 2; idx += NTHR) { const unsigned u = *(const unsigned*)(VF + (bh + k0) * 64 + idx * 2); Vs[idx * 2] = __uint_as_float(u << 16); Vs[idx * 2 + 1] = __uint_as_float(u & 0xffff0000u); }
      __syncthreads();
#pragma unroll 1
      for (int kk = 0; kk < 32; ++kk) {
        float s = 0.f;
#pragma unroll
        for (int i = 0; i < 96; i += 4) { const float4 kv = *(const float4*)(Ks + kk * 96 + i); s += q[i] * kv.x + q[i + 1] * kv.y + q[i + 2] * kv.z + q[i + 3] * kv.w; }
        if (s > m) { const float corr = __expf(m - s); l *= corr;
#pragma unroll
          for (int i = 0; i < 64; ++i) acc[i] *= corr;
          m = s; }
        const float pe = __expf(s - m); l += pe;
#pragma unroll
        for (int i = 0; i < 64; i += 4) { const float4 vv = *(const float4*)(Vs + kk * 64 + i); acc[i] += pe * vv.x; acc[i + 1] += pe * vv.y; acc[i + 2] += pe * vv.z; acc[i + 3] += pe * vv.w; }
      }
    }
    if (active) { const float inv = 1.f / l; bf16_t* op = O + ((size_t)(b * SP + sq)) * D + hh * 64;
#pragma unroll
      for (int i = 0; i < 64; i += 2) *(unsigned*)(op + i) = (unsigned)f2bf(acc[i] * inv) | ((unsigned)f2bf(acc[i + 1] * inv) << 16); }
  }
}


DEV void phase_attn_mfma(CP p, bool last, LAS char* shm) {
  const bf16_t* QF = (const bf16_t*)(p.scratch + OFF_QF); const bf16_t* KF = (const bf16_t*)(p.scratch + OFF_KF); const bf16_t* VT = (const bf16_t*)(p.scratch + OFF_VF);
  bf16_t* O = (bf16_t*)(p.scratch + OFF_O); const bf16_t* KPE = (const bf16_t*)(p.scratch + OFF_KPE);
  constexpr int KSTR = 208, VSTR = 136, KBYTES = 64 * KSTR, VBYTES = 64 * VSTR;
  const int tid = TIDX, wid = tid >> 6, lane = tid & 63, ql = lane & 31, hh = lane >> 5;
  const int nitems = 2048 + (last ? 0 : 256), G = gridDim.x;
  const int k_idx0 = tid, k_idx1 = tid + 512;
  const int vd = tid >> 3, vpart = tid & 7;
  const int bid_ = BIDX, vb_ = (G & 7) ? bid_ : (bid_ & 7) * (G >> 3) + (bid_ >> 3);
  for (int item = vb_; item < nitems; item += G) {
    int b, h, q0, nk;
    if (item < 2048) { b = item >> 7; h = (item >> 3) & 15; q0 = CTX + (item & 7) * 256; nk = SP; }
    else { const int it = item - 2048; b = it >> 4; h = it & 15; q0 = 0; nk = CTX; }
    const size_t bh = (size_t)(b * 16 + h);
    const int sq = q0 + wid * 32 + ql;
    bf16x8 qf[6];
    { const bf16_t* qp = QF + (bh * SP + sq) * 96 + 8 * hh;
      const float qs = 0.10206207261596577f * 1.4426950408889634f;
#pragma unroll
      for (int s = 0; s < 6; ++s) {
        const uint4 w = *(const uint4*)(qp + 16 * s); const unsigned ww[4] = {w.x, w.y, w.z, w.w};
        float v[8];
#pragma unroll
        for (int i = 0; i < 4; ++i) { v[2 * i] = __uint_as_float(ww[i] << 16); v[2 * i + 1] = __uint_as_float(ww[i] & 0xffff0000u); }
        if (s >= 4 && sq >= CTX) { const float* r = p.rope + (sq - CTX) * 32 + (s - 4) * 16;
#pragma unroll
          for (int j = 0; j < 8; ++j) { const float pv = __shfl_xor(v[j], 32), cs = r[j], sn = r[8 + j]; v[j] = hh ? v[j] * cs + pv * sn : v[j] * cs - pv * sn; } }
        unsigned o[4];
#pragma unroll
        for (int i = 0; i < 4; ++i) o[i] = cvt_pk_bf16(v[2 * i] * qs, v[2 * i + 1] * qs);
        qf[s] = __builtin_bit_cast(bf16x8, make_uint4(o[0], o[1], o[2], o[3]));
      } }
    f32x16 oacc[2];
#pragma unroll
    for (int dt = 0; dt < 2; ++dt)
#pragma unroll
      for (int r = 0; r < 16; ++r) oacc[dt][r] = 0.f;
    float m = 0.f, l0 = 0.f, l1 = 0.f, l2 = 0.f, l3 = 0.f;
    const int ntile = nk >> 6;
    uint4 kr0a, kr1a, vra, kr0b, kr1b, vrb;
    const int kp0 = k_idx0 % 12, kk0 = k_idx0 / 12, kp1 = k_idx1 % 12, kk1 = k_idx1 / 12;
    const bf16_t* ksrc0 = kp0 < 8 ? KF + (bh * SP + kk0) * 64 + kp0 * 8 : KPE + ((size_t)b * SP + kk0) * 32 + (kp0 - 8) * 8; const int kst0 = kp0 < 8 ? 64 : 32;
    const bf16_t* ksrc1 = kp1 < 8 ? KF + (bh * SP + kk1) * 64 + kp1 * 8 : KPE + ((size_t)b * SP + kk1) * 32 + (kp1 - 8) * 8; const int kst1 = kp1 < 8 ? 64 : 32;
    const bf16_t* vbase = VT + (bh * 64 + vd) * SP + vpart * 8;
    LAS char* const kw0 = shm + (k_idx0 / 12) * KSTR + (k_idx0 % 12) * 16;
    LAS char* const kw1 = shm + (k_idx1 / 12) * KSTR + (k_idx1 % 12) * 16;
    LAS char* const vw = shm + 2 * KBYTES + vd * VSTR + vpart * 16;
    const LAS char* const kfb = shm + ql * KSTR + 16 * hh;
    const LAS char* const vfb = shm + 2 * KBYTES + ql * VSTR + 8 * hh;
#define ATT_LOAD(R, t_) do { const int k0_ = (t_) * 64; kr0##R = *(const uint4*)(ksrc0 + (size_t)k0_ * kst0); \
      if (k_idx1 < 768) kr1##R = *(const uint4*)(ksrc1 + (size_t)k0_ * kst1); vr##R = *(const uint4*)(vbase + k0_); } while (0)
#define ATT_WRITE(R, ks_, vs_) do { *(LAS u32x4*)(kw0 + (ks_) * KBYTES) = (u32x4){kr0##R.x, kr0##R.y, kr0##R.z, kr0##R.w}; \
      if (k_idx1 < 768) *(LAS u32x4*)(kw1 + (ks_) * KBYTES) = (u32x4){kr1##R.x, kr1##R.y, kr1##R.z, kr1##R.w}; \
      LAS char* vb_ = vw + (vs_) * VBYTES; *(LAS u32x2*)vb_ = (u32x2){vr##R.x, vr##R.y}; *(LAS u32x2*)(vb_ + 8) = (u32x2){vr##R.z, vr##R.w}; } while (0)
#define ATT_STEP(CUR, NXT, KS_NEXT, KS_WRITE, RL, RW) do { \
      if (t + 3 < ntile) ATT_LOAD(RL, t + 3); \
      const LAS char* kb_ = kfb + (KS_NEXT) * KBYTES; const LAS char* vb2_ = vfb + vs * VBYTES; \
      const float ninit_ = -m; \
      _Pragma("unroll") for (int r = 0; r < 16; ++r) { NXT[0][r] = ninit_; NXT[1][r] = ninit_; } \
      bf16x8 kf_[12]; unsigned pw_[16]; \
      kf_[0] = ld_frag_lds(kb_); kf_[1] = ld_frag_lds(kb_ + 32 * KSTR); \
      _Pragma("unroll") for (int i = 0; i < 12; ++i) { \
        if (i + 2 < 12) kf_[i + 2] = ld_frag_lds(kb_ + ((i + 2) & 1) * 32 * KSTR + ((i + 2) >> 1) * 32); \
        NXT[i & 1] = __builtin_amdgcn_mfma_f32_32x32x16_bf16(kf_[i], qf[i >> 1], NXT[i & 1], 0, 0, 0); \
        _Pragma("unroll") for (int j = (16 * i) / 12; j < (16 * (i + 1)) / 12; ++j) { \
          const float ea_ = __builtin_amdgcn_exp2f(CUR[j >> 3][(2 * j) & 15]), eb_ = __builtin_amdgcn_exp2f(CUR[j >> 3][(2 * j + 1) & 15]); \
          if (j & 1) { l2 += ea_; l3 += eb_; } else { l0 += ea_; l1 += eb_; } pw_[j] = cvt_pk_bf16(ea_, eb_); } \
        __builtin_amdgcn_sched_barrier(0); } \
      float mx_ = NXT[0][0]; \
      u32x2 va_[8], vb3_[8]; \
      va_[0] = *(const LAS u32x2*)(vb2_); vb3_[0] = *(const LAS u32x2*)(vb2_ + 16); \
      _Pragma("unroll") for (int i = 0; i < 8; ++i) { \
        if (i + 1 < 8) { const LAS char* vp_ = vb2_ + ((i + 1) & 1) * 32 * VSTR + (((i + 1) >> 1) & 1) * 64 + ((i + 1) >> 2) * 32; va_[i + 1] = *(const LAS u32x2*)vp_; vb3_[i + 1] = *(const LAS u32x2*)(vp_ + 16); } \
        const int kk_ = (i >> 1) & 1, s2_ = i >> 2; \
        const bf16x8 vf_ = __builtin_bit_cast(bf16x8, (u32x4){va_[i].x, va_[i].y, vb3_[i].x, vb3_[i].y}); \
        const bf16x8 pf_ = __builtin_bit_cast(bf16x8, (u32x4){pw_[kk_ * 8 + s2_ * 4], pw_[kk_ * 8 + s2_ * 4 + 1], pw_[kk_ * 8 + s2_ * 4 + 2], pw_[kk_ * 8 + s2_ * 4 + 3]}); \
        oacc[i & 1] = __builtin_amdgcn_mfma_f32_32x32x16_bf16(vf_, pf_, oacc[i & 1], 0, 0, 0); \
        _Pragma("unroll") for (int x = 4 * i; x < 4 * i + 4; ++x) mx_ = fmaxf(mx_, NXT[x >> 4][x & 15]); \
        __builtin_amdgcn_sched_barrier(0); } \
      mx_ = fmaxf(mx_, __shfl_xor(mx_, 32)); \
      if (t + 1 < ntile && __any(mx_ > 8.0f)) {              \
        const float delta_ = mx_ > 8.0f ? mx_ : 0.f, corr_ = __builtin_amdgcn_exp2f(-delta_); \
        m += delta_; l0 *= corr_; l1 *= corr_; l2 *= corr_; l3 *= corr_; \
        _Pragma("unroll") for (int r = 0; r < 16; ++r) { oacc[0][r] *= corr_; oacc[1][r] *= corr_; NXT[0][r] -= delta_; NXT[1][r] -= delta_; } } \
      if (t + 2 < ntile) ATT_WRITE(RW, KS_WRITE, vs == 0 ? 2 : vs - 1); \
      vs = vs == 2 ? 0 : vs + 1; ++t; \
      GRAW_BARRIER(); } while (0)
    __syncthreads();
    ATT_LOAD(a, 0); ATT_WRITE(a, 0, 0);
    ATT_LOAD(a, 1); ATT_LOAD(b, 2);
    GRAW_BARRIER();
    f32x16 sa[2], sb[2];
    {
#pragma unroll
      for (int r = 0; r < 16; ++r) { sa[0][r] = 0.f; sa[1][r] = 0.f; }
#pragma unroll
      for (int i = 0; i < 12; ++i) sa[i & 1] = __builtin_amdgcn_mfma_f32_32x32x16_bf16(ld_frag_lds(kfb + (i & 1) * 32 * KSTR + (i >> 1) * 32), qf[i >> 1], sa[i & 1], 0, 0, 0);
      float mx = sa[0][0];
#pragma unroll
      for (int x = 1; x < 32; ++x) mx = fmaxf(mx, sa[x >> 4][x & 15]);
      mx = fmaxf(mx, __shfl_xor(mx, 32));
      m = mx;
#pragma unroll
      for (int r = 0; r < 16; ++r) { sa[0][r] -= mx; sa[1][r] -= mx; }
    }
    ATT_WRITE(a, 1, 1);
    GRAW_BARRIER();
    int t = 0, vs = 0;
    while (t < ntile) {
      ATT_STEP(sa, sb, 1, 0, a, b);
      ATT_STEP(sb, sa, 0, 1, b, a);
    }
#undef ATT_STEP
#undef ATT_LOAD
#undef ATT_WRITE
    float l = (l0 + l1) + (l2 + l3);
    l += __shfl_xor(l, 32);
    const float inv = 1.f / l;
    bf16_t* op = O + ((size_t)(b * SP + sq)) * D + h * 64 + 4 * hh;
#pragma unroll
    for (int dt = 0; dt < 2; ++dt)
#pragma unroll
      for (int g = 0; g < 4; ++g) { uint2 w; w.x = cvt_pk_bf16(oacc[dt][4 * g] * inv, oacc[dt][4 * g + 1] * inv); w.y = cvt_pk_bf16(oacc[dt][4 * g + 2] * inv, oacc[dt][4 * g + 3] * inv);
        *(uint2*)(op + dt * 32 + 8 * g) = w; }
  }
}

#define INSERT16(val, pay, tv, ti) { float s_ = (val); int i_ = (pay); _Pragma("unroll") for (int j_ = 0; j_ < 16; ++j_) { if (s_ > tv[j_]) { float t_ = tv[j_]; tv[j_] = s_; s_ = t_; int u_ = ti[j_]; ti[j_] = i_; i_ = u_; } } }

DEV void phase_peer_subtopk(CP p, int layer, float* lds) {
  const float* PQ = (const float*)(p.scratch + OFF_PQ); float* SV = (float*)(p.scratch + OFF_SV); int* SI = (int*)(p.scratch + OFF_SI);
  const int tid = TIDX;
  for (int item = BIDX; item < 16 * 72; item += gridDim.x) {
    const int hp = item / 72, tb = item - hp * 72, t = tb * 512 + tid;
    __syncthreads();
    const float* kp = p.peer_keys + ((size_t)(layer * 16 + hp)) * 128 * 64;
    for (int idx = tid; idx < 128 * 64 / 4; idx += NTHR) *(float4*)(lds + idx * 4) = *(const float4*)(kp + idx * 4);
    __syncthreads();
    float q[64];
#pragma unroll
    for (int i = 0; i < 64; i += 4) { const float4 v = *(const float4*)(PQ + (size_t)t * 1024 + hp * 64 + i); q[i] = v.x; q[i + 1] = v.y; q[i + 2] = v.z; q[i + 3] = v.w; }
    float tv[16]; int ti[16];
#pragma unroll
    for (int j = 0; j < 16; ++j) { tv[j] = -3.0e38f; ti[j] = 0; }
#pragma unroll 1
    for (int key = 0; key < 128; ++key) {
      float s = 0.f;
#pragma unroll
      for (int i = 0; i < 64; i += 4) { const float4 kv = *(const float4*)(lds + key * 64 + i); s += q[i] * kv.x + q[i + 1] * kv.y + q[i + 2] * kv.z + q[i + 3] * kv.w; }
      INSERT16(s, key, tv, ti);
    }
#pragma unroll
    for (int j = 0; j < 16; ++j) { SV[((size_t)t * 16 + hp) * 16 + j] = tv[j]; SI[((size_t)t * 16 + hp) * 16 + j] = ti[j]; }
  }
}

DEV void phase_peer_final_topk(CP p) {
  const float* SV = (const float*)(p.scratch + OFF_SV); const int* SI = (const int*)(p.scratch + OFF_SI);
  int* EID = (int*)(p.scratch + OFF_EID); float* GATE = (float*)(p.scratch + OFF_GATE);
  for (int idx = BIDX * NTHR + TIDX; idx < T * 8; idx += gridDim.x * NTHR) {
    float a[16], bq[16]; int ia[16], ib[16];
#pragma unroll
    for (int j = 0; j < 16; ++j) { a[j] = SV[(size_t)idx * 32 + j]; ia[j] = SI[(size_t)idx * 32 + j]; bq[j] = SV[(size_t)idx * 32 + 16 + j]; ib[j] = SI[(size_t)idx * 32 + 16 + j]; }
    float tv[16]; int ti[16];
#pragma unroll
    for (int j = 0; j < 16; ++j) { tv[j] = -3.0e38f; ti[j] = 0; }
#pragma unroll
    for (int i0 = 0; i0 < 16; ++i0)
#pragma unroll
      for (int i1 = 0; i1 < 16; ++i1)
        if ((i0 + 1) * (i1 + 1) <= 16) INSERT16(a[i0] + bq[i1], ia[i0] * 128 + ib[i1], tv, ti);
    float e[16], sum = 0.f;
#pragma unroll
    for (int j = 0; j < 16; ++j) { e[j] = __expf(tv[j] - tv[0]); sum += e[j]; }
    const float inv = 1.f / sum;
#pragma unroll
    for (int j = 0; j < 16; ++j) { EID[(size_t)idx * 16 + j] = ti[j]; GATE[(size_t)idx * 16 + j] = e[j] * inv; }
  }
}

DEV void phase_peer_gather(CP p, int layer) {
  const int* EID = (const int*)(p.scratch + OFF_EID); const float* GATE = (const float*)(p.scratch + OFF_GATE);
  const int lane = TIDX & 63, gw = BIDX * (NTHR / 64) + (TIDX >> 6), nw = gridDim.x * (NTHR / 64);
  const bool last = layer == 3;
  const float* U = p.peer_u + (size_t)layer * 16384 * 1024; const float* V = p.peer_v + (size_t)layer * 16384 * 1024;
  for (int t = gw; t < T; t += nw) {
    const int b = t / SP, s = t - b * SP;
    if (last && s < CTX) continue;
    float x[16];
    { const bf16_t* hr = p.h + (size_t)t * D;
#pragma unroll
      for (int j = 0; j < 4; ++j) { const uint2 w = *(const uint2*)(hr + j * 256 + lane * 4); x[j * 4] = __uint_as_float(w.x << 16); x[j * 4 + 1] = __uint_as_float(w.x & 0xffff0000u); x[j * 4 + 2] = __uint_as_float(w.y << 16); x[j * 4 + 3] = __uint_as_float(w.y & 0xffff0000u); } }
    float f[16];
#pragma unroll
    for (int i = 0; i < 16; ++i) f[i] = 0.f;
#pragma unroll 2
    for (int e = 0; e < 128; ++e) {
      const int eid = EID[(size_t)t * 128 + e]; const float gate = GATE[(size_t)t * 128 + e];
      const float* ur = U + (size_t)eid * 1024; const float* vr = V + (size_t)eid * 1024;
      float4 uu[4], vv[4];
#pragma unroll
      for (int j = 0; j < 4; ++j) { uu[j] = *(const float4*)(ur + j * 256 + lane * 4); vv[j] = *(const float4*)(vr + j * 256 + lane * 4); }
      float dsum = 0.f;
#pragma unroll
      for (int j = 0; j < 4; ++j) dsum += uu[j].x * x[j * 4] + uu[j].y * x[j * 4 + 1] + uu[j].z * x[j * 4 + 2] + uu[j].w * x[j * 4 + 3];
      dsum = wave_sum(dsum);
      const float w = gate * gelu_tanh(dsum);
#pragma unroll
      for (int j = 0; j < 4; ++j) { f[j * 4] += w * vv[j].x; f[j * 4 + 1] += w * vv[j].y; f[j * 4 + 2] += w * vv[j].z; f[j * 4 + 3] += w * vv[j].w; }
    }
    bf16_t* xr = xrow_ptr(p, t);
    float xv[16]; load_row_bf(xr, lane, xv);
    const float* ad = ada_ptr(p, layer, t);
#pragma unroll
    for (int j = 0; j < 4; ++j) { const float4 g2 = *(const float4*)(ad + 5120 + j * 256 + lane * 4);
      xv[j * 4] += g2.x * f[j * 4]; xv[j * 4 + 1] += g2.y * f[j * 4 + 1]; xv[j * 4 + 2] += g2.z * f[j * 4 + 2]; xv[j * 4 + 3] += g2.w * f[j * 4 + 3]; }
    if (!last) {
      store_row_bf(xr, lane, xv);
      const float* ad2 = ada_ptr(p, layer + 1, t);
      norm_mod_store(xv, p.norm_g + ((layer + 1) * 2) * D, ad2 + 1024, ad2, p.h + (size_t)t * D, lane);
    } else {
      float ss = 0.f;
#pragma unroll
      for (int i = 0; i < 16; ++i) ss += xv[i] * xv[i];
      ss = wave_sum(ss); const float rstd = rsqrtf(ss * (1.0f / D) + 1e-6f);
#pragma unroll
      for (int j = 0; j < 4; ++j) { const float4 g = *(const float4*)(p.final_g + j * 256 + lane * 4);
        xv[j * 4] *= rstd * g.x; xv[j * 4 + 1] *= rstd * g.y; xv[j * 4 + 2] *= rstd * g.z; xv[j * 4 + 3] *= rstd * g.w; }
      store_row_f32(p.out + ((size_t)(b * SEQ + s - CTX)) * D, lane, xv);
    }
  }
}


typedef float f32x2 __attribute__((ext_vector_type(2)));
constexpr float U8_SCALE = 64.0f, V8_SCALE = 4.0f;
DEV unsigned pack4_fp8(float a, float b, float c, float d, float sc) {
  a = fminf(fmaxf(a * sc, -448.f), 448.f); b = fminf(fmaxf(b * sc, -448.f), 448.f); c = fminf(fmaxf(c * sc, -448.f), 448.f); d = fminf(fmaxf(d * sc, -448.f), 448.f);
  int w = 0; w = __builtin_amdgcn_cvt_pk_fp8_f32(a, b, w, false); w = __builtin_amdgcn_cvt_pk_fp8_f32(c, d, w, true); return (unsigned)w;
}
DEV void phase_peer_tables(CP p, int layer) {
  uint4* UV = (uint4*)(p.scratch + OFF_U8);
  const float4* U = (const float4*)(p.peer_u + (size_t)layer * 16384 * 1024); const float4* V = (const float4*)(p.peer_v + (size_t)layer * 16384 * 1024);
  const int n16 = 16384 * 1024 / 16;
  for (int i = BIDX * NTHR + TIDX; i < n16; i += gridDim.x * NTHR) {
    unsigned uw0, uw1;
    { const float4 a = U[(size_t)i * 4], b = U[(size_t)i * 4 + 1], c = U[(size_t)i * 4 + 2], d = U[(size_t)i * 4 + 3];
      const float e[16] = {a.x, a.y, a.z, a.w, b.x, b.y, b.z, b.w, c.x, c.y, c.z, c.w, d.x, d.y, d.z, d.w};
      unsigned w0 = 0u, w1 = 0u;
#define U4C(k_) fminf(fmaxf(e[k_] * U8_SCALE, -6.f), 6.f)
      w0 = __builtin_amdgcn_cvt_scalef32_pk_fp4_f32(w0, U4C(0), U4C(1), 1.0f, 0); w0 = __builtin_amdgcn_cvt_scalef32_pk_fp4_f32(w0, U4C(2), U4C(3), 1.0f, 1);
      w0 = __builtin_amdgcn_cvt_scalef32_pk_fp4_f32(w0, U4C(4), U4C(5), 1.0f, 2); w0 = __builtin_amdgcn_cvt_scalef32_pk_fp4_f32(w0, U4C(6), U4C(7), 1.0f, 3);
      w1 = __builtin_amdgcn_cvt_scalef32_pk_fp4_f32(w1, U4C(8), U4C(9), 1.0f, 0); w1 = __builtin_amdgcn_cvt_scalef32_pk_fp4_f32(w1, U4C(10), U4C(11), 1.0f, 1);
      w1 = __builtin_amdgcn_cvt_scalef32_pk_fp4_f32(w1, U4C(12), U4C(13), 1.0f, 2); w1 = __builtin_amdgcn_cvt_scalef32_pk_fp4_f32(w1, U4C(14), U4C(15), 1.0f, 3);
#undef U4C
      uw0 = w0; uw1 = w1; }
    { const float4 a = V[(size_t)i * 4], b = V[(size_t)i * 4 + 1], c = V[(size_t)i * 4 + 2], d = V[(size_t)i * 4 + 3];
      const float e[16] = {a.x, a.y, a.z, a.w, b.x, b.y, b.z, b.w, c.x, c.y, c.z, c.w, d.x, d.y, d.z, d.w};
      unsigned w0 = 0u, w1 = 0u;
#define V4C(k_) fminf(fmaxf(e[k_] * V8_SCALE, -6.f), 6.f)
      w0 = __builtin_amdgcn_cvt_scalef32_pk_fp4_f32(w0, V4C(0), V4C(1), 1.0f, 0); w0 = __builtin_amdgcn_cvt_scalef32_pk_fp4_f32(w0, V4C(2), V4C(3), 1.0f, 1);
      w0 = __builtin_amdgcn_cvt_scalef32_pk_fp4_f32(w0, V4C(4), V4C(5), 1.0f, 2); w0 = __builtin_amdgcn_cvt_scalef32_pk_fp4_f32(w0, V4C(6), V4C(7), 1.0f, 3);
      w1 = __builtin_amdgcn_cvt_scalef32_pk_fp4_f32(w1, V4C(8), V4C(9), 1.0f, 0); w1 = __builtin_amdgcn_cvt_scalef32_pk_fp4_f32(w1, V4C(10), V4C(11), 1.0f, 1);
      w1 = __builtin_amdgcn_cvt_scalef32_pk_fp4_f32(w1, V4C(12), V4C(13), 1.0f, 2); w1 = __builtin_amdgcn_cvt_scalef32_pk_fp4_f32(w1, V4C(14), V4C(15), 1.0f, 3);
#undef V4C
      UV[i] = make_uint4(uw0, uw1, w0, w1); }
  }
}
DEV float rdlane_f(float v, int l) { return __builtin_bit_cast(float, __builtin_amdgcn_readlane(__builtin_bit_cast(int, v), l)); }

DEV void phase_peer_gather8(CP p, int layer) {
  const int* EID = (const int*)(p.scratch + OFF_EID); const float* GATE = (const float*)(p.scratch + OFF_GATE);
  const uint4* UV = (const uint4*)(p.scratch + OFF_U8);
  const int lane = TIDX & 63, gw = BIDX * (NTHR / 64) + (TIDX >> 6), nw = gridDim.x * (NTHR / 64);
  const bool last = layer == 3;
  int t = gw;
  while (last && t < T && (t % SP) < CTX) t += nw;
  if (t >= T) return;
  int eid_lo = EID[(size_t)t * 128 + lane], eid_hi = EID[(size_t)t * 128 + 64 + lane];
  float gt_lo = GATE[(size_t)t * 128 + lane], gt_hi = GATE[(size_t)t * 128 + 64 + lane];
  uint4 xr0, xr1; { const bf16_t* hr = p.h + (size_t)t * D + lane * 16; xr0 = *(const uint4*)hr; xr1 = *(const uint4*)(hr + 8); }
  uint4 ra[16], rb[16];
#define GA_LOAD(buf, elo, ehi, g) do { const int ev_ = (g) < 4 ? (elo) : (ehi); const int l0_ = ((g) & 3) * 16; \
    _Pragma("unroll") for (int r = 0; r < 16; ++r) { const int e = __builtin_amdgcn_readlane(ev_, l0_ + r); buf[r] = UV[(size_t)e * 64 + lane]; } } while (0)
#define GA_COMPUTE(buf, g) do { float d[16]; \
    _Pragma("unroll") for (int r = 0; r < 16; ++r) { \
      f32x2 acc = x[0] * __builtin_amdgcn_cvt_scalef32_pk_f32_fp4(buf[r].x, 1.0f, 0); \
      acc += x[1] * __builtin_amdgcn_cvt_scalef32_pk_f32_fp4(buf[r].x, 1.0f, 1); acc += x[2] * __builtin_amdgcn_cvt_scalef32_pk_f32_fp4(buf[r].x, 1.0f, 2); acc += x[3] * __builtin_amdgcn_cvt_scalef32_pk_f32_fp4(buf[r].x, 1.0f, 3); \
      acc += x[4] * __builtin_amdgcn_cvt_scalef32_pk_f32_fp4(buf[r].y, 1.0f, 0); acc += x[5] * __builtin_amdgcn_cvt_scalef32_pk_f32_fp4(buf[r].y, 1.0f, 1); \
      acc += x[6] * __builtin_amdgcn_cvt_scalef32_pk_f32_fp4(buf[r].y, 1.0f, 2); acc += x[7] * __builtin_amdgcn_cvt_scalef32_pk_f32_fp4(buf[r].y, 1.0f, 3); \
      d[r] = acc.x + acc.y; } \
    _Pragma("unroll") for (int i = 0; i < 8; ++i) { const bool hi = lane & 32; const float send = hi ? d[i] : d[i + 8], keep = hi ? d[i + 8] : d[i]; d[i] = keep + __shfl_xor(send, 32); } \
    _Pragma("unroll") for (int i = 0; i < 4; ++i) { const bool hi = lane & 16; const float send = hi ? d[i] : d[i + 4], keep = hi ? d[i + 4] : d[i]; d[i] = keep + __shfl_xor(send, 16); } \
    _Pragma("unroll") for (int i = 0; i < 2; ++i) { const bool hi = lane & 8; const float send = hi ? d[i] : d[i + 2], keep = hi ? d[i + 2] : d[i]; d[i] = keep + __shfl_xor(send, 8); } \
    { const bool hi = lane & 4; const float send = hi ? d[0] : d[1], keep = hi ? d[1] : d[0]; d[0] = keep + __shfl_xor(send, 4); } \
    d[0] += __shfl_xor(d[0], 2); d[0] += __shfl_xor(d[0], 1); \
    const float gv_ = __shfl((g) < 4 ? gt_lo : gt_hi, ((g) & 3) * 16 + (lane >> 2)); \
    const float w = gv_ * gelu_tanh(d[0] * (1.0f / U8_SCALE));        \
    _Pragma("unroll") for (int r = 0; r < 16; ++r) { \
      const float wr = rdlane_f(w, r * 4); \
      f[0] += wr * __builtin_amdgcn_cvt_scalef32_pk_f32_fp4(buf[r].z, 1.0f, 0); f[1] += wr * __builtin_amdgcn_cvt_scalef32_pk_f32_fp4(buf[r].z, 1.0f, 1); \
      f[2] += wr * __builtin_amdgcn_cvt_scalef32_pk_f32_fp4(buf[r].z, 1.0f, 2); f[3] += wr * __builtin_amdgcn_cvt_scalef32_pk_f32_fp4(buf[r].z, 1.0f, 3); \
      f[4] += wr * __builtin_amdgcn_cvt_scalef32_pk_f32_fp4(buf[r].w, 1.0f, 0); f[5] += wr * __builtin_amdgcn_cvt_scalef32_pk_f32_fp4(buf[r].w, 1.0f, 1); \
      f[6] += wr * __builtin_amdgcn_cvt_scalef32_pk_f32_fp4(buf[r].w, 1.0f, 2); f[7] += wr * __builtin_amdgcn_cvt_scalef32_pk_f32_fp4(buf[r].w, 1.0f, 3); } } while (0)
  GA_LOAD(ra, eid_lo, eid_hi, 0);
  for (;;) {
    int tn = t + nw;
    while (last && tn < T && (tn % SP) < CTX) tn += nw;
    const bool more = tn < T;
    const size_t tnc = more ? (size_t)tn : (size_t)t;
    const int neid_lo = EID[tnc * 128 + lane], neid_hi = EID[tnc * 128 + 64 + lane];
    const float ngt_lo = GATE[tnc * 128 + lane], ngt_hi = GATE[tnc * 128 + 64 + lane];
    uint4 nx0, nx1; { const bf16_t* hr = p.h + tnc * D + lane * 16; nx0 = *(const uint4*)hr; nx1 = *(const uint4*)(hr + 8); }
    const int b = t / SP, s = t - b * SP;
    f32x2 x[8];
    { const unsigned hw[8] = {xr0.x, xr0.y, xr0.z, xr0.w, xr1.x, xr1.y, xr1.z, xr1.w};
#pragma unroll
      for (int i = 0; i < 8; ++i) { x[i].x = __uint_as_float(hw[i] << 16); x[i].y = __uint_as_float(hw[i] & 0xffff0000u); } }
    f32x2 f[8];
#pragma unroll
    for (int i = 0; i < 8; ++i) f[i] = (f32x2){0.f, 0.f};
#pragma unroll 1
    for (int g2 = 0; g2 < 4; ++g2) {
      GA_LOAD(rb, eid_lo, eid_hi, 2 * g2 + 1);
      GA_COMPUTE(ra, 2 * g2);
      if (g2 < 3) GA_LOAD(ra, eid_lo, eid_hi, 2 * g2 + 2); else if (more) GA_LOAD(ra, neid_lo, neid_hi, 0);
      GA_COMPUTE(rb, 2 * g2 + 1);
    }
    bf16_t* xr = xrow_ptr(p, t) + lane * 16;
    const float* ad = ada_ptr(p, layer, t);
    float xv[16];
    { const uint4 xa = *(const uint4*)xr, xb = *(const uint4*)(xr + 8); const unsigned xw[8] = {xa.x, xa.y, xa.z, xa.w, xb.x, xb.y, xb.z, xb.w};
#pragma unroll
      for (int j = 0; j < 4; ++j) { const float4 g2 = *(const float4*)(ad + 5120 + lane * 16 + j * 4);
        xv[j * 4] = __uint_as_float(xw[2 * j] << 16) + g2.x * f[2 * j].x * (1.0f / V8_SCALE); xv[j * 4 + 1] = __uint_as_float(xw[2 * j] & 0xffff0000u) + g2.y * f[2 * j].y * (1.0f / V8_SCALE);
        xv[j * 4 + 2] = __uint_as_float(xw[2 * j + 1] << 16) + g2.z * f[2 * j + 1].x * (1.0f / V8_SCALE); xv[j * 4 + 3] = __uint_as_float(xw[2 * j + 1] & 0xffff0000u) + g2.w * f[2 * j + 1].y * (1.0f / V8_SCALE); } }
    float ss = 0.f;
#pragma unroll
    for (int i = 0; i < 16; ++i) ss += xv[i] * xv[i];
    ss = wave_sum(ss); const float rstd = rsqrtf(ss * (1.0f / D) + 1e-6f);
    if (!last) {
      { unsigned xo[8];
#pragma unroll
        for (int j = 0; j < 8; ++j) xo[j] = (unsigned)f2bf(xv[2 * j]) | ((unsigned)f2bf(xv[2 * j + 1]) << 16);
        *(uint4*)xr = make_uint4(xo[0], xo[1], xo[2], xo[3]); *(uint4*)(xr + 8) = make_uint4(xo[4], xo[5], xo[6], xo[7]); }
      const float* ad2 = ada_ptr(p, layer + 1, t); const float* g = p.norm_g + ((layer + 1) * 2) * D;
      unsigned ow[8];
#pragma unroll
      for (int j = 0; j < 4; ++j) { const int c0 = lane * 16 + j * 4; const float4 gg = *(const float4*)(g + c0), s1 = *(const float4*)(ad2 + 1024 + c0), s2 = *(const float4*)(ad2 + c0);
        const float y0 = xv[j * 4] * rstd * gg.x * (1.f + s1.x) + s2.x, y1 = xv[j * 4 + 1] * rstd * gg.y * (1.f + s1.y) + s2.y;
        const float y2 = xv[j * 4 + 2] * rstd * gg.z * (1.f + s1.z) + s2.z, y3 = xv[j * 4 + 3] * rstd * gg.w * (1.f + s1.w) + s2.w;
        ow[j * 2] = (unsigned)f2bf(y0) | ((unsigned)f2bf(y1) << 16); ow[j * 2 + 1] = (unsigned)f2bf(y2) | ((unsigned)f2bf(y3) << 16); }
      bf16_t* hw = p.h + (size_t)t * D + lane * 16;
      *(uint4*)hw = make_uint4(ow[0], ow[1], ow[2], ow[3]); *(uint4*)(hw + 8) = make_uint4(ow[4], ow[5], ow[6], ow[7]);
    } else {
      float* orow = p.out + ((size_t)(b * SEQ + s - CTX)) * D + lane * 16;
#pragma unroll
      for (int j = 0; j < 4; ++j) { const float4 g = *(const float4*)(p.final_g + lane * 16 + j * 4);
        *(float4*)(orow + j * 4) = make_float4(xv[j * 4] * rstd * g.x, xv[j * 4 + 1] * rstd * g.y, xv[j * 4 + 2] * rstd * g.z, xv[j * 4 + 3] * rstd * g.w); }
    }
    if (!more) break;
    t = tn; eid_lo = neid_lo; eid_hi = neid_hi; gt_lo = ngt_lo; gt_hi = ngt_hi; xr0 = nx0; xr1 = nx1;
  }
#undef GA_LOAD
#undef GA_COMPUTE
}


template <int N> DEV void bitonic_sort_desc(float (&v)[N]) {
#pragma unroll
  for (int k = 2; k <= N; k <<= 1)
#pragma unroll
    for (int j = k >> 1; j > 0; j >>= 1)
#pragma unroll
      for (int i = 0; i < N; ++i) { const int l = i ^ j; if (l > i) { const float a = v[i], b = v[l], mx = fmaxf(a, b), mn = fminf(a, b); if ((i & k) == 0) { v[i] = mx; v[l] = mn; } else { v[i] = mn; v[l] = mx; } } }
}
DEV void bitonic_merge16_desc(float (&v)[16]) {
#pragma unroll
  for (int j = 8; j > 0; j >>= 1)
#pragma unroll
    for (int i = 0; i < 16; ++i) { const int l = i ^ j; if (l > i) { const float a = v[i], b = v[l]; v[i] = fmaxf(a, b); v[l] = fminf(a, b); } }
}
DEV void xlane_merge16(float (&v)[16], int mask) {
  float o[16];
#pragma unroll
  for (int i = 0; i < 16; ++i) o[i] = __shfl_xor(v[i], mask);
#pragma unroll
  for (int i = 0; i < 16; ++i) v[i] = fmaxf(v[i], o[15 - i]);
  bitonic_merge16_desc(v);
}
DEV void split_bf16x8(const float (&x)[8], bf16x8& hi, bf16x8& lo) {
  unsigned h[4], l[4];
#pragma unroll
  for (int i = 0; i < 4; ++i) { h[i] = cvt_pk_bf16(x[2 * i], x[2 * i + 1]);
    const float r0 = x[2 * i] - __uint_as_float(h[i] << 16), r1 = x[2 * i + 1] - __uint_as_float(h[i] & 0xffff0000u); l[i] = cvt_pk_bf16(r0, r1); }
  hi = __builtin_bit_cast(bf16x8, (u32x4){h[0], h[1], h[2], h[3]}); lo = __builtin_bit_cast(bf16x8, (u32x4){l[0], l[1], l[2], l[3]});
}
DEV unsigned sel4(int k, unsigned a, unsigned b, unsigned c, unsigned d) { return k == 0 ? a : (k == 1 ? b : (k == 2 ? c : d)); }
DEV float sel4f(int k, float a, float b, float c, float d) { return k == 0 ? a : (k == 1 ? b : (k == 2 ? c : d)); }

DEV void phase_peer_route(CP p, int layer, LAS char* shm) {
  const bf16_t* PQ = (const bf16_t*)(p.scratch + OFF_PQ); int* EID = (int*)(p.scratch + OFF_EID); float* GATE = (float*)(p.scratch + OFF_GATE);
  constexpr int KSTR = 144, KARR = 128 * KSTR;
  const int tid = TIDX, wid = tid >> 6, lane = tid & 63, ln = lane & 15, kgrp = lane >> 4;
  const bool seqonly = layer == 3;
  const int TPH = seqonly ? 256 : 288, NI = 8 * TPH;
  const int G = gridDim.x, per = (NI + G - 1) / G, it0 = BIDX * per, it1 = (it0 + per < NI) ? it0 + per : NI;
  int cur_h = -1;
  for (int item = it0; item < it1; ++item) {
    const int h = item / TPH, tl = item - h * TPH, tile = seqonly ? (tl >> 4) * 18 + 2 + (tl & 15) : tl;
    if (h != cur_h) {
      __syncthreads();
      const float* kp = p.peer_keys + ((size_t)(layer * 8 + h)) * 2 * 128 * 64;
      for (int idx = tid; idx < 2 * 128 * 8; idx += NTHR) {
        const int pc = idx & 7, key = (idx >> 3) & 127, hf = idx >> 10;
        const float4 a = *(const float4*)(kp + ((size_t)hf * 128 + key) * 64 + pc * 8), b = *(const float4*)(kp + ((size_t)hf * 128 + key) * 64 + pc * 8 + 4);
        const float x[8] = {a.x, a.y, a.z, a.w, b.x, b.y, b.z, b.w}; bf16x8 hi, lo; split_bf16x8(x, hi, lo);
        *(LAS bf16x8*)(shm + (hf * 2 + 0) * KARR + key * KSTR + pc * 16) = hi; *(LAS bf16x8*)(shm + (hf * 2 + 1) * KARR + key * KSTR + pc * 16) = lo;
      }
      __syncthreads();
      cur_h = h;
    }
    const int t = tile * 128 + wid * 16 + ln;
    float lst[2][16];
#pragma unroll
    for (int hf = 0; hf < 2; ++hf) {
      bf16x8 qh[2];
#pragma unroll
      for (int ks = 0; ks < 2; ++ks) qh[ks] = *(const bf16x8*)(PQ + (size_t)t * 1024 + h * 128 + hf * 64 + 32 * ks + 8 * kgrp);
      float v[32];
#pragma unroll
      for (int m = 0; m < 8; ++m) {
        f32x4 acc = (f32x4){0.f, 0.f, 0.f, 0.f};
#pragma unroll
        for (int ks = 0; ks < 2; ++ks) {
          const bf16x8 kh = ld_frag_lds(shm + (hf * 2 + 0) * KARR + (16 * m + ln) * KSTR + ks * 64 + kgrp * 16), kl = ld_frag_lds(shm + (hf * 2 + 1) * KARR + (16 * m + ln) * KSTR + ks * 64 + kgrp * 16);
          acc = __builtin_amdgcn_mfma_f32_16x16x32_bf16(kh, qh[ks], acc, 0, 0, 0);
          acc = __builtin_amdgcn_mfma_f32_16x16x32_bf16(kl, qh[ks], acc, 0, 0, 0);
        }
#pragma unroll
        for (int j = 0; j < 4; ++j) v[4 * m + j] = __uint_as_float((__float_as_uint(acc[j]) & ~127u) | (unsigned)(16 * m + 4 * kgrp + j));
      }
      float a16[16], b16[16];
#pragma unroll
      for (int i = 0; i < 16; ++i) { a16[i] = v[i]; b16[i] = v[16 + i]; }
      bitonic_sort_desc<16>(a16); bitonic_sort_desc<16>(b16);
#pragma unroll
      for (int i = 0; i < 16; ++i) a16[i] = fmaxf(a16[i], b16[15 - i]);
      bitonic_merge16_desc(a16);
      xlane_merge16(a16, 16); xlane_merge16(a16, 32);
#pragma unroll
      for (int i = 0; i < 16; ++i) lst[hf][i] = a16[i];
    }
    float av[16], bv[16]; unsigned A4[4], B4[4];
#pragma unroll
    for (int i = 0; i < 16; ++i) { av[i] = __uint_as_float(__float_as_uint(lst[0][i]) & ~127u); bv[i] = __uint_as_float(__float_as_uint(lst[1][i]) & ~127u); }
#pragma unroll
    for (int r = 0; r < 4; ++r) {
      A4[r] = (__float_as_uint(lst[0][4 * r]) & 127u) | ((__float_as_uint(lst[0][4 * r + 1]) & 127u) << 8) | ((__float_as_uint(lst[0][4 * r + 2]) & 127u) << 16) | ((__float_as_uint(lst[0][4 * r + 3]) & 127u) << 24);
      B4[r] = (__float_as_uint(lst[1][4 * r]) & 127u) | ((__float_as_uint(lst[1][4 * r + 1]) & 127u) << 8) | ((__float_as_uint(lst[1][4 * r + 2]) & 127u) << 16) | ((__float_as_uint(lst[1][4 * r + 3]) & 127u) << 24); }
    float cand[16];
    {
      constexpr int NP = 50;
      struct PairTab { int i0[52], i1[52]; };
      constexpr PairTab tab = [] { PairTab tb{}; int n = 0; for (int a = 0; a < 16; ++a) for (int b = 0; b < 16; ++b) if ((a + 1) * (b + 1) <= 16) { tb.i0[n] = a; tb.i1[n] = b; ++n; } for (; n < 52; ++n) { tb.i0[n] = -1; tb.i1[n] = -1; } return tb; }();
      static_assert(tab.i0[NP - 1] >= 0 && tab.i0[NP] < 0, "50 admissible pairs");
#pragma unroll
      for (int sl = 0; sl < 13; ++sl) {
        float c4[4];
#pragma unroll
        for (int kq = 0; kq < 4; ++kq) { const int n = 13 * kq + sl;
          if (tab.i0[n] >= 0) c4[kq] = __uint_as_float((__float_as_uint(av[tab.i0[n]] + bv[tab.i1[n]]) & ~255u) | (unsigned)(tab.i0[n] * 16 + tab.i1[n]));
          else c4[kq] = -3.0e38f; }
        cand[sl] = sel4f(kgrp, c4[0], c4[1], c4[2], c4[3]);
      }
      cand[13] = -3.0e38f; cand[14] = -3.0e38f; cand[15] = -3.0e38f;
    }
    bitonic_sort_desc<16>(cand);
    xlane_merge16(cand, 16); xlane_merge16(cand, 32);
    float gv[16]; int ev[16]; float gsum = 0.f;
    const float v0 = __uint_as_float(__float_as_uint(cand[0]) & ~255u);
#pragma unroll
    for (int j = 0; j < 16; ++j) {
      const unsigned bits = __float_as_uint(cand[j]); const int i0 = (bits >> 4) & 15, i1 = bits & 15;
      const unsigned ra = sel4(i0 >> 2, A4[0], A4[1], A4[2], A4[3]), rb = sel4(i1 >> 2, B4[0], B4[1], B4[2], B4[3]);
      const int k0 = (ra >> (8 * (i0 & 3))) & 127, k1 = (rb >> (8 * (i1 & 3))) & 127;
      ev[j] = k0 * 128 + k1;
      gv[j] = __expf(__uint_as_float(bits & ~255u) - v0); gsum += gv[j];
    }
    const float ginv = 1.f / gsum;
    int4 eo; float4 go;
    eo.x = (int)sel4(kgrp, ev[0], ev[4], ev[8], ev[12]); eo.y = (int)sel4(kgrp, ev[1], ev[5], ev[9], ev[13]); eo.z = (int)sel4(kgrp, ev[2], ev[6], ev[10], ev[14]); eo.w = (int)sel4(kgrp, ev[3], ev[7], ev[11], ev[15]);
    go.x = sel4f(kgrp, gv[0], gv[4], gv[8], gv[12]) * ginv; go.y = sel4f(kgrp, gv[1], gv[5], gv[9], gv[13]) * ginv; go.z = sel4f(kgrp, gv[2], gv[6], gv[10], gv[14]) * ginv; go.w = sel4f(kgrp, gv[3], gv[7], gv[11], gv[15]) * ginv;
    *(int4*)(EID + (size_t)t * 128 + h * 16 + 4 * kgrp) = eo;
    *(float4*)(GATE + (size_t)t * 128 + h * 16 + 4 * kgrp) = go;
  }
}

DEV int seq_of_tau(int tau, int d) { return d == 0 ? tau : (tau < CTX ? CTX - 1 - tau : 2 * CTX + SEQ - 1 - tau); }

DEV void phase_s5_scan(CP p, float* lds) {
  float* Y = (float*)(p.scratch + OFF_Y); bf16_t* GIN = (bf16_t*)(p.scratch + OFF_GIN);
  const int tid = TIDX, wid = tid >> 6, lane = tid & 63;
  float* ub = lds + wid * 2048;
  float* yb = ub + 1024;
  for (int item0 = BIDX * 8; item0 < 1024; item0 += gridDim.x * 8) {
    const int item = item0 + wid, b = item >> 6, g = item & 63;
    for (int d = 0; d < 2; ++d) {
      const int sidx = (d * 64 + g) * 64 + lane;
      const float ar = p.s5_ar[sidx], ai = p.s5_ai[sidx];
      float br[16], bi[16], cr[16], ci[16];
#pragma unroll
      for (int c = 0; c < 16; ++c) { br[c] = p.s5_br[sidx * 16 + c]; bi[c] = p.s5_bi[sidx * 16 + c];
        cr[c] = p.s5_c_re[((size_t)(d * 64 + g) * 16 + c) * 64 + lane]; ci[c] = p.s5_c_im[((size_t)(d * 64 + g) * 16 + c) * 64 + lane]; }
      float xr = 0.f, xi = 0.f;
      for (int k = 0; k < 36; ++k) {
        const int trow = b * SP + seq_of_tau(k * 64 + lane, d);
        __syncthreads();
        { const bf16_t* hp = p.h + (size_t)trow * D + g * 16;
          const uint4 w0 = *(const uint4*)hp, w1 = *(const uint4*)(hp + 8);
          const unsigned ww[8] = {w0.x, w0.y, w0.z, w0.w, w1.x, w1.y, w1.z, w1.w};
#pragma unroll
          for (int i = 0; i < 8; ++i) { ub[lane * 16 + 2 * i] = __uint_as_float(ww[i] << 16); ub[lane * 16 + 2 * i + 1] = __uint_as_float(ww[i] & 0xffff0000u); } }
        __syncthreads();
#pragma unroll 1
        for (int j = 0; j < 64; ++j) {
          float u[16];
#pragma unroll
          for (int c = 0; c < 16; c += 4) { const float4 t4 = *(const float4*)(ub + j * 16 + c); u[c] = t4.x; u[c + 1] = t4.y; u[c + 2] = t4.z; u[c + 3] = t4.w; }
          float bur = 0.f, bui = 0.f;
#pragma unroll
          for (int c = 0; c < 16; ++c) { bur += br[c] * u[c]; bui += bi[c] * u[c]; }
          const float nxr = ar * xr - ai * xi + bur, nxi = ar * xi + ai * xr + bui;
          xr = nxr; xi = nxi;
          float v[16];
#pragma unroll
          for (int c = 0; c < 16; ++c) v[c] = cr[c] * xr - ci[c] * xi;
#pragma unroll
          for (int i = 0; i < 8; ++i) { const bool hi = lane & 32; const float send = hi ? v[i] : v[i + 8], keep = hi ? v[i + 8] : v[i]; v[i] = keep + __shfl_xor(send, 32); }
#pragma unroll
          for (int i = 0; i < 4; ++i) { const bool hi = lane & 16; const float send = hi ? v[i] : v[i + 4], keep = hi ? v[i + 4] : v[i]; v[i] = keep + __shfl_xor(send, 16); }
#pragma unroll
          for (int i = 0; i < 2; ++i) { const bool hi = lane & 8; const float send = hi ? v[i] : v[i + 2], keep = hi ? v[i + 2] : v[i]; v[i] = keep + __shfl_xor(send, 8); }
          { const bool hi = lane & 4; const float send = hi ? v[0] : v[1], keep = hi ? v[1] : v[0]; v[0] = keep + __shfl_xor(send, 4); }
          v[0] += __shfl_xor(v[0], 2); v[0] += __shfl_xor(v[0], 1);
          if ((lane & 3) == 0) yb[j * 16 + (lane >> 2)] = v[0];
        }
        __syncthreads();
        if (d == 0) {
#pragma unroll
          for (int c = 0; c < 16; c += 4) *(float4*)(Y + (size_t)trow * D + g * 16 + c) = *(const float4*)(yb + lane * 16 + c);
        } else {
          unsigned ow[8];
#pragma unroll
          for (int c = 0; c < 16; c += 2) {
            const float y0 = Y[(size_t)trow * D + g * 16 + c] + yb[lane * 16 + c] + p.s5_d[g * 16 + c] * ub[lane * 16 + c];
            const float y1 = Y[(size_t)trow * D + g * 16 + c + 1] + yb[lane * 16 + c + 1] + p.s5_d[g * 16 + c + 1] * ub[lane * 16 + c + 1];
            ow[c >> 1] = (unsigned)f2bf(gelu_tanh(y0)) | ((unsigned)f2bf(gelu_tanh(y1)) << 16);
          }
          *(uint4*)(GIN + (size_t)trow * D + g * 16) = make_uint4(ow[0], ow[1], ow[2], ow[3]);
          *(uint4*)(GIN + (size_t)trow * D + g * 16 + 8) = make_uint4(ow[4], ow[5], ow[6], ow[7]);
        }
      }
    }
  }
}

DEV void phase_s5_out(CP p, int layer) {
  const bf16_t* Z = (const bf16_t*)(p.scratch + OFF_Z);
  const int lane = TIDX & 63, gw = BIDX * (NTHR / 64) + (TIDX >> 6), nw = gridDim.x * (NTHR / 64);
  for (int t = gw; t < T; t += nw) {
    bf16_t* xr = xrow_ptr(p, t); float xv[16]; load_row_bf(xr, lane, xv);
    const float* ad = ada_ptr(p, layer, t);
#pragma unroll
    for (int j = 0; j < 4; ++j) { const int c0 = j * 256 + lane * 4;
      const uint2 za = *(const uint2*)(Z + (size_t)t * 2048 + c0), zg = *(const uint2*)(Z + (size_t)t * 2048 + 1024 + c0);
      const float a[4] = {__uint_as_float(za.x << 16), __uint_as_float(za.x & 0xffff0000u), __uint_as_float(za.y << 16), __uint_as_float(za.y & 0xffff0000u)};
      const float gg[4] = {__uint_as_float(zg.x << 16), __uint_as_float(zg.x & 0xffff0000u), __uint_as_float(zg.y << 16), __uint_as_float(zg.y & 0xffff0000u)};
      const float4 g1 = *(const float4*)(ad + 2048 + c0); const float g1a[4] = {g1.x, g1.y, g1.z, g1.w};
#pragma unroll
      for (int e = 0; e < 4; ++e) xv[j * 4 + e] += g1a[e] * a[e] * sigm(gg[e]); }
    store_row_bf(xr, lane, xv);
    norm_mod_store(xv, p.norm_g + (layer * 2 + 1) * D, ad + 4096, ad + 3072, p.h + (size_t)t * D, lane);
  }
}


typedef unsigned short us16;
DEV void phase_s5_scan_mfma(CP p, LAS char* shm) {
  bf16_t* KT = (bf16_t*)(p.scratch + OFF_KT); bf16_t* W4 = (bf16_t*)(p.scratch + OFF_W4); bf16_t* XIN = (bf16_t*)(p.scratch + OFF_XIN);
  const int tid = TIDX, wid = tid >> 6, lane = tid & 63, n = lane & 15, kgrp = lane >> 4, par = kgrp >> 1, chalf = kgrp & 1;
  for (int unit = BIDX; unit < 256; unit += gridDim.x) {
    __syncthreads();
    if (unit < 128) {
      const int d = unit >> 6, g = unit & 63, ri = n >> 3, pp = n & 7, pidx = (d * 64 + g) * 64 + 8 * wid + pp;
      const float ar = p.s5_ar[pidx], ai = p.s5_ai[pidx];
      float brv[8], biv[8];
#pragma unroll
      for (int j = 0; j < 8; ++j) { brv[j] = p.s5_br[pidx * 16 + 8 * chalf + j]; biv[j] = p.s5_bi[pidx * 16 + 8 * chalf + j]; }
      const float a2r = ar * ar - ai * ai, a2i = 2.f * ar * ai;
      float pr = par ? 1.f : ar, pi = par ? 0.f : ai;
      bf16x8 bfrag[16];
#pragma unroll
      for (int ks = 15; ks >= 0; --ks) {
        unsigned o[4];
#pragma unroll
        for (int j = 0; j < 8; j += 2) {
          const float v0 = ri ? (pr * biv[j] + pi * brv[j]) : (pr * brv[j] - pi * biv[j]);
          const float v1 = ri ? (pr * biv[j + 1] + pi * brv[j + 1]) : (pr * brv[j + 1] - pi * biv[j + 1]);
          o[j >> 1] = cvt_pk_bf16(v0, v1);
        }
        bfrag[ks] = __builtin_bit_cast(bf16x8, (u32x4){o[0], o[1], o[2], o[3]});
        const float npr = pr * a2r - pi * a2i, npi = pr * a2i + pi * a2r; pr = npr; pi = npi;
      }
      float a32r = ar, a32i = ai;
#pragma unroll
      for (int q = 0; q < 5; ++q) { const float tr = a32r * a32r - a32i * a32i, ti = 2.f * a32r * a32i; a32r = tr; a32i = ti; }
      f32x4 xs = (f32x4){0.f, 0.f, 0.f, 0.f};
      const int sb = tid >> 5, ssig = tid & 31;
      const bf16_t* hb = p.h + (size_t)sb * SP * D + g * 16;
      uint4 r0, r1;
      { const bf16_t* hp = hb + (size_t)seq_of_tau(ssig, d) * D; r0 = *(const uint4*)hp; r1 = *(const uint4*)(hp + 8); }
      { LAS char* ub = shm + sb * 1040 + ssig * 32; *(LAS u32x4*)ub = (u32x4){r0.x, r0.y, r0.z, r0.w}; *(LAS u32x4*)(ub + 16) = (u32x4){r1.x, r1.y, r1.z, r1.w}; }
      __syncthreads();
      bf16_t* xin = XIN + (size_t)unit * 72 * 16 * 128;
      for (int k = 0; k < 72; ++k) {
        if (k + 1 < 72) { const bf16_t* hp = hb + (size_t)seq_of_tau((k + 1) * 32 + ssig, d) * D; r0 = *(const uint4*)hp; r1 = *(const uint4*)(hp + 8); }
#pragma unroll
        for (int j = 0; j < 4; ++j) xin[((size_t)k * 16 + 4 * kgrp + j) * 128 + 16 * wid + n] = f2bf(xs[j]);
        const LAS char* ub = shm + (k & 1) * 16640 + n * 1040 + kgrp * 16;
        f32x4 acc = (f32x4){0.f, 0.f, 0.f, 0.f};
#pragma unroll
        for (int ks = 0; ks < 16; ++ks) acc = __builtin_amdgcn_mfma_f32_16x16x32_bf16(ld_frag_lds(ub + ks * 64), bfrag[ks], acc, 0, 0, 0);
#pragma unroll
        for (int j = 0; j < 4; ++j) { const float other = __shfl_xor(xs[j], 8);
          xs[j] = (ri ? (a32r * xs[j] + a32i * other) : (a32r * xs[j] - a32i * other)) + acc[j]; }
        if (k + 1 < 72) { LAS char* uw = shm + ((k + 1) & 1) * 16640 + sb * 1040 + ssig * 32; *(LAS u32x4*)uw = (u32x4){r0.x, r0.y, r0.z, r0.w}; *(LAS u32x4*)(uw + 16) = (u32x4){r1.x, r1.y, r1.z, r1.w}; }
        __syncthreads();
      }
    } else {
      const int u2 = unit - 128, d = u2 >> 6, g = u2 & 63;
      float* pw = (float*)shm;
      float* Bb = pw + 64 * 66;
      float* Ct = Bb + 64 * 32;
      if (tid < 64) { const int pidx = (d * 64 + g) * 64 + tid; const float ar = p.s5_ar[pidx], ai = p.s5_ai[pidx]; float pr = 1.f, pi = 0.f; asm volatile("" : "+v"(pr), "+v"(pi));
        for (int e = 0; e < 33; ++e) { pw[(tid * 33 + e) * 2] = pr; pw[(tid * 33 + e) * 2 + 1] = pi; const float nr = pr * ar - pi * ai, ni = pr * ai + pi * ar; pr = nr; pi = ni; } }
      for (int idx = tid; idx < 1024; idx += NTHR) { const int pp = idx >> 4, c = idx & 15; const int pidx = (d * 64 + g) * 64 + pp;
        Bb[idx * 2] = p.s5_br[pidx * 16 + c]; Bb[idx * 2 + 1] = p.s5_bi[pidx * 16 + c];
        Ct[idx * 2] = p.s5_c_re[((size_t)(d * 64 + g) * 16 + c) * 64 + pp]; Ct[idx * 2 + 1] = p.s5_c_im[((size_t)(d * 64 + g) * 16 + c) * 64 + pp]; }
      __syncthreads();
      { const int dl = tid >> 4, cc = tid & 15;
        float acc[16];
#pragma unroll
        for (int c = 0; c < 16; ++c) acc[c] = 0.f;
        for (int pp = 0; pp < 64; ++pp) {
          const float pr = pw[(pp * 33 + dl) * 2], pi = pw[(pp * 33 + dl) * 2 + 1], cr = Ct[(pp * 16 + cc) * 2], ci = Ct[(pp * 16 + cc) * 2 + 1];
          const float gr = cr * pr - ci * pi, gi = cr * pi + ci * pr;
#pragma unroll
          for (int c = 0; c < 16; ++c) acc[c] += gr * Bb[(pp * 16 + c) * 2] - gi * Bb[(pp * 16 + c) * 2 + 1];
        }
        bf16_t* kt = KT + ((size_t)u2 * 33 + 1 + dl) * 256 + cc * 16;
        unsigned o[8];
#pragma unroll
        for (int c = 0; c < 16; c += 2) o[c >> 1] = cvt_pk_bf16(acc[c], acc[c + 1]);
        *(uint4*)kt = make_uint4(o[0], o[1], o[2], o[3]); *(uint4*)(kt + 8) = make_uint4(o[4], o[5], o[6], o[7]);
        if (tid < 128) *(unsigned*)(KT + (size_t)u2 * 33 * 256 + tid * 2) = 0u;
      }
      for (int idx = tid; idx < 65536; idx += NTHR) {
        const int j = idx & 7, cc = (idx >> 3) & 15, kg2 = (idx >> 7) & 3, ks = (idx >> 9) & 3, tau = idx >> 11;
        const int kidx = 32 * ks + 8 * kg2 + j, wv = kidx >> 4, nn = kidx & 15, ri = nn >> 3, pp = 8 * wv + (nn & 7);
        const float pr = pw[(pp * 33 + tau + 1) * 2], pi = pw[(pp * 33 + tau + 1) * 2 + 1], cr = Ct[(pp * 16 + cc) * 2], ci = Ct[(pp * 16 + cc) * 2 + 1];
        W4[(size_t)u2 * 65536 + idx] = f2bf(ri ? -(cr * pi + ci * pr) : (cr * pr - ci * pi));
      }
    }
  }
}

DEV void phase_s5_out_mfma(CP p, LAS char* shm) {
  const bf16_t* KT = (const bf16_t*)(p.scratch + OFF_KT); const bf16_t* W4 = (const bf16_t*)(p.scratch + OFF_W4); const bf16_t* XIN = (const bf16_t*)(p.scratch + OFF_XIN);
  bf16_t* GIN = (bf16_t*)(p.scratch + OFF_GIN);
  const int tid = TIDX, wid = tid >> 6, lane = tid & 63, cc = lane & 15, kgrp = lane >> 4, par = kgrp >> 1, chalf = kgrp & 1;
  constexpr int KT0_OFF = 0, KT1_OFF = 17408, U_OFF = 34816, XSTR = 272, X0_OFF = U_OFF + 2 * 16640, X1_OFF = X0_OFF + 2 * 16 * XSTR;
  for (int unit = BIDX; unit < 256; unit += gridDim.x) {
    const int g = unit >> 2, q = unit & 3, u0 = g, u1 = 64 + g;
    __syncthreads();
    for (int idx = tid; idx < 33 * 32; idx += NTHR) { *(LAS u32x4*)(shm + KT0_OFF + idx * 16) = *(const u32x4*)(KT + (size_t)u0 * 33 * 256 + idx * 8);
      *(LAS u32x4*)(shm + KT1_OFF + idx * 16) = *(const u32x4*)(KT + (size_t)u1 * 33 * 256 + idx * 8); }
    bf16x8 w4a[4][4];
#pragma unroll
    for (int i = 0; i < 4; ++i)
#pragma unroll
      for (int ks = 0; ks < 4; ++ks) w4a[i][ks] = *(const bf16x8*)(W4 + ((((size_t)u0 * 32 + (wid + 8 * i)) * 4 + ks) * 4 + kgrp) * 128 + cc * 8);
    const float dsk = p.s5_d[g * 16 + cc];
    const int sb = tid >> 5, ssig = tid & 31, xrow = (tid & 255) >> 4, xpc = tid & 15;
    const bf16_t* hb = p.h + (size_t)sb * SP * D + g * 16;
    const bf16_t* xin0 = XIN + (size_t)u0 * 72 * 16 * 128; const bf16_t* xin1 = XIN + (size_t)u1 * 72 * 16 * 128;
    uint4 r0, r1, rx;
#define S5_K1(c_) ((c_) < 8 ? 7 - (c_) : 79 - (c_))
#define S5_LOAD(c_) do { const bf16_t* hp = hb + (size_t)((c_) * 32 + ssig) * D; r0 = *(const uint4*)hp; r1 = *(const uint4*)(hp + 8); \
      rx = tid < 256 ? *(const uint4*)(xin0 + ((size_t)(c_) * 16 + xrow) * 128 + xpc * 8) : *(const uint4*)(xin1 + ((size_t)S5_K1(c_) * 16 + xrow) * 128 + xpc * 8); } while (0)
#define S5_WRITE(buf_) do { LAS char* uw = shm + U_OFF + (buf_) * 16640 + sb * 1040 + ssig * 32; *(LAS u32x4*)uw = (u32x4){r0.x, r0.y, r0.z, r0.w}; *(LAS u32x4*)(uw + 16) = (u32x4){r1.x, r1.y, r1.z, r1.w}; \
      *(LAS u32x4*)(shm + (tid < 256 ? X0_OFF : X1_OFF) + (buf_) * (16 * XSTR) + xrow * XSTR + xpc * 16) = (u32x4){rx.x, rx.y, rx.z, rx.w}; } while (0)
    S5_LOAD(18 * q); S5_WRITE(0);
    __syncthreads();
    for (int ci = 0; ci < 18; ++ci) {
      const int c = 18 * q + ci, buf = ci & 1;
      if (ci + 1 < 18) S5_LOAD(c + 1);
      bf16x8 w4b[4][4];
      int zz = 0; asm volatile("" : "+s"(zz));
#pragma unroll
      for (int i = 0; i < 4; ++i)
#pragma unroll
        for (int ks = 0; ks < 4; ++ks) w4b[i][ks] = *(const bf16x8*)(W4 + zz + ((((size_t)u1 * 32 + (31 - wid - 8 * i)) * 4 + ks) * 4 + kgrp) * 128 + cc * 8);
      const LAS char* ub = shm + U_OFF + buf * 16640 + cc * 1040;
      const LAS char* x0b = shm + X0_OFF + buf * (16 * XSTR) + cc * XSTR + kgrp * 16;
      const LAS char* x1b = shm + X1_OFF + buf * (16 * XSTR) + cc * XSTR + kgrp * 16;
      f32x4 acc0[4], acc1[4];
#pragma unroll
      for (int i = 0; i < 4; ++i) { acc0[i] = (f32x4){0.f, 0.f, 0.f, 0.f}; acc1[i] = (f32x4){0.f, 0.f, 0.f, 0.f}; }
#pragma unroll
      for (int ks = 0; ks < 4; ++ks) { const bf16x8 ax0 = ld_frag_lds(x0b + ks * 64), ax1 = ld_frag_lds(x1b + ks * 64);
#pragma unroll
        for (int i = 0; i < 4; ++i) { acc0[i] = __builtin_amdgcn_mfma_f32_16x16x32_bf16(ax0, w4a[i][ks], acc0[i], 0, 0, 0); acc1[i] = __builtin_amdgcn_mfma_f32_16x16x32_bf16(ax1, w4b[i][ks], acc1[i], 0, 0, 0); } }
      asm volatile("" ::: "memory");
      { const LAS char* ua = ub + kgrp * 16;
        const LAS char* kb = shm + KT0_OFF + (wid - par + 1) * 512 + cc * 32 + chalf * 16;
#pragma unroll 2
        for (int ks = 0; ks < 16; ++ks) { const bf16x8 au = ld_frag_lds(ua + ks * 64);
#pragma unroll
          for (int i = 0; i < 4; ++i) if (2 * ks <= wid + 8 * i) acc0[i] = __builtin_amdgcn_mfma_f32_16x16x32_bf16(au, ld_frag_lds(kb + (8 * i - 2 * ks) * 512), acc0[i], 0, 0, 0); } }
      { const LAS char* ua = ub + (31 - par) * 32 + chalf * 16;
        const LAS char* kb = shm + KT1_OFF + (31 - wid - par + 1) * 512 + cc * 32 + chalf * 16;
#pragma unroll 2
        for (int ks = 0; ks < 16; ++ks) { const bf16x8 au = ld_frag_lds(ua - ks * 64);
#pragma unroll
          for (int i = 0; i < 4; ++i) if (2 * ks <= 31 - wid - 8 * i) acc1[i] = __builtin_amdgcn_mfma_f32_16x16x32_bf16(au, ld_frag_lds(kb - (8 * i + 2 * ks) * 512), acc1[i], 0, 0, 0); } }
#pragma unroll
      for (int i = 0; i < 4; ++i) {
        const int slot = wid + 8 * i, sq = c * 32 + slot;
#pragma unroll
        for (int j = 0; j < 4; ++j) {
          const float uval = bf2f(*(const LAS us16*)(ub + (4 * kgrp + j - cc) * 1040 + slot * 32 + cc * 2));
          GIN[((size_t)(4 * kgrp + j) * SP + sq) * D + g * 16 + cc] = f2bf(gelu_tanh(acc0[i][j] + acc1[i][j] + dsk * uval));
        }
      }
      if (ci + 1 < 18) S5_WRITE((ci + 1) & 1);
      __syncthreads();
    }
#undef S5_K1
#undef S5_LOAD
#undef S5_WRITE
  }
}

DEV void phase_gla_scan(CP p, float* lds) {
  const bf16_t* QKVG = (const bf16_t*)(p.scratch + OFF_QKVG); const bf16_t* LG = (const bf16_t*)(p.scratch + OFF_LG); bf16_t* OD = (bf16_t*)(p.scratch + OFF_OD);
  float* qs = lds; float* ks = lds + 16 * 128; float* es = lds + 32 * 128; float* vs = lds + 48 * 128; float* op = vs + 16 * 256;
  const int tid = TIDX, col = tid & 255, kh = tid >> 8;
  for (int item = BIDX; item < 128; item += gridDim.x) {
    const int b = item >> 3, hd = (item >> 1) & 3, d = item & 1;
    float S[64];
#pragma unroll
    for (int i = 0; i < 64; ++i) S[i] = 0.f;
    for (int st = 0; st < SP / 16; ++st) {
      __syncthreads();
      for (int idx = tid; idx < 16 * 128; idx += NTHR) { const int j = idx >> 7, k = idx & 127; const size_t trow = (size_t)b * SP + seq_of_tau(st * 16 + j, d);
        qs[idx] = bf2f(QKVG[trow * 3072 + hd * 128 + k]); ks[idx] = bf2f(QKVG[trow * 3072 + 512 + hd * 128 + k]); es[idx] = __expf(bf2f(LG[((size_t)d * T + trow) * 512 + hd * 128 + k])); }
      for (int idx = tid; idx < 16 * 256; idx += NTHR) { const int j = idx >> 8, c = idx & 255; const size_t trow = (size_t)b * SP + seq_of_tau(st * 16 + j, d);
        vs[idx] = bf2f(QKVG[trow * 3072 + 1024 + hd * 256 + c]); }
      __syncthreads();
#pragma unroll 1
      for (int j = 0; j < 16; ++j) {
        const float vv = vs[j * 256 + col]; float acc = 0.f;
#pragma unroll
        for (int kk = 0; kk < 64; kk += 4) {
          const float4 e4 = *(const float4*)(es + j * 128 + kh * 64 + kk), k4 = *(const float4*)(ks + j * 128 + kh * 64 + kk), q4 = *(const float4*)(qs + j * 128 + kh * 64 + kk);
          S[kk] = e4.x * S[kk] + k4.x * vv; acc += q4.x * S[kk];
          S[kk + 1] = e4.y * S[kk + 1] + k4.y * vv; acc += q4.y * S[kk + 1];
          S[kk + 2] = e4.z * S[kk + 2] + k4.z * vv; acc += q4.z * S[kk + 2];
          S[kk + 3] = e4.w * S[kk + 3] + k4.w * vv; acc += q4.w * S[kk + 3];
        }
        op[kh * 16 * 256 + j * 256 + col] = acc;
      }
      __syncthreads();
      for (int idx = tid; idx < 16 * 256; idx += NTHR) { const int j = idx >> 8, c = idx & 255; const size_t trow = (size_t)b * SP + seq_of_tau(st * 16 + j, d);
        OD[((size_t)d * T + trow) * D + hd * 256 + c] = f2bf(op[idx] + op[16 * 256 + idx]); }
    }
  }
}


DEV bf16x8 ld_frag2x64(const LAS char* p) { const u32x2 a = *(const LAS u32x2*)p, b = *(const LAS u32x2*)(p + 8); return __builtin_bit_cast(bf16x8, (u32x4){a.x, a.y, b.x, b.y}); }
DEV void phase_gla_scan_mfma(CP p, LAS char* shm) {
  const bf16_t* QKVG = (const bf16_t*)(p.scratch + OFF_QKVG); const bf16_t* LG = (const bf16_t*)(p.scratch + OFF_LG); const bf16_t* VTG = (const bf16_t*)(p.scratch + OFF_VTG);
  bf16_t* OD = (bf16_t*)(p.scratch + OFF_OD);
  constexpr int QG_O = 0, KG_O = 17408, KDT_O = 34816, VT_O = 52224, ATT_O = 69632, ST_O = 78336, GS_O = 113152, EB_O = 115200;
  const int tid = TIDX, wid = tid >> 6, lane = tid & 63, ln = lane & 15, kgrp = lane >> 4;
  const int kcol = tid & 127, grp = tid >> 7;
  for (int unit = BIDX; unit < 256; unit += gridDim.x) {
    const int b = unit >> 4, head = (unit >> 2) & 3, d = (unit >> 1) & 1, dvh = unit & 1;
    __syncthreads();
    for (int idx = tid; idx < 34816 / 16; idx += NTHR) *(LAS u32x4*)(shm + ST_O + idx * 16) = (u32x4){0u, 0u, 0u, 0u};
    f32x4 accS[8];
#pragma unroll
    for (int i = 0; i < 8; ++i) accS[i] = (f32x4){0.f, 0.f, 0.f, 0.f};
    const bf16_t* vtg = VTG + ((size_t)(b * 4 + head) * 256 + dvh * 128 + (tid >> 2)) * SP + (tid & 3) * 16;
    us16 rl[16], rq[16], rk[16]; uint4 pv0, pv1;
#define GLA_FETCH(ci_) do { const int c_ = d == 0 ? (ci_) : ((ci_) < 4 ? 3 - (ci_) : 39 - (ci_)); const size_t t0_ = (size_t)b * SP + c_ * 64; \
      _Pragma("unroll") for (int j = 0; j < 16; ++j) { const size_t t = t0_ + grp * 16 + j; \
        rl[j] = LG[((size_t)d * T + t) * 512 + head * 128 + kcol]; rq[j] = QKVG[t * 3072 + head * 128 + kcol]; rk[j] = QKVG[t * 3072 + 512 + head * 128 + kcol]; } \
      pv0 = *(const uint4*)(vtg + c_ * 64); pv1 = *(const uint4*)(vtg + c_ * 64 + 8); } while (0)
    GLA_FETCH(0);
    for (int ci = 0; ci < 36; ++ci) {
      const int c = d == 0 ? ci : (ci < 4 ? 3 - ci : 39 - ci);
      const size_t t0 = (size_t)b * SP + c * 64;
      { float lgv[16], qv[16], kv[16];
#pragma unroll
        for (int j = 0; j < 16; ++j) { lgv[j] = bf2f(rl[j]); qv[j] = bf2f(rq[j]); kv[j] = bf2f(rk[j]); }
        const uint4 v0 = pv0, v1 = pv1;
        if (ci + 1 < 36) GLA_FETCH(ci + 1);
        float run = 0.f;
        if (d == 0) {
#pragma unroll
          for (int j = 0; j < 16; ++j) { run += lgv[j]; lgv[j] = run; }
        } else {
#pragma unroll
          for (int j = 15; j >= 0; --j) { run += lgv[j]; lgv[j] = run; }
        }
        float* GS = (float*)0; (void)GS;
        *(LAS float*)(shm + GS_O + (grp * 128 + kcol) * 4) = run;
        { LAS char* vw = shm + VT_O + (tid >> 2) * 136 + (tid & 3) * 32;
          *(LAS u32x2*)vw = (u32x2){v0.x, v0.y}; *(LAS u32x2*)(vw + 8) = (u32x2){v0.z, v0.w}; *(LAS u32x2*)(vw + 16) = (u32x2){v1.x, v1.y}; *(LAS u32x2*)(vw + 24) = (u32x2){v1.z, v1.w}; }
        __syncthreads();
        float g0 = *(const LAS float*)(shm + GS_O + (0 * 128 + kcol) * 4), g1 = *(const LAS float*)(shm + GS_O + (1 * 128 + kcol) * 4);
        float g2 = *(const LAS float*)(shm + GS_O + (2 * 128 + kcol) * 4), g3 = *(const LAS float*)(shm + GS_O + (3 * 128 + kcol) * 4);
        const float blast = (g0 + g1) + (g2 + g3);
        float off;
        if (d == 0) off = (grp > 0 ? g0 : 0.f) + (grp > 1 ? g1 : 0.f) + (grp > 2 ? g2 : 0.f);
        else off = (grp < 3 ? g3 : 0.f) + (grp < 2 ? g2 : 0.f) + (grp < 1 ? g1 : 0.f);
        unsigned kd[8];
#pragma unroll
        for (int j = 0; j < 16; j += 2) {
          const float bc0 = off + lgv[j], bc1 = off + lgv[j + 1];
          const float e0 = __expf(bc0), e1 = __expf(bc1);
          *(LAS us16*)(shm + QG_O + (grp * 16 + j) * 272 + kcol * 2) = f2bf(qv[j] * e0);
          *(LAS us16*)(shm + QG_O + (grp * 16 + j + 1) * 272 + kcol * 2) = f2bf(qv[j + 1] * e1);
          *(LAS us16*)(shm + KG_O + (grp * 16 + j) * 272 + kcol * 2) = f2bf(kv[j] * __expf(-bc0));
          *(LAS us16*)(shm + KG_O + (grp * 16 + j + 1) * 272 + kcol * 2) = f2bf(kv[j + 1] * __expf(-bc1));
          kd[j >> 1] = cvt_pk_bf16(kv[j] * __expf(blast - bc0), kv[j + 1] * __expf(blast - bc1));
        }
        { LAS char* kw = shm + KDT_O + kcol * 136 + grp * 32;
          *(LAS u32x2*)kw = (u32x2){kd[0], kd[1]}; *(LAS u32x2*)(kw + 8) = (u32x2){kd[2], kd[3]}; *(LAS u32x2*)(kw + 16) = (u32x2){kd[4], kd[5]}; *(LAS u32x2*)(kw + 24) = (u32x2){kd[6], kd[7]}; }
        if (grp == 0) *(LAS float*)(shm + EB_O + kcol * 4) = __expf(blast);
      }
      __syncthreads();
      { const int it = wid >> 1;
#pragma unroll
        for (int jj = 0; jj < 2; ++jj) {
          const int jt = 2 * (wid & 1) + jj;
          f32x4 a = (f32x4){0.f, 0.f, 0.f, 0.f};
          const bool dead = d == 0 ? (jt > it) : (jt < it);
          if (!dead) {
#pragma unroll
            for (int ks = 0; ks < 4; ++ks) a = __builtin_amdgcn_mfma_f32_16x16x32_bf16(ld_frag_lds(shm + QG_O + (16 * it + ln) * 272 + ks * 64 + kgrp * 16), ld_frag_lds(shm + KG_O + (16 * jt + ln) * 272 + ks * 64 + kgrp * 16), a, 0, 0, 0);
          }
          const int jc = 16 * jt + ln;
#pragma unroll
          for (int r = 0; r < 4; ++r) { const int ir = 16 * it + 4 * kgrp + r; const bool keep = d == 0 ? (jc <= ir) : (jc >= ir);
            *(LAS us16*)(shm + ATT_O + ir * 136 + jc * 2) = f2bf(keep ? a[r] : 0.f); }
        } }
      __syncthreads();
      { bf16x8 vtf[2], stf[4];
#pragma unroll
        for (int ks = 0; ks < 2; ++ks) vtf[ks] = ld_frag2x64(shm + VT_O + (16 * wid + ln) * 136 + ks * 64 + kgrp * 16);
#pragma unroll
        for (int ks = 0; ks < 4; ++ks) stf[ks] = ld_frag_lds(shm + ST_O + (16 * wid + ln) * 272 + ks * 64 + kgrp * 16);
#pragma unroll
        for (int it = 0; it < 4; ++it) {
          f32x4 o = (f32x4){0.f, 0.f, 0.f, 0.f};
#pragma unroll
          for (int ks = 0; ks < 2; ++ks) o = __builtin_amdgcn_mfma_f32_16x16x32_bf16(ld_frag2x64(shm + ATT_O + (16 * it + ln) * 136 + ks * 64 + kgrp * 16), vtf[ks], o, 0, 0, 0);
#pragma unroll
          for (int ks = 0; ks < 4; ++ks) o = __builtin_amdgcn_mfma_f32_16x16x32_bf16(ld_frag_lds(shm + QG_O + (16 * it + ln) * 272 + ks * 64 + kgrp * 16), stf[ks], o, 0, 0, 0);
#pragma unroll
          for (int r = 0; r < 4; ++r) OD[((size_t)d * T + t0 + 16 * it + 4 * kgrp + r) * D + head * 256 + dvh * 128 + 16 * wid + ln] = f2bf(o[r]);
        }
#pragma unroll
        for (int dkt = 0; dkt < 8; ++dkt) {
          const float eb = *(const LAS float*)(shm + EB_O + (16 * dkt + ln) * 4);
          f32x4 a = accS[dkt] * eb;
#pragma unroll
          for (int ks = 0; ks < 2; ++ks) a = __builtin_amdgcn_mfma_f32_16x16x32_bf16(vtf[ks], ld_frag2x64(shm + KDT_O + (16 * dkt + ln) * 136 + ks * 64 + kgrp * 16), a, 0, 0, 0);
          accS[dkt] = a;
        }
      }
      __syncthreads();
#pragma unroll
      for (int dkt = 0; dkt < 8; ++dkt)
#pragma unroll
        for (int r = 0; r < 4; ++r) *(LAS us16*)(shm + ST_O + (16 * wid + 4 * kgrp + r) * 272 + (16 * dkt + ln) * 2) = f2bf(accS[dkt][r]);
      __syncthreads();
    }
  }
#undef GLA_FETCH
}

DEV void phase_gla_out(CP p) {
  const bf16_t* QKVG = (const bf16_t*)(p.scratch + OFF_QKVG); const bf16_t* OD = (const bf16_t*)(p.scratch + OFF_OD); bf16_t* GO = (bf16_t*)(p.scratch + OFF_GO);
  const int lane = TIDX & 63, gw = BIDX * (NTHR / 64) + (TIDX >> 6), nw = gridDim.x * (NTHR / 64);
  const float4 on = *(const float4*)(p.gla_o_norm + lane * 4); const float ona[4] = {on.x, on.y, on.z, on.w};
  for (int t0 = gw; t0 < T; t0 += 2 * nw) {
    uint2 a[2][4], bq[2][4], gg[2][4];
#pragma unroll
    for (int u = 0; u < 2; ++u) { const int t = t0 + u * nw; if (t < T) {
#pragma unroll
      for (int hd = 0; hd < 4; ++hd) { const int c0 = hd * 256 + lane * 4;
        a[u][hd] = *(const uint2*)(OD + (size_t)t * D + c0); bq[u][hd] = *(const uint2*)(OD + ((size_t)T + t) * D + c0); gg[u][hd] = *(const uint2*)(QKVG + (size_t)t * 3072 + 2048 + c0); } } }
#pragma unroll
    for (int u = 0; u < 2; ++u) { const int t = t0 + u * nw; if (t < T) {
#pragma unroll
      for (int hd = 0; hd < 4; ++hd) {
        const int c0 = hd * 256 + lane * 4;
        const uint2 av = a[u][hd], bv = bq[u][hd], gv2 = gg[u][hd];
        float o[4] = {__uint_as_float(av.x << 16) + __uint_as_float(bv.x << 16), __uint_as_float(av.x & 0xffff0000u) + __uint_as_float(bv.x & 0xffff0000u),
                      __uint_as_float(av.y << 16) + __uint_as_float(bv.y << 16), __uint_as_float(av.y & 0xffff0000u) + __uint_as_float(bv.y & 0xffff0000u)};
        const float gv[4] = {__uint_as_float(gv2.x << 16), __uint_as_float(gv2.x & 0xffff0000u), __uint_as_float(gv2.y << 16), __uint_as_float(gv2.y & 0xffff0000u)};
        float ss = o[0] * o[0] + o[1] * o[1] + o[2] * o[2] + o[3] * o[3];
        ss = wave_sum(ss); const float rstd = rsqrtf(ss * (1.0f / 256.0f) + 1e-6f);
        unsigned w[2];
#pragma unroll
        for (int e = 0; e < 4; e += 2) w[e >> 1] = (unsigned)f2bf(o[e] * rstd * ona[e] * silu(gv[e])) | ((unsigned)f2bf(o[e + 1] * rstd * ona[e + 1] * silu(gv[e + 1])) << 16);
        *(uint2*)(GO + (size_t)t * D + c0) = make_uint2(w[0], w[1]);
      }
    } }
  }
}


#define XB_TMO      128
#define XB_XCNT(j)  (256  + 64 * (j))
#define XB_XSUB(j)  (1280 + 64 * (j))
#define XB_XGEN(j)  (2304 + 64 * (j))
#define XB_TOP      3328
#define XB_TOPGEN   3392
#define XCD_BAR_WORDS 3456
#define XB_SPIN_CAP (1u << 22)
DEV unsigned xb_ld(unsigned* p)              { return __hip_atomic_load(p, __ATOMIC_RELAXED, __HIP_MEMORY_SCOPE_AGENT); }
DEV unsigned xb_add(unsigned* p, unsigned v) { return __hip_atomic_fetch_add(p, v, __ATOMIC_RELAXED, __HIP_MEMORY_SCOPE_AGENT); }
DEV unsigned xb_xcc_id() { return (unsigned)__builtin_amdgcn_s_getreg((3 << 11) | 20) & 0xFu; }
#define XB_SPIN(cond, bar) do { unsigned _sp = 0; while (cond) { __builtin_amdgcn_s_sleep(1); \
    if ((++_sp & 255u) == 0u) { if (xb_ld(&(bar)[XB_TMO])) break; if (_sp > XB_SPIN_CAP) { atomicAdd(&(bar)[XB_TMO], 1u); break; } } } } while (0)
struct XcdBarrier { unsigned* bar; unsigned x; volatile LAS unsigned* st; };
DEV XcdBarrier xcd_barrier_post(unsigned* bar, volatile LAS unsigned* st) {
  XcdBarrier b; b.bar = bar; b.x = xb_xcc_id(); b.st = st;
  if (threadIdx.x == 0) (void)xb_add(&bar[XB_XCNT(b.x)], 1u);
  return b;
}
DEV void xcd_barrier_complete(unsigned* bar, unsigned x, unsigned& nloc, unsigned& nx) {
  const unsigned G = gridDim.x * gridDim.y * gridDim.z;
  unsigned sum, cnt, mine, sp = 0u;
  for (;;) {
    sum = 0u; cnt = 0u; mine = 0u;
#pragma unroll
    for (unsigned j = 0; j < 16; ++j) { const unsigned c = xb_ld(&bar[XB_XCNT(j)]); sum += c; cnt += (c > 0u) ? 1u : 0u; mine = (j == x) ? c : mine; }
    if (sum == G) break;
    __builtin_amdgcn_s_sleep(1);
    if ((++sp & 255u) == 0u) { if (xb_ld(&bar[XB_TMO])) break; if (sp > XB_SPIN_CAP) { atomicAdd(&bar[XB_TMO], 1u); break; } }
  }
  nloc = mine > 0u ? mine : 1u; nx = cnt > 0u ? cnt : 1u;
}
DEV void xcd_barrier(const XcdBarrier& b) {
  asm volatile("s_waitcnt vmcnt(0)" ::: "memory");
  __syncthreads();
  if (threadIdx.x == 0) {
    unsigned* bar = b.bar; asm volatile("" : "+s"(bar)); unsigned bx = b.x; asm volatile("" : "+s"(bx));
    __builtin_amdgcn_s_waitcnt(0);
    unsigned nloc = b.st[0], nx = b.st[1];
    if (nloc == 0u) { xcd_barrier_complete(bar, bx, nloc, nx); b.st[0] = nloc; b.st[1] = nx; }
    const unsigned old = xb_add(&bar[XB_XSUB(bx)], 1u);
    const unsigned gen = old / nloc;
    if (old + 1u == (gen + 1u) * nloc) {
      __builtin_amdgcn_fence(__ATOMIC_RELEASE, "agent");
      asm volatile("s_waitcnt vmcnt(0)" ::: "memory");
      const unsigned og = xb_add(&bar[XB_TOP], 1u);
      const unsigned tg = og / nx;
      if (og + 1u == (tg + 1u) * nx) xb_add(&bar[XB_TOPGEN], 1u);
      else XB_SPIN(xb_ld(&bar[XB_TOPGEN]) == tg, bar);
      __builtin_amdgcn_fence(__ATOMIC_ACQUIRE, "agent");
      xb_add(&bar[XB_XGEN(bx)], 1u);
      asm volatile("s_waitcnt vmcnt(0)" ::: "memory");
    } else {
      XB_SPIN(xb_ld(&bar[XB_XGEN(bx)]) == gen, bar);
      __builtin_amdgcn_fence(__ATOMIC_ACQUIRE, "agent");
      asm volatile("s_waitcnt vmcnt(0)" ::: "memory");
    }
  }
  __syncthreads();
}

__global__ void __launch_bounds__(NTHR) fwd_megakernel(Params p_arg) {
#define KP (*params_now())
  cg::grid_group grid = cg::this_grid();
  __shared__ __attribute__((aligned(1024))) char shm_raw[144 * 1024];
  float* lds = (float*)shm_raw; LAS char* shm = (LAS char*)shm_raw;
  __shared__ uint4 xb_words;
  if (threadIdx.x == 0) xb_words = make_uint4(0u, 0u, 0u, 0u);
  __syncthreads();
  const XcdBarrier xb = xcd_barrier_post(KP.bar, (volatile LAS unsigned*)&xb_words);
  phase_prologue(KP, lds);
  grid.sync();
#define GSYNC() xcd_barrier(xb)
#ifndef PROBE
#define PROBE 0
#endif
#define PH(grp, ...) do { unsigned long long t0_ = 0; if (PROBE == (grp)) t0_ = __builtin_amdgcn_s_memrealtime(); __VA_ARGS__; GSYNC(); \
    if (PROBE == (grp)) { const unsigned long long d_ = __builtin_amdgcn_s_memrealtime() - t0_, t1_ = __builtin_amdgcn_s_memrealtime(); \
      while (__builtin_amdgcn_s_memrealtime() - t1_ < d_) __builtin_amdgcn_s_sleep(8); GSYNC(); } } while (0)
  PH(8, phase_norm1_first(KP));
  for (int layer = 0; layer < 4; ++layer) {
    const int kind = layer % 3, j = layer / 3; const bool last = layer == 3;
    if (kind == 0) {
      PH(2, gemm_pg8(KP.h, KP.w_mla_in + (size_t)j * 768 * 1024, T, 768, 1024, EpiStoreBf16R{(bf16_t*)(KP.scratch + OFF_A1), 768, 672}, shm));
      PH(7, phase_mla_norm(KP, j));
      PH(2, gemm_pg8((const bf16_t*)(KP.scratch + OFF_CQN), KP.w_uq + (size_t)j * 1536 * 384, T, 1536, 384, EpiQR{(bf16_t*)(KP.scratch + OFF_QF)}, shm, false, last);
            gemm_pg8((const bf16_t*)(KP.scratch + OFF_CKVN), KP.w_ukv + (size_t)j * 2048 * 256, T, 2048, 256, EpiKVR{(bf16_t*)(KP.scratch + OFF_KF), (bf16_t*)(KP.scratch + OFF_VF)}, shm, true));
      PH(6, phase_attn_mfma(KP, last, shm));
      if (last) { PH(2, gemm_pg8((const bf16_t*)(KP.scratch + OFF_O), KP.w_mla_o + (size_t)j * 1024 * 1024, T, 1024, 1024, EpiResR{KP.xc, KP.xl, KP.ada, layer, 2048, last}, shm, false, true)); }
      else { PH(2, gemm256s_t<192>((const bf16_t*)(KP.scratch + OFF_O), D, KP.w_mla_o + (size_t)j * 1024 * 1024, 1024, T, 1024, 1024, EpiResR{KP.xc, KP.xl, KP.ada, layer, 2048, last}, shm)); }
      PH(7, phase_norm2(KP, layer));
    } else if (kind == 1) {
      PH(4, phase_s5_scan_mfma(KP, shm));
      PH(4, phase_s5_out_mfma(KP, shm));
      PH(2, gemm256s_t<192>((const bf16_t*)(KP.scratch + OFF_GIN), D, KP.w_glu, 1024, T, 2048, 1024, EpiGluResR{KP.xc, KP.xl, KP.ada, layer}, shm));
      PH(7, phase_norm2(KP, layer));
    } else {
      PH(2, gemm_pg8(KP.h, KP.w_gla_in, T, 4096, 1024, EpiGlaR{(bf16_t*)(KP.scratch + OFF_QKVG), (bf16_t*)(KP.scratch + OFF_LG), KP.gla_gk_b, (bf16_t*)(KP.scratch + OFF_VTG)}, shm));
      PH(4, phase_gla_scan_mfma(KP, shm));
      PH(7, phase_gla_out(KP));
      PH(2, gemm256s_t<192>((const bf16_t*)(KP.scratch + OFF_GO), D, KP.w_gla_o, 1024, T, 1024, 1024, EpiResR{KP.xc, KP.xl, KP.ada, layer, 2048, false}, shm));
      PH(7, phase_norm2(KP, layer));
    }
    if (last) { PH(2, gemm_pg8(KP.h, KP.w_pq + (size_t)layer * 1024 * 1024, T, 1024, 1024, EpiStoreBf16R{(bf16_t*)(KP.scratch + OFF_PQ), 1024, 1024}, shm, false, true);
          phase_peer_tables(KP, layer)); } else { PH(2, gemm256s_t<192>(KP.h, D, KP.w_pq + (size_t)layer * 1024 * 1024, 1024, T, 1024, 1024, EpiStoreBf16R{(bf16_t*)(KP.scratch + OFF_PQ), 1024, 1024}, shm);
          phase_peer_tables(KP, layer)); }
    PH(3, phase_peer_route(KP, layer, shm));
    if (layer < 3) { PH(1, phase_peer_gather8(KP, layer)); } else phase_peer_gather8(KP, layer);
  }
}

extern "C" void kernel_launch(void* const* d_in, const int* in_sizes, int n_in, void* d_out,
                              int out_size, void* d_ws, size_t ws_size, hipStream_t stream) {
  static int grid_blocks = 0;
  if (!grid_blocks) {
    int dev = 0, cus = 0, per_cu = 0;
    (void)hipGetDevice(&dev);
    (void)hipDeviceGetAttribute(&cus, hipDeviceAttributeMultiprocessorCount, dev);
    (void)hipOccupancyMaxActiveBlocksPerMultiprocessor(&per_cu, fwd_megakernel, NTHR, 0);
    if (per_cu > 1) per_cu = 1;
    grid_blocks = cus * per_cu;
  }
  Params p{};
  const float* const* in = (const float* const*)d_in;
  p.x = in[0]; p.c = in[1]; p.ctx = in[2]; p.c_ctx = in[3]; p.norm_g = in[4]; p.ada_w = in[5]; p.ada_b = in[6];
  p.mla_w_in = in[7]; p.mla_q_norm = in[8]; p.mla_w_uq = in[9]; p.mla_kv_norm = in[10]; p.mla_w_ukv = in[11]; p.mla_w_o = in[12];
  p.s5_lam_re = in[13]; p.s5_lam_im = in[14]; p.s5_b_re = in[15]; p.s5_b_im = in[16]; p.s5_c_re = in[17]; p.s5_c_im = in[18]; p.s5_log_step = in[19]; p.s5_d = in[20]; p.s5_w_glu = in[21];
  p.gla_w_in = in[22]; p.gla_gk_w1 = in[23]; p.gla_gk_w2 = in[24]; p.gla_gk_b = in[25]; p.gla_o_norm = in[26]; p.gla_w_o = in[27];
  p.peer_w_q = in[28]; p.peer_keys = in[29]; p.peer_u = in[30]; p.peer_v = in[31]; p.final_g = in[32];
  p.out = (float*)d_out;
  char* w = (char*)d_ws; size_t off = 0;
  auto take = [&](size_t bytes) { char* r = w + off; off += (bytes + 255) & ~(size_t)255; return r; };
  p.xc = (bf16_t*)take((size_t)NB * CTX * D * 2);
  p.xl = (bf16_t*)take((size_t)NB * SEQ * D * 2);
  p.ada = (float*)take((size_t)4 * 17 * 6144 * 4);
  p.rope = (float*)take((size_t)2048 * 32 * 4);
  p.h = (bf16_t*)take((size_t)T * D * 2);
  p.w_mla_in = (bf16_t*)take((size_t)2 * 768 * 1024 * 2);
  p.w_uq = (bf16_t*)take((size_t)2 * 1536 * 384 * 2);
  p.w_ukv = (bf16_t*)take((size_t)2 * 2048 * 256 * 2);
  p.w_mla_o = (bf16_t*)take((size_t)2 * 1024 * 1024 * 2);
  p.w_glu = (bf16_t*)take((size_t)2048 * 1024 * 2);
  p.w_gla_in = (bf16_t*)take((size_t)4096 * 1024 * 2);
  p.w_gla_o = (bf16_t*)take((size_t)1024 * 1024 * 2);
  p.w_pq = (bf16_t*)take((size_t)4 * 1024 * 1024 * 2);
  p.s5_ar = (float*)take(2 * 64 * 64 * 4); p.s5_ai = (float*)take(2 * 64 * 64 * 4);
  p.s5_br = (float*)take(2 * 64 * 64 * 16 * 4); p.s5_bi = (float*)take(2 * 64 * 64 * 16 * 4);
  p.scratch = take(SCRATCH_BYTES);
  p.bar = (unsigned*)take(XCD_BAR_WORDS * 4);
  if (off > ws_size) { fprintf(stderr, "workspace too small: need %zu have %zu\n", off, ws_size); return; }
  (void)hipMemsetAsync(p.bar, 0, XCD_BAR_WORDS * 4, stream);
  void* args[] = {&p};
  hipError_t e = hipLaunchCooperativeKernel((void*)fwd_megakernel, dim3(grid_blocks), dim3(NTHR), args, 0, stream);
  if (e != hipSuccess) fprintf(stderr, "cooperative launch failed: %s (grid %d)\n", hipGetErrorString(e), grid_blocks);
}
```

```cpp
#include <hip/hip_runtime.h>
#include <hip/hip_cooperative_groups.h>
#include <cstdio>
#include <cstdint>
namespace cg = cooperative_groups;

typedef unsigned short bf16_t;
#define DEV __device__ __forceinline__

DEV int tid_op() { int t = threadIdx.x; asm volatile("" : "+v"(t)); return t; }
DEV int bid_op() { int t = blockIdx.x; asm volatile("" : "+s"(t)); return t; }
#define TIDX tid_op()
#define BIDX bid_op()
constexpr int D = 1024, NB = 16, SEQ = 2048, CTX = 256, SP = 2304, T = NB * SP;
constexpr int NTHR = 512;

struct Params {
  const float *x, *c, *ctx, *c_ctx, *norm_g, *ada_w, *ada_b;
  const float *mla_w_in, *mla_q_norm, *mla_w_uq, *mla_kv_norm, *mla_w_ukv, *mla_w_o;
  const float *s5_lam_re, *s5_lam_im, *s5_b_re, *s5_b_im, *s5_c_re, *s5_c_im, *s5_log_step, *s5_d, *s5_w_glu;
  const float *gla_w_in, *gla_gk_w1, *gla_gk_w2, *gla_gk_b, *gla_o_norm, *gla_w_o;
  const float *peer_w_q, *peer_keys, *peer_u, *peer_v, *final_g;
  float* out;
  bf16_t *xl, *xc;
  float *ada, *rope;
  bf16_t* h;
  bf16_t *w_mla_in, *w_uq, *w_ukv, *w_mla_o, *w_glu, *w_gla_in, *w_gla_o, *w_pq;
  float *s5_ar, *s5_ai, *s5_br, *s5_bi;
  char* scratch;
  unsigned* bar;
};
typedef const __attribute__((address_space(4))) Params& CP;
__device__ __forceinline__ const __attribute__((address_space(4))) Params* params_now() {
  unsigned long long kp = (unsigned long long)__builtin_amdgcn_kernarg_segment_ptr();
  asm volatile("" : "+s"(kp));
  return (const __attribute__((address_space(4))) Params*)kp;
}

constexpr size_t MB = 1ull << 20;
constexpr size_t OFF_A1 = 0;
constexpr size_t OFF_CQN = 54 * MB;
constexpr size_t OFF_CKVN = 81 * MB;
constexpr size_t OFF_QF = 99 * MB;
constexpr size_t OFF_KF = 207 * MB;
constexpr size_t OFF_VF = 315 * MB;
constexpr size_t OFF_O = 387 * MB;
constexpr size_t OFF_KPE = 459 * MB;
constexpr size_t OFF_Y = 0;
constexpr size_t OFF_GIN = 144 * MB;
constexpr size_t OFF_Z = 216 * MB;
constexpr size_t OFF_KT = 360 * MB;
constexpr size_t OFF_W4 = 364 * MB;
constexpr size_t OFF_XIN = 384 * MB;
constexpr size_t OFF_QKVG = 0;
constexpr size_t OFF_LG = 216 * MB;
constexpr size_t OFF_OD = 360 * MB;
constexpr size_t OFF_GO = 504 * MB;
constexpr size_t OFF_PQ = 0;
constexpr size_t OFF_SV = 144 * MB;
constexpr size_t OFF_SI = 180 * MB;
constexpr size_t OFF_EID = 216 * MB;
constexpr size_t OFF_GATE = 234 * MB;
constexpr size_t OFF_U8 = 256 * MB;
constexpr size_t OFF_V8 = 272 * MB;
constexpr size_t OFF_VTG = 576 * MB;
constexpr size_t SCRATCH_BYTES = 648 * MB;

DEV float bf2f(bf16_t v) { return __uint_as_float(((unsigned)v) << 16); }
DEV bf16_t f2bf(float f) { unsigned u = __float_as_uint(f); u += 0x7fffu + ((u >> 16) & 1u); return (bf16_t)(u >> 16); }
DEV float wave_sum(float v) {
#pragma unroll
  for (int o = 32; o > 0; o >>= 1) v += __shfl_xor(v, o);
  return v;
}
DEV float gelu_tanh(float x) { const float u2 = 1.5957691216057308f * (x + 0.044715f * x * x * x); return x / (1.f + __expf(-u2)); }
DEV float sigm(float x) { return 1.f / (1.f + __expf(-x)); }
DEV float silu(float x) { return x * sigm(x); }

DEV bf16_t* xrow_ptr(CP p, int t) {
  int b = t / SP, s = t - b * SP;
  return s < CTX ? p.xc + ((size_t)(b * CTX + s)) * D : p.xl + ((size_t)(b * SEQ + s - CTX)) * D;
}
DEV const float* ada_ptr(CP p, int layer, int t) {
  int b = t / SP, s = t - b * SP;
  return p.ada + ((size_t)(layer * 17 + (s < CTX ? 16 : b))) * 6144;
}

DEV void load_row_f32(const float* row, int lane, float (&v)[16]) {
#pragma unroll
  for (int j = 0; j < 4; ++j) { float4 t = *(const float4*)(row + j * 256 + lane * 4); v[j * 4] = t.x; v[j * 4 + 1] = t.y; v[j * 4 + 2] = t.z; v[j * 4 + 3] = t.w; }
}
DEV void load_row_bf(const bf16_t* row, int lane, float (&v)[16]) {
#pragma unroll
  for (int j = 0; j < 4; ++j) { const uint2 w = *(const uint2*)(row + j * 256 + lane * 4); v[j * 4] = __uint_as_float(w.x << 16); v[j * 4 + 1] = __uint_as_float(w.x & 0xffff0000u); v[j * 4 + 2] = __uint_as_float(w.y << 16); v[j * 4 + 3] = __uint_as_float(w.y & 0xffff0000u); }
}
DEV void store_row_bf(bf16_t* row, int lane, const float (&v)[16]) {
#pragma unroll
  for (int j = 0; j < 4; ++j) { uint2 w; w.x = (unsigned)f2bf(v[j * 4]) | ((unsigned)f2bf(v[j * 4 + 1]) << 16); w.y = (unsigned)f2bf(v[j * 4 + 2]) | ((unsigned)f2bf(v[j * 4 + 3]) << 16); *(uint2*)(row + j * 256 + lane * 4) = w; }
}
DEV void store_row_f32(float* row, int lane, const float (&v)[16]) {
#pragma unroll
  for (int j = 0; j < 4; ++j) *(float4*)(row + j * 256 + lane * 4) = make_float4(v[j * 4], v[j * 4 + 1], v[j * 4 + 2], v[j * 4 + 3]);
}
DEV void norm_mod_store(const float (&v)[16], const float* g, const float* sc, const float* sh, bf16_t* hrow, int lane) {
  float ss = 0.f;
#pragma unroll
  for (int i = 0; i < 16; ++i) ss += v[i] * v[i];
  ss = wave_sum(ss);
  const float rstd = rsqrtf(ss * (1.0f / D) + 1e-6f);
#pragma unroll
  for (int j = 0; j < 4; ++j) {
    const int c0 = j * 256 + lane * 4;
    float4 gg = *(const float4*)(g + c0), s1 = *(const float4*)(sc + c0), s2 = *(const float4*)(sh + c0);
    float y0 = v[j * 4] * rstd * gg.x * (1.f + s1.x) + s2.x, y1 = v[j * 4 + 1] * rstd * gg.y * (1.f + s1.y) + s2.y;
    float y2 = v[j * 4 + 2] * rstd * gg.z * (1.f + s1.z) + s2.z, y3 = v[j * 4 + 3] * rstd * gg.w * (1.f + s1.w) + s2.w;
    uint2 w; w.x = (unsigned)f2bf(y0) | ((unsigned)f2bf(y1) << 16); w.y = (unsigned)f2bf(y2) | ((unsigned)f2bf(y3) << 16);
    *(uint2*)(hrow + c0) = w;
  }
}

DEV void conv_weights(CP p, float* lds) {
  const int tid = TIDX;
  constexpr int NT = 2000;
  float r[16];
  const float* src = nullptr; bf16_t* dst = nullptr; int K = 0, N = 0, k0 = 0, n0 = 0; bool glu = false;
  auto decode = [&](int g) {
    int base, Np; glu = false;
    if (g < 192) { const int j = g >= 96; base = j * 96; src = p.mla_w_in + (size_t)j * 1024 * 672; dst = p.w_mla_in + (size_t)j * 768 * 1024; K = 1024; N = 672; Np = 768; }
    else if (g < 336) { const int j = g >= 264; base = 192 + j * 72; src = p.mla_w_uq + (size_t)j * 384 * 1536; dst = p.w_uq + (size_t)j * 1536 * 384; K = 384; N = Np = 1536; }
    else if (g < 464) { const int j = g >= 400; base = 336 + j * 64; src = p.mla_w_ukv + (size_t)j * 256 * 2048; dst = p.w_ukv + (size_t)j * 2048 * 256; K = 256; N = Np = 2048; }
    else if (g < 720) { const int j = g >= 592; base = 464 + j * 128; src = p.mla_w_o + (size_t)j * 1024 * 1024; dst = p.w_mla_o + (size_t)j * 1024 * 1024; K = 1024; N = Np = 1024; }
    else if (g < 976) { base = 720; src = p.s5_w_glu; dst = p.w_glu; K = 1024; N = Np = 2048; glu = true; }
    else if (g < 1360) { base = 976; src = p.gla_w_in; dst = p.w_gla_in; K = 1024; N = Np = 3072; }
    else if (g < 1488) { base = 1360; src = p.gla_w_o; dst = p.w_gla_o; K = 1024; N = Np = 1024; }
    else { const int i = (g - 1488) >> 7; base = 1488 + i * 128; src = p.peer_w_q + (size_t)i * 1024 * 1024; dst = p.w_pq + (size_t)i * 1024 * 1024; K = 1024; N = Np = 1024; }
    const int local = g - base, tk = K >> 6;
    k0 = (local % tk) * 64; n0 = (local / tk) * 128; (void)Np;
  };
  auto loadt = [&]() {
#pragma unroll
    for (int i = 0; i < 16; ++i) { const int idx = tid + i * NTHR, kk = idx >> 7, nn = idx & 127;
      r[i] = (n0 + nn < N) ? src[(size_t)(k0 + kk) * N + n0 + nn] : 0.f; }
  };
  int g = BIDX;
  if (g < NT) { decode(g); loadt(); }
  while (g < NT) {
    __syncthreads();
#pragma unroll
    for (int i = 0; i < 16; ++i) { const int idx = tid + i * NTHR, kk = idx >> 7, nn = idx & 127; lds[kk * 129 + nn] = r[i]; }
    bf16_t* d0 = dst + k0; const int Kc = K, n0c = n0; const bool gluc = glu;
    const int gn = g + gridDim.x;
    if (gn < NT) { decode(gn); loadt(); }
    __syncthreads();
#pragma unroll
    for (int i = 0; i < 4; ++i) { const int idx = tid + i * NTHR, nn = idx >> 4, kq = idx & 15;
      const float* l = lds + (kq * 4) * 129 + nn;
      uint2 w; w.x = (unsigned)f2bf(l[0]) | ((unsigned)f2bf(l[129]) << 16); w.y = (unsigned)f2bf(l[258]) | ((unsigned)f2bf(l[387]) << 16);
      const int nrow = n0c + nn, orow = gluc ? (nrow < 1024 ? 2 * nrow : 2 * (nrow - 1024) + 1) : nrow;
      *(uint2*)(d0 + (size_t)orow * Kc + kq * 4) = w; }
    g = gn;
  }
}

DEV void ada_load(float (&W)[8][3], const float* w, int kb) {
#pragma unroll
  for (int i = 0; i < 8; ++i) { const float* wp = w + (size_t)(kb + i) * 6144; W[i][0] = wp[0]; W[i][1] = wp[1]; W[i][2] = wp[2]; }
}
DEV void ada_fma(float (&acc)[17][3], const float (&W)[8][3], const float* sp, int kb) {
#pragma unroll
  for (int i = 0; i < 8; ++i) {
    const float* sr = sp + (kb + i) * 20;
    const float4 s0 = *(const float4*)sr, s1 = *(const float4*)(sr + 4), s2 = *(const float4*)(sr + 8), s3 = *(const float4*)(sr + 12); const float s16 = sr[16];
    const float sv[17] = {s0.x, s0.y, s0.z, s0.w, s1.x, s1.y, s1.z, s1.w, s2.x, s2.y, s2.z, s2.w, s3.x, s3.y, s3.z, s3.w, s16};
#pragma unroll
    for (int r = 0; r < 17; ++r) { acc[r][0] += sv[r] * W[i][0]; acc[r][1] += sv[r] * W[i][1]; acc[r][2] += sv[r] * W[i][2]; }
  }
}

DEV void phase_prologue(CP p, float* lds) {
  const int tid = TIDX, gtid = BIDX * NTHR + tid, gn = gridDim.x * NTHR;
  conv_weights(p, lds);
  for (int idx = gtid; idx < 2 * 64 * 1024; idx += gn) {
    const int k = idx & 1023, ns = (idx >> 10) & 63, d = idx >> 16;
    const float4* w1 = (const float4*)(p.gla_gk_w1 + ((size_t)d * 1024 + k) * 16); const float* w2 = p.gla_gk_w2 + (size_t)d * 16 * 512 + ns * 8;
    const float4 a0 = w1[0], a1 = w1[1], a2 = w1[2], a3 = w1[3];
    const float a[16] = {a0.x, a0.y, a0.z, a0.w, a1.x, a1.y, a1.z, a1.w, a2.x, a2.y, a2.z, a2.w, a3.x, a3.y, a3.z, a3.w};
#pragma unroll
    for (int i = 0; i < 8; ++i) {
      float sacc = 0.f;
#pragma unroll
      for (int r = 0; r < 16; ++r) sacc += a[r] * w2[r * 512 + i];
      p.w_gla_in[(size_t)(3072 + d * 512 + ns * 8 + i) * 1024 + k] = f2bf(sacc);
    }
  }
  for (int idx = gtid; idx < 2048 * 8; idx += gn) {
    const int pos = idx >> 3, i = idx & 7;
    const float inv = powf(10000.0f, -(float)i / 8.0f);
    const float ar = (float)(pos / 64) * inv, ac = (float)(pos % 64) * inv;
    float* r = p.rope + pos * 32;
    r[i] = cosf(ar); r[8 + i] = sinf(ar); r[16 + i] = cosf(ac); r[24 + i] = sinf(ac);
  }
  for (int idx = gtid; idx < 2 * 64 * 64; idx += gn) {
    const int g = (idx >> 6) & 63, d = idx >> 12;
    const float lr = p.s5_lam_re[idx], li = p.s5_lam_im[idx], dt = expf(p.s5_log_step[d * 64 + g]);
    const float mag = expf(lr * dt), ar = mag * cosf(li * dt), ai = mag * sinf(li * dt), den = lr * lr + li * li;
    const float fr = ((ar - 1.f) * lr + ai * li) / den, fi = (ai * lr - (ar - 1.f) * li) / den;
    p.s5_ar[idx] = ar; p.s5_ai[idx] = ai;
    for (int c = 0; c < 16; ++c) { const float bre = p.s5_b_re[idx * 16 + c], bim = p.s5_b_im[idx * 16 + c];
      p.s5_br[idx * 16 + c] = fr * bre - fi * bim; p.s5_bi[idx * 16 + c] = fr * bim + fi * bre; }
  }
  {
    float* st = lds;
    for (int cb = BIDX; cb < 4 * 64; cb += gridDim.x) {
      const int layer = cb >> 6, n0 = (cb & 63) * 96;
      __syncthreads();
      for (int idx = tid; idx < 17 * 1024; idx += NTHR) { const int r = idx >> 10, k = idx & 1023; const float cv = r < 16 ? p.c[r * 1024 + k] : p.c_ctx[k]; st[k * 20 + (k >> 6) * 4 + r] = silu(cv); }
      __syncthreads();
      const int ct = tid & 31, kg = tid >> 5;
      const float* w = p.ada_w + ((size_t)layer * 1024 + kg * 64) * 6144 + n0 + ct * 3;
      const float* sp = st + kg * 64 * 20 + kg * 4;
      float acc[17][3];
#pragma unroll
      for (int r = 0; r < 17; ++r) { acc[r][0] = 0.f; acc[r][1] = 0.f; acc[r][2] = 0.f; }
      float wa[8][3], wb[8][3];
      ada_load(wa, w, 0);
#pragma unroll 1
      for (int kb = 0; kb < 64; kb += 16) {
        ada_load(wb, w, kb + 8);
        ada_fma(acc, wa, sp, kb);
        ada_load(wa, w, kb + 16 < 64 ? kb + 16 : 56);
        ada_fma(acc, wb, sp, kb + 8);
      }
      __syncthreads();
      float* part = lds;
#pragma unroll
      for (int r = 0; r < 17; ++r) { float* pp = part + (kg * 17 + r) * 96 + ct * 3; pp[0] = acc[r][0]; pp[1] = acc[r][1]; pp[2] = acc[r][2]; }
      __syncthreads();
      for (int idx = tid; idx < 96 * 17; idx += NTHR) { const int r = idx / 96, col = idx - r * 96;
        float v = 0.f;
#pragma unroll
        for (int q = 0; q < 16; ++q) v += part[(q * 17 + r) * 96 + col];
        p.ada[((size_t)(layer * 17 + r)) * 6144 + n0 + col] = v + p.ada_b[layer * 6144 + n0 + col]; }
    }
    __syncthreads();
  }
}

DEV void phase_norm1_first(CP p) {
  const int lane = TIDX & 63, gw = BIDX * (NTHR / 64) + (TIDX >> 6), nw = gridDim.x * (NTHR / 64);
  for (int t = gw; t < T; t += nw) {
    const int b = t / SP, s = t - b * SP;
    const float* src = s < CTX ? p.ctx + ((size_t)(b * CTX + s)) * D : p.x + ((size_t)(b * SEQ + s - CTX)) * D;
    float v[16]; load_row_f32(src, lane, v);
    store_row_bf(xrow_ptr(p, t), lane, v);
    const float* ad = ada_ptr(p, 0, t);
    norm_mod_store(v, p.norm_g, ad + 1024, ad, p.h + (size_t)t * D, lane);
  }
}
DEV void phase_norm2(CP p, int layer) {
  const int lane = TIDX & 63, gw = BIDX * (NTHR / 64) + (TIDX >> 6), nw = gridDim.x * (NTHR / 64);
  for (int t = gw; t < T; t += 3 * nw) {
    float v[3][16];
#pragma unroll
    for (int u = 0; u < 3; ++u) { const int tt = t + u * nw; if (tt < T) load_row_bf(xrow_ptr(p, tt), lane, v[u]); }
#pragma unroll
    for (int u = 0; u < 3; ++u) { const int tt = t + u * nw; if (tt < T) {
      const float* ad = ada_ptr(p, layer, tt);
      norm_mod_store(v[u], p.norm_g + (layer * 2 + 1) * D, ad + 4096, ad + 3072, p.h + (size_t)tt * D, lane); } }
  }
}

template <class Epi>
DEV void gemm_naive(const bf16_t* A, int lda, const bf16_t* Bt, int ldb, int M, int N, int K, const Epi& epi, float* lds) {
  float* As = lds;
  float* Bs = lds + 16 * 132;
  const int tid = TIDX, ty = tid >> 5, tx = tid & 31, nM = M / 128, nN = N / 128;
  const int lrow = tid >> 2, lkq = tid & 3;
  for (int tile = BIDX; tile < nM * nN; tile += gridDim.x) {
    const int pm = tile / nN, pn = tile - pm * nN;
    float acc[8][4];
#pragma unroll
    for (int i = 0; i < 8; ++i)
#pragma unroll
      for (int j = 0; j < 4; ++j) acc[i][j] = 0.f;
    const bf16_t* ap = A + (size_t)(pm * 128 + lrow) * lda + lkq * 4;
    const bf16_t* bp = Bt + (size_t)(pn * 128 + lrow) * ldb + lkq * 4;
    for (int k0 = 0; k0 < K; k0 += 16) {
      const uint2 av = *(const uint2*)(ap + k0), bv = *(const uint2*)(bp + k0);
      __syncthreads();
      As[(lkq * 4 + 0) * 132 + lrow] = __uint_as_float(av.x << 16); As[(lkq * 4 + 1) * 132 + lrow] = __uint_as_float(av.x & 0xffff0000u);
      As[(lkq * 4 + 2) * 132 + lrow] = __uint_as_float(av.y << 16); As[(lkq * 4 + 3) * 132 + lrow] = __uint_as_float(av.y & 0xffff0000u);
      Bs[(lkq * 4 + 0) * 132 + lrow] = __uint_as_float(bv.x << 16); Bs[(lkq * 4 + 1) * 132 + lrow] = __uint_as_float(bv.x & 0xffff0000u);
      Bs[(lkq * 4 + 2) * 132 + lrow] = __uint_as_float(bv.y << 16); Bs[(lkq * 4 + 3) * 132 + lrow] = __uint_as_float(bv.y & 0xffff0000u);
      __syncthreads();
#pragma unroll 2
      for (int kk = 0; kk < 16; ++kk) {
        const float4 a0 = *(const float4*)(As + kk * 132 + ty * 8), a1 = *(const float4*)(As + kk * 132 + ty * 8 + 4), b0 = *(const float4*)(Bs + kk * 132 + tx * 4);
        const float a[8] = {a0.x, a0.y, a0.z, a0.w, a1.x, a1.y, a1.z, a1.w}, b[4] = {b0.x, b0.y, b0.z, b0.w};
#pragma unroll
        for (int i = 0; i < 8; ++i)
#pragma unroll
          for (int j = 0; j < 4; ++j) acc[i][j] += a[i] * b[j];
      }
    }
#pragma unroll
    for (int i = 0; i < 8; ++i)
#pragma unroll
      for (int j = 0; j < 4; ++j) epi(pm * 128 + ty * 8 + i, pn * 128 + tx * 4 + j, acc[i][j]);
  }
}


#define LAS __attribute__((address_space(3)))
typedef short bf16x8 __attribute__((ext_vector_type(8)));
typedef float f32x4 __attribute__((ext_vector_type(4)));
typedef float f32x16 __attribute__((ext_vector_type(16)));
typedef unsigned u32x4 __attribute__((ext_vector_type(4)));
typedef unsigned u32x2 __attribute__((ext_vector_type(2)));
DEV bf16x8 ld_frag_lds(const LAS char* p) { return *(const LAS bf16x8*)p; }
typedef __bf16 hwbf16x2 __attribute__((ext_vector_type(2)));
typedef float f32pair __attribute__((ext_vector_type(2)));
DEV unsigned cvt_pk_bf16(float lo, float hi) { const f32pair v = {lo, hi}; return __builtin_bit_cast(unsigned, __builtin_convertvector(v, hwbf16x2)); }
DEV int lds_byte2(int r, int c) { const int st = (r >> 4) * 2 + (c >> 5), ob = (r & 15) * 64 + (c & 31) * 2; return st * 1024 + (ob ^ (((ob >> 9) & 1) << 5)); }
DEV void stage_rc2(int b, int& R, int& C) { const int st = b >> 10, sb = b & 1023, swz = sb ^ (((sb >> 9) & 1) << 5); R = (st >> 1) * 16 + (swz >> 6); C = (st & 1) * 32 + ((swz & 63) >> 1); }

template <int BM, class Epi>
DEV void gemm_mfma(const bf16_t* A, int lda, const bf16_t* Bt, int ldb, int M, int N, int K, const Epi& epi, LAS char* shm) {
  constexpr int MF = BM / 32, TA = BM * 128, TB = 256 * 128, STG = TA + TB, GA = TA / 8192, GB = TB / 8192;
  const int tid = TIDX, wid = __builtin_amdgcn_readfirstlane(tid >> 6), lane = tid & 63, wr = wid >> 2, wc = wid & 3, fr = lane & 15, fq = lane >> 4;
  int offA0, offB0;
  { int R, C; stage_rc2(wid * 1024 + lane * 16, R, C); offA0 = R * lda + C; offB0 = R * ldb + C; }
  const int nM = M / BM, nN = N / 256, ntile = nM * nN, nt = K / 64;
  const int G = gridDim.x, bid = BIDX, vb = (G & 7) ? bid : (bid & 7) * (G >> 3) + (bid >> 3);
  const int aoff0 = lds_byte2(wr * (BM / 2) + fr, fq * 8), boff0 = TA + lds_byte2(wc * 64 + fr, fq * 8);
  for (int tile = vb; tile < ntile; tile += G) {
    const int Wn = (nN > 4 && (nN & 3) == 0) ? 4 : ((nN > 3 && nN % 3 == 0) ? 3 : nN), tpg = nM * Wn, gn = tile / tpg, rem = tile - gn * tpg;
    const int pm = rem / Wn, pn = gn * Wn + (rem - pm * Wn);
    const bf16_t* Ab = A + (size_t)pm * BM * lda; const bf16_t* Bb = Bt + (size_t)pn * 256 * ldb;
    f32x4 acc[MF][4];
#pragma unroll
    for (int m = 0; m < MF; ++m)
#pragma unroll
      for (int n = 0; n < 4; ++n) acc[m][n] = (f32x4){0.f, 0.f, 0.f, 0.f};
#define GSTAGE(buf, kt) do { _Pragma("unroll") for (int i = 0; i < GB; ++i) { \
      if (i < GA) __builtin_amdgcn_global_load_lds((const unsigned*)(Ab + offA0 + i * 64 * lda + (kt) * 64), (LAS unsigned*)(shm + (buf) * STG + wid * 1024 + i * 8192), 16, 0, 0); \
      __builtin_amdgcn_global_load_lds((const unsigned*)(Bb + offB0 + i * 64 * ldb + (kt) * 64), (LAS unsigned*)(shm + (buf) * STG + TA + wid * 1024 + i * 8192), 16, 0, 0); } } while (0)
#define GWAIT_V(n_) asm volatile("s_waitcnt vmcnt(%0)" ::"n"(n_) : "memory")
#define GRAW_BARRIER() do { asm volatile("s_waitcnt lgkmcnt(0)" ::: "memory"); __builtin_amdgcn_s_barrier(); } while (0)
    constexpr int GL = GA + GB;
    if constexpr (BM == 256) {
      GWAIT_V(0); GRAW_BARRIER();
      GSTAGE(0, 0);
      int cur = 0;
      for (int t = 0; t < nt; ++t) {
        GWAIT_V(0); GRAW_BARRIER();
        if (t + 1 < nt) GSTAGE(cur ^ 1, t + 1);
#pragma unroll
        for (int ks = 0; ks < 2; ++ks) {
          bf16x8 At[MF], Bf[4];
#pragma unroll
          for (int m = 0; m < MF; ++m) At[m] = *(const LAS bf16x8*)(shm + cur * STG + aoff0 + m * 2048 + ks * 1024);
#pragma unroll
          for (int n = 0; n < 4; ++n) Bf[n] = *(const LAS bf16x8*)(shm + cur * STG + boff0 + n * 2048 + ks * 1024);
          __builtin_amdgcn_s_setprio(1);
#pragma unroll
          for (int m = 0; m < MF; ++m)
#pragma unroll
            for (int n = 0; n < 4; ++n) acc[m][n] = __builtin_amdgcn_mfma_f32_16x16x32_bf16(At[m], Bf[n], acc[m][n], 0, 0, 0);
          __builtin_amdgcn_s_setprio(0);
        }
        cur ^= 1;
      }
      GRAW_BARRIER();
    } else {
    GWAIT_V(0); GRAW_BARRIER();
    GSTAGE(0, 0);
    if (nt > 1) { GSTAGE(1, 1); GWAIT_V(GL); } else GWAIT_V(0);
    GRAW_BARRIER();
    int cur = 0;
    for (int t = 0; t < nt; ++t) {
      if (t + 2 < nt) { const int nb = cur >= 1 ? cur - 1 : 2; GSTAGE(nb, t + 2); }
#pragma unroll
      for (int ks = 0; ks < 2; ++ks) {
        bf16x8 At[MF], Bf[4];
#pragma unroll
        for (int m = 0; m < MF; ++m) At[m] = *(const LAS bf16x8*)(shm + cur * STG + aoff0 + m * 2048 + ks * 1024);
#pragma unroll
        for (int n = 0; n < 4; ++n) Bf[n] = *(const LAS bf16x8*)(shm + cur * STG + boff0 + n * 2048 + ks * 1024);
#pragma unroll
        for (int m = 0; m < MF; ++m)
#pragma unroll
          for (int n = 0; n < 4; ++n) acc[m][n] = __builtin_amdgcn_mfma_f32_16x16x32_bf16(At[m], Bf[n], acc[m][n], 0, 0, 0);
      }
      if (t + 2 < nt) GWAIT_V(GL); else GWAIT_V(0);
      GRAW_BARRIER();
      cur = cur == 2 ? 0 : cur + 1;
    }
    }
#undef GSTAGE
    const int row0 = pm * BM + wr * (BM / 2) + fq * 4, col0 = pn * 256 + wc * 64 + fr;
    if constexpr (Epi::PRELOAD) {
      f32x4 xin[MF][4];
#pragma unroll
      for (int m = 0; m < MF; ++m)
#pragma unroll
        for (int n = 0; n < 4; ++n) xin[m][n] = epi.load(row0 + m * 16, col0 + n * 16);
#pragma unroll
      for (int m = 0; m < MF; ++m)
#pragma unroll
        for (int n = 0; n < 4; ++n) epi.store(row0 + m * 16, col0 + n * 16, acc[m][n], xin[m][n]);
    } else {
#pragma unroll
    for (int m = 0; m < MF; ++m) {
#pragma unroll
      for (int n = 0; n < 4; ++n)
        epi(row0 + m * 16, col0 + n * 16, acc[m][n]);
      if (BM == 256) asm volatile("" ::: "memory");
    }
    }
  }
}


template <int BM, class Epi>
DEV void gemm256s_t(const bf16_t* A, int lda, const bf16_t* Bt, int ldb, int M, int N, int K, const Epi& epi, LAS char* shm, bool rev = false, bool seqonly = false) {
  constexpr int MF = BM / 32, TA = 256 * 128, STG = 2 * TA;
  const int tid = TIDX, wid = __builtin_amdgcn_readfirstlane(tid >> 6), lane = tid & 63, wr = wid >> 2, wc = wid & 3, fr = lane & 15, fq = lane >> 4;
  int offA0, offB0;
  { int R, C; stage_rc2(wid * 1024 + lane * 16, R, C); offA0 = R * lda + C; offB0 = R * ldb + C; }
  const int nM = seqonly ? NB * (SEQ / 256) : M / BM, nN = N / 256, ntile = nM * nN, nt = K / 64;
  const int G = gridDim.x, bid = BIDX, vb0 = (G & 7) ? bid : (bid & 7) * (G >> 3) + (bid >> 3), vb = rev ? G - 1 - vb0 : vb0;
  if (vb >= ntile) return;
  const int cnt = (ntile - vb + G - 1) / G, J = cnt * nt;
  const int aoff0 = lds_byte2(wr * (BM / 2) + fr, fq * 8), boff0 = TA + lds_byte2(wc * 64 + fr, fq * 8);
  const int Wn = (nN > 4 && (nN & 3) == 0) ? 4 : ((nN > 3 && nN % 3 == 0) ? 3 : nN), tpg = nM * Wn;
#define G2_ROW0(pm_) (seqonly ? ((pm_) >> 3) * SP + CTX + ((pm_) & 7) * 256 : (pm_) * BM)
#define G2_PMPN(tile_, pm_, pn_) do { const int gn_ = (tile_) / tpg, rem_ = (tile_) - gn_ * tpg; pm_ = rem_ / Wn; pn_ = gn_ * Wn + (rem_ - pm_ * Wn); } while (0)
#define G2_STAGE(j_) do { if ((j_) < J) { const int i_ = (j_) / nt, kt_ = (j_) - i_ * nt; int pm_, pn_; G2_PMPN(vb + i_ * G, pm_, pn_); \
      const bf16_t* Ab_ = A + (size_t)G2_ROW0(pm_) * lda + kt_ * 64; const bf16_t* Bb_ = Bt + (size_t)pn_ * 256 * ldb + kt_ * 64; LAS char* db_ = shm + ((j_) & 1) * STG + wid * 1024; \
      _Pragma("unroll") for (int q_ = 0; q_ < 4; ++q_) { \
        if (q_ < BM / 64) __builtin_amdgcn_global_load_lds((const unsigned*)(Ab_ + offA0 + q_ * 64 * lda), (LAS unsigned*)(db_ + q_ * 8192), 16, 0, 0); \
        __builtin_amdgcn_global_load_lds((const unsigned*)(Bb_ + offB0 + q_ * 64 * ldb), (LAS unsigned*)(db_ + TA + q_ * 8192), 16, 0, 0); } } } while (0)
#define G2_BAR() do { asm volatile("s_waitcnt lgkmcnt(0)" ::: "memory"); __builtin_amdgcn_sched_barrier(0); __builtin_amdgcn_s_barrier(); __builtin_amdgcn_sched_barrier(0); } while (0)
#define G2_WAITV() asm volatile("s_waitcnt vmcnt(0)" ::: "memory")
#define G2_LOADF(buf_, ks_) do { _Pragma("unroll") for (int m = 0; m < MF; ++m) At[m] = *(const LAS bf16x8*)(shm + (buf_) * STG + aoff0 + m * 2048 + (ks_) * 1024); \
      _Pragma("unroll") for (int n = 0; n < 4; ++n) Bf[n] = *(const LAS bf16x8*)(shm + (buf_) * STG + boff0 + n * 2048 + (ks_) * 1024); } while (0)
#define G2_MMA() do { __builtin_amdgcn_s_setprio(1); _Pragma("unroll") for (int m = 0; m < MF; ++m) _Pragma("unroll") for (int n = 0; n < 4; ++n) \
      acc[m][n] = Epi::ROWVEC ? __builtin_amdgcn_mfma_f32_16x16x32_bf16(Bf[n], At[m], acc[m][n], 0, 0, 0) : __builtin_amdgcn_mfma_f32_16x16x32_bf16(At[m], Bf[n], acc[m][n], 0, 0, 0); __builtin_amdgcn_s_setprio(0); } while (0)
  f32x4 acc[MF][4];
#pragma unroll
  for (int m = 0; m < MF; ++m)
#pragma unroll
    for (int n = 0; n < 4; ++n) acc[m][n] = (f32x4){0.f, 0.f, 0.f, 0.f};
  bf16x8 At[MF], Bf[4];
  G2_WAITV(); G2_BAR();
  G2_STAGE(0);
  G2_WAITV(); G2_BAR();
  if (wr == 1) { G2_STAGE(1); G2_BAR(); }
  int kt = 0, ti = 0;
  for (int j = 0; j < J; ++j) {
    const int buf = j & 1;
    const bool tile_end = (kt == nt - 1);
    if (wr == 0) G2_STAGE(j + 1);
    G2_LOADF(buf, 0); G2_BAR();
    G2_MMA(); G2_BAR();
    G2_LOADF(buf, 1); if (wr == 1) G2_WAITV(); G2_BAR();
    if (wr == 1) G2_STAGE(j + 2);
    G2_MMA();
    if (wr == 0) G2_WAITV();
    if (wr == 0 || j + 1 < J) G2_BAR();
    if (tile_end) {
      int pm, pn; G2_PMPN(vb + ti * G, pm, pn);
      if constexpr (Epi::ROWVEC) {
        LAS char* stg = shm + 2 * STG + wid * 2048;
        const int rr = lane >> 3, ch = lane & 7, rbase = G2_ROW0(pm) + wr * (BM / 2) + rr, cbase = pn * 256 + wc * 64 + ch * 8;
        uint4 xin[3][2];
        if constexpr (Epi::PRELOAD) {
#pragma unroll
          for (int m = 0; m < 2; ++m) { xin[m][0] = epi.load8(rbase + m * 16, cbase); xin[m][1] = epi.load8(rbase + m * 16 + 8, cbase); }
        }
#pragma unroll
        for (int m = 0; m < MF; ++m) {
          if constexpr (Epi::PRELOAD) { if (m + 2 < MF) { xin[(m + 2) % 3][0] = epi.load8(rbase + (m + 2) * 16, cbase); xin[(m + 2) % 3][1] = epi.load8(rbase + (m + 2) * 16 + 8, cbase); } }
#pragma unroll
          for (int n = 0; n < 4; ++n) {
            if constexpr (Epi::HAS_PRE) epi.pre(pn * 256 + wc * 64 + n * 16 + 4 * fq, acc[m][n]);
            const u32x2 w = (u32x2){cvt_pk_bf16(acc[m][n][0], acc[m][n][1]), cvt_pk_bf16(acc[m][n][2], acc[m][n][3])};
            *(LAS u32x2*)(stg + fr * 128 + (((n * 2 + (fq >> 1)) ^ (fr & 7)) << 4) + (fq & 1) * 8) = w;
            acc[m][n] = (f32x4){0.f, 0.f, 0.f, 0.f};
          }
          bool tr = false;
          if constexpr (Epi::HAS_T) tr = epi.transposed(pn * 256 + wc * 64);
          if (tr) {
            if constexpr (Epi::HAS_T) {
              unsigned w[8];
#pragma unroll
              for (int k = 0; k < 8; ++k) {
                const unsigned lo = *(const LAS unsigned short*)(stg + (2 * k) * 128 + ((((lane >> 3) ^ ((2 * k) & 7))) << 4) + (lane & 7) * 2);
                const unsigned hi = *(const LAS unsigned short*)(stg + (2 * k + 1) * 128 + ((((lane >> 3) ^ ((2 * k + 1) & 7))) << 4) + (lane & 7) * 2);
                w[k] = lo | (hi << 16);
              }
              epi.col16(G2_ROW0(pm) + wr * (BM / 2) + m * 16, pn * 256 + wc * 64 + lane, w);
            }
          } else {
#pragma unroll
          for (int i = 0; i < 2; ++i) {
            const int row = rr + 8 * i;
            const u32x4 v = *(const LAS u32x4*)(stg + row * 128 + ((ch ^ (row & 7)) << 4));
            if constexpr (Epi::PRELOAD) epi.row8(rbase + m * 16 + 8 * i, cbase, v, xin[m % 3][i]); else epi.row8(rbase + m * 16 + 8 * i, cbase, v);
          }
          }
          asm volatile("" ::: "memory");
        }
      } else {
      const int row0 = G2_ROW0(pm) + wr * (BM / 2) + fq * 4, col0 = pn * 256 + wc * 64 + fr;
#pragma unroll
      for (int m = 0; m < MF; ++m) {
#pragma unroll
        for (int n = 0; n < 4; ++n) { epi(row0 + m * 16, col0 + n * 16, acc[m][n]); acc[m][n] = (f32x4){0.f, 0.f, 0.f, 0.f}; }
        asm volatile("" ::: "memory");
      }
      }
      kt = 0; ++ti;
    } else ++kt;
  }
#undef G2_PMPN
#undef G2_ROW0
#undef G2_STAGE
#undef G2_BAR
#undef G2_WAITV
#undef G2_LOADF
#undef G2_MMA
}
template <class Epi>
DEV void gemm256s(const bf16_t* A, int lda, const bf16_t* Bt, int ldb, int M, int N, int K, const Epi& epi, LAS char* shm, bool rev = false, bool seqonly = false) { gemm256s_t<256, Epi>(A, lda, Bt, ldb, M, N, K, epi, shm, rev, seqonly); }


DEV int pg_perm32(int rho) { const int n = rho >> 4, i = rho & 15; return 8 * (i >> 2) + 4 * n + (i & 3); }
struct PgUnit { int pm, pn; };
DEV bool pg_next(int nM, int nN, int G, int c, int i, PgUnit& u) {
  const int nwg = nM * nN; const long L = (long)i * G + c; if (L >= nwg) return false;
  int wgid = (int)L; { const int q = nwg / 8, r = nwg % 8, xcd = wgid % 8, off = wgid / 8; wgid = (xcd < r ? xcd * (q + 1) : r * (q + 1) + (xcd - r) * q) + off; }
  const int nig = 8 * nN, gid = wgid / nig, fm = gid * 8, gsz = (nM - fm) < 8 ? (nM - fm) : 8;
  u.pm = fm + ((wgid % nig) % gsz); u.pn = (wgid % nig) / gsz; return true;
}
template <class Epi>
DEV void pg_epilogue(const Epi& E, f32x4 (&acc)[2][2][4][2], const PgUnit& u, int wr, int wc, int fr, int fq, LAS char* stg, int lane) {
  const int row0 = u.pm * 256 + wr * 64 + fr, col0 = u.pn * 256 + wc * 32 + 8 * fq;
  bool tr = false;
  if constexpr (Epi::HAS_T) tr = E.transposed(u.pn * 256 + wc * 32);
  if (tr) {
    if constexpr (Epi::HAS_T) {
#pragma unroll
      for (int ai = 0; ai < 2; ++ai)
#pragma unroll
        for (int m = 0; m < 4; ++m)
#pragma unroll
          for (int bj = 0; bj < 2; ++bj) {
            const f32x4 v0 = acc[ai][bj][m][0], v1 = acc[ai][bj][m][1];
            *(LAS u32x4*)(stg + fr * 64 + ((fq ^ ((fr >> 1) & 3)) << 4)) = (u32x4){cvt_pk_bf16(v0[0], v0[1]), cvt_pk_bf16(v0[2], v0[3]), cvt_pk_bf16(v1[0], v1[1]), cvt_pk_bf16(v1[2], v1[3])};
            const int col = lane & 31, hf = lane >> 5;
            unsigned w[4];
#pragma unroll
            for (int k = 0; k < 4; ++k) {
              const int r0 = 8 * hf + 2 * k, r1 = r0 + 1;
              const unsigned lo = *(const LAS unsigned short*)(stg + r0 * 64 + (((col >> 3) ^ ((r0 >> 1) & 3)) << 4) + (col & 7) * 2);
              const unsigned hi = *(const LAS unsigned short*)(stg + r1 * 64 + (((col >> 3) ^ ((r1 >> 1) & 3)) << 4) + (col & 7) * 2);
              w[k] = lo | (hi << 16);
            }
            E.col8(u.pm * 256 + ai * 128 + wr * 64 + m * 16 + 8 * hf, u.pn * 256 + bj * 128 + wc * 32 + col, (u32x4){w[0], w[1], w[2], w[3]});
            asm volatile("" ::: "memory");
          }
    }
  } else {
    uint4 xin[3];
#define PG_RC(i_, r_, c_) const int r_ = row0 + ((i_) >> 3) * 128 + (((i_) >> 1) & 3) * 16, c_ = col0 + ((i_) & 1) * 128
    if constexpr (Epi::PRELOAD) { { PG_RC(0, r, c); xin[0] = E.load8(r, c); } { PG_RC(1, r, c); xin[1] = E.load8(r, c); } }
#pragma unroll
    for (int i = 0; i < 16; ++i) {
      if constexpr (Epi::PRELOAD) { if (i + 2 < 16) { PG_RC(i + 2, r2, c2); xin[(i + 2) % 3] = E.load8(r2, c2); } }
      PG_RC(i, r, c);
      f32x4 v0 = acc[i >> 3][i & 1][(i >> 1) & 3][0], v1 = acc[i >> 3][i & 1][(i >> 1) & 3][1];
      if constexpr (Epi::HAS_PRE) { E.pre(c, v0); E.pre(c + 4, v1); }
      const u32x4 w = (u32x4){cvt_pk_bf16(v0[0], v0[1]), cvt_pk_bf16(v0[2], v0[3]), cvt_pk_bf16(v1[0], v1[1]), cvt_pk_bf16(v1[2], v1[3])};
      if constexpr (Epi::PRELOAD) E.row8(r, c, w, xin[i % 3]); else E.row8(r, c, w);
      asm volatile("" ::: "memory");
    }
#undef PG_RC
  }
}
template <class Epi>
DEV void gemm_pg8(const bf16_t* A, const bf16_t* Bt, int M, int N, int K, const Epi& E, LAS char* lds, bool rev = false, bool seqonly = false) {
  constexpr int HALF = 128, HTB = HALF * 64 * 2;
  const int tid = TIDX, wid = __builtin_amdgcn_readfirstlane(tid >> 6), lane = tid & 63, wr = wid >> 2, wc = wid & 3, fr = lane & 15, fq = lane >> 4;
  const int nt = K / 64, nM = seqonly ? NB * (SEQ / 256) : M / 256, nN = N / 256, G = gridDim.x, cidx = rev ? (int)gridDim.x - 1 - BIDX : BIDX;
  unsigned voffA[2], voffB[2];
#pragma unroll
  for (int i = 0; i < 2; ++i) { int R, C; stage_rc2(tid * 16 + i * 8192, R, C); const int Rb = (R & ~31) + pg_perm32(R & 31);
    voffA[i] = (unsigned)(R * K + C) * 2u; voffB[i] = (unsigned)(Rb * K + C) * 2u; }
  const size_t kstep = (size_t)(64 * 2), hstep = (size_t)HALF * K * 2, tstep = 2 * hstep;
  const unsigned ldsw = (unsigned)wid * 1024u;
  const int aoff = lds_byte2(wr * 64 + fr, fq * 8), boff = lds_byte2(wc * 32 + fr, fq * 8);
#define PG8_SA(b, h) (((b) * 2 + (h)) * HTB)
#define PG8_SB(b, h) ((4 + (b) * 2 + (h)) * HTB)
#define PG8_STAGE(bufoff, gbase, voff) do { _Pragma("unroll") for (int _i = 0; _i < 2; ++_i) \
    __builtin_amdgcn_global_load_lds((const unsigned*)((const char*)(gbase) + (voff)[_i]), (LAS unsigned*)(lds + (bufoff) + ldsw + _i * 8192), 16, 0, 0); } while (0)
#define PG8_LDA(dst, b, h) do { _Pragma("unroll") for (int m = 0; m < 4; ++m) _Pragma("unroll") for (int k = 0; k < 2; ++k) dst[m][k] = *(const LAS bf16x8*)(lds + PG8_SA(b, h) + aoff + m * 2048 + k * 1024); } while (0)
#define PG8_LDB(dst, b, h) do { _Pragma("unroll") for (int n = 0; n < 2; ++n) _Pragma("unroll") for (int k = 0; k < 2; ++k) dst[n][k] = *(const LAS bf16x8*)(lds + PG8_SB(b, h) + boff + n * 2048 + k * 1024); } while (0)
#define PG8_MMA(ai, bj, At_, Bt_) do { __builtin_amdgcn_s_setprio(1); _Pragma("unroll") for (int m = 0; m < 4; ++m) _Pragma("unroll") for (int n = 0; n < 2; ++n) _Pragma("unroll") for (int k = 0; k < 2; ++k) \
    acc[ai][bj][m][n] = __builtin_amdgcn_mfma_f32_16x16x32_bf16(Bt_[n][k], At_[m][k], acc[ai][bj][m][n], 0, 0, 0); __builtin_amdgcn_s_setprio(0); } while (0)
#define PG8_WAIT_V(n) asm volatile("s_waitcnt vmcnt(" #n ")" ::: "memory")
#define PG8_WAIT_L(n) asm volatile("s_waitcnt lgkmcnt(" #n ")" ::: "memory")
#define PG8_BAR __builtin_amdgcn_s_barrier()
#define PG8_SCHED __builtin_amdgcn_sched_barrier(0)
  PgUnit cur, nxt; int ui = 0;
  PG8_WAIT_V(0); PG8_WAIT_L(0); PG8_BAR;
#define PG_SEQ(u_) do { if (seqonly) (u_).pm = ((u_).pm >> 3) * 9 + 1 + ((u_).pm & 7); } while (0)
  if (!pg_next(nM, nN, G, cidx, 0, cur)) return;
  PG_SEQ(cur);
  f32x4 acc[2][2][4][2];
#pragma unroll
  for (int a = 0; a < 2; ++a)
#pragma unroll
    for (int b = 0; b < 2; ++b)
#pragma unroll
      for (int m = 0; m < 4; ++m)
#pragma unroll
        for (int n = 0; n < 2; ++n) acc[a][b][m][n] = (f32x4){0.f, 0.f, 0.f, 0.f};
  bf16x8 At[4][2], B0[2][2], B1[2][2];
  const char* cA = (const char*)A + (size_t)cur.pm * tstep; const char* cB = (const char*)Bt + (size_t)cur.pn * tstep;
  PG8_STAGE(PG8_SB(0, 0), cB, voffB); PG8_STAGE(PG8_SA(0, 0), cA, voffA); PG8_STAGE(PG8_SB(0, 1), cB + hstep, voffB); PG8_STAGE(PG8_SA(0, 1), cA + hstep, voffA);
  if (wr == 1) PG8_BAR;
  PG8_WAIT_V(4); PG8_BAR;
  PG8_STAGE(PG8_SB(1, 0), cB + kstep, voffB); PG8_STAGE(PG8_SA(1, 0), cA + kstep, voffA); PG8_STAGE(PG8_SB(1, 1), cB + hstep + kstep, voffB);
  PG8_WAIT_V(6); PG8_BAR;
  for (;;) {
    const bool has_next = pg_next(nM, nN, G, cidx, ui + 1, nxt); if (has_next) PG_SEQ(nxt);
    const char* nA = has_next ? (const char*)A + (size_t)nxt.pm * tstep : cA; const char* nB = has_next ? (const char*)Bt + (size_t)nxt.pn * tstep : cB;
    for (int t = 0; t < nt; t += 2) {
      const bool last = (t == nt - 2);
      const char* a1 = cA + (size_t)(t + 1) * kstep;
      const char* a2 = last ? nA : cA + (size_t)(t + 2) * kstep; const char* b2 = last ? nB : cB + (size_t)(t + 2) * kstep;
      const char* a3 = a2 + kstep; const char* b3 = b2 + kstep;
      PG8_LDB(B0, 0, 0); PG8_SCHED; PG8_LDA(At, 0, 0); PG8_STAGE(PG8_SA(1, 1), a1 + hstep, voffA);
      PG8_WAIT_L(8); PG8_BAR; PG8_WAIT_L(0); PG8_MMA(0, 0, At, B0); PG8_BAR; PG8_SCHED;
      PG8_LDB(B1, 0, 1); PG8_STAGE(PG8_SB(0, 0), b2, voffB);
      PG8_BAR; PG8_WAIT_L(0); PG8_MMA(0, 1, At, B1); PG8_BAR;
      PG8_LDA(At, 0, 1); PG8_STAGE(PG8_SA(0, 0), a2, voffA);
      PG8_BAR; PG8_WAIT_L(0); PG8_MMA(1, 0, At, B0); PG8_BAR; PG8_SCHED;
      PG8_STAGE(PG8_SB(0, 1), b2 + hstep, voffB);
      PG8_WAIT_V(6); PG8_BAR; PG8_MMA(1, 1, At, B1); PG8_BAR;
      PG8_LDB(B0, 1, 0); PG8_SCHED; PG8_LDA(At, 1, 0); PG8_STAGE(PG8_SA(0, 1), a2 + hstep, voffA);
      PG8_WAIT_L(8); PG8_BAR; PG8_WAIT_L(0); PG8_MMA(0, 0, At, B0); PG8_BAR; PG8_SCHED;
      PG8_LDB(B1, 1, 1); PG8_STAGE(PG8_SB(1, 0), b3, voffB);
      PG8_BAR; PG8_WAIT_L(0); PG8_MMA(0, 1, At, B1); PG8_BAR;
      PG8_LDA(At, 1, 1); PG8_STAGE(PG8_SA(1, 0), a3, voffA);
      PG8_BAR; PG8_WAIT_L(0); PG8_MMA(1, 0, At, B0); PG8_BAR; PG8_SCHED;
      PG8_STAGE(PG8_SB(1, 1), b3 + hstep, voffB);
      PG8_WAIT_V(6); PG8_BAR; PG8_MMA(1, 1, At, B1); PG8_BAR;
    }
    pg_epilogue(E, acc, cur, wr, wc, fr, fq, lds + 131072 + wid * 2048, lane);
    if (!has_next) break;
#pragma unroll
    for (int a = 0; a < 2; ++a)
#pragma unroll
      for (int b = 0; b < 2; ++b)
#pragma unroll
        for (int m = 0; m < 4; ++m)
#pragma unroll
          for (int n = 0; n < 2; ++n) acc[a][b][m][n] = (f32x4){0.f, 0.f, 0.f, 0.f};
    cur = nxt; cA = nA; cB = nB; ++ui;
  }
  PG8_WAIT_V(0);
  if (wr == 0) PG8_BAR;
  PG8_BAR;
#undef PG_SEQ
#undef PG8_SA
#undef PG8_SB
#undef PG8_STAGE
#undef PG8_LDA
#undef PG8_LDB
#undef PG8_MMA
#undef PG8_WAIT_V
#undef PG8_WAIT_L
#undef PG8_BAR
#undef PG8_SCHED
}

struct EpiStoreBf16 { static constexpr bool ROWVEC = false; static constexpr bool HAS_PRE = false; static constexpr bool HAS_T = false; static constexpr bool PRELOAD = false; bf16_t* C; int ldc; int ncols; DEV void operator()(int r, int c, f32x4 v) const { if (c < ncols) {
#pragma unroll
    for (int j = 0; j < 4; ++j) C[(size_t)(r + j) * ldc + c] = f2bf(v[j]); } } };
struct EpiStoreF32 { static constexpr bool ROWVEC = false; static constexpr bool HAS_PRE = false; static constexpr bool HAS_T = false; static constexpr bool PRELOAD = false; float* C; int ldc; DEV void operator()(int r, int c, f32x4 v) const {
#pragma unroll
    for (int j = 0; j < 4; ++j) C[(size_t)(r + j) * ldc + c] = v[j]; } };
struct EpiQ { static constexpr bool ROWVEC = false; static constexpr bool HAS_PRE = false; static constexpr bool HAS_T = false; static constexpr bool PRELOAD = false; bf16_t* QF; DEV void operator()(int r, int c, f32x4 v) const { const int b = r / SP, s = r - b * SP, h = c / 96, d = c - h * 96;
#pragma unroll
    for (int j = 0; j < 4; ++j) QF[((size_t)(b * 16 + h) * SP + s + j) * 96 + d] = f2bf(v[j]); } };
struct EpiKV { static constexpr bool ROWVEC = false; static constexpr bool HAS_PRE = false; static constexpr bool HAS_T = false; static constexpr bool PRELOAD = false; bf16_t* KF; bf16_t* VT; DEV void operator()(int r, int c, f32x4 v) const { const int b = r / SP, s = r - b * SP, h = c >> 7, d = c & 127;
    if (d < 64) {
#pragma unroll
      for (int j = 0; j < 4; ++j) KF[((size_t)(b * 16 + h) * SP + s + j) * 64 + d] = f2bf(v[j]);
    } else { uint2 w; w.x = (unsigned)f2bf(v[0]) | ((unsigned)f2bf(v[1]) << 16); w.y = (unsigned)f2bf(v[2]) | ((unsigned)f2bf(v[3]) << 16);
      *(uint2*)(VT + ((size_t)(b * 16 + h) * 64 + d - 64) * SP + s) = w; } } };
struct EpiRes { static constexpr bool ROWVEC = false; static constexpr bool HAS_PRE = false; static constexpr bool HAS_T = false; static constexpr bool PRELOAD = true; bf16_t* xc; bf16_t* xl; const float* ada; int layer; int goff; bool last;
  DEV bf16_t* xptr(int r, int c) const { const int b = r / SP, s = r - b * SP; return s < CTX ? (last ? nullptr : xc + ((size_t)(b * CTX + s)) * D + c) : xl + ((size_t)(b * SEQ + s - CTX)) * D + c; }
  DEV f32x4 load(int r, int c) const { const bf16_t* xp = xptr(r, c); f32x4 x = (f32x4){0.f, 0.f, 0.f, 0.f};
    if (xp) { x[0] = bf2f(xp[0]); x[1] = bf2f(xp[D]); x[2] = bf2f(xp[2 * D]); x[3] = bf2f(xp[3 * D]); } return x; }
  DEV void store(int r, int c, f32x4 v, f32x4 x) const { bf16_t* xp = xptr(r, c); if (!xp) return;
    const int b = r / SP, s = r - b * SP; const float g = ada[((size_t)(layer * 17 + (s < CTX ? 16 : b))) * 6144 + goff + c];
    xp[0] = f2bf(x[0] + g * v[0]); xp[D] = f2bf(x[1] + g * v[1]); xp[2 * D] = f2bf(x[2] + g * v[2]); xp[3 * D] = f2bf(x[3] + g * v[3]); } };
struct EpiStoreBf16R { static constexpr bool ROWVEC = true; static constexpr bool PRELOAD = false; static constexpr bool HAS_PRE = false; static constexpr bool HAS_T = false; bf16_t* C; int ldc; int ncols;
  DEV void row8(int r, int c, u32x4 v) const { if (c < ncols) *(uint4*)(C + (size_t)r * ldc + c) = make_uint4(v[0], v[1], v[2], v[3]); } };
struct EpiResR { static constexpr bool ROWVEC = true; static constexpr bool PRELOAD = true; static constexpr bool HAS_PRE = false; static constexpr bool HAS_T = false; bf16_t* xc; bf16_t* xl; const float* ada; int layer; int goff; bool last;
  DEV bf16_t* xptr(int r, int c) const { const int b = r / SP, s = r - b * SP; return s < CTX ? (last ? nullptr : xc + ((size_t)(b * CTX + s)) * D + c) : xl + ((size_t)(b * SEQ + s - CTX)) * D + c; }
  DEV uint4 load8(int r, int c) const { const bf16_t* xp = xptr(r, c); return xp ? *(const uint4*)xp : make_uint4(0u, 0u, 0u, 0u); }
  DEV void row8(int r, int c, u32x4 v, uint4 x) const { bf16_t* xp = xptr(r, c); if (!xp) return;
    const int b = r / SP, s = r - b * SP; const float* gp = ada + ((size_t)(layer * 17 + (s < CTX ? 16 : b))) * 6144 + goff + c;
    const float4 g0 = *(const float4*)gp, g1 = *(const float4*)(gp + 4);
    const unsigned xv[4] = {x.x, x.y, x.z, x.w}; const float g[8] = {g0.x, g0.y, g0.z, g0.w, g1.x, g1.y, g1.z, g1.w};
    unsigned o[4];
#pragma unroll
    for (int i = 0; i < 4; ++i) {
      const float lo = __uint_as_float(xv[i] << 16) + g[2 * i] * __uint_as_float(v[i] << 16), hi = __uint_as_float(xv[i] & 0xffff0000u) + g[2 * i + 1] * __uint_as_float(v[i] & 0xffff0000u);
      o[i] = cvt_pk_bf16(lo, hi); }
    *(uint4*)xp = make_uint4(o[0], o[1], o[2], o[3]); } };
struct EpiGla { static constexpr bool ROWVEC = false; static constexpr bool HAS_PRE = false; static constexpr bool HAS_T = false; static constexpr bool PRELOAD = false; bf16_t* QKVG; bf16_t* LG; const float* gkb; bf16_t* VTG;
  DEV void operator()(int r, int c, f32x4 v) const {
    if (c >= 1024 && c < 2048) { const int b = r / SP, s = r - b * SP; uint2 w; w.x = (unsigned)f2bf(v[0]) | ((unsigned)f2bf(v[1]) << 16); w.y = (unsigned)f2bf(v[2]) | ((unsigned)f2bf(v[3]) << 16);
      *(uint2*)(VTG + ((size_t)b * 1024 + c - 1024) * SP + s) = w; }
    else if (c < 3072) { const float sc = c < 512 ? 0.08838834764831845f : 1.0f;
#pragma unroll
      for (int j = 0; j < 4; ++j) QKVG[(size_t)(r + j) * 3072 + c] = f2bf(v[j] * sc); }
    else { const int d = (c - 3072) >> 9, n = (c - 3072) & 511; const float bias = gkb[d * 512 + n];
#pragma unroll
      for (int j = 0; j < 4; ++j) { const float z = v[j] + bias; const float ls = fminf(z, 0.f) - __logf(1.f + __expf(-fabsf(z)));
        LG[((size_t)d * T + r + j) * 512 + n] = f2bf(ls * (1.0f / 16.0f)); } } } };

struct EpiQR { static constexpr bool ROWVEC = true; static constexpr bool PRELOAD = false; static constexpr bool HAS_PRE = false; static constexpr bool HAS_T = false; bf16_t* QF;
  DEV void row8(int r, int c, u32x4 v) const { const int b = r / SP, s = r - b * SP, h = c / 96, d = c - h * 96;
    *(uint4*)(QF + ((size_t)(b * 16 + h) * SP + s) * 96 + d) = make_uint4(v[0], v[1], v[2], v[3]); } };
struct EpiKVR { static constexpr bool ROWVEC = true; static constexpr bool PRELOAD = false; static constexpr bool HAS_PRE = false; static constexpr bool HAS_T = true; bf16_t* KF; bf16_t* VT;
  DEV bool transposed(int c) const { return (c & 64) != 0; }
  DEV void row8(int r, int c, u32x4 v) const { const int b = r / SP, s = r - b * SP, h = c >> 7, d = c & 127;
    *(uint4*)(KF + ((size_t)(b * 16 + h) * SP + s) * 64 + d) = make_uint4(v[0], v[1], v[2], v[3]); }
  DEV void col16(int r, int c, const unsigned (&w)[8]) const { const int b = r / SP, s = r - b * SP, h = c >> 7, d = c & 127;
    bf16_t* vp = VT + ((size_t)(b * 16 + h) * 64 + d - 64) * SP + s;
    *(uint4*)vp = make_uint4(w[0], w[1], w[2], w[3]); *(uint4*)(vp + 8) = make_uint4(w[4], w[5], w[6], w[7]); }
  DEV void col8(int r, int c, u32x4 w) const { const int b = r / SP, s = r - b * SP, h = c >> 7, d = c & 127;
    *(uint4*)(VT + ((size_t)(b * 16 + h) * 64 + d - 64) * SP + s) = make_uint4(w[0], w[1], w[2], w[3]); } };
struct EpiGluResR { static constexpr bool ROWVEC = true; static constexpr bool PRELOAD = true; static constexpr bool HAS_PRE = false; static constexpr bool HAS_T = false; bf16_t* xc; bf16_t* xl; const float* ada; int layer;
  DEV bf16_t* xptr(int r, int c) const { const int b = r / SP, s = r - b * SP; return s < CTX ? xc + ((size_t)(b * CTX + s)) * D + c : xl + ((size_t)(b * SEQ + s - CTX)) * D + c; }
  DEV uint4 load8(int r, int c) const { const uint2 x = *(const uint2*)xptr(r, c >> 1); return make_uint4(x.x, x.y, 0u, 0u); }
  DEV void row8(int r, int c, u32x4 v, uint4 x) const { const int oc = c >> 1; bf16_t* xp = xptr(r, oc);
    const int b = r / SP, s = r - b * SP; const float4 g1 = *(const float4*)(ada + ((size_t)(layer * 17 + (s < CTX ? 16 : b))) * 6144 + 2048 + oc);
    const float g[4] = {g1.x, g1.y, g1.z, g1.w}; const unsigned xv[2] = {x.x, x.y};
    float o[4];
#pragma unroll
    for (int i = 0; i < 4; ++i) { const float a = __uint_as_float(v[i] << 16), gt = __uint_as_float(v[i] & 0xffff0000u);
      const float xo = (i & 1) ? __uint_as_float(xv[i >> 1] & 0xffff0000u) : __uint_as_float(xv[i >> 1] << 16);
      o[i] = xo + g[i] * a * sigm(gt); }
    *(uint2*)xp = make_uint2(cvt_pk_bf16(o[0], o[1]), cvt_pk_bf16(o[2], o[3])); } };
struct EpiGlaR { static constexpr bool ROWVEC = true; static constexpr bool PRELOAD = false; static constexpr bool HAS_PRE = true; static constexpr bool HAS_T = true; bf16_t* QKVG; bf16_t* LG; const float* gkb; bf16_t* VTG;
  DEV void pre(int c, f32x4& v) const {
    if (c < 512) { v[0] *= 0.08838834764831845f; v[1] *= 0.08838834764831845f; v[2] *= 0.08838834764831845f; v[3] *= 0.08838834764831845f; }
    else if (c >= 3072) { const float4 bias = *(const float4*)(gkb + c - 3072); const float bb[4] = {bias.x, bias.y, bias.z, bias.w};
#pragma unroll
      for (int j = 0; j < 4; ++j) { const float z = v[j] + bb[j]; v[j] = (fminf(z, 0.f) - __logf(1.f + __expf(-fabsf(z)))) * (1.0f / 16.0f); } } }
  DEV bool transposed(int c) const { return c >= 1024 && c < 2048; }
  DEV void row8(int r, int c, u32x4 v) const {
    if (c < 3072) *(uint4*)(QKVG + (size_t)r * 3072 + c) = make_uint4(v[0], v[1], v[2], v[3]);
    else { const int d = (c - 3072) >> 9, n = (c - 3072) & 511; *(uint4*)(LG + ((size_t)d * T + r) * 512 + n) = make_uint4(v[0], v[1], v[2], v[3]); } }
  DEV void col16(int r, int c, const unsigned (&w)[8]) const { const int b = r / SP, s = r - b * SP;
    bf16_t* vp = VTG + ((size_t)b * 1024 + c - 1024) * SP + s;
    *(uint4*)vp = make_uint4(w[0], w[1], w[2], w[3]); *(uint4*)(vp + 8) = make_uint4(w[4], w[5], w[6], w[7]); }
  DEV void col8(int r, int c, u32x4 w) const { const int b = r / SP, s = r - b * SP;
    *(uint4*)(VTG + ((size_t)b * 1024 + c - 1024) * SP + s) = make_uint4(w[0], w[1], w[2], w[3]); } };
DEV void phase_mla_norm(CP p, int j) {
  const bf16_t* A1 = (const bf16_t*)(p.scratch + OFF_A1); bf16_t* CQN = (bf16_t*)(p.scratch + OFF_CQN); bf16_t* CKVN = (bf16_t*)(p.scratch + OFF_CKVN); bf16_t* KPE = (bf16_t*)(p.scratch + OFF_KPE);
  const int lane = TIDX & 63, gw = BIDX * (NTHR / 64) + (TIDX >> 6), nw = gridDim.x * (NTHR / 64);
  const float* qn = p.mla_q_norm + j * 384; const float* kn = p.mla_kv_norm + j * 256;
  for (int t0 = gw; t0 < T; t0 += 2 * nw) {
    float v[2][6], w[2][4], val[2];
#pragma unroll
    for (int u = 0; u < 2; ++u) { const int t = t0 + u * nw; if (t < T) { const bf16_t* a = A1 + (size_t)t * 768;
#pragma unroll
      for (int i = 0; i < 6; ++i) v[u][i] = bf2f(a[lane + 64 * i]);
#pragma unroll
      for (int i = 0; i < 4; ++i) w[u][i] = bf2f(a[384 + lane + 64 * i]);
      val[u] = bf2f(a[640 + (lane & 31)]); } }
#pragma unroll
    for (int u = 0; u < 2; ++u) { const int t = t0 + u * nw; if (t < T) {
      float ss = 0.f;
#pragma unroll
      for (int i = 0; i < 6; ++i) ss += v[u][i] * v[u][i];
      ss = wave_sum(ss); float rstd = rsqrtf(ss * (1.0f / 384.0f) + 1e-6f);
#pragma unroll
      for (int i = 0; i < 6; ++i) CQN[(size_t)t * 384 + lane + 64 * i] = f2bf(v[u][i] * rstd * qn[lane + 64 * i]);
      ss = 0.f;
#pragma unroll
      for (int i = 0; i < 4; ++i) ss += w[u][i] * w[u][i];
      ss = wave_sum(ss); rstd = rsqrtf(ss * (1.0f / 256.0f) + 1e-6f);
#pragma unroll
      for (int i = 0; i < 4; ++i) CKVN[(size_t)t * 256 + lane + 64 * i] = f2bf(w[u][i] * rstd * kn[lane + 64 * i]);
      const int b = t / SP, s = t - b * SP;
      float vl = val[u];
      const float other = __shfl_xor(vl, 8);
      if (s >= CTX) { const int pos = s - CTX, d = lane & 31, hb = d >> 4, dd = d & 15, i = dd & 7;
        const float cs = p.rope[pos * 32 + hb * 16 + i], sn = p.rope[pos * 32 + hb * 16 + 8 + i];
        vl = dd < 8 ? vl * cs - other * sn : vl * cs + other * sn; }
      if (lane < 32) KPE[(size_t)t * 32 + lane] = f2bf(vl);
    } }
  }
}

DEV void phase_attn_naive(CP p, bool last, float* lds) {
  const bf16_t* QF = (const bf16_t*)(p.scratch + OFF_QF); const bf16_t* KF = (const bf16_t*)(p.scratch + OFF_KF); const bf16_t* VF = (const bf16_t*)(p.scratch + OFF_VF);
  bf16_t* O = (bf16_t*)(p.scratch + OFF_O);
  float* Ks = lds;
  float* Vs = lds + 32 * 96;
  const int tid = TIDX;
  const int nitems = 1024 + (last ? 0 : 256);
  for (int item = BIDX; item < nitems; item += gridDim.x) {
    int b, hh, q0, nq, nkeys;
    if (item < 1024) { b = item >> 6; hh = (item >> 2) & 15; q0 = CTX + (item & 3) * 512; nq = 512; nkeys = SP; }
    else { const int it = item - 1024; b = it >> 4; hh = it & 15; q0 = 0; nq = 256; nkeys = CTX; }
    const size_t bh = (size_t)(b * 16 + hh) * SP;
    const bool active = tid < nq;
    const int sq = q0 + (active ? tid : 0);
    float q[96];
    { const bf16_t* qp = QF + (bh + sq) * 96;
#pragma unroll
      for (int i = 0; i < 96; i += 2) { const unsigned u = *(const unsigned*)(qp + i); q[i] = __uint_as_float(u << 16); q[i + 1] = __uint_as_float(u & 0xffff0000u); } }
    if (sq >= CTX) { const float* r = p.rope + (sq - CTX) * 32;
#pragma unroll
      for (int hb = 0; hb < 2; ++hb)
#pragma unroll
        for (int i = 0; i < 8; ++i) { const float cs = r[hb * 16 + i], sn = r[hb * 16 + 8 + i], x1 = q[64 + hb * 16 + i], x2 = q[64 + hb * 16 + 8 + i];
          q[64 + hb * 16 + i] = x1 * cs - x2 * sn; q[64 + hb * 16 + 8 + i] = x2 * cs + x1 * sn; } }
#pragma unroll
    for (int i = 0; i < 96; ++i) q[i] *= 0.10206207261596577f;
    float acc[64], m = -1e30f, l = 0.f;
#pragma unroll
    for (int i = 0; i < 64; ++i) acc[i] = 0.f;
    for (int k0 = 0; k0 < nkeys; k0 += 32) {
      __syncthreads();
      for (int idx = tid; idx < 32 * 96 / 2; idx += NTHR) { const unsigned u = *(const unsigned*)(KF + (bh + k0) * 96 + idx * 2); Ks[idx * 2] = __uint_as_float(u << 16); Ks[idx * 2 + 1] = __uint_as_float(u & 0xffff0000u); }
      for (int idx = tid; idx < 32 * 64 / 2; idx += NTHR) { const unsigned u = *(const unsigned*)(VF + (bh + k0) * 64 + idx * 2); Vs[idx * 2] = __uint_as_float(u << 16); Vs[idx * 2 + 1] = __uint_as_float(u & 0xffff0000u); }
      __syncthreads();
#pragma unroll 1
      for (int kk = 0; kk < 32; ++kk) {
        float s = 0.f;
#pragma unroll
        for (int i = 0; i < 96; i += 4) { const float4 kv = *(const float4*)(Ks + kk * 96 + i); s += q[i] * kv.x + q[i + 1] * kv.y + q[i + 2] * kv.z + q[i + 3] * kv.w; }
        if (s > m) { const float corr = __expf(m - s); l *= corr;
#pragma unroll
          for (int i = 0; i < 64; ++i) acc[i] *= corr;
          m = s; }
        const float pe = __expf(s - m); l += pe;
#pragma unroll
        for (int i = 0; i < 64; i += 4) { const float4 vv = *(const float4*)(Vs + kk * 64 + i); acc[i] += pe * vv.x; acc[i + 1] += pe * vv.y; acc[i + 2] += pe * vv.z; acc[i + 3] += pe * vv.w; }
      }
    }
    if (active) { const float inv = 1.f / l; bf16_t* op = O + ((size_t)(b * SP + sq)) * D + hh * 64;
#pragma unroll
      for (int i = 0; i < 64; i += 2) *(unsigned*)(op + i) = (unsigned)f2bf(acc[i] * inv) | ((unsigned)f2bf(acc[i + 1] * inv) << 16); }
  }
}


DEV void phase_attn_mfma(CP p, bool last, LAS char* shm) {
  const bf16_t* QF = (const bf16_t*)(p.scratch + OFF_QF); const bf16_t* KF = (const bf16_t*)(p.scratch + OFF_KF); const bf16_t* VT = (const bf16_t*)(p.scratch + OFF_VF);
  bf16_t* O = (bf16_t*)(p.scratch + OFF_O); const bf16_t* KPE = (const bf16_t*)(p.scratch + OFF_KPE);
  constexpr int KSTR = 208, VSTR = 136, KBYTES = 64 * KSTR, VBYTES = 64 * VSTR;
  const int tid = TIDX, wid = tid >> 6, lane = tid & 63, ql = lane & 31, hh = lane >> 5;
  const int nitems = 2048 + (last ? 0 : 256), G = gridDim.x;
  const int k_idx0 = tid, k_idx1 = tid + 512;
  const int vd = tid >> 3, vpart = tid & 7;
  const int bid_ = BIDX, vb_ = (G & 7) ? bid_ : (bid_ & 7) * (G >> 3) + (bid_ >> 3);
  for (int item = vb_; item < nitems; item += G) {
    int b, h, q0, nk;
    if (item < 2048) { b = item >> 7; h = (item >> 3) & 15; q0 = CTX + (item & 7) * 256; nk = SP; }
    else { const int it = item - 2048; b = it >> 4; h = it & 15; q0 = 0; nk = CTX; }
    const size_t bh = (size_t)(b * 16 + h);
    const int sq = q0 + wid * 32 + ql;
    bf16x8 qf[6];
    { const bf16_t* qp = QF + (bh * SP + sq) * 96 + 8 * hh;
      const float qs = 0.10206207261596577f * 1.4426950408889634f;
#pragma unroll
      for (int s = 0; s < 6; ++s) {
        const uint4 w = *(const uint4*)(qp + 16 * s); const unsigned ww[4] = {w.x, w.y, w.z, w.w};
        float v[8];
#pragma unroll
        for (int i = 0; i < 4; ++i) { v[2 * i] = __uint_as_float(ww[i] << 16); v[2 * i + 1] = __uint_as_float(ww[i] & 0xffff0000u); }
        if (s >= 4 && sq >= CTX) { const float* r = p.rope + (sq - CTX) * 32 + (s - 4) * 16;
#pragma unroll
          for (int j = 0; j < 8; ++j) { const float pv = __shfl_xor(v[j], 32), cs = r[j], sn = r[8 + j]; v[j] = hh ? v[j] * cs + pv * sn : v[j] * cs - pv * sn; } }
        unsigned o[4];
#pragma unroll
        for (int i = 0; i < 4; ++i) o[i] = cvt_pk_bf16(v[2 * i] * qs, v[2 * i + 1] * qs);
        qf[s] = __builtin_bit_cast(bf16x8, make_uint4(o[0], o[1], o[2], o[3]));
      } }
    f32x16 oacc[2];
#pragma unroll
    for (int dt = 0; dt < 2; ++dt)
#pragma unroll
      for (int r = 0; r < 16; ++r) oacc[dt][r] = 0.f;
    float m = 0.f, l0 = 0.f, l1 = 0.f, l2 = 0.f, l3 = 0.f;
    const int ntile = nk >> 6;
    uint4 kr0a, kr1a, vra, kr0b, kr1b, vrb;
    const int kp0 = k_idx0 % 12, kk0 = k_idx0 / 12, kp1 = k_idx1 % 12, kk1 = k_idx1 / 12;
    const bf16_t* ksrc0 = kp0 < 8 ? KF + (bh * SP + kk0) * 64 + kp0 * 8 : KPE + ((size_t)b * SP + kk0) * 32 + (kp0 - 8) * 8; const int kst0 = kp0 < 8 ? 64 : 32;
    const bf16_t* ksrc1 = kp1 < 8 ? KF + (bh * SP + kk1) * 64 + kp1 * 8 : KPE + ((size_t)b * SP + kk1) * 32 + (kp1 - 8) * 8; const int kst1 = kp1 < 8 ? 64 : 32;
    const bf16_t* vbase = VT + (bh * 64 + vd) * SP + vpart * 8;
    LAS char* const kw0 = shm + (k_idx0 / 12) * KSTR + (k_idx0 % 12) * 16;
    LAS char* const kw1 = shm + (k_idx1 / 12) * KSTR + (k_idx1 % 12) * 16;
    LAS char* const vw = shm + 2 * KBYTES + vd * VSTR + vpart * 16;
    const LAS char* const kfb = shm + ql * KSTR + 16 * hh;
    const LAS char* const vfb = shm + 2 * KBYTES + ql * VSTR + 8 * hh;
#define ATT_LOAD(R, t_) do { const int k0_ = (t_) * 64; kr0##R = *(const uint4*)(ksrc0 + (size_t)k0_ * kst0); \
      if (k_idx1 < 768) kr1##R = *(const uint4*)(ksrc1 + (size_t)k0_ * kst1); vr##R = *(const uint4*)(vbase + k0_); } while (0)
#define ATT_WRITE(R, ks_, vs_) do { *(LAS u32x4*)(kw0 + (ks_) * KBYTES) = (u32x4){kr0##R.x, kr0##R.y, kr0##R.z, kr0##R.w}; \
      if (k_idx1 < 768) *(LAS u32x4*)(kw1 + (ks_) * KBYTES) = (u32x4){kr1##R.x, kr1##R.y, kr1##R.z, kr1##R.w}; \
      LAS char* vb_ = vw + (vs_) * VBYTES; *(LAS u32x2*)vb_ = (u32x2){vr##R.x, vr##R.y}; *(LAS u32x2*)(vb_ + 8) = (u32x2){vr##R.z, vr##R.w}; } while (0)
#define ATT_STEP(CUR, NXT, KS_NEXT, KS_WRITE, RL, RW) do { \
      if (t + 3 < ntile) ATT_LOAD(RL, t + 3); \
      const LAS char* kb_ = kfb + (KS_NEXT) * KBYTES; const LAS char* vb2_ = vfb + vs * VBYTES; \
      const float ninit_ = -m; \
      _Pragma("unroll") for (int r = 0; r < 16; ++r) { NXT[0][r] = ninit_; NXT[1][r] = ninit_; } \
      bf16x8 kf_[12]; unsigned pw_[16]; \
      kf_[0] = ld_frag_lds(kb_); kf_[1] = ld_frag_lds(kb_ + 32 * KSTR); \
      _Pragma("unroll") for (int i = 0; i < 12; ++i) { \
        if (i + 2 < 12) kf_[i + 2] = ld_frag_lds(kb_ + ((i + 2) & 1) * 32 * KSTR + ((i + 2) >> 1) * 32); \
        NXT[i & 1] = __builtin_amdgcn_mfma_f32_32x32x16_bf16(kf_[i], qf[i >> 1], NXT[i & 1], 0, 0, 0); \
        _Pragma("unroll") for (int j = (16 * i) / 12; j < (16 * (i + 1)) / 12; ++j) { \
          const float ea_ = __builtin_amdgcn_exp2f(CUR[j >> 3][(2 * j) & 15]), eb_ = __builtin_amdgcn_exp2f(CUR[j >> 3][(2 * j + 1) & 15]); \
          if (j & 1) { l2 += ea_; l3 += eb_; } else { l0 += ea_; l1 += eb_; } pw_[j] = cvt_pk_bf16(ea_, eb_); } \
        __builtin_amdgcn_sched_barrier(0); } \
      float mx_ = NXT[0][0]; \
      u32x2 va_[8], vb3_[8]; \
      va_[0] = *(const LAS u32x2*)(vb2_); vb3_[0] = *(const LAS u32x2*)(vb2_ + 16); \
      _Pragma("unroll") for (int i = 0; i < 8; ++i) { \
        if (i + 1 < 8) { const LAS char* vp_ = vb2_ + ((i + 1) & 1) * 32 * VSTR + (((i + 1) >> 1) & 1) * 64 + ((i + 1) >> 2) * 32; va_[i + 1] = *(const LAS u32x2*)vp_; vb3_[i + 1] = *(const LAS u32x2*)(vp_ + 16); } \
        const int kk_ = (i >> 1) & 1, s2_ = i >> 2; \
        const bf16x8 vf_ = __builtin_bit_cast(bf16x8, (u32x4){va_[i].x, va_[i].y, vb3_[i].x, vb3_[i].y}); \
        const bf16x8 pf_ = __builtin_bit_cast(bf16x8, (u32x4){pw_[kk_ * 8 + s2_ * 4], pw_[kk_ * 8 + s2_ * 4 + 1], pw_[kk_ * 8 + s2_ * 4 + 2], pw_[kk_ * 8 + s2_ * 4 + 3]}); \
        oacc[i & 1] = __builtin_amdgcn_mfma_f32_32x32x16_bf16(vf_, pf_, oacc[i & 1], 0, 0, 0); \
        _Pragma("unroll") for (int x = 4 * i; x < 4 * i + 4; ++x) mx_ = fmaxf(mx_, NXT[x >> 4][x & 15]); \
        __builtin_amdgcn_sched_barrier(0); } \
      mx_ = fmaxf(mx_, __shfl_xor(mx_, 32)); \
      if (t + 1 < ntile && __any(mx_ > 8.0f)) {              \
        const float delta_ = mx_ > 8.0f ? mx_ : 0.f, corr_ = __builtin_amdgcn_exp2f(-delta_); \
        m += delta_; l0 *= corr_; l1 *= corr_; l2 *= corr_; l3 *= corr_; \
        _Pragma("unroll") for (int r = 0; r < 16; ++r) { oacc[0][r] *= corr_; oacc[1][r] *= corr_; NXT[0][r] -= delta_; NXT[1][r] -= delta_; } } \
      if (t + 2 < ntile) ATT_WRITE(RW, KS_WRITE, vs == 0 ? 2 : vs - 1); \
      vs = vs == 2 ? 0 : vs + 1; ++t; \
      GRAW_BARRIER(); } while (0)
    __syncthreads();
    ATT_LOAD(a, 0); ATT_WRITE(a, 0, 0);
    ATT_LOAD(a, 1); ATT_LOAD(b, 2);
    GRAW_BARRIER();
    f32x16 sa[2], sb[2];
    {
#pragma unroll
      for (int r = 0; r < 16; ++r) { sa[0][r] = 0.f; sa[1][r] = 0.f; }
#pragma unroll
      for (int i = 0; i < 12; ++i) sa[i & 1] = __builtin_amdgcn_mfma_f32_32x32x16_bf16(ld_frag_lds(kfb + (i & 1) * 32 * KSTR + (i >> 1) * 32), qf[i >> 1], sa[i & 1], 0, 0, 0);
      float mx = sa[0][0];
#pragma unroll
      for (int x = 1; x < 32; ++x) mx = fmaxf(mx, sa[x >> 4][x & 15]);
      mx = fmaxf(mx, __shfl_xor(mx, 32));
      m = mx;
#pragma unroll
      for (int r = 0; r < 16; ++r) { sa[0][r] -= mx; sa[1][r] -= mx; }
    }
    ATT_WRITE(a, 1, 1);
    GRAW_BARRIER();
    int t = 0, vs = 0;
    while (t < ntile) {
      ATT_STEP(sa, sb, 1, 0, a, b);
      ATT_STEP(sb, sa, 0, 1, b, a);
    }
#undef ATT_STEP
#undef ATT_LOAD
#undef ATT_WRITE
    float l = (l0 + l1) + (l2 + l3);
    l += __shfl_xor(l, 32);
    const float inv = 1.f / l;
    bf16_t* op = O + ((size_t)(b * SP + sq)) * D + h * 64 + 4 * hh;
#pragma unroll
    for (int dt = 0; dt < 2; ++dt)
#pragma unroll
      for (int g = 0; g < 4; ++g) { uint2 w; w.x = cvt_pk_bf16(oacc[dt][4 * g] * inv, oacc[dt][4 * g + 1] * inv); w.y = cvt_pk_bf16(oacc[dt][4 * g + 2] * inv, oacc[dt][4 * g + 3] * inv);
        *(uint2*)(op + dt * 32 + 8 * g) = w; }
  }
}

#define INSERT16(val, pay, tv, ti) { float s_ = (val); int i_ = (pay); _Pragma("unroll") for (int j_ = 0; j_ < 16; ++j_) { if (s_ > tv[j_]) { float t_ = tv[j_]; tv[j_] = s_; s_ = t_; int u_ = ti[j_]; ti[j_] = i_; i_ = u_; } } }

DEV void phase_peer_subtopk(CP p, int layer, float* lds) {
  const float* PQ = (const float*)(p.scratch + OFF_PQ); float* SV = (float*)(p.scratch + OFF_SV); int* SI = (int*)(p.scratch + OFF_SI);
  const int tid = TIDX;
  for (int item = BIDX; item < 16 * 72; item += gridDim.x) {
    const int hp = item / 72, tb = item - hp * 72, t = tb * 512 + tid;
    __syncthreads();
    const float* kp = p.peer_keys + ((size_t)(layer * 16 + hp)) * 128 * 64;
    for (int idx = tid; idx < 128 * 64 / 4; idx += NTHR) *(float4*)(lds + idx * 4) = *(const float4*)(kp + idx * 4);
    __syncthreads();
    float q[64];
#pragma unroll
    for (int i = 0; i < 64; i += 4) { const float4 v = *(const float4*)(PQ + (size_t)t * 1024 + hp * 64 + i); q[i] = v.x; q[i + 1] = v.y; q[i + 2] = v.z; q[i + 3] = v.w; }
    float tv[16]; int ti[16];
#pragma unroll
    for (int j = 0; j < 16; ++j) { tv[j] = -3.0e38f; ti[j] = 0; }
#pragma unroll 1
    for (int key = 0; key < 128; ++key) {
      float s = 0.f;
#pragma unroll
      for (int i = 0; i < 64; i += 4) { const float4 kv = *(const float4*)(lds + key * 64 + i); s += q[i] * kv.x + q[i + 1] * kv.y + q[i + 2] * kv.z + q[i + 3] * kv.w; }
      INSERT16(s, key, tv, ti);
    }
#pragma unroll
    for (int j = 0; j < 16; ++j) { SV[((size_t)t * 16 + hp) * 16 + j] = tv[j]; SI[((size_t)t * 16 + hp) * 16 + j] = ti[j]; }
  }
}

DEV void phase_peer_final_topk(CP p) {
  const float* SV = (const float*)(p.scratch + OFF_SV); const int* SI = (const int*)(p.scratch + OFF_SI);
  int* EID = (int*)(p.scratch + OFF_EID); float* GATE = (float*)(p.scratch + OFF_GATE);
  for (int idx = BIDX * NTHR + TIDX; idx < T * 8; idx += gridDim.x * NTHR) {
    float a[16], bq[16]; int ia[16], ib[16];
#pragma unroll
    for (int j = 0; j < 16; ++j) { a[j] = SV[(size_t)idx * 32 + j]; ia[j] = SI[(size_t)idx * 32 + j]; bq[j] = SV[(size_t)idx * 32 + 16 + j]; ib[j] = SI[(size_t)idx * 32 + 16 + j]; }
    float tv[16]; int ti[16];
#pragma unroll
    for (int j = 0; j < 16; ++j) { tv[j] = -3.0e38f; ti[j] = 0; }
#pragma unroll
    for (int i0 = 0; i0 < 16; ++i0)
#pragma unroll
      for (int i1 = 0; i1 < 16; ++i1)
        if ((i0 + 1) * (i1 + 1) <= 16) INSERT16(a[i0] + bq[i1], ia[i0] * 128 + ib[i1], tv, ti);
    float e[16], sum = 0.f;
#pragma unroll
    for (int j = 0; j < 16; ++j) { e[j] = __expf(tv[j] - tv[0]); sum += e[j]; }
    const float inv = 1.f / sum;
#pragma unroll
    for (int j = 0; j < 16; ++j) { EID[(size_t)idx * 16 + j] = ti[j]; GATE[(size_t)idx * 16 + j] = e[j] * inv; }
  }
}

DEV void phase_peer_gather(CP p, int layer) {
  const int* EID = (const int*)(p.scratch + OFF_EID); const float* GATE = (const float*)(p.scratch + OFF_GATE);
  const int lane = TIDX & 63, gw = BIDX * (NTHR / 64) + (TIDX >> 6), nw = gridDim.x * (NTHR / 64);
  const bool last = layer == 3;
  const float* U = p.peer_u + (size_t)layer * 16384 * 1024; const float* V = p.peer_v + (size_t)layer * 16384 * 1024;
  for (int t = gw; t < T; t += nw) {
    const int b = t / SP, s = t - b * SP;
    if (last && s < CTX) continue;
    float x[16];
    { const bf16_t* hr = p.h + (size_t)t * D;
#pragma unroll
      for (int j = 0; j < 4; ++j) { const uint2 w = *(const uint2*)(hr + j * 256 + lane * 4); x[j * 4] = __uint_as_float(w.x << 16); x[j * 4 + 1] = __uint_as_float(w.x & 0xffff0000u); x[j * 4 + 2] = __uint_as_float(w.y << 16); x[j * 4 + 3] = __uint_as_float(w.y & 0xffff0000u); } }
    float f[16];
#pragma unroll
    for (int i = 0; i < 16; ++i) f[i] = 0.f;
#pragma unroll 2
    for (int e = 0; e < 128; ++e) {
      const int eid = EID[(size_t)t * 128 + e]; const float gate = GATE[(size_t)t * 128 + e];
      const float* ur = U + (size_t)eid * 1024; const float* vr = V + (size_t)eid * 1024;
      float4 uu[4], vv[4];
#pragma unroll
      for (int j = 0; j < 4; ++j) { uu[j] = *(const float4*)(ur + j * 256 + lane * 4); vv[j] = *(const float4*)(vr + j * 256 + lane * 4); }
      float dsum = 0.f;
#pragma unroll
      for (int j = 0; j < 4; ++j) dsum += uu[j].x * x[j * 4] + uu[j].y * x[j * 4 + 1] + uu[j].z * x[j * 4 + 2] + uu[j].w * x[j * 4 + 3];
      dsum = wave_sum(dsum);
      const float w = gate * gelu_tanh(dsum);
#pragma unroll
      for (int j = 0; j < 4; ++j) { f[j * 4] += w * vv[j].x; f[j * 4 + 1] += w * vv[j].y; f[j * 4 + 2] += w * vv[j].z; f[j * 4 + 3] += w * vv[j].w; }
    }
    bf16_t* xr = xrow_ptr(p, t);
    float xv[16]; load_row_bf(xr, lane, xv);
    const float* ad = ada_ptr(p, layer, t);
#pragma unroll
    for (int j = 0; j < 4; ++j) { const float4 g2 = *(const float4*)(ad + 5120 + j * 256 + lane * 4);
      xv[j * 4] += g2.x * f[j * 4]; xv[j * 4 + 1] += g2.y * f[j * 4 + 1]; xv[j * 4 + 2] += g2.z * f[j * 4 + 2]; xv[j * 4 + 3] += g2.w * f[j * 4 + 3]; }
    if (!last) {
      store_row_bf(xr, lane, xv);
      const float* ad2 = ada_ptr(p, layer + 1, t);
      norm_mod_store(xv, p.norm_g + ((layer + 1) * 2) * D, ad2 + 1024, ad2, p.h + (size_t)t * D, lane);
    } else {
      float ss = 0.f;
#pragma unroll
      for (int i = 0; i < 16; ++i) ss += xv[i] * xv[i];
      ss = wave_sum(ss); const float rstd = rsqrtf(ss * (1.0f / D) + 1e-6f);
#pragma unroll
      for (int j = 0; j < 4; ++j) { const float4 g = *(const float4*)(p.final_g + j * 256 + lane * 4);
        xv[j * 4] *= rstd * g.x; xv[j * 4 + 1] *= rstd * g.y; xv[j * 4 + 2] *= rstd * g.z; xv[j * 4 + 3] *= rstd * g.w; }
      store_row_f32(p.out + ((size_t)(b * SEQ + s - CTX)) * D, lane, xv);
    }
  }
}


typedef float f32x2 __attribute__((ext_vector_type(2)));
constexpr float U8_SCALE = 64.0f, V8_SCALE = 4.0f;
DEV unsigned pack4_fp8(float a, float b, float c, float d, float sc) {
  a = fminf(fmaxf(a * sc, -448.f), 448.f); b = fminf(fmaxf(b * sc, -448.f), 448.f); c = fminf(fmaxf(c * sc, -448.f), 448.f); d = fminf(fmaxf(d * sc, -448.f), 448.f);
  int w = 0; w = __builtin_amdgcn_cvt_pk_fp8_f32(a, b, w, false); w = __builtin_amdgcn_cvt_pk_fp8_f32(c, d, w, true); return (unsigned)w;
}
DEV void phase_peer_tables(CP p, int layer) {
  uint4* UV = (uint4*)(p.scratch + OFF_U8);
  const float4* U = (const float4*)(p.peer_u + (size_t)layer * 16384 * 1024); const float4* V = (const float4*)(p.peer_v + (size_t)layer * 16384 * 1024);
  const int n16 = 16384 * 1024 / 16;
  for (int i = BIDX * NTHR + TIDX; i < n16; i += gridDim.x * NTHR) {
    unsigned uw0, uw1;
    { const float4 a = U[(size_t)i * 4], b = U[(size_t)i * 4 + 1], c = U[(size_t)i * 4 + 2], d = U[(size_t)i * 4 + 3];
      const float e[16] = {a.x, a.y, a.z, a.w, b.x, b.y, b.z, b.w, c.x, c.y, c.z, c.w, d.x, d.y, d.z, d.w};
      unsigned w0 = 0u, w1 = 0u;
#define U4C(k_) fminf(fmaxf(e[k_] * U8_SCALE, -6.f), 6.f)
      w0 = __builtin_amdgcn_cvt_scalef32_pk_fp4_f32(w0, U4C(0), U4C(1), 1.0f, 0); w0 = __builtin_amdgcn_cvt_scalef32_pk_fp4_f32(w0, U4C(2), U4C(3), 1.0f, 1);
      w0 = __builtin_amdgcn_cvt_scalef32_pk_fp4_f32(w0, U4C(4), U4C(5), 1.0f, 2); w0 = __builtin_amdgcn_cvt_scalef32_pk_fp4_f32(w0, U4C(6), U4C(7), 1.0f, 3);
      w1 = __builtin_amdgcn_cvt_scalef32_pk_fp4_f32(w1, U4C(8), U4C(9), 1.0f, 0); w1 = __builtin_amdgcn_cvt_scalef32_pk_fp4_f32(w1, U4C(10), U4C(11), 1.0f, 1);
      w1 = __builtin_amdgcn_cvt_scalef32_pk_fp4_f32(w1, U4C(12), U4C(13), 1.0f, 2); w1 = __builtin_amdgcn_cvt_scalef32_pk_fp4_f32(w1, U4C(14), U4C(15), 1.0f, 3);
#undef U4C
      uw0 = w0; uw1 = w1; }
    { const float4 a = V[(size_t)i * 4], b = V[(size_t)i * 4 + 1], c = V[(size_t)i * 4 + 2], d = V[(size_t)i * 4 + 3];
      const float e[16] = {a.x, a.y, a.z, a.w, b.x, b.y, b.z, b.w, c.x, c.y, c.z, c.w, d.x, d.y, d.z, d.w};
      unsigned w0 = 0u, w1 = 0u;
#define V4C(k_) fminf(fmaxf(e[k_] * V8_SCALE, -6.f), 6.f)
      w0 = __builtin_amdgcn_cvt_scalef32_pk_fp4_f32(w0, V4C(0), V4C(1), 1.0f, 0); w0 = __builtin_amdgcn_cvt_scalef32_pk_fp4_f32(w0, V4C(2), V4C(3), 1.0f, 1);
      w0 = __builtin_amdgcn_cvt_scalef32_pk_fp4_f32(w0, V4C(4), V4C(5), 1.0f, 2); w0 = __builtin_amdgcn_cvt_scalef32_pk_fp4_f32(w0, V4C(6), V4C(7), 1.0f, 3);
      w1 = __builtin_amdgcn_cvt_scalef32_pk_fp4_f32(w1, V4C(8), V4C(9), 1.0f, 0); w1 = __builtin_amdgcn_cvt_scalef32_pk_fp4_f32(w1, V4C(10), V4C(11), 1.0f, 1);
      w1 = __builtin_amdgcn_cvt_scalef32_pk_fp4_f32(w1, V4C(12), V4C(13), 1.0f, 2); w1 = __builtin_amdgcn_cvt_scalef32_pk_fp4_f32(w1, V4C(14), V4C(15), 1.0f, 3);
#undef V4C
      UV[i] = make_uint4(uw0, uw1, w0, w1); }
  }
}
DEV float rdlane_f(float v, int l) { return __builtin_bit_cast(float, __builtin_amdgcn_readlane(__builtin_bit_cast(int, v), l)); }

DEV void phase_peer_gather8(CP p, int layer) {
  const int* EID = (const int*)(p.scratch + OFF_EID); const float* GATE = (const float*)(p.scratch + OFF_GATE);
  const uint4* UV = (const uint4*)(p.scratch + OFF_U8);
  const int lane = TIDX & 63, gw = BIDX * (NTHR / 64) + (TIDX >> 6), nw = gridDim.x * (NTHR / 64);
  const bool last = layer == 3;
  int t = gw;
  while (last && t < T && (t % SP) < CTX) t += nw;
  if (t >= T) return;
  int eid_lo = EID[(size_t)t * 128 + lane], eid_hi = EID[(size_t)t * 128 + 64 + lane];
  float gt_lo = GATE[(size_t)t * 128 + lane], gt_hi = GATE[(size_t)t * 128 + 64 + lane];
  uint4 xr0, xr1; { const bf16_t* hr = p.h + (size_t)t * D + lane * 16; xr0 = *(const uint4*)hr; xr1 = *(const uint4*)(hr + 8); }
  uint4 ra[16], rb[16];
#define GA_LOAD(buf, elo, ehi, g) do { const int ev_ = (g) < 4 ? (elo) : (ehi); const int l0_ = ((g) & 3) * 16; \
    _Pragma("unroll") for (int r = 0; r < 16; ++r) { const int e = __builtin_amdgcn_readlane(ev_, l0_ + r); buf[r] = UV[(size_t)e * 64 + lane]; } } while (0)
#define GA_COMPUTE(buf, g) do { float d[16]; \
    _Pragma("unroll") for (int r = 0; r < 16; ++r) { \
      f32x2 acc = x[0] * __builtin_amdgcn_cvt_scalef32_pk_f32_fp4(buf[r].x, 1.0f, 0); \
      acc += x[1] * __builtin_amdgcn_cvt_scalef32_pk_f32_fp4(buf[r].x, 1.0f, 1); acc += x[2] * __builtin_amdgcn_cvt_scalef32_pk_f32_fp4(buf[r].x, 1.0f, 2); acc += x[3] * __builtin_amdgcn_cvt_scalef32_pk_f32_fp4(buf[r].x, 1.0f, 3); \
      acc += x[4] * __builtin_amdgcn_cvt_scalef32_pk_f32_fp4(buf[r].y, 1.0f, 0); acc += x[5] * __builtin_amdgcn_cvt_scalef32_pk_f32_fp4(buf[r].y, 1.0f, 1); \
      acc += x[6] * __builtin_amdgcn_cvt_scalef32_pk_f32_fp4(buf[r].y, 1.0f, 2); acc += x[7] * __builtin_amdgcn_cvt_scalef32_pk_f32_fp4(buf[r].y, 1.0f, 3); \
      d[r] = acc.x + acc.y; } \
    _Pragma("unroll") for (int i = 0; i < 8; ++i) { const bool hi = lane & 32; const float send = hi ? d[i] : d[i + 8], keep = hi ? d[i + 8] : d[i]; d[i] = keep + __shfl_xor(send, 32); } \
    _Pragma("unroll") for (int i = 0; i < 4; ++i) { const bool hi = lane & 16; const float send = hi ? d[i] : d[i + 4], keep = hi ? d[i + 4] : d[i]; d[i] = keep + __shfl_xor(send, 16); } \
    _Pragma("unroll") for (int i = 0; i < 2; ++i) { const bool hi = lane & 8; const float send = hi ? d[i] : d[i + 2], keep = hi ? d[i + 2] : d[i]; d[i] = keep + __shfl_xor(send, 8); } \
    { const bool hi = lane & 4; const float send = hi ? d[0] : d[1], keep = hi ? d[1] : d[0]; d[0] = keep + __shfl_xor(send, 4); } \
    d[0] += __shfl_xor(d[0], 2); d[0] += __shfl_xor(d[0], 1); \
    const float gv_ = __shfl((g) < 4 ? gt_lo : gt_hi, ((g) & 3) * 16 + (lane >> 2)); \
    const float w = gv_ * gelu_tanh(d[0] * (1.0f / U8_SCALE));        \
    _Pragma("unroll") for (int r = 0; r < 16; ++r) { \
      const float wr = rdlane_f(w, r * 4); \
      f[0] += wr * __builtin_amdgcn_cvt_scalef32_pk_f32_fp4(buf[r].z, 1.0f, 0); f[1] += wr * __builtin_amdgcn_cvt_scalef32_pk_f32_fp4(buf[r].z, 1.0f, 1); \
      f[2] += wr * __builtin_amdgcn_cvt_scalef32_pk_f32_fp4(buf[r].z, 1.0f, 2); f[3] += wr * __builtin_amdgcn_cvt_scalef32_pk_f32_fp4(buf[r].z, 1.0f, 3); \
      f[4] += wr * __builtin_amdgcn_cvt_scalef32_pk_f32_fp4(buf[r].w, 1.0f, 0); f[5] += wr * __builtin_amdgcn_cvt_scalef32_pk_f32_fp4(buf[r].w, 1.0f, 1); \
      f[6] += wr * __builtin_amdgcn_cvt_scalef32_pk_f32_fp4(buf[r].w, 1.0f, 2); f[7] += wr * __builtin_amdgcn_cvt_scalef32_pk_f32_fp4(buf[r].w, 1.0f, 3); } } while (0)
  GA_LOAD(ra, eid_lo, eid_hi, 0);
  for (;;) {
    int tn = t + nw;
    while (last && tn < T && (tn % SP) < CTX) tn += nw;
    const bool more = tn < T;
    const size_t tnc = more ? (size_t)tn : (size_t)t;
    const int neid_lo = EID[tnc * 128 + lane], neid_hi = EID[tnc * 128 + 64 + lane];
    const float ngt_lo = GATE[tnc * 128 + lane], ngt_hi = GATE[tnc * 128 + 64 + lane];
    uint4 nx0, nx1; { const bf16_t* hr = p.h + tnc * D + lane * 16; nx0 = *(const uint4*)hr; nx1 = *(const uint4*)(hr + 8); }
    const int b = t / SP, s = t - b * SP;
    f32x2 x[8];
    { const unsigned hw[8] = {xr0.x, xr0.y, xr0.z, xr0.w, xr1.x, xr1.y, xr1.z, xr1.w};
#pragma unroll
      for (int i = 0; i < 8; ++i) { x[i].x = __uint_as_float(hw[i] << 16); x[i].y = __uint_as_float(hw[i] & 0xffff0000u); } }
    f32x2 f[8];
#pragma unroll
    for (int i = 0; i < 8; ++i) f[i] = (f32x2){0.f, 0.f};
#pragma unroll 1
    for (int g2 = 0; g2 < 4; ++g2) {
      GA_LOAD(rb, eid_lo, eid_hi, 2 * g2 + 1);
      GA_COMPUTE(ra, 2 * g2);
      if (g2 < 3) GA_LOAD(ra, eid_lo, eid_hi, 2 * g2 + 2); else if (more) GA_LOAD(ra, neid_lo, neid_hi, 0);
      GA_COMPUTE(rb, 2 * g2 + 1);
    }
    bf16_t* xr = xrow_ptr(p, t) + lane * 16;
    const float* ad = ada_ptr(p, layer, t);
    float xv[16];
    { const uint4 xa = *(const uint4*)xr, xb = *(const uint4*)(xr + 8); const unsigned xw[8] = {xa.x, xa.y, xa.z, xa.w, xb.x, xb.y, xb.z, xb.w};
#pragma unroll
      for (int j = 0; j < 4; ++j) { const float4 g2 = *(const float4*)(ad + 5120 + lane * 16 + j * 4);
        xv[j * 4] = __uint_as_float(xw[2 * j] << 16) + g2.x * f[2 * j].x * (1.0f / V8_SCALE); xv[j * 4 + 1] = __uint_as_float(xw[2 * j] & 0xffff0000u) + g2.y * f[2 * j].y * (1.0f / V8_SCALE);
        xv[j * 4 + 2] = __uint_as_float(xw[2 * j + 1] << 16) + g2.z * f[2 * j + 1].x * (1.0f / V8_SCALE); xv[j * 4 + 3] = __uint_as_float(xw[2 * j + 1] & 0xffff0000u) + g2.w * f[2 * j + 1].y * (1.0f / V8_SCALE); } }
    float ss = 0.f;
#pragma unroll
    for (int i = 0; i < 16; ++i) ss += xv[i] * xv[i];
    ss = wave_sum(ss); const float rstd = rsqrtf(ss * (1.0f / D) + 1e-6f);
    if (!last) {
      { unsigned xo[8];
#pragma unroll
        for (int j = 0; j < 8; ++j) xo[j] = (unsigned)f2bf(xv[2 * j]) | ((unsigned)f2bf(xv[2 * j + 1]) << 16);
        *(uint4*)xr = make_uint4(xo[0], xo[1], xo[2], xo[3]); *(uint4*)(xr + 8) = make_uint4(xo[4], xo[5], xo[6], xo[7]); }
      const float* ad2 = ada_ptr(p, layer + 1, t); const float* g = p.norm_g + ((layer + 1) * 2) * D;
      unsigned ow[8];
#pragma unroll
      for (int j = 0; j < 4; ++j) { const int c0 = lane * 16 + j * 4; const float4 gg = *(const float4*)(g + c0), s1 = *(const float4*)(ad2 + 1024 + c0), s2 = *(const float4*)(ad2 + c0);
        const float y0 = xv[j * 4] * rstd * gg.x * (1.f + s1.x) + s2.x, y1 = xv[j * 4 + 1] * rstd * gg.y * (1.f + s1.y) + s2.y;
        const float y2 = xv[j * 4 + 2] * rstd * gg.z * (1.f + s1.z) + s2.z, y3 = xv[j * 4 + 3] * rstd * gg.w * (1.f + s1.w) + s2.w;
        ow[j * 2] = (unsigned)f2bf(y0) | ((unsigned)f2bf(y1) << 16); ow[j * 2 + 1] = (unsigned)f2bf(y2) | ((unsigned)f2bf(y3) << 16); }
      bf16_t* hw = p.h + (size_t)t * D + lane * 16;
      *(uint4*)hw = make_uint4(ow[0], ow[1], ow[2], ow[3]); *(uint4*)(hw + 8) = make_uint4(ow[4], ow[5], ow[6], ow[7]);
    } else {
      float* orow = p.out + ((size_t)(b * SEQ + s - CTX)) * D + lane * 16;
#pragma unroll
      for (int j = 0; j < 4; ++j) { const float4 g = *(const float4*)(p.final_g + lane * 16 + j * 4);
        *(float4*)(orow + j * 4) = make_float4(xv[j * 4] * rstd * g.x, xv[j * 4 + 1] * rstd * g.y, xv[j * 4 + 2] * rstd * g.z, xv[j * 4 + 3] * rstd * g.w); }
    }
    if (!more) break;
    t = tn; eid_lo = neid_lo; eid_hi = neid_hi; gt_lo = ngt_lo; gt_hi = ngt_hi; xr0 = nx0; xr1 = nx1;
  }
#undef GA_LOAD
#undef GA_COMPUTE
}


template <int N> DEV void bitonic_sort_desc(float (&v)[N]) {
#pragma unroll
  for (int k = 2; k <= N; k <<= 1)
#pragma unroll
    for (int j = k >> 1; j > 0; j >>= 1)
#pragma unroll
      for (int i = 0; i < N; ++i) { const int l = i ^ j; if (l > i) { const float a = v[i], b = v[l], mx = fmaxf(a, b), mn = fminf(a, b); if ((i & k) == 0) { v[i] = mx; v[l] = mn; } else { v[i] = mn; v[l] = mx; } } }
}
DEV void bitonic_merge16_desc(float (&v)[16]) {
#pragma unroll
  for (int j = 8; j > 0; j >>= 1)
#pragma unroll
    for (int i = 0; i < 16; ++i) { const int l = i ^ j; if (l > i) { const float a = v[i], b = v[l]; v[i] = fmaxf(a, b); v[l] = fminf(a, b); } }
}
DEV void xlane_merge16(float (&v)[16], int mask) {
  float o[16];
#pragma unroll
  for (int i = 0; i < 16; ++i) o[i] = __shfl_xor(v[i], mask);
#pragma unroll
  for (int i = 0; i < 16; ++i) v[i] = fmaxf(v[i], o[15 - i]);
  bitonic_merge16_desc(v);
}
DEV void split_bf16x8(const float (&x)[8], bf16x8& hi, bf16x8& lo) {
  unsigned h[4], l[4];
#pragma unroll
  for (int i = 0; i < 4; ++i) { h[i] = cvt_pk_bf16(x[2 * i], x[2 * i + 1]);
    const float r0 = x[2 * i] - __uint_as_float(h[i] << 16), r1 = x[2 * i + 1] - __uint_as_float(h[i] & 0xffff0000u); l[i] = cvt_pk_bf16(r0, r1); }
  hi = __builtin_bit_cast(bf16x8, (u32x4){h[0], h[1], h[2], h[3]}); lo = __builtin_bit_cast(bf16x8, (u32x4){l[0], l[1], l[2], l[3]});
}
DEV unsigned sel4(int k, unsigned a, unsigned b, unsigned c, unsigned d) { return k == 0 ? a : (k == 1 ? b : (k == 2 ? c : d)); }
DEV float sel4f(int k, float a, float b, float c, float d) { return k == 0 ? a : (k == 1 ? b : (k == 2 ? c : d)); }

DEV void phase_peer_route(CP p, int layer, LAS char* shm) {
  const bf16_t* PQ = (const bf16_t*)(p.scratch + OFF_PQ); int* EID = (int*)(p.scratch + OFF_EID); float* GATE = (float*)(p.scratch + OFF_GATE);
  constexpr int KSTR = 144, KARR = 128 * KSTR;
  const int tid = TIDX, wid = tid >> 6, lane = tid & 63, ln = lane & 15, kgrp = lane >> 4;
  const bool seqonly = layer == 3;
  const int TPH = seqonly ? 256 : 288, NI = 8 * TPH;
  const int G = gridDim.x, per = (NI + G - 1) / G, it0 = BIDX * per, it1 = (it0 + per < NI) ? it0 + per : NI;
  int cur_h = -1;
  for (int item = it0; item < it1; ++item) {
    const int h = item / TPH, tl = item - h * TPH, tile = seqonly ? (tl >> 4) * 18 + 2 + (tl & 15) : tl;
    if (h != cur_h) {
      __syncthreads();
      const float* kp = p.peer_keys + ((size_t)(layer * 8 + h)) * 2 * 128 * 64;
      for (int idx = tid; idx < 2 * 128 * 8; idx += NTHR) {
        const int pc = idx & 7, key = (idx >> 3) & 127, hf = idx >> 10;
        const float4 a = *(const float4*)(kp + ((size_t)hf * 128 + key) * 64 + pc * 8), b = *(const float4*)(kp + ((size_t)hf * 128 + key) * 64 + pc * 8 + 4);
        const float x[8] = {a.x, a.y, a.z, a.w, b.x, b.y, b.z, b.w}; bf16x8 hi, lo; split_bf16x8(x, hi, lo);
        *(LAS bf16x8*)(shm + (hf * 2 + 0) * KARR + key * KSTR + pc * 16) = hi; *(LAS bf16x8*)(shm + (hf * 2 + 1) * KARR + key * KSTR + pc * 16) = lo;
      }
      __syncthreads();
      cur_h = h;
    }
    const int t = tile * 128 + wid * 16 + ln;
    float lst[2][16];
#pragma unroll
    for (int hf = 0; hf < 2; ++hf) {
      bf16x8 qh[2];
#pragma unroll
      for (int ks = 0; ks < 2; ++ks) qh[ks] = *(const bf16x8*)(PQ + (size_t)t * 1024 + h * 128 + hf * 64 + 32 * ks + 8 * kgrp);
      float v[32];
#pragma unroll
      for (int m = 0; m < 8; ++m) {
        f32x4 acc = (f32x4){0.f, 0.f, 0.f, 0.f};
#pragma unroll
        for (int ks = 0; ks < 2; ++ks) {
          const bf16x8 kh = ld_frag_lds(shm + (hf * 2 + 0) * KARR + (16 * m + ln) * KSTR + ks * 64 + kgrp * 16), kl = ld_frag_lds(shm + (hf * 2 + 1) * KARR + (16 * m + ln) * KSTR + ks * 64 + kgrp * 16);
          acc = __builtin_amdgcn_mfma_f32_16x16x32_bf16(kh, qh[ks], acc, 0, 0, 0);
          acc = __builtin_amdgcn_mfma_f32_16x16x32_bf16(kl, qh[ks], acc, 0, 0, 0);
        }
#pragma unroll
        for (int j = 0; j < 4; ++j) v[4 * m + j] = __uint_as_float((__float_as_uint(acc[j]) & ~127u) | (unsigned)(16 * m + 4 * kgrp + j));
      }
      float a16[16], b16[16];
#pragma unroll
      for (int i = 0; i < 16; ++i) { a16[i] = v[i]; b16[i] = v[16 + i]; }
      bitonic_sort_desc<16>(a16); bitonic_sort_desc<16>(b16);
#pragma unroll
      for (int i = 0; i < 16; ++i) a16[i] = fmaxf(a16[i], b16[15 - i]);
      bitonic_merge16_desc(a16);
      xlane_merge16(a16, 16); xlane_merge16(a16, 32);
#pragma unroll
      for (int i = 0; i < 16; ++i) lst[hf][i] = a16[i];
    }
    float av[16], bv[16]; unsigned A4[4], B4[4];
#pragma unroll
    for (int i = 0; i < 16; ++i) { av[i] = __uint_as_float(__float_as_uint(lst[0][i]) & ~127u); bv[i] = __uint_as_float(__float_as_uint(lst[1][i]) & ~127u); }
#pragma unroll
    for (int r = 0; r < 4; ++r) {
      A4[r] = (__float_as_uint(lst[0][4 * r]) & 127u) | ((__float_as_uint(lst[0][4 * r + 1]) & 127u) << 8) | ((__float_as_uint(lst[0][4 * r + 2]) & 127u) << 16) | ((__float_as_uint(lst[0][4 * r + 3]) & 127u) << 24);
      B4[r] = (__float_as_uint(lst[1][4 * r]) & 127u) | ((__float_as_uint(lst[1][4 * r + 1]) & 127u) << 8) | ((__float_as_uint(lst[1][4 * r + 2]) & 127u) << 16) | ((__float_as_uint(lst[1][4 * r + 3]) & 127u) << 24); }
    float cand[16];
    {
      constexpr int NP = 50;
      struct PairTab { int i0[52], i1[52]; };
      constexpr PairTab tab = [] { PairTab tb{}; int n = 0; for (int a = 0; a < 16; ++a) for (int b = 0; b < 16; ++b) if ((a + 1) * (b + 1) <= 16) { tb.i0[n] = a; tb.i1[n] = b; ++n; } for (; n < 52; ++n) { tb.i0[n] = -1; tb.i1[n] = -1; } return tb; }();
      static_assert(tab.i0[NP - 1] >= 0 && tab.i0[NP] < 0, "50 admissible pairs");
#pragma unroll
      for (int sl = 0; sl < 13; ++sl) {
        float c4[4];
#pragma unroll
        for (int kq = 0; kq < 4; ++kq) { const int n = 13 * kq + sl;
          if (tab.i0[n] >= 0) c4[kq] = __uint_as_float((__float_as_uint(av[tab.i0[n]] + bv[tab.i1[n]]) & ~255u) | (unsigned)(tab.i0[n] * 16 + tab.i1[n]));
          else c4[kq] = -3.0e38f; }
        cand[sl] = sel4f(kgrp, c4[0], c4[1], c4[2], c4[3]);
      }
      cand[13] = -3.0e38f; cand[14] = -3.0e38f; cand[15] = -3.0e38f;
    }
    bitonic_sort_desc<16>(cand);
    xlane_merge16(cand, 16); xlane_merge16(cand, 32);
    float gv[16]; int ev[16]; float gsum = 0.f;
    const float v0 = __uint_as_float(__float_as_uint(cand[0]) & ~255u);
#pragma unroll
    for (int j = 0; j < 16; ++j) {
      const unsigned bits = __float_as_uint(cand[j]); const int i0 = (bits >> 4) & 15, i1 = bits & 15;
      const unsigned ra = sel4(i0 >> 2, A4[0], A4[1], A4[2], A4[3]), rb = sel4(i1 >> 2, B4[0], B4[1], B4[2], B4[3]);
      const int k0 = (ra >> (8 * (i0 & 3))) & 127, k1 = (rb >> (8 * (i1 & 3))) & 127;
      ev[j] = k0 * 128 + k1;
      gv[j] = __expf(__uint_as_float(bits & ~255u) - v0); gsum += gv[j];
    }
    const float ginv = 1.f / gsum;
    int4 eo; float4 go;
    eo.x = (int)sel4(kgrp, ev[0], ev[4], ev[8], ev[12]); eo.y = (int)sel4(kgrp, ev[1], ev[5], ev[9], ev[13]); eo.z = (int)sel4(kgrp, ev[2], ev[6], ev[10], ev[14]); eo.w = (int)sel4(kgrp, ev[3], ev[7], ev[11], ev[15]);
    go.x = sel4f(kgrp, gv[0], gv[4], gv[8], gv[12]) * ginv; go.y = sel4f(kgrp, gv[1], gv[5], gv[9], gv[13]) * ginv; go.z = sel4f(kgrp, gv[2], gv[6], gv[10], gv[14]) * ginv; go.w = sel4f(kgrp, gv[3], gv[7], gv[11], gv[15]) * ginv;
    *(int4*)(EID + (size_t)t * 128 + h * 16 + 4 * kgrp) = eo;
    *(float4*)(GATE + (size_t)t * 128 + h * 16 + 4 * kgrp) = go;
  }
}

DEV int seq_of_tau(int tau, int d) { return d == 0 ? tau : (tau < CTX ? CTX - 1 - tau : 2 * CTX + SEQ - 1 - tau); }

DEV void phase_s5_scan(CP p, float* lds) {
  float* Y = (float*)(p.scratch + OFF_Y); bf16_t* GIN = (bf16_t*)(p.scratch + OFF_GIN);
  const int tid = TIDX, wid = tid >> 6, lane = tid & 63;
  float* ub = lds + wid * 2048;
  float* yb = ub + 1024;
  for (int item0 = BIDX * 8; item0 < 1024; item0 += gridDim.x * 8) {
    const int item = item0 + wid, b = item >> 6, g = item & 63;
    for (int d = 0; d < 2; ++d) {
      const int sidx = (d * 64 + g) * 64 + lane;
      const float ar = p.s5_ar[sidx], ai = p.s5_ai[sidx];
      float br[16], bi[16], cr[16], ci[16];
#pragma unroll
      for (int c = 0; c < 16; ++c) { br[c] = p.s5_br[sidx * 16 + c]; bi[c] = p.s5_bi[sidx * 16 + c];
        cr[c] = p.s5_c_re[((size_t)(d * 64 + g) * 16 + c) * 64 + lane]; ci[c] = p.s5_c_im[((size_t)(d * 64 + g) * 16 + c) * 64 + lane]; }
      float xr = 0.f, xi = 0.f;
      for (int k = 0; k < 36; ++k) {
        const int trow = b * SP + seq_of_tau(k * 64 + lane, d);
        __syncthreads();
        { const bf16_t* hp = p.h + (size_t)trow * D + g * 16;
          const uint4 w0 = *(const uint4*)hp, w1 = *(const uint4*)(hp + 8);
          const unsigned ww[8] = {w0.x, w0.y, w0.z, w0.w, w1.x, w1.y, w1.z, w1.w};
#pragma unroll
          for (int i = 0; i < 8; ++i) { ub[lane * 16 + 2 * i] = __uint_as_float(ww[i] << 16); ub[lane * 16 + 2 * i + 1] = __uint_as_float(ww[i] & 0xffff0000u); } }
        __syncthreads();
#pragma unroll 1
        for (int j = 0; j < 64; ++j) {
          float u[16];
#pragma unroll
          for (int c = 0; c < 16; c += 4) { const float4 t4 = *(const float4*)(ub + j * 16 + c); u[c] = t4.x; u[c + 1] = t4.y; u[c + 2] = t4.z; u[c + 3] = t4.w; }
          float bur = 0.f, bui = 0.f;
#pragma unroll
          for (int c = 0; c < 16; ++c) { bur += br[c] * u[c]; bui += bi[c] * u[c]; }
          const float nxr = ar * xr - ai * xi + bur, nxi = ar * xi + ai * xr + bui;
          xr = nxr; xi = nxi;
          float v[16];
#pragma unroll
          for (int c = 0; c < 16; ++c) v[c] = cr[c] * xr - ci[c] * xi;
#pragma unroll
          for (int i = 0; i < 8; ++i) { const bool hi = lane & 32; const float send = hi ? v[i] : v[i + 8], keep = hi ? v[i + 8] : v[i]; v[i] = keep + __shfl_xor(send, 32); }
#pragma unroll
          for (int i = 0; i < 4; ++i) { const bool hi = lane & 16; const float send = hi ? v[i] : v[i + 4], keep = hi ? v[i + 4] : v[i]; v[i] = keep + __shfl_xor(send, 16); }
#pragma unroll
          for (int i = 0; i < 2; ++i) { const bool hi = lane & 8; const float send = hi ? v[i] : v[i + 2], keep = hi ? v[i + 2] : v[i]; v[i] = keep + __shfl_xor(send, 8); }
          { const bool hi = lane & 4; const float send = hi ? v[0] : v[1], keep = hi ? v[1] : v[0]; v[0] = keep + __shfl_xor(send, 4); }
          v[0] += __shfl_xor(v[0], 2); v[0] += __shfl_xor(v[0], 1);
          if ((lane & 3) == 0) yb[j * 16 + (lane >> 2)] = v[0];
        }
        __syncthreads();
        if (d == 0) {
#pragma unroll
          for (int c = 0; c < 16; c += 4) *(float4*)(Y + (size_t)trow * D + g * 16 + c) = *(const float4*)(yb + lane * 16 + c);
        } else {
          unsigned ow[8];
#pragma unroll
          for (int c = 0; c < 16; c += 2) {
            const float y0 = Y[(size_t)trow * D + g * 16 + c] + yb[lane * 16 + c] + p.s5_d[g * 16 + c] * ub[lane * 16 + c];
            const float y1 = Y[(size_t)trow * D + g * 16 + c + 1] + yb[lane * 16 + c + 1] + p.s5_d[g * 16 + c + 1] * ub[lane * 16 + c + 1];
            ow[c >> 1] = (unsigned)f2bf(gelu_tanh(y0)) | ((unsigned)f2bf(gelu_tanh(y1)) << 16);
          }
          *(uint4*)(GIN + (size_t)trow * D + g * 16) = make_uint4(ow[0], ow[1], ow[2], ow[3]);
          *(uint4*)(GIN + (size_t)trow * D + g * 16 + 8) = make_uint4(ow[4], ow[5], ow[6], ow[7]);
        }
      }
    }
  }
}

DEV void phase_s5_out(CP p, int layer) {
  const bf16_t* Z = (const bf16_t*)(p.scratch + OFF_Z);
  const int lane = TIDX & 63, gw = BIDX * (NTHR / 64) + (TIDX >> 6), nw = gridDim.x * (NTHR / 64);
  for (int t = gw; t < T; t += nw) {
    bf16_t* xr = xrow_ptr(p, t); float xv[16]; load_row_bf(xr, lane, xv);
    const float* ad = ada_ptr(p, layer, t);
#pragma unroll
    for (int j = 0; j < 4; ++j) { const int c0 = j * 256 + lane * 4;
      const uint2 za = *(const uint2*)(Z + (size_t)t * 2048 + c0), zg = *(const uint2*)(Z + (size_t)t * 2048 + 1024 + c0);
      const float a[4] = {__uint_as_float(za.x << 16), __uint_as_float(za.x & 0xffff0000u), __uint_as_float(za.y << 16), __uint_as_float(za.y & 0xffff0000u)};
      const float gg[4] = {__uint_as_float(zg.x << 16), __uint_as_float(zg.x & 0xffff0000u), __uint_as_float(zg.y << 16), __uint_as_float(zg.y & 0xffff0000u)};
      const float4 g1 = *(const float4*)(ad + 2048 + c0); const float g1a[4] = {g1.x, g1.y, g1.z, g1.w};
#pragma unroll
      for (int e = 0; e < 4; ++e) xv[j * 4 + e] += g1a[e] * a[e] * sigm(gg[e]); }
    store_row_bf(xr, lane, xv);
    norm_mod_store(xv, p.norm_g + (layer * 2 + 1) * D, ad + 4096, ad + 3072, p.h + (size_t)t * D, lane);
  }
}


typedef unsigned short us16;
DEV void phase_s5_scan_mfma(CP p, LAS char* shm) {
  bf16_t* KT = (bf16_t*)(p.scratch + OFF_KT); bf16_t* W4 = (bf16_t*)(p.scratch + OFF_W4); bf16_t* XIN = (bf16_t*)(p.scratch + OFF_XIN);
  const int tid = TIDX, wid = tid >> 6, lane = tid & 63, n = lane & 15, kgrp = lane >> 4, par = kgrp >> 1, chalf = kgrp & 1;
  for (int unit = BIDX; unit < 256; unit += gridDim.x) {
    __syncthreads();
    if (unit < 128) {
      const int d = unit >> 6, g = unit & 63, ri = n >> 3, pp = n & 7, pidx = (d * 64 + g) * 64 + 8 * wid + pp;
      const float ar = p.s5_ar[pidx], ai = p.s5_ai[pidx];
      float brv[8], biv[8];
#pragma unroll
      for (int j = 0; j < 8; ++j) { brv[j] = p.s5_br[pidx * 16 + 8 * chalf + j]; biv[j] = p.s5_bi[pidx * 16 + 8 * chalf + j]; }
      const float a2r = ar * ar - ai * ai, a2i = 2.f * ar * ai;
      float pr = par ? 1.f : ar, pi = par ? 0.f : ai;
      bf16x8 bfrag[16];
#pragma unroll
      for (int ks = 15; ks >= 0; --ks) {
        unsigned o[4];
#pragma unroll
        for (int j = 0; j < 8; j += 2) {
          const float v0 = ri ? (pr * biv[j] + pi * brv[j]) : (pr * brv[j] - pi * biv[j]);
          const float v1 = ri ? (pr * biv[j + 1] + pi * brv[j + 1]) : (pr * brv[j + 1] - pi * biv[j + 1]);
          o[j >> 1] = cvt_pk_bf16(v0, v1);
        }
        bfrag[ks] = __builtin_bit_cast(bf16x8, (u32x4){o[0], o[1], o[2], o[3]});
        const float npr = pr * a2r - pi * a2i, npi = pr * a2i + pi * a2r; pr = npr; pi = npi;
      }
      float a32r = ar, a32i = ai;
#pragma unroll
      for (int q = 0; q < 5; ++q) { const float tr = a32r * a32r - a32i * a32i, ti = 2.f * a32r * a32i; a32r = tr; a32i = ti; }
      f32x4 xs = (f32x4){0.f, 0.f, 0.f, 0.f};
      const int sb = tid >> 5, ssig = tid & 31;
      const bf16_t* hb = p.h + (size_t)sb * SP * D + g * 16;
      uint4 r0, r1;
      { const bf16_t* hp = hb + (size_t)seq_of_tau(ssig, d) * D; r0 = *(const uint4*)hp; r1 = *(const uint4*)(hp + 8); }
      { LAS char* ub = shm + sb * 1040 + ssig * 32; *(LAS u32x4*)ub = (u32x4){r0.x, r0.y, r0.z, r0.w}; *(LAS u32x4*)(ub + 16) = (u32x4){r1.x, r1.y, r1.z, r1.w}; }
      __syncthreads();
      bf16_t* xin = XIN + (size_t)unit * 72 * 16 * 128;
      for (int k = 0; k < 72; ++k) {
        if (k + 1 < 72) { const bf16_t* hp = hb + (size_t)seq_of_tau((k + 1) * 32 + ssig, d) * D; r0 = *(const uint4*)hp; r1 = *(const uint4*)(hp + 8); }
#pragma unroll
        for (int j = 0; j < 4; ++j) xin[((size_t)k * 16 + 4 * kgrp + j) * 128 + 16 * wid + n] = f2bf(xs[j]);
        const LAS char* ub = shm + (k & 1) * 16640 + n * 1040 + kgrp * 16;
        f32x4 acc = (f32x4){0.f, 0.f, 0.f, 0.f};
#pragma unroll
        for (int ks = 0; ks < 16; ++ks) acc = __builtin_amdgcn_mfma_f32_16x16x32_bf16(ld_frag_lds(ub + ks * 64), bfrag[ks], acc, 0, 0, 0);
#pragma unroll
        for (int j = 0; j < 4; ++j) { const float other = __shfl_xor(xs[j], 8);
          xs[j] = (ri ? (a32r * xs[j] + a32i * other) : (a32r * xs[j] - a32i * other)) + acc[j]; }
        if (k + 1 < 72) { LAS char* uw = shm + ((k + 1) & 1) * 16640 + sb * 1040 + ssig * 32; *(LAS u32x4*)uw = (u32x4){r0.x, r0.y, r0.z, r0.w}; *(LAS u32x4*)(uw + 16) = (u32x4){r1.x, r1.y, r1.z, r1.w}; }
        __syncthreads();
      }
    } else {
      const int u2 = unit - 128, d = u2 >> 6, g = u2 & 63;
      float* pw = (float*)shm;
      float* Bb = pw + 64 * 66;
      float* Ct = Bb + 64 * 32;
      if (tid < 64) { const int pidx = (d * 64 + g) * 64 + tid; const float ar = p.s5_ar[pidx], ai = p.s5_ai[pidx]; float pr = 1.f, pi = 0.f; asm volatile("" : "+v"(pr), "+v"(pi));
        for (int e = 0; e < 33; ++e) { pw[(tid * 33 + e) * 2] = pr; pw[(tid * 33 + e) * 2 + 1] = pi; const float nr = pr * ar - pi * ai, ni = pr * ai + pi * ar; pr = nr; pi = ni; } }
      for (int idx = tid; idx < 1024; idx += NTHR) { const int pp = idx >> 4, c = idx & 15; const int pidx = (d * 64 + g) * 64 + pp;
        Bb[idx * 2] = p.s5_br[pidx * 16 + c]; Bb[idx * 2 + 1] = p.s5_bi[pidx * 16 + c];
        Ct[idx * 2] = p.s5_c_re[((size_t)(d * 64 + g) * 16 + c) * 64 + pp]; Ct[idx * 2 + 1] = p.s5_c_im[((size_t)(d * 64 + g) * 16 + c) * 64 + pp]; }
      __syncthreads();
      { const int dl = tid >> 4, cc = tid & 15;
        float acc[16];
#pragma unroll
        for (int c = 0; c < 16; ++c) acc[c] = 0.f;
        for (int pp = 0; pp < 64; ++pp) {
          const float pr = pw[(pp * 33 + dl) * 2], pi = pw[(pp * 33 + dl) * 2 + 1], cr = Ct[(pp * 16 + cc) * 2], ci = Ct[(pp * 16 + cc) * 2 + 1];
          const float gr = cr * pr - ci * pi, gi = cr * pi + ci * pr;
#pragma unroll
          for (int c = 0; c < 16; ++c) acc[c] += gr * Bb[(pp * 16 + c) * 2] - gi * Bb[(pp * 16 + c) * 2 + 1];
        }
        bf16_t* kt = KT + ((size_t)u2 * 33 + 1 + dl) * 256 + cc * 16;
        unsigned o[8];
#pragma unroll
        for (int c = 0; c < 16; c += 2) o[c >> 1] = cvt_pk_bf16(acc[c], acc[c + 1]);
        *(uint4*)kt = make_uint4(o[0], o[1], o[2], o[3]); *(uint4*)(kt + 8) = make_uint4(o[4], o[5], o[6], o[7]);
        if (tid < 128) *(unsigned*)(KT + (size_t)u2 * 33 * 256 + tid * 2) = 0u;
      }
      for (int idx = tid; idx < 65536; idx += NTHR) {
        const int j = idx & 7, cc = (idx >> 3) & 15, kg2 = (idx >> 7) & 3, ks = (idx >> 9) & 3, tau = idx >> 11;
        const int kidx = 32 * ks + 8 * kg2 + j, wv = kidx >> 4, nn = kidx & 15, ri = nn >> 3, pp = 8 * wv + (nn & 7);
        const float pr = pw[(pp * 33 + tau + 1) * 2], pi = pw[(pp * 33 + tau + 1) * 2 + 1], cr = Ct[(pp * 16 + cc) * 2], ci = Ct[(pp * 16 + cc) * 2 + 1];
        W4[(size_t)u2 * 65536 + idx] = f2bf(ri ? -(cr * pi + ci * pr) : (cr * pr - ci * pi));
      }
    }
  }
}

DEV void phase_s5_out_mfma(CP p, LAS char* shm) {
  const bf16_t* KT = (const bf16_t*)(p.scratch + OFF_KT); const bf16_t* W4 = (const bf16_t*)(p.scratch + OFF_W4); const bf16_t* XIN = (const bf16_t*)(p.scratch + OFF_XIN);
  bf16_t* GIN = (bf16_t*)(p.scratch + OFF_GIN);
  const int tid = TIDX, wid = tid >> 6, lane = tid & 63, cc = lane & 15, kgrp = lane >> 4, par = kgrp >> 1, chalf = kgrp & 1;
  constexpr int KT0_OFF = 0, KT1_OFF = 17408, U_OFF = 34816, XSTR = 272, X0_OFF = U_OFF + 2 * 16640, X1_OFF = X0_OFF + 2 * 16 * XSTR;
  for (int unit = BIDX; unit < 256; unit += gridDim.x) {
    const int g = unit >> 2, q = unit & 3, u0 = g, u1 = 64 + g;
    __syncthreads();
    for (int idx = tid; idx < 33 * 32; idx += NTHR) { *(LAS u32x4*)(shm + KT0_OFF + idx * 16) = *(const u32x4*)(KT + (size_t)u0 * 33 * 256 + idx * 8);
      *(LAS u32x4*)(shm + KT1_OFF + idx * 16) = *(const u32x4*)(KT + (size_t)u1 * 33 * 256 + idx * 8); }
    bf16x8 w4a[4][4];
#pragma unroll
    for (int i = 0; i < 4; ++i)
#pragma unroll
      for (int ks = 0; ks < 4; ++ks) w4a[i][ks] = *(const bf16x8*)(W4 + ((((size_t)u0 * 32 + (wid + 8 * i)) * 4 + ks) * 4 + kgrp) * 128 + cc * 8);
    const float dsk = p.s5_d[g * 16 + cc];
    const int sb = tid >> 5, ssig = tid & 31, xrow = (tid & 255) >> 4, xpc = tid & 15;
    const bf16_t* hb = p.h + (size_t)sb * SP * D + g * 16;
    const bf16_t* xin0 = XIN + (size_t)u0 * 72 * 16 * 128; const bf16_t* xin1 = XIN + (size_t)u1 * 72 * 16 * 128;
    uint4 r0, r1, rx;
#define S5_K1(c_) ((c_) < 8 ? 7 - (c_) : 79 - (c_))
#define S5_LOAD(c_) do { const bf16_t* hp = hb + (size_t)((c_) * 32 + ssig) * D; r0 = *(const uint4*)hp; r1 = *(const uint4*)(hp + 8); \
      rx = tid < 256 ? *(const uint4*)(xin0 + ((size_t)(c_) * 16 + xrow) * 128 + xpc * 8) : *(const uint4*)(xin1 + ((size_t)S5_K1(c_) * 16 + xrow) * 128 + xpc * 8); } while (0)
#define S5_WRITE(buf_) do { LAS char* uw = shm + U_OFF + (buf_) * 16640 + sb * 1040 + ssig * 32; *(LAS u32x4*)uw = (u32x4){r0.x, r0.y, r0.z, r0.w}; *(LAS u32x4*)(uw + 16) = (u32x4){r1.x, r1.y, r1.z, r1.w}; \
      *(LAS u32x4*)(shm + (tid < 256 ? X0_OFF : X1_OFF) + (buf_) * (16 * XSTR) + xrow * XSTR + xpc * 16) = (u32x4){rx.x, rx.y, rx.z, rx.w}; } while (0)
    S5_LOAD(18 * q); S5_WRITE(0);
    __syncthreads();
    for (int ci = 0; ci < 18; ++ci) {
      const int c = 18 * q + ci, buf = ci & 1;
      if (ci + 1 < 18) S5_LOAD(c + 1);
      bf16x8 w4b[4][4];
      int zz = 0; asm volatile("" : "+s"(zz));
#pragma unroll
      for (int i = 0; i < 4; ++i)
#pragma unroll
        for (int ks = 0; ks < 4; ++ks) w4b[i][ks] = *(const bf16x8*)(W4 + zz + ((((size_t)u1 * 32 + (31 - wid - 8 * i)) * 4 + ks) * 4 + kgrp) * 128 + cc * 8);
      const LAS char* ub = shm + U_OFF + buf * 16640 + cc * 1040;
      const LAS char* x0b = shm + X0_OFF + buf * (16 * XSTR) + cc * XSTR + kgrp * 16;
      const LAS char* x1b = shm + X1_OFF + buf * (16 * XSTR) + cc * XSTR + kgrp * 16;
      f32x4 acc0[4], acc1[4];
#pragma unroll
      for (int i = 0; i < 4; ++i) { acc0[i] = (f32x4){0.f, 0.f, 0.f, 0.f}; acc1[i] = (f32x4){0.f, 0.f, 0.f, 0.f}; }
#pragma unroll
      for (int ks = 0; ks < 4; ++ks) { const bf16x8 ax0 = ld_frag_lds(x0b + ks * 64), ax1 = ld_frag_lds(x1b + ks * 64);
#pragma unroll
        for (int i = 0; i < 4; ++i) { acc0[i] = __builtin_amdgcn_mfma_f32_16x16x32_bf16(ax0, w4a[i][ks], acc0[i], 0, 0, 0); acc1[i] = __builtin_amdgcn_mfma_f32_16x16x32_bf16(ax1, w4b[i][ks], acc1[i], 0, 0, 0); } }
      asm volatile("" ::: "memory");
      { const LAS char* ua = ub + kgrp * 16;
        const LAS char* kb = shm + KT0_OFF + (wid - par + 1) * 512 + cc * 32 + chalf * 16;
#pragma unroll 2
        for (int ks = 0; ks < 16; ++ks) { const bf16x8 au = ld_frag_lds(ua + ks * 64);
#pragma unroll
          for (int i = 0; i < 4; ++i) if (2 * ks <= wid + 8 * i) acc0[i] = __builtin_amdgcn_mfma_f32_16x16x32_bf16(au, ld_frag_lds(kb + (8 * i - 2 * ks) * 512), acc0[i], 0, 0, 0); } }
      { const LAS char* ua = ub + (31 - par) * 32 + chalf * 16;
        const LAS char* kb = shm + KT1_OFF + (31 - wid - par + 1) * 512 + cc * 32 + chalf * 16;
#pragma unroll 2
        for (int ks = 0; ks < 16; ++ks) { const bf16x8 au = ld_frag_lds(ua - ks * 64);
#pragma unroll
          for (int i = 0; i < 4; ++i) if (2 * ks <= 31 - wid - 8 * i) acc1[i] = __builtin_amdgcn_mfma_f32_16x16x32_bf16(au, ld_frag_lds(kb - (8 * i + 2 * ks) * 512), acc1[i], 0, 0, 0); } }
#pragma unroll
      for (int i = 0; i < 4; ++i) {
        const int slot = wid + 8 * i, sq = c * 32 + slot;
#pragma unroll
        for (int j = 0; j < 4; ++j) {
          const float uval = bf2f(*(const LAS us16*)(ub + (4 * kgrp + j - cc) * 1040 + slot * 32 + cc * 2));
          GIN[((size_t)(4 * kgrp + j) * SP + sq) * D + g * 16 + cc] = f2bf(gelu_tanh(acc0[i][j] + acc1[i][j] + dsk * uval));
        }
      }
      if (ci + 1 < 18) S5_WRITE((ci + 1) & 1);
      __syncthreads();
    }
#undef S5_K1
#undef S5_LOAD
#undef S5_WRITE
  }
}

DEV void phase_gla_scan(CP p, float* lds) {
  const bf16_t* QKVG = (const bf16_t*)(p.scratch + OFF_QKVG); const bf16_t* LG = (const bf16_t*)(p.scratch + OFF_LG); bf16_t* OD = (bf16_t*)(p.scratch + OFF_OD);
  float* qs = lds; float* ks = lds + 16 * 128; float* es = lds + 32 * 128; float* vs = lds + 48 * 128; float* op = vs + 16 * 256;
  const int tid = TIDX, col = tid & 255, kh = tid >> 8;
  for (int item = BIDX; item < 128; item += gridDim.x) {
    const int b = item >> 3, hd = (item >> 1) & 3, d = item & 1;
    float S[64];
#pragma unroll
    for (int i = 0; i < 64; ++i) S[i] = 0.f;
    for (int st = 0; st < SP / 16; ++st) {
      __syncthreads();
      for (int idx = tid; idx < 16 * 128; idx += NTHR) { const int j = idx >> 7, k = idx & 127; const size_t trow = (size_t)b * SP + seq_of_tau(st * 16 + j, d);
        qs[idx] = bf2f(QKVG[trow * 3072 + hd * 128 + k]); ks[idx] = bf2f(QKVG[trow * 3072 + 512 + hd * 128 + k]); es[idx] = __expf(bf2f(LG[((size_t)d * T + trow) * 512 + hd * 128 + k])); }
      for (int idx = tid; idx < 16 * 256; idx += NTHR) { const int j = idx >> 8, c = idx & 255; const size_t trow = (size_t)b * SP + seq_of_tau(st * 16 + j, d);
        vs[idx] = bf2f(QKVG[trow * 3072 + 1024 + hd * 256 + c]); }
      __syncthreads();
#pragma unroll 1
      for (int j = 0; j < 16; ++j) {
        const float vv = vs[j * 256 + col]; float acc = 0.f;
#pragma unroll
        for (int kk = 0; kk < 64; kk += 4) {
          const float4 e4 = *(const float4*)(es + j * 128 + kh * 64 + kk), k4 = *(const float4*)(ks + j * 128 + kh * 64 + kk), q4 = *(const float4*)(qs + j * 128 + kh * 64 + kk);
          S[kk] = e4.x * S[kk] + k4.x * vv; acc += q4.x * S[kk];
          S[kk + 1] = e4.y * S[kk + 1] + k4.y * vv; acc += q4.y * S[kk + 1];
          S[kk + 2] = e4.z * S[kk + 2] + k4.z * vv; acc += q4.z * S[kk + 2];
          S[kk + 3] = e4.w * S[kk + 3] + k4.w * vv; acc += q4.w * S[kk + 3];
        }
        op[kh * 16 * 256 + j * 256 + col] = acc;
      }
      __syncthreads();
      for (int idx = tid; idx < 16 * 256; idx += NTHR) { const int j = idx >> 8, c = idx & 255; const size_t trow = (size_t)b * SP + seq_of_tau(st * 16 + j, d);
        OD[((size_t)d * T + trow) * D + hd * 256 + c] = f2bf(op[idx] + op[16 * 256 + idx]); }
    }
  }
}


DEV bf16x8 ld_frag2x64(const LAS char* p) { const u32x2 a = *(const LAS u32x2*)p, b = *(const LAS u32x2*)(p + 8); return __builtin_bit_cast(bf16x8, (u32x4){a.x, a.y, b.x, b.y}); }
DEV void phase_gla_scan_mfma(CP p, LAS char* shm) {
  const bf16_t* QKVG = (const bf16_t*)(p.scratch + OFF_QKVG); const bf16_t* LG = (const bf16_t*)(p.scratch + OFF_LG); const bf16_t* VTG = (const bf16_t*)(p.scratch + OFF_VTG);
  bf16_t* OD = (bf16_t*)(p.scratch + OFF_OD);
  constexpr int QG_O = 0, KG_O = 17408, KDT_O = 34816, VT_O = 52224, ATT_O = 69632, ST_O = 78336, GS_O = 113152, EB_O = 115200;
  const int tid = TIDX, wid = tid >> 6, lane = tid & 63, ln = lane & 15, kgrp = lane >> 4;
  const int kcol = tid & 127, grp = tid >> 7;
  for (int unit = BIDX; unit < 256; unit += gridDim.x) {
    const int b = unit >> 4, head = (unit >> 2) & 3, d = (unit >> 1) & 1, dvh = unit & 1;
    __syncthreads();
    for (int idx = tid; idx < 34816 / 16; idx += NTHR) *(LAS u32x4*)(shm + ST_O + idx * 16) = (u32x4){0u, 0u, 0u, 0u};
    f32x4 accS[8];
#pragma unroll
    for (int i = 0; i < 8; ++i) accS[i] = (f32x4){0.f, 0.f, 0.f, 0.f};
    const bf16_t* vtg = VTG + ((size_t)(b * 4 + head) * 256 + dvh * 128 + (tid >> 2)) * SP + (tid & 3) * 16;
    for (int ci = 0; ci < 36; ++ci) {
      const int c = d == 0 ? ci : (ci < 4 ? 3 - ci : 39 - ci);
      const size_t t0 = (size_t)b * SP + c * 64;
      { float lgv[16], qv[16], kv[16];
#pragma unroll
        for (int j = 0; j < 16; ++j) { const size_t t = t0 + grp * 16 + j;
          lgv[j] = bf2f(LG[((size_t)d * T + t) * 512 + head * 128 + kcol]); qv[j] = bf2f(QKVG[t * 3072 + head * 128 + kcol]); kv[j] = bf2f(QKVG[t * 3072 + 512 + head * 128 + kcol]); }
        const uint4 v0 = *(const uint4*)(vtg + c * 64), v1 = *(const uint4*)(vtg + c * 64 + 8);
        float run = 0.f;
        if (d == 0) {
#pragma unroll
          for (int j = 0; j < 16; ++j) { run += lgv[j]; lgv[j] = run; }
        } else {
#pragma unroll
          for (int j = 15; j >= 0; --j) { run += lgv[j]; lgv[j] = run; }
        }
        float* GS = (float*)0; (void)GS;
        *(LAS float*)(shm + GS_O + (grp * 128 + kcol) * 4) = run;
        { LAS char* vw = shm + VT_O + (tid >> 2) * 136 + (tid & 3) * 32;
          *(LAS u32x2*)vw = (u32x2){v0.x, v0.y}; *(LAS u32x2*)(vw + 8) = (u32x2){v0.z, v0.w}; *(LAS u32x2*)(vw + 16) = (u32x2){v1.x, v1.y}; *(LAS u32x2*)(vw + 24) = (u32x2){v1.z, v1.w}; }
        __syncthreads();
        float g0 = *(const LAS float*)(shm + GS_O + (0 * 128 + kcol) * 4), g1 = *(const LAS float*)(shm + GS_O + (1 * 128 + kcol) * 4);
        float g2 = *(const LAS float*)(shm + GS_O + (2 * 128 + kcol) * 4), g3 = *(const LAS float*)(shm + GS_O + (3 * 128 + kcol) * 4);
        const float blast = (g0 + g1) + (g2 + g3);
        float off;
        if (d == 0) off = (grp > 0 ? g0 : 0.f) + (grp > 1 ? g1 : 0.f) + (grp > 2 ? g2 : 0.f);
        else off = (grp < 3 ? g3 : 0.f) + (grp < 2 ? g2 : 0.f) + (grp < 1 ? g1 : 0.f);
        unsigned kd[8];
#pragma unroll
        for (int j = 0; j < 16; j += 2) {
          const float bc0 = off + lgv[j], bc1 = off + lgv[j + 1];
          const float e0 = __expf(bc0), e1 = __expf(bc1);
          *(LAS us16*)(shm + QG_O + (grp * 16 + j) * 272 + kcol * 2) = f2bf(qv[j] * e0);
          *(LAS us16*)(shm + QG_O + (grp * 16 + j + 1) * 272 + kcol * 2) = f2bf(qv[j + 1] * e1);
          *(LAS us16*)(shm + KG_O + (grp * 16 + j) * 272 + kcol * 2) = f2bf(kv[j] * __expf(-bc0));
          *(LAS us16*)(shm + KG_O + (grp * 16 + j + 1) * 272 + kcol * 2) = f2bf(kv[j + 1] * __expf(-bc1));
          kd[j >> 1] = cvt_pk_bf16(kv[j] * __expf(blast - bc0), kv[j + 1] * __expf(blast - bc1));
        }
        { LAS char* kw = shm + KDT_O + kcol * 136 + grp * 32;
          *(LAS u32x2*)kw = (u32x2){kd[0], kd[1]}; *(LAS u32x2*)(kw + 8) = (u32x2){kd[2], kd[3]}; *(LAS u32x2*)(kw + 16) = (u32x2){kd[4], kd[5]}; *(LAS u32x2*)(kw + 24) = (u32x2){kd[6], kd[7]}; }
        if (grp == 0) *(LAS float*)(shm + EB_O + kcol * 4) = __expf(blast);
      }
      __syncthreads();
      { const int it = wid >> 1;
#pragma unroll
        for (int jj = 0; jj < 2; ++jj) {
          const int jt = 2 * (wid & 1) + jj;
          f32x4 a = (f32x4){0.f, 0.f, 0.f, 0.f};
          const bool dead = d == 0 ? (jt > it) : (jt < it);
          if (!dead) {
#pragma unroll
            for (int ks = 0; ks < 4; ++ks) a = __builtin_amdgcn_mfma_f32_16x16x32_bf16(ld_frag_lds(shm + QG_O + (16 * it + ln) * 272 + ks * 64 + kgrp * 16), ld_frag_lds(shm + KG_O + (16 * jt + ln) * 272 + ks * 64 + kgrp * 16), a, 0, 0, 0);
          }
          const int jc = 16 * jt + ln;
#pragma unroll
          for (int r = 0; r < 4; ++r) { const int ir = 16 * it + 4 * kgrp + r; const bool keep = d == 0 ? (jc <= ir) : (jc >= ir);
            *(LAS us16*)(shm + ATT_O + ir * 136 + jc * 2) = f2bf(keep ? a[r] : 0.f); }
        } }
      __syncthreads();
      { bf16x8 vtf[2], stf[4];
#pragma unroll
        for (int ks = 0; ks < 2; ++ks) vtf[ks] = ld_frag2x64(shm + VT_O + (16 * wid + ln) * 136 + ks * 64 + kgrp * 16);
#pragma unroll
        for (int ks = 0; ks < 4; ++ks) stf[ks] = ld_frag_lds(shm + ST_O + (16 * wid + ln) * 272 + ks * 64 + kgrp * 16);
#pragma unroll
        for (int it = 0; it < 4; ++it) {
          f32x4 o = (f32x4){0.f, 0.f, 0.f, 0.f};
#pragma unroll
          for (int ks = 0; ks < 2; ++ks) o = __builtin_amdgcn_mfma_f32_16x16x32_bf16(ld_frag2x64(shm + ATT_O + (16 * it + ln) * 136 + ks * 64 + kgrp * 16), vtf[ks], o, 0, 0, 0);
#pragma unroll
          for (int ks = 0; ks < 4; ++ks) o = __builtin_amdgcn_mfma_f32_16x16x32_bf16(ld_frag_lds(shm + QG_O + (16 * it + ln) * 272 + ks * 64 + kgrp * 16), stf[ks], o, 0, 0, 0);
#pragma unroll
          for (int r = 0; r < 4; ++r) OD[((size_t)d * T + t0 + 16 * it + 4 * kgrp + r) * D + head * 256 + dvh * 128 + 16 * wid + ln] = f2bf(o[r]);
        }
#pragma unroll
        for (int dkt = 0; dkt < 8; ++dkt) {
          const float eb = *(const LAS float*)(shm + EB_O + (16 * dkt + ln) * 4);
          f32x4 a = accS[dkt] * eb;
#pragma unroll
          for (int ks = 0; ks < 2; ++ks) a = __builtin_amdgcn_mfma_f32_16x16x32_bf16(vtf[ks], ld_frag2x64(shm + KDT_O + (16 * dkt + ln) * 136 + ks * 64 + kgrp * 16), a, 0, 0, 0);
          accS[dkt] = a;
        }
      }
      __syncthreads();
#pragma unroll
      for (int dkt = 0; dkt < 8; ++dkt)
#pragma unroll
        for (int r = 0; r < 4; ++r) *(LAS us16*)(shm + ST_O + (16 * wid + 4 * kgrp + r) * 272 + (16 * dkt + ln) * 2) = f2bf(accS[dkt][r]);
      __syncthreads();
    }
  }
}

DEV void phase_gla_out(CP p) {
  const bf16_t* QKVG = (const bf16_t*)(p.scratch + OFF_QKVG); const bf16_t* OD = (const bf16_t*)(p.scratch + OFF_OD); bf16_t* GO = (bf16_t*)(p.scratch + OFF_GO);
  const int lane = TIDX & 63, gw = BIDX * (NTHR / 64) + (TIDX >> 6), nw = gridDim.x * (NTHR / 64);
  const float4 on = *(const float4*)(p.gla_o_norm + lane * 4); const float ona[4] = {on.x, on.y, on.z, on.w};
  for (int t0 = gw; t0 < T; t0 += 2 * nw) {
    uint2 a[2][4], bq[2][4], gg[2][4];
#pragma unroll
    for (int u = 0; u < 2; ++u) { const int t = t0 + u * nw; if (t < T) {
#pragma unroll
      for (int hd = 0; hd < 4; ++hd) { const int c0 = hd * 256 + lane * 4;
        a[u][hd] = *(const uint2*)(OD + (size_t)t * D + c0); bq[u][hd] = *(const uint2*)(OD + ((size_t)T + t) * D + c0); gg[u][hd] = *(const uint2*)(QKVG + (size_t)t * 3072 + 2048 + c0); } } }
#pragma unroll
    for (int u = 0; u < 2; ++u) { const int t = t0 + u * nw; if (t < T) {
#pragma unroll
      for (int hd = 0; hd < 4; ++hd) {
        const int c0 = hd * 256 + lane * 4;
        const uint2 av = a[u][hd], bv = bq[u][hd], gv2 = gg[u][hd];
        float o[4] = {__uint_as_float(av.x << 16) + __uint_as_float(bv.x << 16), __uint_as_float(av.x & 0xffff0000u) + __uint_as_float(bv.x & 0xffff0000u),
                      __uint_as_float(av.y << 16) + __uint_as_float(bv.y << 16), __uint_as_float(av.y & 0xffff0000u) + __uint_as_float(bv.y & 0xffff0000u)};
        const float gv[4] = {__uint_as_float(gv2.x << 16), __uint_as_float(gv2.x & 0xffff0000u), __uint_as_float(gv2.y << 16), __uint_as_float(gv2.y & 0xffff0000u)};
        float ss = o[0] * o[0] + o[1] * o[1] + o[2] * o[2] + o[3] * o[3];
        ss = wave_sum(ss); const float rstd = rsqrtf(ss * (1.0f / 256.0f) + 1e-6f);
        unsigned w[2];
#pragma unroll
        for (int e = 0; e < 4; e += 2) w[e >> 1] = (unsigned)f2bf(o[e] * rstd * ona[e] * silu(gv[e])) | ((unsigned)f2bf(o[e + 1] * rstd * ona[e + 1] * silu(gv[e + 1])) << 16);
        *(uint2*)(GO + (size_t)t * D + c0) = make_uint2(w[0], w[1]);
      }
    } }
  }
}


#define XB_TMO      128
#define XB_XCNT(j)  (256  + 64 * (j))
#define XB_XSUB(j)  (1280 + 64 * (j))
#define XB_XGEN(j)  (2304 + 64 * (j))
#define XB_TOP      3328
#define XB_TOPGEN   3392
#define XCD_BAR_WORDS 3456
#define XB_SPIN_CAP (1u << 22)
DEV unsigned xb_ld(unsigned* p)              { return __hip_atomic_load(p, __ATOMIC_RELAXED, __HIP_MEMORY_SCOPE_AGENT); }
DEV unsigned xb_add(unsigned* p, unsigned v) { return __hip_atomic_fetch_add(p, v, __ATOMIC_RELAXED, __HIP_MEMORY_SCOPE_AGENT); }
DEV unsigned xb_xcc_id() { return (unsigned)__builtin_amdgcn_s_getreg((3 << 11) | 20) & 0xFu; }
#define XB_SPIN(cond, bar) do { unsigned _sp = 0; while (cond) { __builtin_amdgcn_s_sleep(1); \
    if ((++_sp & 255u) == 0u) { if (xb_ld(&(bar)[XB_TMO])) break; if (_sp > XB_SPIN_CAP) { atomicAdd(&(bar)[XB_TMO], 1u); break; } } } } while (0)
struct XcdBarrier { unsigned* bar; unsigned x; volatile LAS unsigned* st; };
DEV XcdBarrier xcd_barrier_post(unsigned* bar, volatile LAS unsigned* st) {
  XcdBarrier b; b.bar = bar; b.x = xb_xcc_id(); b.st = st;
  if (threadIdx.x == 0) (void)xb_add(&bar[XB_XCNT(b.x)], 1u);
  return b;
}
DEV void xcd_barrier_complete(unsigned* bar, unsigned x, unsigned& nloc, unsigned& nx) {
  const unsigned G = gridDim.x * gridDim.y * gridDim.z;
  unsigned sum, cnt, mine, sp = 0u;
  for (;;) {
    sum = 0u; cnt = 0u; mine = 0u;
#pragma unroll
    for (unsigned j = 0; j < 16; ++j) { const unsigned c = xb_ld(&bar[XB_XCNT(j)]); sum += c; cnt += (c > 0u) ? 1u : 0u; mine = (j == x) ? c : mine; }
    if (sum == G) break;
    __builtin_amdgcn_s_sleep(1);
    if ((++sp & 255u) == 0u) { if (xb_ld(&bar[XB_TMO])) break; if (sp > XB_SPIN_CAP) { atomicAdd(&bar[XB_TMO], 1u); break; } }
  }
  nloc = mine > 0u ? mine : 1u; nx = cnt > 0u ? cnt : 1u;
}
DEV void xcd_barrier(const XcdBarrier& b) {
  asm volatile("s_waitcnt vmcnt(0)" ::: "memory");
  __syncthreads();
  if (threadIdx.x == 0) {
    unsigned* bar = b.bar; asm volatile("" : "+s"(bar)); unsigned bx = b.x; asm volatile("" : "+s"(bx));
    __builtin_amdgcn_s_waitcnt(0);
    unsigned nloc = b.st[0], nx = b.st[1];
    if (nloc == 0u) { xcd_barrier_complete(bar, bx, nloc, nx); b.st[0] = nloc; b.st[1] = nx; }
    const unsigned old = xb_add(&bar[XB_XSUB(bx)], 1u);
    const unsigned gen = old / nloc;
    if (old + 1u == (gen + 1u) * nloc) {
      __builtin_amdgcn_fence(__ATOMIC_RELEASE, "agent");
      asm volatile("s_waitcnt vmcnt(0)" ::: "memory");
      const unsigned og = xb_add(&bar[XB_TOP], 1u);
      const unsigned tg = og / nx;
      if (og + 1u == (tg + 1u) * nx) xb_add(&bar[XB_TOPGEN], 1u);
      else XB_SPIN(xb_ld(&bar[XB_TOPGEN]) == tg, bar);
      __builtin_amdgcn_fence(__ATOMIC_ACQUIRE, "agent");
      xb_add(&bar[XB_XGEN(bx)], 1u);
      asm volatile("s_waitcnt vmcnt(0)" ::: "memory");
    } else {
      XB_SPIN(xb_ld(&bar[XB_XGEN(bx)]) == gen, bar);
      __builtin_amdgcn_fence(__ATOMIC_ACQUIRE, "agent");
      asm volatile("s_waitcnt vmcnt(0)" ::: "memory");
    }
  }
  __syncthreads();
}

__global__ void __launch_bounds__(NTHR) fwd_megakernel(Params p_arg) {
#define KP (*params_now())
  cg::grid_group grid = cg::this_grid();
  __shared__ __attribute__((aligned(1024))) char shm_raw[144 * 1024];
  float* lds = (float*)shm_raw; LAS char* shm = (LAS char*)shm_raw;
  __shared__ uint4 xb_words;
  if (threadIdx.x == 0) xb_words = make_uint4(0u, 0u, 0u, 0u);
  __syncthreads();
  const XcdBarrier xb = xcd_barrier_post(KP.bar, (volatile LAS unsigned*)&xb_words);
  phase_prologue(KP, lds);
  grid.sync();
#define GSYNC() xcd_barrier(xb)
#ifndef PROBE
#define PROBE 0
#endif
#define PH(grp, ...) do { unsigned long long t0_ = 0; if (PROBE == (grp)) t0_ = __builtin_amdgcn_s_memrealtime(); __VA_ARGS__; GSYNC(); \
    if (PROBE == (grp)) { const unsigned long long d_ = __builtin_amdgcn_s_memrealtime() - t0_, t1_ = __builtin_amdgcn_s_memrealtime(); \
      while (__builtin_amdgcn_s_memrealtime() - t1_ < d_) __builtin_amdgcn_s_sleep(8); GSYNC(); } } while (0)
  PH(8, phase_norm1_first(KP));
  for (int layer = 0; layer < 4; ++layer) {
    const int kind = layer % 3, j = layer / 3; const bool last = layer == 3;
    if (kind == 0) {
      PH(2, gemm_pg8(KP.h, KP.w_mla_in + (size_t)j * 768 * 1024, T, 768, 1024, EpiStoreBf16R{(bf16_t*)(KP.scratch + OFF_A1), 768, 672}, shm));
      PH(7, phase_mla_norm(KP, j));
      PH(2, gemm_pg8((const bf16_t*)(KP.scratch + OFF_CQN), KP.w_uq + (size_t)j * 1536 * 384, T, 1536, 384, EpiQR{(bf16_t*)(KP.scratch + OFF_QF)}, shm, false, last);
            gemm_pg8((const bf16_t*)(KP.scratch + OFF_CKVN), KP.w_ukv + (size_t)j * 2048 * 256, T, 2048, 256, EpiKVR{(bf16_t*)(KP.scratch + OFF_KF), (bf16_t*)(KP.scratch + OFF_VF)}, shm, true));
      PH(6, phase_attn_mfma(KP, last, shm));
      if (last) { PH(2, gemm_pg8((const bf16_t*)(KP.scratch + OFF_O), KP.w_mla_o + (size_t)j * 1024 * 1024, T, 1024, 1024, EpiResR{KP.xc, KP.xl, KP.ada, layer, 2048, last}, shm, false, true)); }
      else { PH(2, gemm256s_t<192>((const bf16_t*)(KP.scratch + OFF_O), D, KP.w_mla_o + (size_t)j * 1024 * 1024, 1024, T, 1024, 1024, EpiResR{KP.xc, KP.xl, KP.ada, layer, 2048, last}, shm)); }
      PH(7, phase_norm2(KP, layer));
    } else if (kind == 1) {
      PH(4, phase_s5_scan_mfma(KP, shm));
      PH(4, phase_s5_out_mfma(KP, shm));
      PH(2, gemm256s_t<192>((const bf16_t*)(KP.scratch + OFF_GIN), D, KP.w_glu, 1024, T, 2048, 1024, EpiGluResR{KP.xc, KP.xl, KP.ada, layer}, shm));
      PH(7, phase_norm2(KP, layer));
    } else {
      PH(2, gemm_pg8(KP.h, KP.w_gla_in, T, 4096, 1024, EpiGlaR{(bf16_t*)(KP.scratch + OFF_QKVG), (bf16_t*)(KP.scratch + OFF_LG), KP.gla_gk_b, (bf16_t*)(KP.scratch + OFF_VTG)}, shm));
      PH(4, phase_gla_scan_mfma(KP, shm));
      PH(7, phase_gla_out(KP));
      PH(2, gemm256s_t<192>((const bf16_t*)(KP.scratch + OFF_GO), D, KP.w_gla_o, 1024, T, 1024, 1024, EpiResR{KP.xc, KP.xl, KP.ada, layer, 2048, false}, shm));
      PH(7, phase_norm2(KP, layer));
    }
    if (last) { PH(2, gemm_pg8(KP.h, KP.w_pq + (size_t)layer * 1024 * 1024, T, 1024, 1024, EpiStoreBf16R{(bf16_t*)(KP.scratch + OFF_PQ), 1024, 1024}, shm, false, true);
          phase_peer_tables(KP, layer)); } else { PH(2, gemm256s_t<192>(KP.h, D, KP.w_pq + (size_t)layer * 1024 * 1024, 1024, T, 1024, 1024, EpiStoreBf16R{(bf16_t*)(KP.scratch + OFF_PQ), 1024, 1024}, shm);
          phase_peer_tables(KP, layer)); }
    PH(3, phase_peer_route(KP, layer, shm));
    if (layer < 3) { PH(1, phase_peer_gather8(KP, layer)); } else phase_peer_gather8(KP, layer);
  }
}

extern "C" void kernel_launch(void* const* d_in, const int* in_sizes, int n_in, void* d_out,
                              int out_size, void* d_ws, size_t ws_size, hipStream_t stream) {
  static int grid_blocks = 0;
  if (!grid_blocks) {
    int dev = 0, cus = 0, per_cu = 0;
    (void)hipGetDevice(&dev);
    (void)hipDeviceGetAttribute(&cus, hipDeviceAttributeMultiprocessorCount, dev);
    (void)hipOccupancyMaxActiveBlocksPerMultiprocessor(&per_cu, fwd_megakernel, NTHR, 0);
    if (per_cu > 1) per_cu = 1;
    grid_blocks = cus * per_cu;
  }
  Params p{};
  const float* const* in = (const float* const*)d_in;
  p.x = in[0]; p.c = in[1]; p.ctx = in[2]; p.c_ctx = in[3]; p.norm_g = in[4]; p.ada_w = in[5]; p.ada_b = in[6];
  p.mla_w_in = in[7]; p.mla_q_norm = in[8]; p.mla_w_uq = in[9]; p.mla_kv_norm = in[10]; p.mla_w_ukv = in[11]; p.mla_w_o = in[12];
  p.s5_lam_re = in[13]; p.s5_lam_im = in[14]; p.s5_b_re = in[15]; p.s5_b_im = in[16]; p.s5_c_re = in[17]; p.s5_c_im = in[18]; p.s5_log_step = in[19]; p.s5_d = in[20]; p.s5_w_glu = in[21];
  p.gla_w_in = in[22]; p.gla_gk_w1 = in[23]; p.gla_gk_w2 = in[24]; p.gla_gk_b = in[25]; p.gla_o_norm = in[26]; p.gla_w_o = in[27];
  p.peer_w_q = in[28]; p.peer_keys = in[29]; p.peer_u = in[30]; p.peer_v = in[31]; p.final_g = in[32];
  p.out = (float*)d_out;
  char* w = (char*)d_ws; size_t off = 0;
  auto take = [&](size_t bytes) { char* r = w + off; off += (bytes + 255) & ~(size_t)255; return r; };
  p.xc = (bf16_t*)take((size_t)NB * CTX * D * 2);
  p.xl = (bf16_t*)take((size_t)NB * SEQ * D * 2);
  p.ada = (float*)take((size_t)4 * 17 * 6144 * 4);
  p.rope = (float*)take((size_t)2048 * 32 * 4);
  p.h = (bf16_t*)take((size_t)T * D * 2);
  p.w_mla_in = (bf16_t*)take((size_t)2 * 768 * 1024 * 2);
  p.w_uq = (bf16_t*)take((size_t)2 * 1536 * 384 * 2);
  p.w_ukv = (bf16_t*)take((size_t)2 * 2048 * 256 * 2);
  p.w_mla_o = (bf16_t*)take((size_t)2 * 1024 * 1024 * 2);
  p.w_glu = (bf16_t*)take((size_t)2048 * 1024 * 2);
  p.w_gla_in = (bf16_t*)take((size_t)4096 * 1024 * 2);
  p.w_gla_o = (bf16_t*)take((size_t)1024 * 1024 * 2);
  p.w_pq = (bf16_t*)take((size_t)4 * 1024 * 1024 * 2);
  p.s5_ar = (float*)take(2 * 64 * 64 * 4); p.s5_ai = (float*)take(2 * 64 * 64 * 4);
  p.s5_br = (float*)take(2 * 64 * 64 * 16 * 4); p.s5_bi = (float*)take(2 * 64 * 64 * 16 * 4);
  p.scratch = take(SCRATCH_BYTES);
  p.bar = (unsigned*)take(XCD_BAR_WORDS * 4);
  if (off > ws_size) { fprintf(stderr, "workspace too small: need %zu have %zu\n", off, ws_size); return; }
  (void)hipMemsetAsync(p.bar, 0, XCD_BAR_WORDS * 4, stream);
  void* args[] = {&p};
  hipError_t e = hipLaunchCooperativeKernel((void*)fwd_megakernel, dim3(grid_blocks), dim3(NTHR), args, 0, stream);
  if (e != hipSuccess) fprintf(stderr, "cooperative launch failed: %s (grid %d)\n", hipGetErrorString(e), grid_blocks);
}
```

```cpp
#include <hip/hip_runtime.h>
#include <hip/hip_cooperative_groups.h>
#include <cstdio>
#include <cstdint>
namespace cg = cooperative_groups;

typedef unsigned short bf16_t;
#define DEV __device__ __forceinline__

DEV int tid_op() { int t = threadIdx.x; asm volatile("" : "+v"(t)); return t; }
DEV int bid_op() { int t = blockIdx.x; asm volatile("" : "+s"(t)); return t; }
#define TIDX tid_op()
#define BIDX bid_op()
constexpr int D = 1024, NB = 16, SEQ = 2048, CTX = 256, SP = 2304, T = NB * SP;
constexpr int NTHR = 512;

struct Params {
  const float *x, *c, *ctx, *c_ctx, *norm_g, *ada_w, *ada_b;
  const float *mla_w_in, *mla_q_norm, *mla_w_uq, *mla_kv_norm, *mla_w_ukv, *mla_w_o;
  const float *s5_lam_re, *s5_lam_im, *s5_b_re, *s5_b_im, *s5_c_re, *s5_c_im, *s5_log_step, *s5_d, *s5_w_glu;
  const float *gla_w_in, *gla_gk_w1, *gla_gk_w2, *gla_gk_b, *gla_o_norm, *gla_w_o;
  const float *peer_w_q, *peer_keys, *peer_u, *peer_v, *final_g;
  float* out;
  bf16_t *xl, *xc;
  float *ada, *rope;
  bf16_t* h;
  bf16_t *w_mla_in, *w_uq, *w_ukv, *w_mla_o, *w_glu, *w_gla_in, *w_gla_o, *w_pq;
  float *s5_ar, *s5_ai, *s5_br, *s5_bi;
  char* scratch;
  unsigned* bar;
};
typedef const __attribute__((address_space(4))) Params& CP;
__device__ __forceinline__ const __attribute__((address_space(4))) Params* params_now() {
  unsigned long long kp = (unsigned long long)__builtin_amdgcn_kernarg_segment_ptr();
  asm volatile("" : "+s"(kp));
  return (const __attribute__((address_space(4))) Params*)kp;
}

constexpr size_t MB = 1ull << 20;
constexpr size_t OFF_A1 = 0;
constexpr size_t OFF_CQN = 54 * MB;
constexpr size_t OFF_CKVN = 81 * MB;
constexpr size_t OFF_QF = 99 * MB;
constexpr size_t OFF_KF = 207 * MB;
constexpr size_t OFF_VF = 315 * MB;
constexpr size_t OFF_O = 387 * MB;
constexpr size_t OFF_KPE = 459 * MB;
constexpr size_t OFF_Y = 0;
constexpr size_t OFF_GIN = 144 * MB;
constexpr size_t OFF_Z = 216 * MB;
constexpr size_t OFF_KT = 360 * MB;
constexpr size_t OFF_W4 = 364 * MB;
constexpr size_t OFF_XIN = 384 * MB;
constexpr size_t OFF_QKVG = 0;
constexpr size_t OFF_LG = 216 * MB;
constexpr size_t OFF_OD = 360 * MB;
constexpr size_t OFF_GO = 504 * MB;
constexpr size_t OFF_PQ = 0;
constexpr size_t OFF_SV = 144 * MB;
constexpr size_t OFF_SI = 180 * MB;
constexpr size_t OFF_EID = 216 * MB;
constexpr size_t OFF_GATE = 234 * MB;
constexpr size_t OFF_U8 = 256 * MB;
constexpr size_t OFF_V8 = 272 * MB;
constexpr size_t OFF_VTG = 576 * MB;
constexpr size_t SCRATCH_BYTES = 648 * MB;

DEV float bf2f(bf16_t v) { return __uint_as_float(((unsigned)v) << 16); }
typedef __bf16 hwbf16x2 __attribute__((ext_vector_type(2)));
typedef float f32pair __attribute__((ext_vector_type(2)));
DEV unsigned cvt_pk_bf16(float lo, float hi) { const f32pair v = {lo, hi}; return __builtin_bit_cast(unsigned, __builtin_convertvector(v, hwbf16x2)); }
DEV bf16_t f2bf(float f) { return (bf16_t)__builtin_bit_cast(unsigned short, (__bf16)f); }
DEV float wave_sum(float v) {
#pragma unroll
  for (int o = 32; o > 0; o >>= 1) v += __shfl_xor(v, o);
  return v;
}
DEV float gelu_tanh(float x) { const float u2 = 1.5957691216057308f * (x + 0.044715f * x * x * x); return x * __builtin_amdgcn_rcpf(1.f + __expf(-u2)); }
DEV float sigm(float x) { return __builtin_amdgcn_rcpf(1.f + __expf(-x)); }
DEV float silu(float x) { return x * sigm(x); }

DEV bf16_t* xrow_ptr(CP p, int t) {
  int b = t / SP, s = t - b * SP;
  return s < CTX ? p.xc + ((size_t)(b * CTX + s)) * D : p.xl + ((size_t)(b * SEQ + s - CTX)) * D;
}
DEV const float* ada_ptr(CP p, int layer, int t) {
  int b = t / SP, s = t - b * SP;
  return p.ada + ((size_t)(layer * 17 + (s < CTX ? 16 : b))) * 6144;
}

DEV void load_row_f32(const float* row, int lane, float (&v)[16]) {
#pragma unroll
  for (int j = 0; j < 4; ++j) { float4 t = *(const float4*)(row + j * 256 + lane * 4); v[j * 4] = t.x; v[j * 4 + 1] = t.y; v[j * 4 + 2] = t.z; v[j * 4 + 3] = t.w; }
}
DEV void load_row_bf(const bf16_t* row, int lane, float (&v)[16]) {
#pragma unroll
  for (int j = 0; j < 4; ++j) { const uint2 w = *(const uint2*)(row + j * 256 + lane * 4); v[j * 4] = __uint_as_float(w.x << 16); v[j * 4 + 1] = __uint_as_float(w.x & 0xffff0000u); v[j * 4 + 2] = __uint_as_float(w.y << 16); v[j * 4 + 3] = __uint_as_float(w.y & 0xffff0000u); }
}
DEV void store_row_bf(bf16_t* row, int lane, const float (&v)[16]) {
#pragma unroll
  for (int j = 0; j < 4; ++j) { uint2 w; w.x = cvt_pk_bf16(v[j * 4], v[j * 4 + 1]); w.y = cvt_pk_bf16(v[j * 4 + 2], v[j * 4 + 3]); *(uint2*)(row + j * 256 + lane * 4) = w; }
}
DEV void store_row_f32(float* row, int lane, const float (&v)[16]) {
#pragma unroll
  for (int j = 0; j < 4; ++j) *(float4*)(row + j * 256 + lane * 4) = make_float4(v[j * 4], v[j * 4 + 1], v[j * 4 + 2], v[j * 4 + 3]);
}
DEV void norm_mod_store(const float (&v)[16], const float* g, const float* sc, const float* sh, bf16_t* hrow, int lane) {
  float ss = 0.f;
#pragma unroll
  for (int i = 0; i < 16; ++i) ss += v[i] * v[i];
  ss = wave_sum(ss);
  const float rstd = rsqrtf(ss * (1.0f / D) + 1e-6f);
#pragma unroll
  for (int j = 0; j < 4; ++j) {
    const int c0 = j * 256 + lane * 4;
    float4 gg = *(const float4*)(g + c0), s1 = *(const float4*)(sc + c0), s2 = *(const float4*)(sh + c0);
    float y0 = v[j * 4] * rstd * gg.x * (1.f + s1.x) + s2.x, y1 = v[j * 4 + 1] * rstd * gg.y * (1.f + s1.y) + s2.y;
    float y2 = v[j * 4 + 2] * rstd * gg.z * (1.f + s1.z) + s2.z, y3 = v[j * 4 + 3] * rstd * gg.w * (1.f + s1.w) + s2.w;
    uint2 w; w.x = cvt_pk_bf16(y0, y1); w.y = cvt_pk_bf16(y2, y3);
    *(uint2*)(hrow + c0) = w;
  }
}

DEV void conv_weights(CP p, float* lds) {
  const int tid = TIDX;
  constexpr int NT = 2000;
  float r[16];
  const float* src = nullptr; bf16_t* dst = nullptr; int K = 0, N = 0, k0 = 0, n0 = 0; bool glu = false;
  auto decode = [&](int g) {
    int base, Np; glu = false;
    if (g < 192) { const int j = g >= 96; base = j * 96; src = p.mla_w_in + (size_t)j * 1024 * 672; dst = p.w_mla_in + (size_t)j * 768 * 1024; K = 1024; N = 672; Np = 768; }
    else if (g < 336) { const int j = g >= 264; base = 192 + j * 72; src = p.mla_w_uq + (size_t)j * 384 * 1536; dst = p.w_uq + (size_t)j * 1536 * 384; K = 384; N = Np = 1536; }
    else if (g < 464) { const int j = g >= 400; base = 336 + j * 64; src = p.mla_w_ukv + (size_t)j * 256 * 2048; dst = p.w_ukv + (size_t)j * 2048 * 256; K = 256; N = Np = 2048; }
    else if (g < 720) { const int j = g >= 592; base = 464 + j * 128; src = p.mla_w_o + (size_t)j * 1024 * 1024; dst = p.w_mla_o + (size_t)j * 1024 * 1024; K = 1024; N = Np = 1024; }
    else if (g < 976) { base = 720; src = p.s5_w_glu; dst = p.w_glu; K = 1024; N = Np = 2048; glu = true; }
    else if (g < 1360) { base = 976; src = p.gla_w_in; dst = p.w_gla_in; K = 1024; N = Np = 3072; }
    else if (g < 1488) { base = 1360; src = p.gla_w_o; dst = p.w_gla_o; K = 1024; N = Np = 1024; }
    else { const int i = (g - 1488) >> 7; base = 1488 + i * 128; src = p.peer_w_q + (size_t)i * 1024 * 1024; dst = p.w_pq + (size_t)i * 1024 * 1024; K = 1024; N = Np = 1024; }
    const int local = g - base, tk = K >> 6;
    k0 = (local % tk) * 64; n0 = (local / tk) * 128; (void)Np;
  };
  auto loadt = [&]() {
#pragma unroll
    for (int i = 0; i < 16; ++i) { const int idx = tid + i * NTHR, kk = idx >> 7, nn = idx & 127;
      r[i] = (n0 + nn < N) ? src[(size_t)(k0 + kk) * N + n0 + nn] : 0.f; }
  };
  int g = BIDX;
  if (g < NT) { decode(g); loadt(); }
  while (g < NT) {
    __syncthreads();
#pragma unroll
    for (int i = 0; i < 16; ++i) { const int idx = tid + i * NTHR, kk = idx >> 7, nn = idx & 127; lds[kk * 129 + nn] = r[i]; }
    bf16_t* d0 = dst + k0; const int Kc = K, n0c = n0; const bool gluc = glu;
    const int gn = g + gridDim.x;
    if (gn < NT) { decode(gn); loadt(); }
    __syncthreads();
#pragma unroll
    for (int i = 0; i < 4; ++i) { const int idx = tid + i * NTHR, nn = idx >> 4, kq = idx & 15;
      const float* l = lds + (kq * 4) * 129 + nn;
      uint2 w; w.x = cvt_pk_bf16(l[0], l[129]); w.y = cvt_pk_bf16(l[258], l[387]);
      const int nrow = n0c + nn, orow = gluc ? (nrow < 1024 ? 2 * nrow : 2 * (nrow - 1024) + 1) : nrow;
      *(uint2*)(d0 + (size_t)orow * Kc + kq * 4) = w; }
    g = gn;
  }
}

DEV void ada_load(float (&W)[8][3], const float* w, int kb) {
#pragma unroll
  for (int i = 0; i < 8; ++i) { const float* wp = w + (size_t)(kb + i) * 6144; W[i][0] = wp[0]; W[i][1] = wp[1]; W[i][2] = wp[2]; }
}
DEV void ada_fma(float (&acc)[17][3], const float (&W)[8][3], const float* sp, int kb) {
#pragma unroll
  for (int i = 0; i < 8; ++i) {
    const float* sr = sp + (kb + i) * 20;
    const float4 s0 = *(const float4*)sr, s1 = *(const float4*)(sr + 4), s2 = *(const float4*)(sr + 8), s3 = *(const float4*)(sr + 12); const float s16 = sr[16];
    const float sv[17] = {s0.x, s0.y, s0.z, s0.w, s1.x, s1.y, s1.z, s1.w, s2.x, s2.y, s2.z, s2.w, s3.x, s3.y, s3.z, s3.w, s16};
#pragma unroll
    for (int r = 0; r < 17; ++r) { acc[r][0] += sv[r] * W[i][0]; acc[r][1] += sv[r] * W[i][1]; acc[r][2] += sv[r] * W[i][2]; }
  }
}

DEV void phase_prologue(CP p, float* lds) {
  const int tid = TIDX, gtid = BIDX * NTHR + tid, gn = gridDim.x * NTHR;
  conv_weights(p, lds);
  for (int idx = gtid; idx < 2 * 64 * 1024; idx += gn) {
    const int k = idx & 1023, ns = (idx >> 10) & 63, d = idx >> 16;
    const float4* w1 = (const float4*)(p.gla_gk_w1 + ((size_t)d * 1024 + k) * 16); const float* w2 = p.gla_gk_w2 + (size_t)d * 16 * 512 + ns * 8;
    const float4 a0 = w1[0], a1 = w1[1], a2 = w1[2], a3 = w1[3];
    const float a[16] = {a0.x, a0.y, a0.z, a0.w, a1.x, a1.y, a1.z, a1.w, a2.x, a2.y, a2.z, a2.w, a3.x, a3.y, a3.z, a3.w};
#pragma unroll
    for (int i = 0; i < 8; ++i) {
      float sacc = 0.f;
#pragma unroll
      for (int r = 0; r < 16; ++r) sacc += a[r] * w2[r * 512 + i];
      p.w_gla_in[(size_t)(3072 + d * 512 + ns * 8 + i) * 1024 + k] = f2bf(sacc);
    }
  }
  for (int idx = gtid; idx < 2048 * 8; idx += gn) {
    const int pos = idx >> 3, i = idx & 7;
    const float inv = powf(10000.0f, -(float)i / 8.0f);
    const float ar = (float)(pos / 64) * inv, ac = (float)(pos % 64) * inv;
    float* r = p.rope + pos * 32;
    r[i] = cosf(ar); r[8 + i] = sinf(ar); r[16 + i] = cosf(ac); r[24 + i] = sinf(ac);
  }
  for (int idx = gtid; idx < 2 * 64 * 64; idx += gn) {
    const int g = (idx >> 6) & 63, d = idx >> 12;
    const float lr = p.s5_lam_re[idx], li = p.s5_lam_im[idx], dt = expf(p.s5_log_step[d * 64 + g]);
    const float mag = expf(lr * dt), ar = mag * cosf(li * dt), ai = mag * sinf(li * dt), den = lr * lr + li * li;
    const float fr = ((ar - 1.f) * lr + ai * li) / den, fi = (ai * lr - (ar - 1.f) * li) / den;
    p.s5_ar[idx] = ar; p.s5_ai[idx] = ai;
    for (int c = 0; c < 16; ++c) { const float bre = p.s5_b_re[idx * 16 + c], bim = p.s5_b_im[idx * 16 + c];
      p.s5_br[idx * 16 + c] = fr * bre - fi * bim; p.s5_bi[idx * 16 + c] = fr * bim + fi * bre; }
  }
  {
    float* st = lds;
    for (int cb = BIDX; cb < 4 * 64; cb += gridDim.x) {
      const int layer = cb >> 6, n0 = (cb & 63) * 96;
      __syncthreads();
      for (int idx = tid; idx < 17 * 1024; idx += NTHR) { const int r = idx >> 10, k = idx & 1023; const float cv = r < 16 ? p.c[r * 1024 + k] : p.c_ctx[k]; st[k * 20 + (k >> 6) * 4 + r] = silu(cv); }
      __syncthreads();
      const int ct = tid & 31, kg = tid >> 5;
      const float* w = p.ada_w + ((size_t)layer * 1024 + kg * 64) * 6144 + n0 + ct * 3;
      const float* sp = st + kg * 64 * 20 + kg * 4;
      float acc[17][3];
#pragma unroll
      for (int r = 0; r < 17; ++r) { acc[r][0] = 0.f; acc[r][1] = 0.f; acc[r][2] = 0.f; }
      float wa[8][3], wb[8][3];
      ada_load(wa, w, 0);
#pragma unroll 1
      for (int kb = 0; kb < 64; kb += 16) {
        ada_load(wb, w, kb + 8);
        ada_fma(acc, wa, sp, kb);
        ada_load(wa, w, kb + 16 < 64 ? kb + 16 : 56);
        ada_fma(acc, wb, sp, kb + 8);
      }
      __syncthreads();
      float* part = lds;
#pragma unroll
      for (int r = 0; r < 17; ++r) { float* pp = part + (kg * 17 + r) * 96 + ct * 3; pp[0] = acc[r][0]; pp[1] = acc[r][1]; pp[2] = acc[r][2]; }
      __syncthreads();
      for (int idx = tid; idx < 96 * 17; idx += NTHR) { const int r = idx / 96, col = idx - r * 96;
        float v = 0.f;
#pragma unroll
        for (int q = 0; q < 16; ++q) v += part[(q * 17 + r) * 96 + col];
        p.ada[((size_t)(layer * 17 + r)) * 6144 + n0 + col] = v + p.ada_b[layer * 6144 + n0 + col]; }
    }
    __syncthreads();
  }
}

DEV void phase_norm1_first(CP p) {
  const int lane = TIDX & 63, gw = BIDX * (NTHR / 64) + __builtin_amdgcn_readfirstlane(TIDX >> 6), nw = gridDim.x * (NTHR / 64);
  for (int t = gw; t < T; t += nw) {
    const int b = t / SP, s = t - b * SP;
    const float* src = s < CTX ? p.ctx + ((size_t)(b * CTX + s)) * D : p.x + ((size_t)(b * SEQ + s - CTX)) * D;
    float v[16]; load_row_f32(src, lane, v);
    store_row_bf(xrow_ptr(p, t), lane, v);
    const float* ad = ada_ptr(p, 0, t);
    norm_mod_store(v, p.norm_g, ad + 1024, ad, p.h + (size_t)t * D, lane);
  }
}
DEV void phase_norm2(CP p, int layer) {
  const int lane = TIDX & 63, gw = BIDX * (NTHR / 64) + __builtin_amdgcn_readfirstlane(TIDX >> 6), nw = gridDim.x * (NTHR / 64);
  for (int t = gw; t < T; t += 3 * nw) {
    float v[3][16];
#pragma unroll
    for (int u = 0; u < 3; ++u) { const int tt = t + u * nw; if (tt < T) load_row_bf(xrow_ptr(p, tt), lane, v[u]); }
#pragma unroll
    for (int u = 0; u < 3; ++u) { const int tt = t + u * nw; if (tt < T) {
      const float* ad = ada_ptr(p, layer, tt);
      norm_mod_store(v[u], p.norm_g + (layer * 2 + 1) * D, ad + 4096, ad + 3072, p.h + (size_t)tt * D, lane); } }
  }
}

template <class Epi>
DEV void gemm_naive(const bf16_t* A, int lda, const bf16_t* Bt, int ldb, int M, int N, int K, const Epi& epi, float* lds) {
  float* As = lds;
  float* Bs = lds + 16 * 132;
  const int tid = TIDX, ty = tid >> 5, tx = tid & 31, nM = M / 128, nN = N / 128;
  const int lrow = tid >> 2, lkq = tid & 3;
  for (int tile = BIDX; tile < nM * nN; tile += gridDim.x) {
    const int pm = tile / nN, pn = tile - pm * nN;
    float acc[8][4];
#pragma unroll
    for (int i = 0; i < 8; ++i)
#pragma unroll
      for (int j = 0; j < 4; ++j) acc[i][j] = 0.f;
    const bf16_t* ap = A + (size_t)(pm * 128 + lrow) * lda + lkq * 4;
    const bf16_t* bp = Bt + (size_t)(pn * 128 + lrow) * ldb + lkq * 4;
    for (int k0 = 0; k0 < K; k0 += 16) {
      const uint2 av = *(const uint2*)(ap + k0), bv = *(const uint2*)(bp + k0);
      __syncthreads();
      As[(lkq * 4 + 0) * 132 + lrow] = __uint_as_float(av.x << 16); As[(lkq * 4 + 1) * 132 + lrow] = __uint_as_float(av.x & 0xffff0000u);
      As[(lkq * 4 + 2) * 132 + lrow] = __uint_as_float(av.y << 16); As[(lkq * 4 + 3) * 132 + lrow] = __uint_as_float(av.y & 0xffff0000u);
      Bs[(lkq * 4 + 0) * 132 + lrow] = __uint_as_float(bv.x << 16); Bs[(lkq * 4 + 1) * 132 + lrow] = __uint_as_float(bv.x & 0xffff0000u);
      Bs[(lkq * 4 + 2) * 132 + lrow] = __uint_as_float(bv.y << 16); Bs[(lkq * 4 + 3) * 132 + lrow] = __uint_as_float(bv.y & 0xffff0000u);
      __syncthreads();
#pragma unroll 2
      for (int kk = 0; kk < 16; ++kk) {
        const float4 a0 = *(const float4*)(As + kk * 132 + ty * 8), a1 = *(const float4*)(As + kk * 132 + ty * 8 + 4), b0 = *(const float4*)(Bs + kk * 132 + tx * 4);
        const float a[8] = {a0.x, a0.y, a0.z, a0.w, a1.x, a1.y, a1.z, a1.w}, b[4] = {b0.x, b0.y, b0.z, b0.w};
#pragma unroll
        for (int i = 0; i < 8; ++i)
#pragma unroll
          for (int j = 0; j < 4; ++j) acc[i][j] += a[i] * b[j];
      }
    }
#pragma unroll
    for (int i = 0; i < 8; ++i)
#pragma unroll
      for (int j = 0; j < 4; ++j) epi(pm * 128 + ty * 8 + i, pn * 128 + tx * 4 + j, acc[i][j]);
  }
}


#define LAS __attribute__((address_space(3)))
typedef short bf16x8 __attribute__((ext_vector_type(8)));
typedef float f32x4 __attribute__((ext_vector_type(4)));
typedef float f32x16 __attribute__((ext_vector_type(16)));
typedef unsigned u32x4 __attribute__((ext_vector_type(4)));
typedef unsigned u32x2 __attribute__((ext_vector_type(2)));
DEV bf16x8 ld_frag_lds(const LAS char* p) { return *(const LAS bf16x8*)p; }
DEV int lds_byte2(int r, int c) { const int st = (r >> 4) * 2 + (c >> 5), ob = (r & 15) * 64 + (c & 31) * 2; return st * 1024 + (ob ^ (((ob >> 9) & 1) << 5)); }
DEV void stage_rc2(int b, int& R, int& C) { const int st = b >> 10, sb = b & 1023, swz = sb ^ (((sb >> 9) & 1) << 5); R = (st >> 1) * 16 + (swz >> 6); C = (st & 1) * 32 + ((swz & 63) >> 1); }

template <int BM, class Epi>
DEV void gemm_mfma(const bf16_t* A, int lda, const bf16_t* Bt, int ldb, int M, int N, int K, const Epi& epi, LAS char* shm) {
  constexpr int MF = BM / 32, TA = BM * 128, TB = 256 * 128, STG = TA + TB, GA = TA / 8192, GB = TB / 8192;
  const int tid = TIDX, wid = __builtin_amdgcn_readfirstlane(tid >> 6), lane = tid & 63, wr = wid >> 2, wc = wid & 3, fr = lane & 15, fq = lane >> 4;
  int offA0, offB0;
  { int R, C; stage_rc2(wid * 1024 + lane * 16, R, C); offA0 = R * lda + C; offB0 = R * ldb + C; }
  const int nM = M / BM, nN = N / 256, ntile = nM * nN, nt = K / 64;
  const int G = gridDim.x, bid = BIDX, vb = (G & 7) ? bid : (bid & 7) * (G >> 3) + (bid >> 3);
  const int aoff0 = lds_byte2(wr * (BM / 2) + fr, fq * 8), boff0 = TA + lds_byte2(wc * 64 + fr, fq * 8);
  for (int tile = vb; tile < ntile; tile += G) {
    const int Wn = (nN > 4 && (nN & 3) == 0) ? 4 : ((nN > 3 && nN % 3 == 0) ? 3 : nN), tpg = nM * Wn, gn = tile / tpg, rem = tile - gn * tpg;
    const int pm = rem / Wn, pn = gn * Wn + (rem - pm * Wn);
    const bf16_t* Ab = A + (size_t)pm * BM * lda; const bf16_t* Bb = Bt + (size_t)pn * 256 * ldb;
    f32x4 acc[MF][4];
#pragma unroll
    for (int m = 0; m < MF; ++m)
#pragma unroll
      for (int n = 0; n < 4; ++n) acc[m][n] = (f32x4){0.f, 0.f, 0.f, 0.f};
#define GSTAGE(buf, kt) do { _Pragma("unroll") for (int i = 0; i < GB; ++i) { \
      if (i < GA) __builtin_amdgcn_global_load_lds((const unsigned*)(Ab + offA0 + i * 64 * lda + (kt) * 64), (LAS unsigned*)(shm + (buf) * STG + wid * 1024 + i * 8192), 16, 0, 0); \
      __builtin_amdgcn_global_load_lds((const unsigned*)(Bb + offB0 + i * 64 * ldb + (kt) * 64), (LAS unsigned*)(shm + (buf) * STG + TA + wid * 1024 + i * 8192), 16, 0, 0); } } while (0)
#define GWAIT_V(n_) asm volatile("s_waitcnt vmcnt(%0)" ::"n"(n_) : "memory")
#define GRAW_BARRIER() do { asm volatile("s_waitcnt lgkmcnt(0)" ::: "memory"); __builtin_amdgcn_s_barrier(); } while (0)
    constexpr int GL = GA + GB;
    if constexpr (BM == 256) {
      GWAIT_V(0); GRAW_BARRIER();
      GSTAGE(0, 0);
      int cur = 0;
      for (int t = 0; t < nt; ++t) {
        GWAIT_V(0); GRAW_BARRIER();
        if (t + 1 < nt) GSTAGE(cur ^ 1, t + 1);
#pragma unroll
        for (int ks = 0; ks < 2; ++ks) {
          bf16x8 At[MF], Bf[4];
#pragma unroll
          for (int m = 0; m < MF; ++m) At[m] = *(const LAS bf16x8*)(shm + cur * STG + aoff0 + m * 2048 + ks * 1024);
#pragma unroll
          for (int n = 0; n < 4; ++n) Bf[n] = *(const LAS bf16x8*)(shm + cur * STG + boff0 + n * 2048 + ks * 1024);
          __builtin_amdgcn_s_setprio(1);
#pragma unroll
          for (int m = 0; m < MF; ++m)
#pragma unroll
            for (int n = 0; n < 4; ++n) acc[m][n] = __builtin_amdgcn_mfma_f32_16x16x32_bf16(At[m], Bf[n], acc[m][n], 0, 0, 0);
          __builtin_amdgcn_s_setprio(0);
        }
        cur ^= 1;
      }
      GRAW_BARRIER();
    } else {
    GWAIT_V(0); GRAW_BARRIER();
    GSTAGE(0, 0);
    if (nt > 1) { GSTAGE(1, 1); GWAIT_V(GL); } else GWAIT_V(0);
    GRAW_BARRIER();
    int cur = 0;
    for (int t = 0; t < nt; ++t) {
      if (t + 2 < nt) { const int nb = cur >= 1 ? cur - 1 : 2; GSTAGE(nb, t + 2); }
#pragma unroll
      for (int ks = 0; ks < 2; ++ks) {
        bf16x8 At[MF], Bf[4];
#pragma unroll
        for (int m = 0; m < MF; ++m) At[m] = *(const LAS bf16x8*)(shm + cur * STG + aoff0 + m * 2048 + ks * 1024);
#pragma unroll
        for (int n = 0; n < 4; ++n) Bf[n] = *(const LAS bf16x8*)(shm + cur * STG + boff0 + n * 2048 + ks * 1024);
#pragma unroll
        for (int m = 0; m < MF; ++m)
#pragma unroll
          for (int n = 0; n < 4; ++n) acc[m][n] = __builtin_amdgcn_mfma_f32_16x16x32_bf16(At[m], Bf[n], acc[m][n], 0, 0, 0);
      }
      if (t + 2 < nt) GWAIT_V(GL); else GWAIT_V(0);
      GRAW_BARRIER();
      cur = cur == 2 ? 0 : cur + 1;
    }
    }
#undef GSTAGE
    const int row0 = pm * BM + wr * (BM / 2) + fq * 4, col0 = pn * 256 + wc * 64 + fr;
    if constexpr (Epi::PRELOAD) {
      f32x4 xin[MF][4];
#pragma unroll
      for (int m = 0; m < MF; ++m)
#pragma unroll
        for (int n = 0; n < 4; ++n) xin[m][n] = epi.load(row0 + m * 16, col0 + n * 16);
#pragma unroll
      for (int m = 0; m < MF; ++m)
#pragma unroll
        for (int n = 0; n < 4; ++n) epi.store(row0 + m * 16, col0 + n * 16, acc[m][n], xin[m][n]);
    } else {
#pragma unroll
    for (int m = 0; m < MF; ++m) {
#pragma unroll
      for (int n = 0; n < 4; ++n)
        epi(row0 + m * 16, col0 + n * 16, acc[m][n]);
      if (BM == 256) asm volatile("" ::: "memory");
    }
    }
  }
}


template <int BM, class Epi, bool AG16 = false>
DEV void gemm256s_t(const bf16_t* A, int lda, const bf16_t* Bt, int ldb, int M, int N, int K, const Epi& epi, LAS char* shm, bool rev = false, bool seqonly = false) {
  constexpr int MF = BM / 32, TA = 256 * 128, STG = 2 * TA;
  const int tid = TIDX, wid = __builtin_amdgcn_readfirstlane(tid >> 6), lane = tid & 63, wr = wid >> 2, wc = wid & 3, fr = lane & 15, fq = lane >> 4;
  int offA0, offB0;
  { int R, C; stage_rc2(wid * 1024 + lane * 16, R, C); offA0 = AG16 ? ((C >> 4) * M + R) * 16 + (C & 15) : R * lda + C; offB0 = R * ldb + C; }
  const int nM = seqonly ? NB * (SEQ / 256) : M / BM, nN = N / 256, ntile = nM * nN, nt = K / 64;
  const int G = gridDim.x, bid = BIDX, vb0 = (G & 7) ? bid : (bid & 7) * (G >> 3) + (bid >> 3), vb = rev ? G - 1 - vb0 : vb0;
  if (vb >= ntile) return;
  const int cnt = (ntile - vb + G - 1) / G, J = cnt * nt;
  const int aoff0 = lds_byte2(wr * (BM / 2) + fr, fq * 8), boff0 = TA + lds_byte2(wc * 64 + fr, fq * 8);
  const int Wn = (nN > 4 && (nN & 3) == 0) ? 4 : ((nN > 3 && nN % 3 == 0) ? 3 : nN), tpg = nM * Wn;
#define G2_ROW0(pm_) (seqonly ? ((pm_) >> 3) * SP + CTX + ((pm_) & 7) * 256 : (pm_) * BM)
#define G2_PMPN(tile_, pm_, pn_) do { const int gn_ = (tile_) / tpg, rem_ = (tile_) - gn_ * tpg; pm_ = rem_ / Wn; pn_ = gn_ * Wn + (rem_ - pm_ * Wn); } while (0)
#define G2_STAGE(j_) do { if ((j_) < J) { const int i_ = (j_) / nt, kt_ = (j_) - i_ * nt; int pm_, pn_; G2_PMPN(vb + i_ * G, pm_, pn_); \
      const bf16_t* Ab_ = AG16 ? A + (size_t)G2_ROW0(pm_) * 16 + (size_t)kt_ * 4 * M * 16 : A + (size_t)G2_ROW0(pm_) * lda + kt_ * 64; const bf16_t* Bb_ = Bt + (size_t)pn_ * 256 * ldb + kt_ * 64; LAS char* db_ = shm + ((j_) & 1) * STG + wid * 1024; \
      _Pragma("unroll") for (int q_ = 0; q_ < 4; ++q_) { \
        if (q_ < BM / 64) __builtin_amdgcn_global_load_lds((const unsigned*)(Ab_ + offA0 + q_ * 64 * (AG16 ? 16 : lda)), (LAS unsigned*)(db_ + q_ * 8192), 16, 0, 0); \
        __builtin_amdgcn_global_load_lds((const unsigned*)(Bb_ + offB0 + q_ * 64 * ldb), (LAS unsigned*)(db_ + TA + q_ * 8192), 16, 0, 0); } } } while (0)
#define G2_BAR() do { asm volatile("s_waitcnt lgkmcnt(0)" ::: "memory"); __builtin_amdgcn_sched_barrier(0); __builtin_amdgcn_s_barrier(); __builtin_amdgcn_sched_barrier(0); } while (0)
#define G2_WAITV() asm volatile("s_waitcnt vmcnt(0)" ::: "memory")
#define G2_LOADF(buf_, ks_) do { _Pragma("unroll") for (int m = 0; m < MF; ++m) At[m] = *(const LAS bf16x8*)(shm + (buf_) * STG + aoff0 + m * 2048 + (ks_) * 1024); \
      _Pragma("unroll") for (int n = 0; n < 4; ++n) Bf[n] = *(const LAS bf16x8*)(shm + (buf_) * STG + boff0 + n * 2048 + (ks_) * 1024); } while (0)
#define G2_MMA() do { __builtin_amdgcn_s_setprio(1); _Pragma("unroll") for (int m = 0; m < MF; ++m) _Pragma("unroll") for (int n = 0; n < 4; ++n) \
      acc[m][n] = Epi::ROWVEC ? __builtin_amdgcn_mfma_f32_16x16x32_bf16(Bf[n], At[m], acc[m][n], 0, 0, 0) : __builtin_amdgcn_mfma_f32_16x16x32_bf16(At[m], Bf[n], acc[m][n], 0, 0, 0); __builtin_amdgcn_s_setprio(0); } while (0)
  f32x4 acc[MF][4];
#pragma unroll
  for (int m = 0; m < MF; ++m)
#pragma unroll
    for (int n = 0; n < 4; ++n) acc[m][n] = (f32x4){0.f, 0.f, 0.f, 0.f};
  bf16x8 At[MF], Bf[4];
  G2_WAITV(); G2_BAR();
  G2_STAGE(0);
  G2_WAITV(); G2_BAR();
  if (wr == 1) { G2_STAGE(1); G2_BAR(); }
  int kt = 0, ti = 0;
  for (int j = 0; j < J; ++j) {
    const int buf = j & 1;
    const bool tile_end = (kt == nt - 1);
    if (wr == 0) G2_STAGE(j + 1);
    G2_LOADF(buf, 0); G2_BAR();
    G2_MMA(); G2_BAR();
    G2_LOADF(buf, 1); if (wr == 1) G2_WAITV(); G2_BAR();
    if (wr == 1) G2_STAGE(j + 2);
    G2_MMA();
    if (wr == 0) G2_WAITV();
    if (wr == 0 || j + 1 < J) G2_BAR();
    if (tile_end) {
      int pm, pn; G2_PMPN(vb + ti * G, pm, pn);
      if constexpr (Epi::ROWVEC) {
        LAS char* stg = shm + 2 * STG + wid * 2048;
        const int rr = lane >> 3, ch = lane & 7, rbase = G2_ROW0(pm) + wr * (BM / 2) + rr, cbase = pn * 256 + wc * 64 + ch * 8;
        uint4 xin[3][2];
        if constexpr (Epi::PRELOAD) {
#pragma unroll
          for (int m = 0; m < 2; ++m) { xin[m][0] = epi.load8(rbase + m * 16, cbase); xin[m][1] = epi.load8(rbase + m * 16 + 8, cbase); }
        }
#pragma unroll
        for (int m = 0; m < MF; ++m) {
          if constexpr (Epi::PRELOAD) { if (m + 2 < MF) { xin[(m + 2) % 3][0] = epi.load8(rbase + (m + 2) * 16, cbase); xin[(m + 2) % 3][1] = epi.load8(rbase + (m + 2) * 16 + 8, cbase); } }
#pragma unroll
          for (int n = 0; n < 4; ++n) {
            if constexpr (Epi::HAS_PRE) epi.pre(pn * 256 + wc * 64 + n * 16 + 4 * fq, acc[m][n]);
            const u32x2 w = (u32x2){cvt_pk_bf16(acc[m][n][0], acc[m][n][1]), cvt_pk_bf16(acc[m][n][2], acc[m][n][3])};
            *(LAS u32x2*)(stg + fr * 128 + (((n * 2 + (fq >> 1)) ^ (fr & 7)) << 4) + (fq & 1) * 8) = w;
            acc[m][n] = (f32x4){0.f, 0.f, 0.f, 0.f};
          }
          bool tr = false;
          if constexpr (Epi::HAS_T) tr = epi.transposed(pn * 256 + wc * 64);
          if (tr) {
            if constexpr (Epi::HAS_T) {
              unsigned w[8];
#pragma unroll
              for (int k = 0; k < 8; ++k) {
                const unsigned lo = *(const LAS unsigned short*)(stg + (2 * k) * 128 + ((((lane >> 3) ^ ((2 * k) & 7))) << 4) + (lane & 7) * 2);
                const unsigned hi = *(const LAS unsigned short*)(stg + (2 * k + 1) * 128 + ((((lane >> 3) ^ ((2 * k + 1) & 7))) << 4) + (lane & 7) * 2);
                w[k] = lo | (hi << 16);
              }
              epi.col16(G2_ROW0(pm) + wr * (BM / 2) + m * 16, pn * 256 + wc * 64 + lane, w);
            }
          } else {
#pragma unroll
          for (int i = 0; i < 2; ++i) {
            const int row = rr + 8 * i;
            const u32x4 v = *(const LAS u32x4*)(stg + row * 128 + ((ch ^ (row & 7)) << 4));
            if constexpr (Epi::PRELOAD) epi.row8(rbase + m * 16 + 8 * i, cbase, v, xin[m % 3][i]); else epi.row8(rbase + m * 16 + 8 * i, cbase, v);
          }
          }
          asm volatile("" ::: "memory");
        }
      } else {
      const int row0 = G2_ROW0(pm) + wr * (BM / 2) + fq * 4, col0 = pn * 256 + wc * 64 + fr;
#pragma unroll
      for (int m = 0; m < MF; ++m) {
#pragma unroll
        for (int n = 0; n < 4; ++n) { epi(row0 + m * 16, col0 + n * 16, acc[m][n]); acc[m][n] = (f32x4){0.f, 0.f, 0.f, 0.f}; }
        asm volatile("" ::: "memory");
      }
      }
      kt = 0; ++ti;
    } else ++kt;
  }
#undef G2_PMPN
#undef G2_ROW0
#undef G2_STAGE
#undef G2_BAR
#undef G2_WAITV
#undef G2_LOADF
#undef G2_MMA
}
template <class Epi>
DEV void gemm256s(const bf16_t* A, int lda, const bf16_t* Bt, int ldb, int M, int N, int K, const Epi& epi, LAS char* shm, bool rev = false, bool seqonly = false) { gemm256s_t<256, Epi>(A, lda, Bt, ldb, M, N, K, epi, shm, rev, seqonly); }


DEV int pg_perm32(int rho) { const int n = rho >> 4, i = rho & 15; return 8 * (i >> 2) + 4 * n + (i & 3); }
struct PgUnit { int pm, pn; };
DEV bool pg_next(int nM, int nN, int G, int c, int i, PgUnit& u) {
  const int nwg = nM * nN; const long L = (long)i * G + c; if (L >= nwg) return false;
  int wgid = (int)L; { const int q = nwg / 8, r = nwg % 8, xcd = wgid % 8, off = wgid / 8; wgid = (xcd < r ? xcd * (q + 1) : r * (q + 1) + (xcd - r) * q) + off; }
  const int nig = 8 * nN, gid = wgid / nig, fm = gid * 8, gsz = (nM - fm) < 8 ? (nM - fm) : 8;
  u.pm = fm + ((wgid % nig) % gsz); u.pn = (wgid % nig) / gsz; return true;
}
template <class Epi>
DEV void pg_epilogue(const Epi& E, f32x4 (&acc)[2][2][4][2], const PgUnit& u, int wr, int wc, int fr, int fq, LAS char* stg, int lane) {
  const int row0 = u.pm * 256 + wr * 64 + fr, col0 = u.pn * 256 + wc * 32 + 8 * fq;
  bool tr = false;
  if constexpr (Epi::HAS_T) tr = E.transposed(u.pn * 256 + wc * 32);
  if (tr) {
    if constexpr (Epi::HAS_T) {
#pragma unroll
      for (int ai = 0; ai < 2; ++ai)
#pragma unroll
        for (int m = 0; m < 4; ++m)
#pragma unroll
          for (int bj = 0; bj < 2; ++bj) {
            const f32x4 v0 = acc[ai][bj][m][0], v1 = acc[ai][bj][m][1];
            *(LAS u32x4*)(stg + fr * 64 + ((fq ^ ((fr >> 1) & 3)) << 4)) = (u32x4){cvt_pk_bf16(v0[0], v0[1]), cvt_pk_bf16(v0[2], v0[3]), cvt_pk_bf16(v1[0], v1[1]), cvt_pk_bf16(v1[2], v1[3])};
            const int col = lane & 31, hf = lane >> 5;
            unsigned w[4];
#pragma unroll
            for (int k = 0; k < 4; ++k) {
              const int r0 = 8 * hf + 2 * k, r1 = r0 + 1;
              const unsigned lo = *(const LAS unsigned short*)(stg + r0 * 64 + (((col >> 3) ^ ((r0 >> 1) & 3)) << 4) + (col & 7) * 2);
              const unsigned hi = *(const LAS unsigned short*)(stg + r1 * 64 + (((col >> 3) ^ ((r1 >> 1) & 3)) << 4) + (col & 7) * 2);
              w[k] = lo | (hi << 16);
            }
            E.col8(u.pm * 256 + ai * 128 + wr * 64 + m * 16 + 8 * hf, u.pn * 256 + bj * 128 + wc * 32 + col, (u32x4){w[0], w[1], w[2], w[3]});
            asm volatile("" ::: "memory");
          }
    }
  } else {
    uint4 xin[3];
#define PG_RC(i_, r_, c_) const int r_ = row0 + ((i_) >> 3) * 128 + (((i_) >> 1) & 3) * 16, c_ = col0 + ((i_) & 1) * 128
    if constexpr (Epi::PRELOAD) { { PG_RC(0, r, c); xin[0] = E.load8(r, c); } { PG_RC(1, r, c); xin[1] = E.load8(r, c); } }
#pragma unroll
    for (int i = 0; i < 16; ++i) {
      if constexpr (Epi::PRELOAD) { if (i + 2 < 16) { PG_RC(i + 2, r2, c2); xin[(i + 2) % 3] = E.load8(r2, c2); } }
      PG_RC(i, r, c);
      f32x4 v0 = acc[i >> 3][i & 1][(i >> 1) & 3][0], v1 = acc[i >> 3][i & 1][(i >> 1) & 3][1];
      if constexpr (Epi::HAS_PRE) { E.pre(c, v0); E.pre(c + 4, v1); }
      const u32x4 w = (u32x4){cvt_pk_bf16(v0[0], v0[1]), cvt_pk_bf16(v0[2], v0[3]), cvt_pk_bf16(v1[0], v1[1]), cvt_pk_bf16(v1[2], v1[3])};
      if constexpr (Epi::PRELOAD) E.row8(r, c, w, xin[i % 3]); else E.row8(r, c, w);
      asm volatile("" ::: "memory");
    }
#undef PG_RC
  }
}
template <class Epi>
DEV void gemm_pg8(const bf16_t* A, const bf16_t* Bt, int M, int N, int K, const Epi& E, LAS char* lds, bool rev = false, bool seqonly = false) {
  constexpr int HALF = 128, HTB = HALF * 64 * 2;
  const int tid = TIDX, wid = __builtin_amdgcn_readfirstlane(tid >> 6), lane = tid & 63, wr = wid >> 2, wc = wid & 3, fr = lane & 15, fq = lane >> 4;
  const int nt = K / 64, nM = seqonly ? NB * (SEQ / 256) : M / 256, nN = N / 256, G = gridDim.x, cidx = rev ? (int)gridDim.x - 1 - BIDX : BIDX;
  unsigned voffA[2], voffB[2];
#pragma unroll
  for (int i = 0; i < 2; ++i) { int R, C; stage_rc2(tid * 16 + i * 8192, R, C); const int Rb = (R & ~31) + pg_perm32(R & 31);
    voffA[i] = (unsigned)(R * K + C) * 2u; voffB[i] = (unsigned)(Rb * K + C) * 2u; }
  const size_t kstep = (size_t)(64 * 2), hstep = (size_t)HALF * K * 2, tstep = 2 * hstep;
  const unsigned ldsw = (unsigned)wid * 1024u;
  const int aoff = lds_byte2(wr * 64 + fr, fq * 8), boff = lds_byte2(wc * 32 + fr, fq * 8);
#define PG8_SA(b, h) (((b) * 2 + (h)) * HTB)
#define PG8_SB(b, h) ((4 + (b) * 2 + (h)) * HTB)
#define PG8_STAGE(bufoff, gbase, voff) do { _Pragma("unroll") for (int _i = 0; _i < 2; ++_i) \
    __builtin_amdgcn_global_load_lds((const unsigned*)((const char*)(gbase) + (voff)[_i]), (LAS unsigned*)(lds + (bufoff) + ldsw + _i * 8192), 16, 0, 0); } while (0)
#define PG8_LDA(dst, b, h) do { _Pragma("unroll") for (int m = 0; m < 4; ++m) _Pragma("unroll") for (int k = 0; k < 2; ++k) dst[m][k] = *(const LAS bf16x8*)(lds + PG8_SA(b, h) + aoff + m * 2048 + k * 1024); } while (0)
#define PG8_LDB(dst, b, h) do { _Pragma("unroll") for (int n = 0; n < 2; ++n) _Pragma("unroll") for (int k = 0; k < 2; ++k) dst[n][k] = *(const LAS bf16x8*)(lds + PG8_SB(b, h) + boff + n * 2048 + k * 1024); } while (0)
#define PG8_MMA(ai, bj, At_, Bt_) do { __builtin_amdgcn_s_setprio(1); _Pragma("unroll") for (int m = 0; m < 4; ++m) _Pragma("unroll") for (int n = 0; n < 2; ++n) _Pragma("unroll") for (int k = 0; k < 2; ++k) \
    acc[ai][bj][m][n] = __builtin_amdgcn_mfma_f32_16x16x32_bf16(Bt_[n][k], At_[m][k], acc[ai][bj][m][n], 0, 0, 0); __builtin_amdgcn_s_setprio(0); } while (0)
#define PG8_WAIT_V(n) asm volatile("s_waitcnt vmcnt(" #n ")" ::: "memory")
#define PG8_WAIT_L(n) asm volatile("s_waitcnt lgkmcnt(" #n ")" ::: "memory")
#define PG8_BAR __builtin_amdgcn_s_barrier()
#define PG8_SCHED __builtin_amdgcn_sched_barrier(0)
  PgUnit cur, nxt; int ui = 0;
  PG8_WAIT_V(0); PG8_WAIT_L(0); PG8_BAR;
#define PG_SEQ(u_) do { if (seqonly) (u_).pm = ((u_).pm >> 3) * 9 + 1 + ((u_).pm & 7); } while (0)
  if (!pg_next(nM, nN, G, cidx, 0, cur)) return;
  PG_SEQ(cur);
  f32x4 acc[2][2][4][2];
#pragma unroll
  for (int a = 0; a < 2; ++a)
#pragma unroll
    for (int b = 0; b < 2; ++b)
#pragma unroll
      for (int m = 0; m < 4; ++m)
#pragma unroll
        for (int n = 0; n < 2; ++n) acc[a][b][m][n] = (f32x4){0.f, 0.f, 0.f, 0.f};
  bf16x8 At[4][2], B0[2][2], B1[2][2];
  const char* cA = (const char*)A + (size_t)cur.pm * tstep; const char* cB = (const char*)Bt + (size_t)cur.pn * tstep;
  PG8_STAGE(PG8_SB(0, 0), cB, voffB); PG8_STAGE(PG8_SA(0, 0), cA, voffA); PG8_STAGE(PG8_SB(0, 1), cB + hstep, voffB); PG8_STAGE(PG8_SA(0, 1), cA + hstep, voffA);
  if (wr == 1) PG8_BAR;
  PG8_WAIT_V(4); PG8_BAR;
  PG8_STAGE(PG8_SB(1, 0), cB + kstep, voffB); PG8_STAGE(PG8_SA(1, 0), cA + kstep, voffA); PG8_STAGE(PG8_SB(1, 1), cB + hstep + kstep, voffB);
  PG8_WAIT_V(6); PG8_BAR;
  for (;;) {
    const bool has_next = pg_next(nM, nN, G, cidx, ui + 1, nxt); if (has_next) PG_SEQ(nxt);
    const char* nA = has_next ? (const char*)A + (size_t)nxt.pm * tstep : cA; const char* nB = has_next ? (const char*)Bt + (size_t)nxt.pn * tstep : cB;
    for (int t = 0; t < nt; t += 2) {
      const bool last = (t == nt - 2);
      const char* a1 = cA + (size_t)(t + 1) * kstep;
      const char* a2 = last ? nA : cA + (size_t)(t + 2) * kstep; const char* b2 = last ? nB : cB + (size_t)(t + 2) * kstep;
      const char* a3 = a2 + kstep; const char* b3 = b2 + kstep;
      PG8_LDB(B0, 0, 0); PG8_SCHED; PG8_LDA(At, 0, 0); PG8_STAGE(PG8_SA(1, 1), a1 + hstep, voffA);
      PG8_WAIT_L(8); PG8_BAR; PG8_WAIT_L(0); PG8_MMA(0, 0, At, B0); PG8_BAR; PG8_SCHED;
      PG8_LDB(B1, 0, 1); PG8_STAGE(PG8_SB(0, 0), b2, voffB);
      PG8_BAR; PG8_WAIT_L(0); PG8_MMA(0, 1, At, B1); PG8_BAR;
      PG8_LDA(At, 0, 1); PG8_STAGE(PG8_SA(0, 0), a2, voffA);
      PG8_BAR; PG8_WAIT_L(0); PG8_MMA(1, 0, At, B0); PG8_BAR; PG8_SCHED;
      PG8_STAGE(PG8_SB(0, 1), b2 + hstep, voffB);
      PG8_WAIT_V(6); PG8_BAR; PG8_MMA(1, 1, At, B1); PG8_BAR;
      PG8_LDB(B0, 1, 0); PG8_SCHED; PG8_LDA(At, 1, 0); PG8_STAGE(PG8_SA(0, 1), a2 + hstep, voffA);
      PG8_WAIT_L(8); PG8_BAR; PG8_WAIT_L(0); PG8_MMA(0, 0, At, B0); PG8_BAR; PG8_SCHED;
      PG8_LDB(B1, 1, 1); PG8_STAGE(PG8_SB(1, 0), b3, voffB);
      PG8_BAR; PG8_WAIT_L(0); PG8_MMA(0, 1, At, B1); PG8_BAR;
      PG8_LDA(At, 1, 1); PG8_STAGE(PG8_SA(1, 0), a3, voffA);
      PG8_BAR; PG8_WAIT_L(0); PG8_MMA(1, 0, At, B0); PG8_BAR; PG8_SCHED;
      PG8_STAGE(PG8_SB(1, 1), b3 + hstep, voffB);
      PG8_WAIT_V(6); PG8_BAR; PG8_MMA(1, 1, At, B1); PG8_BAR;
    }
    pg_epilogue(E, acc, cur, wr, wc, fr, fq, lds + 131072 + wid * 2048, lane);
    if (!has_next) break;
#pragma unroll
    for (int a = 0; a < 2; ++a)
#pragma unroll
      for (int b = 0; b < 2; ++b)
#pragma unroll
        for (int m = 0; m < 4; ++m)
#pragma unroll
          for (int n = 0; n < 2; ++n) acc[a][b][m][n] = (f32x4){0.f, 0.f, 0.f, 0.f};
    cur = nxt; cA = nA; cB = nB; ++ui;
  }
  PG8_WAIT_V(0);
  if (wr == 0) PG8_BAR;
  PG8_BAR;
#undef PG_SEQ
#undef PG8_SA
#undef PG8_SB
#undef PG8_STAGE
#undef PG8_LDA
#undef PG8_LDB
#undef PG8_MMA
#undef PG8_WAIT_V
#undef PG8_WAIT_L
#undef PG8_BAR
#undef PG8_SCHED
}

struct EpiStoreBf16 { static constexpr bool ROWVEC = false; static constexpr bool HAS_PRE = false; static constexpr bool HAS_T = false; static constexpr bool PRELOAD = false; bf16_t* C; int ldc; int ncols; DEV void operator()(int r, int c, f32x4 v) const { if (c < ncols) {
#pragma unroll
    for (int j = 0; j < 4; ++j) C[(size_t)(r + j) * ldc + c] = f2bf(v[j]); } } };
struct EpiStoreF32 { static constexpr bool ROWVEC = false; static constexpr bool HAS_PRE = false; static constexpr bool HAS_T = false; static constexpr bool PRELOAD = false; float* C; int ldc; DEV void operator()(int r, int c, f32x4 v) const {
#pragma unroll
    for (int j = 0; j < 4; ++j) C[(size_t)(r + j) * ldc + c] = v[j]; } };
struct EpiQ { static constexpr bool ROWVEC = false; static constexpr bool HAS_PRE = false; static constexpr bool HAS_T = false; static constexpr bool PRELOAD = false; bf16_t* QF; DEV void operator()(int r, int c, f32x4 v) const { const int b = r / SP, s = r - b * SP, h = c / 96, d = c - h * 96;
#pragma unroll
    for (int j = 0; j < 4; ++j) QF[((size_t)(b * 16 + h) * SP + s + j) * 96 + d] = f2bf(v[j]); } };
struct EpiKV { static constexpr bool ROWVEC = false; static constexpr bool HAS_PRE = false; static constexpr bool HAS_T = false; static constexpr bool PRELOAD = false; bf16_t* KF; bf16_t* VT; DEV void operator()(int r, int c, f32x4 v) const { const int b = r / SP, s = r - b * SP, h = c >> 7, d = c & 127;
    if (d < 64) {
#pragma unroll
      for (int j = 0; j < 4; ++j) KF[((size_t)(b * 16 + h) * SP + s + j) * 64 + d] = f2bf(v[j]);
    } else { uint2 w; w.x = cvt_pk_bf16(v[0], v[1]); w.y = cvt_pk_bf16(v[2], v[3]);
      *(uint2*)(VT + ((size_t)(b * 16 + h) * 64 + d - 64) * SP + s) = w; } } };
struct EpiRes { static constexpr bool ROWVEC = false; static constexpr bool HAS_PRE = false; static constexpr bool HAS_T = false; static constexpr bool PRELOAD = true; bf16_t* xc; bf16_t* xl; const float* ada; int layer; int goff; bool last;
  DEV bf16_t* xptr(int r, int c) const { const int b = r / SP, s = r - b * SP; return s < CTX ? (last ? nullptr : xc + ((size_t)(b * CTX + s)) * D + c) : xl + ((size_t)(b * SEQ + s - CTX)) * D + c; }
  DEV f32x4 load(int r, int c) const { const bf16_t* xp = xptr(r, c); f32x4 x = (f32x4){0.f, 0.f, 0.f, 0.f};
    if (xp) { x[0] = bf2f(xp[0]); x[1] = bf2f(xp[D]); x[2] = bf2f(xp[2 * D]); x[3] = bf2f(xp[3 * D]); } return x; }
  DEV void store(int r, int c, f32x4 v, f32x4 x) const { bf16_t* xp = xptr(r, c); if (!xp) return;
    const int b = r / SP, s = r - b * SP; const float g = ada[((size_t)(layer * 17 + (s < CTX ? 16 : b))) * 6144 + goff + c];
    xp[0] = f2bf(x[0] + g * v[0]); xp[D] = f2bf(x[1] + g * v[1]); xp[2 * D] = f2bf(x[2] + g * v[2]); xp[3 * D] = f2bf(x[3] + g * v[3]); } };
struct EpiStoreBf16R { static constexpr bool ROWVEC = true; static constexpr bool PRELOAD = false; static constexpr bool HAS_PRE = false; static constexpr bool HAS_T = false; bf16_t* C; int ldc; int ncols;
  DEV void row8(int r, int c, u32x4 v) const { if (c < ncols) *(uint4*)(C + (size_t)r * ldc + c) = make_uint4(v[0], v[1], v[2], v[3]); } };
struct EpiResR { static constexpr bool ROWVEC = true; static constexpr bool PRELOAD = true; static constexpr bool HAS_PRE = false; static constexpr bool HAS_T = false; bf16_t* xc; bf16_t* xl; const float* ada; int layer; int goff; bool last;
  DEV bf16_t* xptr(int r, int c) const { const int b = r / SP, s = r - b * SP; return s < CTX ? (last ? nullptr : xc + ((size_t)(b * CTX + s)) * D + c) : xl + ((size_t)(b * SEQ + s - CTX)) * D + c; }
  DEV uint4 load8(int r, int c) const { const bf16_t* xp = xptr(r, c); return xp ? *(const uint4*)xp : make_uint4(0u, 0u, 0u, 0u); }
  DEV void row8(int r, int c, u32x4 v, uint4 x) const { bf16_t* xp = xptr(r, c); if (!xp) return;
    const int b = r / SP, s = r - b * SP; const float* gp = ada + ((size_t)(layer * 17 + (s < CTX ? 16 : b))) * 6144 + goff + c;
    const float4 g0 = *(const float4*)gp, g1 = *(const float4*)(gp + 4);
    const unsigned xv[4] = {x.x, x.y, x.z, x.w}; const float g[8] = {g0.x, g0.y, g0.z, g0.w, g1.x, g1.y, g1.z, g1.w};
    unsigned o[4];
#pragma unroll
    for (int i = 0; i < 4; ++i) {
      const float lo = __uint_as_float(xv[i] << 16) + g[2 * i] * __uint_as_float(v[i] << 16), hi = __uint_as_float(xv[i] & 0xffff0000u) + g[2 * i + 1] * __uint_as_float(v[i] & 0xffff0000u);
      o[i] = cvt_pk_bf16(lo, hi); }
    *(uint4*)xp = make_uint4(o[0], o[1], o[2], o[3]); } };
struct EpiGla { static constexpr bool ROWVEC = false; static constexpr bool HAS_PRE = false; static constexpr bool HAS_T = false; static constexpr bool PRELOAD = false; bf16_t* QKVG; bf16_t* LG; const float* gkb; bf16_t* VTG;
  DEV void operator()(int r, int c, f32x4 v) const {
    if (c >= 1024 && c < 2048) { const int b = r / SP, s = r - b * SP; uint2 w; w.x = cvt_pk_bf16(v[0], v[1]); w.y = cvt_pk_bf16(v[2], v[3]);
      *(uint2*)(VTG + ((size_t)b * 1024 + c - 1024) * SP + s) = w; }
    else if (c < 3072) { const float sc = c < 512 ? 0.08838834764831845f : 1.0f;
#pragma unroll
      for (int j = 0; j < 4; ++j) QKVG[(size_t)(r + j) * 3072 + c] = f2bf(v[j] * sc); }
    else { const int d = (c - 3072) >> 9, n = (c - 3072) & 511; const float bias = gkb[d * 512 + n];
#pragma unroll
      for (int j = 0; j < 4; ++j) { const float z = v[j] + bias; const float ls = fminf(z, 0.f) - __logf(1.f + __expf(-fabsf(z)));
        LG[((size_t)d * T + r + j) * 512 + n] = f2bf(ls * (1.0f / 16.0f)); } } } };

struct EpiQR { static constexpr bool ROWVEC = true; static constexpr bool PRELOAD = false; static constexpr bool HAS_PRE = false; static constexpr bool HAS_T = false; bf16_t* QF;
  DEV void row8(int r, int c, u32x4 v) const { const int b = r / SP, s = r - b * SP, h = c / 96, d = c - h * 96;
    *(uint4*)(QF + ((size_t)(b * 16 + h) * SP + s) * 96 + d) = make_uint4(v[0], v[1], v[2], v[3]); } };
struct EpiKVR { static constexpr bool ROWVEC = true; static constexpr bool PRELOAD = false; static constexpr bool HAS_PRE = false; static constexpr bool HAS_T = true; bf16_t* KF; bf16_t* VT;
  DEV bool transposed(int c) const { return (c & 64) != 0; }
  DEV void row8(int r, int c, u32x4 v) const { const int b = r / SP, s = r - b * SP, h = c >> 7, d = c & 127;
    *(uint4*)(KF + ((size_t)(b * 16 + h) * SP + s) * 64 + d) = make_uint4(v[0], v[1], v[2], v[3]); }
  DEV void col16(int r, int c, const unsigned (&w)[8]) const { const int b = r / SP, s = r - b * SP, h = c >> 7, d = c & 127;
    bf16_t* vp = VT + ((size_t)(b * 16 + h) * 64 + d - 64) * SP + s;
    *(uint4*)vp = make_uint4(w[0], w[1], w[2], w[3]); *(uint4*)(vp + 8) = make_uint4(w[4], w[5], w[6], w[7]); }
  DEV void col8(int r, int c, u32x4 w) const { const int b = r / SP, s = r - b * SP, h = c >> 7, d = c & 127;
    *(uint4*)(VT + ((size_t)(b * 16 + h) * 64 + d - 64) * SP + s) = make_uint4(w[0], w[1], w[2], w[3]); } };
struct EpiGluResR { static constexpr bool ROWVEC = true; static constexpr bool PRELOAD = true; static constexpr bool HAS_PRE = false; static constexpr bool HAS_T = false; bf16_t* xc; bf16_t* xl; const float* ada; int layer;
  DEV bf16_t* xptr(int r, int c) const { const int b = r / SP, s = r - b * SP; return s < CTX ? xc + ((size_t)(b * CTX + s)) * D + c : xl + ((size_t)(b * SEQ + s - CTX)) * D + c; }
  DEV uint4 load8(int r, int c) const { const uint2 x = *(const uint2*)xptr(r, c >> 1); return make_uint4(x.x, x.y, 0u, 0u); }
  DEV void row8(int r, int c, u32x4 v, uint4 x) const { const int oc = c >> 1; bf16_t* xp = xptr(r, oc);
    const int b = r / SP, s = r - b * SP; const float4 g1 = *(const float4*)(ada + ((size_t)(layer * 17 + (s < CTX ? 16 : b))) * 6144 + 2048 + oc);
    const float g[4] = {g1.x, g1.y, g1.z, g1.w}; const unsigned xv[2] = {x.x, x.y};
    float o[4];
#pragma unroll
    for (int i = 0; i < 4; ++i) { const float a = __uint_as_float(v[i] << 16), gt = __uint_as_float(v[i] & 0xffff0000u);
      const float xo = (i & 1) ? __uint_as_float(xv[i >> 1] & 0xffff0000u) : __uint_as_float(xv[i >> 1] << 16);
      o[i] = xo + g[i] * a * sigm(gt); }
    *(uint2*)xp = make_uint2(cvt_pk_bf16(o[0], o[1]), cvt_pk_bf16(o[2], o[3])); } };
struct EpiGlaR { static constexpr bool ROWVEC = true; static constexpr bool PRELOAD = false; static constexpr bool HAS_PRE = true; static constexpr bool HAS_T = true; bf16_t* QKVG; bf16_t* LG; const float* gkb; bf16_t* VTG;
  DEV void pre(int c, f32x4& v) const {
    if (c < 512) { v[0] *= 0.08838834764831845f; v[1] *= 0.08838834764831845f; v[2] *= 0.08838834764831845f; v[3] *= 0.08838834764831845f; }
    else if (c >= 3072) { const float4 bias = *(const float4*)(gkb + c - 3072); const float bb[4] = {bias.x, bias.y, bias.z, bias.w};
#pragma unroll
      for (int j = 0; j < 4; ++j) { const float z = v[j] + bb[j]; v[j] = (fminf(z, 0.f) - __logf(1.f + __expf(-fabsf(z)))) * (1.0f / 16.0f); } } }
  DEV bool transposed(int c) const { return c >= 1024 && c < 2048; }
  DEV void row8(int r, int c, u32x4 v) const {
    if (c < 3072) *(uint4*)(QKVG + (size_t)r * 3072 + c) = make_uint4(v[0], v[1], v[2], v[3]);
    else { const int d = (c - 3072) >> 9, n = (c - 3072) & 511; *(uint4*)(LG + ((size_t)d * T + r) * 512 + n) = make_uint4(v[0], v[1], v[2], v[3]); } }
  DEV void col16(int r, int c, const unsigned (&w)[8]) const { const int b = r / SP, s = r - b * SP;
    bf16_t* vp = VTG + ((size_t)b * 1024 + c - 1024) * SP + s;
    *(uint4*)vp = make_uint4(w[0], w[1], w[2], w[3]); *(uint4*)(vp + 8) = make_uint4(w[4], w[5], w[6], w[7]); }
  DEV void col8(int r, int c, u32x4 w) const { const int b = r / SP, s = r - b * SP;
    *(uint4*)(VTG + ((size_t)b * 1024 + c - 1024) * SP + s) = make_uint4(w[0], w[1], w[2], w[3]); } };
DEV void phase_mla_norm(CP p, int j) {
  const bf16_t* A1 = (const bf16_t*)(p.scratch + OFF_A1); bf16_t* CQN = (bf16_t*)(p.scratch + OFF_CQN); bf16_t* CKVN = (bf16_t*)(p.scratch + OFF_CKVN); bf16_t* KPE = (bf16_t*)(p.scratch + OFF_KPE);
  const int lane = TIDX & 63, gw = BIDX * (NTHR / 64) + __builtin_amdgcn_readfirstlane(TIDX >> 6), nw = gridDim.x * (NTHR / 64);
  const float* qn = p.mla_q_norm + j * 384; const float* kn = p.mla_kv_norm + j * 256;
  for (int t0 = gw; t0 < T; t0 += 2 * nw) {
    float v[2][6], w[2][4], val[2];
#pragma unroll
    for (int u = 0; u < 2; ++u) { const int t = t0 + u * nw; if (t < T) { const bf16_t* a = A1 + (size_t)t * 768;
#pragma unroll
      for (int i = 0; i < 6; ++i) v[u][i] = bf2f(a[lane + 64 * i]);
#pragma unroll
      for (int i = 0; i < 4; ++i) w[u][i] = bf2f(a[384 + lane + 64 * i]);
      val[u] = bf2f(a[640 + (lane & 31)]); } }
#pragma unroll
    for (int u = 0; u < 2; ++u) { const int t = t0 + u * nw; if (t < T) {
      float ss = 0.f;
#pragma unroll
      for (int i = 0; i < 6; ++i) ss += v[u][i] * v[u][i];
      ss = wave_sum(ss); float rstd = rsqrtf(ss * (1.0f / 384.0f) + 1e-6f);
#pragma unroll
      for (int i = 0; i < 6; ++i) CQN[(size_t)t * 384 + lane + 64 * i] = f2bf(v[u][i] * rstd * qn[lane + 64 * i]);
      ss = 0.f;
#pragma unroll
      for (int i = 0; i < 4; ++i) ss += w[u][i] * w[u][i];
      ss = wave_sum(ss); rstd = rsqrtf(ss * (1.0f / 256.0f) + 1e-6f);
#pragma unroll
      for (int i = 0; i < 4; ++i) CKVN[(size_t)t * 256 + lane + 64 * i] = f2bf(w[u][i] * rstd * kn[lane + 64 * i]);
      const int b = t / SP, s = t - b * SP;
      float vl = val[u];
      const float other = __shfl_xor(vl, 8);
      if (s >= CTX) { const int pos = s - CTX, d = lane & 31, hb = d >> 4, dd = d & 15, i = dd & 7;
        const float cs = p.rope[pos * 32 + hb * 16 + i], sn = p.rope[pos * 32 + hb * 16 + 8 + i];
        vl = dd < 8 ? vl * cs - other * sn : vl * cs + other * sn; }
      if (lane < 32) KPE[(size_t)t * 32 + lane] = f2bf(vl);
    } }
  }
}

DEV void phase_attn_naive(CP p, bool last, float* lds) {
  const bf16_t* QF = (const bf16_t*)(p.scratch + OFF_QF); const bf16_t* KF = (const bf16_t*)(p.scratch + OFF_KF); const bf16_t* VF = (const bf16_t*)(p.scratch + OFF_VF);
  bf16_t* O = (bf16_t*)(p.scratch + OFF_O);
  float* Ks = lds;
  float* Vs = lds + 32 * 96;
  const int tid = TIDX;
  const int nitems = 1024 + (last ? 0 : 256);
  for (int item = BIDX; item < nitems; item += gridDim.x) {
    int b, hh, q0, nq, nkeys;
    if (item < 1024) { b = item >> 6; hh = (item >> 2) & 15; q0 = CTX + (item & 3) * 512; nq = 512; nkeys = SP; }
    else { const int it = item - 1024; b = it >> 4; hh = it & 15; q0 = 0; nq = 256; nkeys = CTX; }
    const size_t bh = (size_t)(b * 16 + hh) * SP;
    const bool active = tid < nq;
    const int sq = q0 + (active ? tid : 0);
    float q[96];
    { const bf16_t* qp = QF + (bh + sq) * 96;
#pragma unroll
      for (int i = 0; i < 96; i += 2) { const unsigned u = *(const unsigned*)(qp + i); q[i] = __uint_as_float(u << 16); q[i + 1] = __uint_as_float(u & 0xffff0000u); } }
    if (sq >= CTX) { const float* r = p.rope + (sq - CTX) * 32;
#pragma unroll
      for (int hb = 0; hb < 2; ++hb)
#pragma unroll
        for (int i = 0; i < 8; ++i) { const float cs = r[hb * 16 + i], sn = r[hb * 16 + 8 + i], x1 = q[64 + hb * 16 + i], x2 = q[64 + hb * 16 + 8 + i];
          q[64 + hb * 16 + i] = x1 * cs - x2 * sn; q[64 + hb * 16 + 8 + i] = x2 * cs + x1 * sn; } }
#pragma unroll
    for (int i = 0; i < 96; ++i) q[i] *= 0.10206207261596577f;
    float acc[64], m = -1e30f, l = 0.f;
#pragma unroll
    for (int i = 0; i < 64; ++i) acc[i] = 0.f;
    for (int k0 = 0; k0 < nkeys; k0 += 32) {
      __syncthreads();
      for (int idx = tid; idx < 32 * 96 / 2; idx += NTHR) { const unsigned u = *(const unsigned*)(KF + (bh + k0) * 96 + idx * 2); Ks[idx * 2] = __uint_as_float(u << 16); Ks[idx * 2 + 1] = __uint_as_float(u & 0xffff0000u); }
      for (int idx = tid; idx < 32 * 64 / 2; idx += NTHR) { const unsigned u = *(const unsigned*)(VF + (bh + k0) * 64 + idx * 2); Vs[idx * 2] = __uint_as_float(u << 16); Vs[idx * 2 + 1] = __uint_as_float(u & 0xffff0000u); }
      __syncthreads();
#pragma unroll 1
      for (int kk = 0; kk < 32; ++kk) {
        float s = 0.f;
#pragma unroll
        for (int i = 0; i < 96; i += 4) { const float4 kv = *(const float4*)(Ks + kk * 96 + i); s += q[i] * kv.x + q[i + 1] * kv.y + q[i + 2] * kv.z + q[i + 3] * kv.w; }
        if (s > m) { const float corr = __expf(m - s); l *= corr;
#pragma unroll
          for (int i = 0; i < 64; ++i) acc[i] *= corr;
          m = s; }
        const float pe = __expf(s - m); l += pe;
#pragma unroll
        for (int i = 0; i < 64; i += 4) { const float4 vv = *(const float4*)(Vs + kk * 64 + i); acc[i] += pe * vv.x; acc[i + 1] += pe * vv.y; acc[i + 2] += pe * vv.z; acc[i + 3] += pe * vv.w; }
      }
    }
    if (active) { const float inv = 1.f / l; bf16_t* op = O + ((size_t)(b * SP + sq)) * D + hh * 64;
#pragma unroll
      for (int i = 0; i < 64; i += 2) *(unsigned*)(op + i) = cvt_pk_bf16(acc[i] * inv, acc[i + 1] * inv); }
  }
}


DEV void phase_attn_mfma(CP p, bool last, LAS char* shm) {
  const bf16_t* QF = (const bf16_t*)(p.scratch + OFF_QF); const bf16_t* KF = (const bf16_t*)(p.scratch + OFF_KF); const bf16_t* VT = (const bf16_t*)(p.scratch + OFF_VF);
  bf16_t* O = (bf16_t*)(p.scratch + OFF_O); const bf16_t* KPE = (const bf16_t*)(p.scratch + OFF_KPE);
  constexpr int KSTR = 208, VSTR = 136, KBYTES = 64 * KSTR, VBYTES = 64 * VSTR;
  const int tid = TIDX, wid = __builtin_amdgcn_readfirstlane(tid >> 6), lane = tid & 63, ql = lane & 31, hh = lane >> 5;
  const int nitems = 2048 + (last ? 0 : 256), G = gridDim.x;
  const int k_idx0 = tid, k_idx1 = tid + 512;
  const int vd = tid >> 3, vpart = tid & 7;
  const int bid_ = BIDX, vb_ = (G & 7) ? bid_ : (bid_ & 7) * (G >> 3) + (bid_ >> 3);
  for (int item = vb_; item < nitems; item += G) {
    int b, h, q0, nk;
    if (item < 2048) { b = item >> 7; h = (item >> 3) & 15; q0 = CTX + (item & 7) * 256; nk = SP; }
    else { const int it = item - 2048; b = it >> 4; h = it & 15; q0 = 0; nk = CTX; }
    const size_t bh = (size_t)(b * 16 + h);
    const int sq = q0 + wid * 32 + ql;
    bf16x8 qf[6];
    { const bf16_t* qp = QF + (bh * SP + sq) * 96 + 8 * hh;
      const float qs = 0.10206207261596577f * 1.4426950408889634f;
#pragma unroll
      for (int s = 0; s < 6; ++s) {
        const uint4 w = *(const uint4*)(qp + 16 * s); const unsigned ww[4] = {w.x, w.y, w.z, w.w};
        float v[8];
#pragma unroll
        for (int i = 0; i < 4; ++i) { v[2 * i] = __uint_as_float(ww[i] << 16); v[2 * i + 1] = __uint_as_float(ww[i] & 0xffff0000u); }
        if (s >= 4 && sq >= CTX) { const float* r = p.rope + (sq - CTX) * 32 + (s - 4) * 16;
#pragma unroll
          for (int j = 0; j < 8; ++j) { const float pv = __shfl_xor(v[j], 32), cs = r[j], sn = r[8 + j]; v[j] = hh ? v[j] * cs + pv * sn : v[j] * cs - pv * sn; } }
        unsigned o[4];
#pragma unroll
        for (int i = 0; i < 4; ++i) o[i] = cvt_pk_bf16(v[2 * i] * qs, v[2 * i + 1] * qs);
        qf[s] = __builtin_bit_cast(bf16x8, make_uint4(o[0], o[1], o[2], o[3]));
      } }
    f32x16 oacc[2];
#pragma unroll
    for (int dt = 0; dt < 2; ++dt)
#pragma unroll
      for (int r = 0; r < 16; ++r) oacc[dt][r] = 0.f;
    float m = 0.f, l0 = 0.f, l1 = 0.f, l2 = 0.f, l3 = 0.f;
    const int ntile = nk >> 6;
    uint4 kr0a, kr1a, vra, kr0b, kr1b, vrb;
    const int kp0 = k_idx0 % 12, kk0 = k_idx0 / 12, kp1 = k_idx1 % 12, kk1 = k_idx1 / 12;
    const bf16_t* ksrc0 = kp0 < 8 ? KF + (bh * SP + kk0) * 64 + kp0 * 8 : KPE + ((size_t)b * SP + kk0) * 32 + (kp0 - 8) * 8; const int kst0 = kp0 < 8 ? 64 : 32;
    const bf16_t* ksrc1 = kp1 < 8 ? KF + (bh * SP + kk1) * 64 + kp1 * 8 : KPE + ((size_t)b * SP + kk1) * 32 + (kp1 - 8) * 8; const int kst1 = kp1 < 8 ? 64 : 32;
    const bf16_t* vbase = VT + (bh * 64 + vd) * SP + vpart * 8;
    LAS char* const kw0 = shm + (k_idx0 / 12) * KSTR + (k_idx0 % 12) * 16;
    LAS char* const kw1 = shm + (k_idx1 / 12) * KSTR + (k_idx1 % 12) * 16;
    LAS char* const vw = shm + 2 * KBYTES + vd * VSTR + vpart * 16;
    const LAS char* const kfb = shm + ql * KSTR + 16 * hh;
    const LAS char* const vfb = shm + 2 * KBYTES + ql * VSTR + 8 * hh;
#define ATT_LOAD(R, t_) do { const int k0_ = (t_) * 64; kr0##R = *(const uint4*)(ksrc0 + (size_t)k0_ * kst0); \
      if (k_idx1 < 768) kr1##R = *(const uint4*)(ksrc1 + (size_t)k0_ * kst1); vr##R = *(const uint4*)(vbase + k0_); } while (0)
#define ATT_WRITE(R, ks_, vs_) do { *(LAS u32x4*)(kw0 + (ks_) * KBYTES) = (u32x4){kr0##R.x, kr0##R.y, kr0##R.z, kr0##R.w}; \
      if (k_idx1 < 768) *(LAS u32x4*)(kw1 + (ks_) * KBYTES) = (u32x4){kr1##R.x, kr1##R.y, kr1##R.z, kr1##R.w}; \
      LAS char* vb_ = vw + (vs_) * VBYTES; *(LAS u32x2*)vb_ = (u32x2){vr##R.x, vr##R.y}; *(LAS u32x2*)(vb_ + 8) = (u32x2){vr##R.z, vr##R.w}; } while (0)
#define ATT_STEP(CUR, NXT, KS_NEXT, KS_WRITE, RL, RW) do { \
      if (t + 3 < ntile) ATT_LOAD(RL, t + 3); \
      const LAS char* kb_ = kfb + (KS_NEXT) * KBYTES; const LAS char* vb2_ = vfb + vs * VBYTES; \
      const float ninit_ = -m; \
      _Pragma("unroll") for (int r = 0; r < 16; ++r) { NXT[0][r] = ninit_; NXT[1][r] = ninit_; } \
      bf16x8 kf_[12]; unsigned pw_[16]; \
      kf_[0] = ld_frag_lds(kb_); kf_[1] = ld_frag_lds(kb_ + 32 * KSTR); \
      _Pragma("unroll") for (int i = 0; i < 12; ++i) { \
        if (i + 2 < 12) kf_[i + 2] = ld_frag_lds(kb_ + ((i + 2) & 1) * 32 * KSTR + ((i + 2) >> 1) * 32); \
        NXT[i & 1] = __builtin_amdgcn_mfma_f32_32x32x16_bf16(kf_[i], qf[i >> 1], NXT[i & 1], 0, 0, 0); \
        _Pragma("unroll") for (int j = (16 * i) / 12; j < (16 * (i + 1)) / 12; ++j) { \
          const float ea_ = __builtin_amdgcn_exp2f(CUR[j >> 3][(2 * j) & 15]), eb_ = __builtin_amdgcn_exp2f(CUR[j >> 3][(2 * j + 1) & 15]); \
          if (j & 1) { l2 += ea_; l3 += eb_; } else { l0 += ea_; l1 += eb_; } pw_[j] = cvt_pk_bf16(ea_, eb_); } \
        __builtin_amdgcn_sched_barrier(0); } \
      float mx_ = NXT[0][0]; \
      u32x2 va_[8], vb3_[8]; \
      va_[0] = *(const LAS u32x2*)(vb2_); vb3_[0] = *(const LAS u32x2*)(vb2_ + 16); \
      _Pragma("unroll") for (int i = 0; i < 8; ++i) { \
        if (i + 1 < 8) { const LAS char* vp_ = vb2_ + ((i + 1) & 1) * 32 * VSTR + (((i + 1) >> 1) & 1) * 64 + ((i + 1) >> 2) * 32; va_[i + 1] = *(const LAS u32x2*)vp_; vb3_[i + 1] = *(const LAS u32x2*)(vp_ + 16); } \
        const int kk_ = (i >> 1) & 1, s2_ = i >> 2; \
        const bf16x8 vf_ = __builtin_bit_cast(bf16x8, (u32x4){va_[i].x, va_[i].y, vb3_[i].x, vb3_[i].y}); \
        const bf16x8 pf_ = __builtin_bit_cast(bf16x8, (u32x4){pw_[kk_ * 8 + s2_ * 4], pw_[kk_ * 8 + s2_ * 4 + 1], pw_[kk_ * 8 + s2_ * 4 + 2], pw_[kk_ * 8 + s2_ * 4 + 3]}); \
        oacc[i & 1] = __builtin_amdgcn_mfma_f32_32x32x16_bf16(vf_, pf_, oacc[i & 1], 0, 0, 0); \
        _Pragma("unroll") for (int x = 4 * i; x < 4 * i + 4; ++x) mx_ = fmaxf(mx_, NXT[x >> 4][x & 15]); \
        __builtin_amdgcn_sched_barrier(0); } \
      mx_ = fmaxf(mx_, __shfl_xor(mx_, 32)); \
      if (t + 1 < ntile && __any(mx_ > 8.0f)) {              \
        const float delta_ = mx_ > 8.0f ? mx_ : 0.f, corr_ = __builtin_amdgcn_exp2f(-delta_); \
        m += delta_; l0 *= corr_; l1 *= corr_; l2 *= corr_; l3 *= corr_; \
        _Pragma("unroll") for (int r = 0; r < 16; ++r) { oacc[0][r] *= corr_; oacc[1][r] *= corr_; NXT[0][r] -= delta_; NXT[1][r] -= delta_; } } \
      if (t + 2 < ntile) ATT_WRITE(RW, KS_WRITE, vs == 0 ? 2 : vs - 1); \
      vs = vs == 2 ? 0 : vs + 1; ++t; \
      GRAW_BARRIER(); } while (0)
    __syncthreads();
    ATT_LOAD(a, 0); ATT_WRITE(a, 0, 0);
    ATT_LOAD(a, 1); ATT_LOAD(b, 2);
    GRAW_BARRIER();
    f32x16 sa[2], sb[2];
    {
#pragma unroll
      for (int r = 0; r < 16; ++r) { sa[0][r] = 0.f; sa[1][r] = 0.f; }
#pragma unroll
      for (int i = 0; i < 12; ++i) sa[i & 1] = __builtin_amdgcn_mfma_f32_32x32x16_bf16(ld_frag_lds(kfb + (i & 1) * 32 * KSTR + (i >> 1) * 32), qf[i >> 1], sa[i & 1], 0, 0, 0);
      float mx = sa[0][0];
#pragma unroll
      for (int x = 1; x < 32; ++x) mx = fmaxf(mx, sa[x >> 4][x & 15]);
      mx = fmaxf(mx, __shfl_xor(mx, 32));
      m = mx;
#pragma unroll
      for (int r = 0; r < 16; ++r) { sa[0][r] -= mx; sa[1][r] -= mx; }
    }
    ATT_WRITE(a, 1, 1);
    GRAW_BARRIER();
    int t = 0, vs = 0;
    while (t < ntile) {
      ATT_STEP(sa, sb, 1, 0, a, b);
      ATT_STEP(sb, sa, 0, 1, b, a);
    }
#undef ATT_STEP
#undef ATT_LOAD
#undef ATT_WRITE
    float l = (l0 + l1) + (l2 + l3);
    l += __shfl_xor(l, 32);
    const float inv = 1.f / l;
    bf16_t* op = O + ((size_t)(b * SP + sq)) * D + h * 64 + 4 * hh;
#pragma unroll
    for (int dt = 0; dt < 2; ++dt)
#pragma unroll
      for (int g = 0; g < 4; ++g) { uint2 w; w.x = cvt_pk_bf16(oacc[dt][4 * g] * inv, oacc[dt][4 * g + 1] * inv); w.y = cvt_pk_bf16(oacc[dt][4 * g + 2] * inv, oacc[dt][4 * g + 3] * inv);
        *(uint2*)(op + dt * 32 + 8 * g) = w; }
  }
}

#define INSERT16(val, pay, tv, ti) { float s_ = (val); int i_ = (pay); _Pragma("unroll") for (int j_ = 0; j_ < 16; ++j_) { if (s_ > tv[j_]) { float t_ = tv[j_]; tv[j_] = s_; s_ = t_; int u_ = ti[j_]; ti[j_] = i_; i_ = u_; } } }

DEV void phase_peer_subtopk(CP p, int layer, float* lds) {
  const float* PQ = (const float*)(p.scratch + OFF_PQ); float* SV = (float*)(p.scratch + OFF_SV); int* SI = (int*)(p.scratch + OFF_SI);
  const int tid = TIDX;
  for (int item = BIDX; item < 16 * 72; item += gridDim.x) {
    const int hp = item / 72, tb = item - hp * 72, t = tb * 512 + tid;
    __syncthreads();
    const float* kp = p.peer_keys + ((size_t)(layer * 16 + hp)) * 128 * 64;
    for (int idx = tid; idx < 128 * 64 / 4; idx += NTHR) *(float4*)(lds + idx * 4) = *(const float4*)(kp + idx * 4);
    __syncthreads();
    float q[64];
#pragma unroll
    for (int i = 0; i < 64; i += 4) { const float4 v = *(const float4*)(PQ + (size_t)t * 1024 + hp * 64 + i); q[i] = v.x; q[i + 1] = v.y; q[i + 2] = v.z; q[i + 3] = v.w; }
    float tv[16]; int ti[16];
#pragma unroll
    for (int j = 0; j < 16; ++j) { tv[j] = -3.0e38f; ti[j] = 0; }
#pragma unroll 1
    for (int key = 0; key < 128; ++key) {
      float s = 0.f;
#pragma unroll
      for (int i = 0; i < 64; i += 4) { const float4 kv = *(const float4*)(lds + key * 64 + i); s += q[i] * kv.x + q[i + 1] * kv.y + q[i + 2] * kv.z + q[i + 3] * kv.w; }
      INSERT16(s, key, tv, ti);
    }
#pragma unroll
    for (int j = 0; j < 16; ++j) { SV[((size_t)t * 16 + hp) * 16 + j] = tv[j]; SI[((size_t)t * 16 + hp) * 16 + j] = ti[j]; }
  }
}

DEV void phase_peer_final_topk(CP p) {
  const float* SV = (const float*)(p.scratch + OFF_SV); const int* SI = (const int*)(p.scratch + OFF_SI);
  int* EID = (int*)(p.scratch + OFF_EID); float* GATE = (float*)(p.scratch + OFF_GATE);
  for (int idx = BIDX * NTHR + TIDX; idx < T * 8; idx += gridDim.x * NTHR) {
    float a[16], bq[16]; int ia[16], ib[16];
#pragma unroll
    for (int j = 0; j < 16; ++j) { a[j] = SV[(size_t)idx * 32 + j]; ia[j] = SI[(size_t)idx * 32 + j]; bq[j] = SV[(size_t)idx * 32 + 16 + j]; ib[j] = SI[(size_t)idx * 32 + 16 + j]; }
    float tv[16]; int ti[16];
#pragma unroll
    for (int j = 0; j < 16; ++j) { tv[j] = -3.0e38f; ti[j] = 0; }
#pragma unroll
    for (int i0 = 0; i0 < 16; ++i0)
#pragma unroll
      for (int i1 = 0; i1 < 16; ++i1)
        if ((i0 + 1) * (i1 + 1) <= 16) INSERT16(a[i0] + bq[i1], ia[i0] * 128 + ib[i1], tv, ti);
    float e[16], sum = 0.f;
#pragma unroll
    for (int j = 0; j < 16; ++j) { e[j] = __expf(tv[j] - tv[0]); sum += e[j]; }
    const float inv = 1.f / sum;
#pragma unroll
    for (int j = 0; j < 16; ++j) { EID[(size_t)idx * 16 + j] = ti[j]; GATE[(size_t)idx * 16 + j] = e[j] * inv; }
  }
}

DEV void phase_peer_gather(CP p, int layer) {
  const int* EID = (const int*)(p.scratch + OFF_EID); const float* GATE = (const float*)(p.scratch + OFF_GATE);
  const int lane = TIDX & 63, gw = BIDX * (NTHR / 64) + __builtin_amdgcn_readfirstlane(TIDX >> 6), nw = gridDim.x * (NTHR / 64);
  const bool last = layer == 3;
  const float* U = p.peer_u + (size_t)layer * 16384 * 1024; const float* V = p.peer_v + (size_t)layer * 16384 * 1024;
  for (int t = gw; t < T; t += nw) {
    const int b = t / SP, s = t - b * SP;
    if (last && s < CTX) continue;
    float x[16];
    { const bf16_t* hr = p.h + (size_t)t * D;
#pragma unroll
      for (int j = 0; j < 4; ++j) { const uint2 w = *(const uint2*)(hr + j * 256 + lane * 4); x[j * 4] = __uint_as_float(w.x << 16); x[j * 4 + 1] = __uint_as_float(w.x & 0xffff0000u); x[j * 4 + 2] = __uint_as_float(w.y << 16); x[j * 4 + 3] = __uint_as_float(w.y & 0xffff0000u); } }
    float f[16];
#pragma unroll
    for (int i = 0; i < 16; ++i) f[i] = 0.f;
#pragma unroll 2
    for (int e = 0; e < 128; ++e) {
      const int eid = EID[(size_t)t * 128 + e]; const float gate = GATE[(size_t)t * 128 + e];
      const float* ur = U + (size_t)eid * 1024; const float* vr = V + (size_t)eid * 1024;
      float4 uu[4], vv[4];
#pragma unroll
      for (int j = 0; j < 4; ++j) { uu[j] = *(const float4*)(ur + j * 256 + lane * 4); vv[j] = *(const float4*)(vr + j * 256 + lane * 4); }
      float dsum = 0.f;
#pragma unroll
      for (int j = 0; j < 4; ++j) dsum += uu[j].x * x[j * 4] + uu[j].y * x[j * 4 + 1] + uu[j].z * x[j * 4 + 2] + uu[j].w * x[j * 4 + 3];
      dsum = wave_sum(dsum);
      const float w = gate * gelu_tanh(dsum);
#pragma unroll
      for (int j = 0; j < 4; ++j) { f[j * 4] += w * vv[j].x; f[j * 4 + 1] += w * vv[j].y; f[j * 4 + 2] += w * vv[j].z; f[j * 4 + 3] += w * vv[j].w; }
    }
    bf16_t* xr = xrow_ptr(p, t);
    float xv[16]; load_row_bf(xr, lane, xv);
    const float* ad = ada_ptr(p, layer, t);
#pragma unroll
    for (int j = 0; j < 4; ++j) { const float4 g2 = *(const float4*)(ad + 5120 + j * 256 + lane * 4);
      xv[j * 4] += g2.x * f[j * 4]; xv[j * 4 + 1] += g2.y * f[j * 4 + 1]; xv[j * 4 + 2] += g2.z * f[j * 4 + 2]; xv[j * 4 + 3] += g2.w * f[j * 4 + 3]; }
    if (!last) {
      store_row_bf(xr, lane, xv);
      const float* ad2 = ada_ptr(p, layer + 1, t);
      norm_mod_store(xv, p.norm_g + ((layer + 1) * 2) * D, ad2 + 1024, ad2, p.h + (size_t)t * D, lane);
    } else {
      float ss = 0.f;
#pragma unroll
      for (int i = 0; i < 16; ++i) ss += xv[i] * xv[i];
      ss = wave_sum(ss); const float rstd = rsqrtf(ss * (1.0f / D) + 1e-6f);
#pragma unroll
      for (int j = 0; j < 4; ++j) { const float4 g = *(const float4*)(p.final_g + j * 256 + lane * 4);
        xv[j * 4] *= rstd * g.x; xv[j * 4 + 1] *= rstd * g.y; xv[j * 4 + 2] *= rstd * g.z; xv[j * 4 + 3] *= rstd * g.w; }
      store_row_f32(p.out + ((size_t)(b * SEQ + s - CTX)) * D, lane, xv);
    }
  }
}


typedef float f32x2 __attribute__((ext_vector_type(2)));
constexpr float U8_SCALE = 64.0f, V8_SCALE = 4.0f;
DEV unsigned pack4_fp8(float a, float b, float c, float d, float sc) {
  a = fminf(fmaxf(a * sc, -448.f), 448.f); b = fminf(fmaxf(b * sc, -448.f), 448.f); c = fminf(fmaxf(c * sc, -448.f), 448.f); d = fminf(fmaxf(d * sc, -448.f), 448.f);
  int w = 0; w = __builtin_amdgcn_cvt_pk_fp8_f32(a, b, w, false); w = __builtin_amdgcn_cvt_pk_fp8_f32(c, d, w, true); return (unsigned)w;
}
DEV void phase_peer_tables(CP p, int layer) {
  uint2* UV2 = (uint2*)(p.scratch + OFF_U8);
  const float4* U = (const float4*)(p.peer_u + (size_t)layer * 16384 * 1024); const float4* V = (const float4*)(p.peer_v + (size_t)layer * 16384 * 1024);
  const int n16 = 16384 * 1024 / 16;
  for (int i = BIDX * NTHR + TIDX; i < n16; i += gridDim.x * NTHR) {
    unsigned uw0, uw1;
    { const float4 a = U[(size_t)i * 4], b = U[(size_t)i * 4 + 1], c = U[(size_t)i * 4 + 2], d = U[(size_t)i * 4 + 3];
      const float e[16] = {a.x, a.y, a.z, a.w, b.x, b.y, b.z, b.w, c.x, c.y, c.z, c.w, d.x, d.y, d.z, d.w};
      unsigned w0 = 0u, w1 = 0u;
#define U4C(k_) fminf(fmaxf(e[k_] * U8_SCALE, -6.f), 6.f)
      w0 = __builtin_amdgcn_cvt_scalef32_pk_fp4_f32(w0, U4C(0), U4C(1), 1.0f, 0); w0 = __builtin_amdgcn_cvt_scalef32_pk_fp4_f32(w0, U4C(2), U4C(3), 1.0f, 1);
      w0 = __builtin_amdgcn_cvt_scalef32_pk_fp4_f32(w0, U4C(4), U4C(5), 1.0f, 2); w0 = __builtin_amdgcn_cvt_scalef32_pk_fp4_f32(w0, U4C(6), U4C(7), 1.0f, 3);
      w1 = __builtin_amdgcn_cvt_scalef32_pk_fp4_f32(w1, U4C(8), U4C(9), 1.0f, 0); w1 = __builtin_amdgcn_cvt_scalef32_pk_fp4_f32(w1, U4C(10), U4C(11), 1.0f, 1);
      w1 = __builtin_amdgcn_cvt_scalef32_pk_fp4_f32(w1, U4C(12), U4C(13), 1.0f, 2); w1 = __builtin_amdgcn_cvt_scalef32_pk_fp4_f32(w1, U4C(14), U4C(15), 1.0f, 3);
#undef U4C
      uw0 = w0; uw1 = w1; }
    { const float4 a = V[(size_t)i * 4], b = V[(size_t)i * 4 + 1], c = V[(size_t)i * 4 + 2], d = V[(size_t)i * 4 + 3];
      const float e[16] = {a.x, a.y, a.z, a.w, b.x, b.y, b.z, b.w, c.x, c.y, c.z, c.w, d.x, d.y, d.z, d.w};
      unsigned w0 = 0u, w1 = 0u;
#define V4C(k_) fminf(fmaxf(e[k_] * V8_SCALE, -6.f), 6.f)
      w0 = __builtin_amdgcn_cvt_scalef32_pk_fp4_f32(w0, V4C(0), V4C(1), 1.0f, 0); w0 = __builtin_amdgcn_cvt_scalef32_pk_fp4_f32(w0, V4C(2), V4C(3), 1.0f, 1);
      w0 = __builtin_amdgcn_cvt_scalef32_pk_fp4_f32(w0, V4C(4), V4C(5), 1.0f, 2); w0 = __builtin_amdgcn_cvt_scalef32_pk_fp4_f32(w0, V4C(6), V4C(7), 1.0f, 3);
      w1 = __builtin_amdgcn_cvt_scalef32_pk_fp4_f32(w1, V4C(8), V4C(9), 1.0f, 0); w1 = __builtin_amdgcn_cvt_scalef32_pk_fp4_f32(w1, V4C(10), V4C(11), 1.0f, 1);
      w1 = __builtin_amdgcn_cvt_scalef32_pk_fp4_f32(w1, V4C(12), V4C(13), 1.0f, 2); w1 = __builtin_amdgcn_cvt_scalef32_pk_fp4_f32(w1, V4C(14), V4C(15), 1.0f, 3);
#undef V4C
      { const int e_ = i >> 6, l_ = i & 63; UV2[(size_t)e_ * 128 + l_] = make_uint2(uw0, uw1); UV2[(size_t)e_ * 128 + 64 + l_] = make_uint2(w0, w1); } }
  }
}
DEV float rdlane_f(float v, int l) { return __builtin_bit_cast(float, __builtin_amdgcn_readlane(__builtin_bit_cast(int, v), l)); }

typedef int i32x8 __attribute__((ext_vector_type(8)));
DEV void phase_peer_gather8(CP p, int layer, LAS char* shm) {
  const int* EID = (const int*)(p.scratch + OFF_EID); const float* GATE = (const float*)(p.scratch + OFF_GATE);
  const char* UVB = (const char*)(p.scratch + OFF_U8); const uint2* UV2 = (const uint2*)(p.scratch + OFF_U8);
  const int wid = __builtin_amdgcn_readfirstlane(TIDX >> 6), lane = TIDX & 63, gw = BIDX * (NTHR / 64) + wid, nw = gridDim.x * (NTHR / 64);
  LAS char* xq = shm + wid * 1024;
  const bool last = layer == 3;
  for (int t = gw; t < T; t += nw) {
    const int b = t / SP, s = t - b * SP;
    if (last && s < CTX) continue;
    { const bf16_t* hr = p.h + (size_t)t * D + lane * 16; const uint4 h0 = *(const uint4*)hr, h1 = *(const uint4*)(hr + 8);
      const unsigned hw[8] = {h0.x, h0.y, h0.z, h0.w, h1.x, h1.y, h1.z, h1.w};
      unsigned q[4];
#pragma unroll
      for (int i = 0; i < 4; ++i) {
        unsigned w = __builtin_amdgcn_cvt_pk_fp8_f32(__uint_as_float(hw[2 * i] << 16), __uint_as_float(hw[2 * i] & 0xffff0000u), 0u, false);
        q[i] = __builtin_amdgcn_cvt_pk_fp8_f32(__uint_as_float(hw[2 * i + 1] << 16), __uint_as_float(hw[2 * i + 1] & 0xffff0000u), w, true); }
      *(LAS u32x4*)(xq + lane * 16) = (u32x4){q[0], q[1], q[2], q[3]}; }
    f32x2 f[8];
#pragma unroll
    for (int i = 0; i < 8; ++i) f[i] = (f32x2){0.f, 0.f};
#pragma unroll 1
    for (int grp = 0; grp < 8; ++grp) {
      const int eidv = EID[(size_t)t * 128 + grp * 16 + (lane & 15)];
      const float4 gv4 = *(const float4*)(GATE + (size_t)t * 128 + grp * 16 + 4 * (lane >> 4));
      uint4 ua[8]; uint2 vv[16];
      { const char* ub = UVB + (size_t)eidv * 1024 + (lane >> 4) * 16;
#pragma unroll
        for (int ks = 0; ks < 8; ++ks) ua[ks] = *(const uint4*)(ub + ks * 64); }
#pragma unroll
      for (int r = 0; r < 16; ++r) { const int e = __builtin_amdgcn_readlane(eidv, r); vv[r] = UV2[(size_t)e * 128 + 64 + lane]; }
      f32x4 dacc = (f32x4){0.f, 0.f, 0.f, 0.f};
#pragma unroll
      for (int ks = 0; ks < 8; ++ks) {
        const u32x4 b0 = *(const LAS u32x4*)(xq + ks * 128 + (lane >> 4) * 16), b1 = *(const LAS u32x4*)(xq + ks * 128 + 64 + (lane >> 4) * 16);
        const i32x8 av = {(int)ua[ks].x, (int)ua[ks].y, (int)ua[ks].z, (int)ua[ks].w, 0, 0, 0, 0};
        const i32x8 bv = {(int)b0[0], (int)b0[1], (int)b0[2], (int)b0[3], (int)b1[0], (int)b1[1], (int)b1[2], (int)b1[3]};
        dacc = __builtin_amdgcn_mfma_scale_f32_16x16x128_f8f6f4(av, bv, dacc, 4  , 0  , 0, 0x7f7f7f7f, 0, 0x7f7f7f7f);
      }
      const float w4[4] = {gv4.x * gelu_tanh(dacc[0] * (1.0f / U8_SCALE)), gv4.y * gelu_tanh(dacc[1] * (1.0f / U8_SCALE)), gv4.z * gelu_tanh(dacc[2] * (1.0f / U8_SCALE)), gv4.w * gelu_tanh(dacc[3] * (1.0f / U8_SCALE))};
#pragma unroll
      for (int r = 0; r < 16; ++r) {
        const float wr = rdlane_f(w4[r & 3], 16 * (r >> 2));
        f[0] += wr * __builtin_amdgcn_cvt_scalef32_pk_f32_fp4(vv[r].x, 1.0f, 0); f[1] += wr * __builtin_amdgcn_cvt_scalef32_pk_f32_fp4(vv[r].x, 1.0f, 1);
        f[2] += wr * __builtin_amdgcn_cvt_scalef32_pk_f32_fp4(vv[r].x, 1.0f, 2); f[3] += wr * __builtin_amdgcn_cvt_scalef32_pk_f32_fp4(vv[r].x, 1.0f, 3);
        f[4] += wr * __builtin_amdgcn_cvt_scalef32_pk_f32_fp4(vv[r].y, 1.0f, 0); f[5] += wr * __builtin_amdgcn_cvt_scalef32_pk_f32_fp4(vv[r].y, 1.0f, 1);
        f[6] += wr * __builtin_amdgcn_cvt_scalef32_pk_f32_fp4(vv[r].y, 1.0f, 2); f[7] += wr * __builtin_amdgcn_cvt_scalef32_pk_f32_fp4(vv[r].y, 1.0f, 3);
      }
    }
    bf16_t* xr = xrow_ptr(p, t) + lane * 16;
    const float* ad = ada_ptr(p, layer, t);
    float xv[16];
    { const uint4 xa = *(const uint4*)xr, xb = *(const uint4*)(xr + 8); const unsigned xw[8] = {xa.x, xa.y, xa.z, xa.w, xb.x, xb.y, xb.z, xb.w};
#pragma unroll
      for (int j = 0; j < 4; ++j) { const float4 g2 = *(const float4*)(ad + 5120 + lane * 16 + j * 4);
        xv[j * 4] = __uint_as_float(xw[2 * j] << 16) + g2.x * f[2 * j].x * (1.0f / V8_SCALE); xv[j * 4 + 1] = __uint_as_float(xw[2 * j] & 0xffff0000u) + g2.y * f[2 * j].y * (1.0f / V8_SCALE);
        xv[j * 4 + 2] = __uint_as_float(xw[2 * j + 1] << 16) + g2.z * f[2 * j + 1].x * (1.0f / V8_SCALE); xv[j * 4 + 3] = __uint_as_float(xw[2 * j + 1] & 0xffff0000u) + g2.w * f[2 * j + 1].y * (1.0f / V8_SCALE); } }
    float ss = 0.f;
#pragma unroll
    for (int i = 0; i < 16; ++i) ss += xv[i] * xv[i];
    ss = wave_sum(ss); const float rstd = rsqrtf(ss * (1.0f / D) + 1e-6f);
    if (!last) {
      { unsigned xo[8];
#pragma unroll
        for (int j = 0; j < 8; ++j) xo[j] = cvt_pk_bf16(xv[2 * j], xv[2 * j + 1]);
        *(uint4*)xr = make_uint4(xo[0], xo[1], xo[2], xo[3]); *(uint4*)(xr + 8) = make_uint4(xo[4], xo[5], xo[6], xo[7]); }
      const float* ad2 = ada_ptr(p, layer + 1, t); const float* g = p.norm_g + ((layer + 1) * 2) * D;
      unsigned ow[8];
#pragma unroll
      for (int j = 0; j < 4; ++j) { const int c0 = lane * 16 + j * 4; const float4 gg = *(const float4*)(g + c0), s1 = *(const float4*)(ad2 + 1024 + c0), s2 = *(const float4*)(ad2 + c0);
        const float y0 = xv[j * 4] * rstd * gg.x * (1.f + s1.x) + s2.x, y1 = xv[j * 4 + 1] * rstd * gg.y * (1.f + s1.y) + s2.y;
        const float y2 = xv[j * 4 + 2] * rstd * gg.z * (1.f + s1.z) + s2.z, y3 = xv[j * 4 + 3] * rstd * gg.w * (1.f + s1.w) + s2.w;
        ow[j * 2] = cvt_pk_bf16(y0, y1); ow[j * 2 + 1] = cvt_pk_bf16(y2, y3); }
      bf16_t* hw = p.h + (size_t)t * D + lane * 16;
      *(uint4*)hw = make_uint4(ow[0], ow[1], ow[2], ow[3]); *(uint4*)(hw + 8) = make_uint4(ow[4], ow[5], ow[6], ow[7]);
    } else {
      float* orow = p.out + ((size_t)(b * SEQ + s - CTX)) * D + lane * 16;
#pragma unroll
      for (int j = 0; j < 4; ++j) { const float4 g = *(const float4*)(p.final_g + lane * 16 + j * 4);
        *(float4*)(orow + j * 4) = make_float4(xv[j * 4] * rstd * g.x, xv[j * 4 + 1] * rstd * g.y, xv[j * 4 + 2] * rstd * g.z, xv[j * 4 + 3] * rstd * g.w); }
    }
  }
}


DEV float vmaxf(float a, float b) { float r; asm("v_max_f32 %0, %1, %2" : "=v"(r) : "v"(a), "v"(b)); return r; }
DEV float vminf(float a, float b) { float r; asm("v_min_f32 %0, %1, %2" : "=v"(r) : "v"(a), "v"(b)); return r; }
template <int N> DEV void bitonic_sort_desc(float (&v)[N]) {
#pragma unroll
  for (int k = 2; k <= N; k <<= 1)
#pragma unroll
    for (int j = k >> 1; j > 0; j >>= 1)
#pragma unroll
      for (int i = 0; i < N; ++i) { const int l = i ^ j; if (l > i) { const float a = v[i], b = v[l], mx = vmaxf(a, b), mn = vminf(a, b); if ((i & k) == 0) { v[i] = mx; v[l] = mn; } else { v[i] = mn; v[l] = mx; } } }
}
DEV void bitonic_merge16_desc(float (&v)[16]) {
#pragma unroll
  for (int j = 8; j > 0; j >>= 1)
#pragma unroll
    for (int i = 0; i < 16; ++i) { const int l = i ^ j; if (l > i) { const float a = v[i], b = v[l]; v[i] = vmaxf(a, b); v[l] = vminf(a, b); } }
}
DEV void xlane_merge16(float (&v)[16], int mask) {
  float o[16];
#pragma unroll
  for (int i = 0; i < 16; ++i) o[i] = __shfl_xor(v[i], mask);
#pragma unroll
  for (int i = 0; i < 16; ++i) v[i] = vmaxf(v[i], o[15 - i]);
  bitonic_merge16_desc(v);
}
DEV void split_bf16x8(const float (&x)[8], bf16x8& hi, bf16x8& lo) {
  unsigned h[4], l[4];
#pragma unroll
  for (int i = 0; i < 4; ++i) { h[i] = cvt_pk_bf16(x[2 * i], x[2 * i + 1]);
    const float r0 = x[2 * i] - __uint_as_float(h[i] << 16), r1 = x[2 * i + 1] - __uint_as_float(h[i] & 0xffff0000u); l[i] = cvt_pk_bf16(r0, r1); }
  hi = __builtin_bit_cast(bf16x8, (u32x4){h[0], h[1], h[2], h[3]}); lo = __builtin_bit_cast(bf16x8, (u32x4){l[0], l[1], l[2], l[3]});
}
DEV unsigned sel4(int k, unsigned a, unsigned b, unsigned c, unsigned d) { const unsigned ab = (k & 1) ? b : a, cd = (k & 1) ? d : c; return (k & 2) ? cd : ab; }
DEV float sel4f(int k, float a, float b, float c, float d) { const float ab = (k & 1) ? b : a, cd = (k & 1) ? d : c; return (k & 2) ? cd : ab; }

DEV void phase_peer_route(CP p, int layer, LAS char* shm) {
  const bf16_t* PQ = (const bf16_t*)(p.scratch + OFF_PQ); int* EID = (int*)(p.scratch + OFF_EID); float* GATE = (float*)(p.scratch + OFF_GATE);
  constexpr int KSTR = 144, KARR = 128 * KSTR;
  const int tid = TIDX, wid = __builtin_amdgcn_readfirstlane(tid >> 6), lane = tid & 63, ln = lane & 15, kgrp = lane >> 4;
  const bool seqonly = layer == 3;
  const int TPH = seqonly ? 256 : 288, NI = 8 * TPH;
  const int G = gridDim.x, per = (NI + G - 1) / G, it0 = BIDX * per, it1 = (it0 + per < NI) ? it0 + per : NI;
  int cur_h = -1;
  auto qaddr = [&](int item_, int hf_, int ks_) { const int h_ = item_ / TPH, tl_ = item_ - h_ * TPH, tile_ = seqonly ? (tl_ >> 4) * 18 + 2 + (tl_ & 15) : tl_;
    return PQ + (size_t)(tile_ * 128 + wid * 16 + ln) * 1024 + h_ * 128 + hf_ * 64 + 32 * ks_ + 8 * kgrp; };
  bf16x8 nq[2][2];
  if (it0 < it1) {
#pragma unroll
    for (int hf = 0; hf < 2; ++hf)
#pragma unroll
      for (int ks = 0; ks < 2; ++ks) nq[hf][ks] = *(const bf16x8*)qaddr(it0, hf, ks); }
  for (int item = it0; item < it1; ++item) {
    const int h = item / TPH, tl = item - h * TPH, tile = seqonly ? (tl >> 4) * 18 + 2 + (tl & 15) : tl;
    if (h != cur_h) {
      __syncthreads();
      const float* kp = p.peer_keys + ((size_t)(layer * 8 + h)) * 2 * 128 * 64;
      for (int idx = tid; idx < 2 * 128 * 8; idx += NTHR) {
        const int pc = idx & 7, key = (idx >> 3) & 127, hf = idx >> 10;
        const float4 a = *(const float4*)(kp + ((size_t)hf * 128 + key) * 64 + pc * 8), b = *(const float4*)(kp + ((size_t)hf * 128 + key) * 64 + pc * 8 + 4);
        const float x[8] = {a.x, a.y, a.z, a.w, b.x, b.y, b.z, b.w}; bf16x8 hi, lo; split_bf16x8(x, hi, lo);
        *(LAS bf16x8*)(shm + (hf * 2 + 0) * KARR + key * KSTR + pc * 16) = hi; *(LAS bf16x8*)(shm + (hf * 2 + 1) * KARR + key * KSTR + pc * 16) = lo;
      }
      __syncthreads();
      cur_h = h;
    }
    const int t = tile * 128 + wid * 16 + ln;
    bf16x8 cq[2][2];
#pragma unroll
    for (int hf = 0; hf < 2; ++hf) { cq[hf][0] = nq[hf][0]; cq[hf][1] = nq[hf][1]; }
    { const int itn = item + 1 < it1 ? item + 1 : item;
#pragma unroll
      for (int hf = 0; hf < 2; ++hf)
#pragma unroll
        for (int ks = 0; ks < 2; ++ks) nq[hf][ks] = *(const bf16x8*)qaddr(itn, hf, ks); }
    float lst[2][16];
#pragma unroll
    for (int hf = 0; hf < 2; ++hf) {
      const bf16x8 qh[2] = {cq[hf][0], cq[hf][1]};
      float v[32];
      f32x4 acc8[8];
#pragma unroll
      for (int m = 0; m < 8; ++m) acc8[m] = (f32x4){0.f, 0.f, 0.f, 0.f};
#pragma unroll
      for (int ks = 0; ks < 2; ++ks)
#pragma unroll
        for (int part = 0; part < 2; ++part)
#pragma unroll
          for (int m = 0; m < 8; ++m)
            acc8[m] = __builtin_amdgcn_mfma_f32_16x16x32_bf16(ld_frag_lds(shm + (hf * 2 + part) * KARR + (16 * m + ln) * KSTR + ks * 64 + kgrp * 16), qh[ks], acc8[m], 0, 0, 0);
#pragma unroll
      for (int m = 0; m < 8; ++m)
#pragma unroll
        for (int j = 0; j < 4; ++j) v[4 * m + j] = __uint_as_float((__float_as_uint(acc8[m][j]) & ~127u) | (unsigned)(16 * m + 4 * kgrp + j));
      float a16[16], b16[16];
#pragma unroll
      for (int i = 0; i < 16; ++i) { a16[i] = v[i]; b16[i] = v[16 + i]; }
      bitonic_sort_desc<16>(a16); bitonic_sort_desc<16>(b16);
#pragma unroll
      for (int i = 0; i < 16; ++i) a16[i] = vmaxf(a16[i], b16[15 - i]);
      bitonic_merge16_desc(a16);
      xlane_merge16(a16, 16); xlane_merge16(a16, 32);
#pragma unroll
      for (int i = 0; i < 16; ++i) lst[hf][i] = a16[i];
    }
    float av[16], bv[16]; unsigned A4[4], B4[4];
#pragma unroll
    for (int i = 0; i < 16; ++i) { av[i] = __uint_as_float(__float_as_uint(lst[0][i]) & ~127u); bv[i] = __uint_as_float(__float_as_uint(lst[1][i]) & ~127u); }
#pragma unroll
    for (int r = 0; r < 4; ++r) {
      A4[r] = (__float_as_uint(lst[0][4 * r]) & 127u) | ((__float_as_uint(lst[0][4 * r + 1]) & 127u) << 8) | ((__float_as_uint(lst[0][4 * r + 2]) & 127u) << 16) | ((__float_as_uint(lst[0][4 * r + 3]) & 127u) << 24);
      B4[r] = (__float_as_uint(lst[1][4 * r]) & 127u) | ((__float_as_uint(lst[1][4 * r + 1]) & 127u) << 8) | ((__float_as_uint(lst[1][4 * r + 2]) & 127u) << 16) | ((__float_as_uint(lst[1][4 * r + 3]) & 127u) << 24); }
    float cand[16];
    {
      constexpr int NP = 50;
      struct PairTab { int i0[52], i1[52]; };
      constexpr PairTab tab = [] { PairTab tb{}; int n = 0; for (int a = 0; a < 16; ++a) for (int b = 0; b < 16; ++b) if ((a + 1) * (b + 1) <= 16) { tb.i0[n] = a; tb.i1[n] = b; ++n; } for (; n < 52; ++n) { tb.i0[n] = -1; tb.i1[n] = -1; } return tb; }();
      static_assert(tab.i0[NP - 1] >= 0 && tab.i0[NP] < 0, "50 admissible pairs");
#pragma unroll
      for (int sl = 0; sl < 13; ++sl) {
        float c4[4];
#pragma unroll
        for (int kq = 0; kq < 4; ++kq) { const int n = 13 * kq + sl;
          if (tab.i0[n] >= 0) c4[kq] = __uint_as_float((__float_as_uint(av[tab.i0[n]] + bv[tab.i1[n]]) & ~255u) | (unsigned)(tab.i0[n] * 16 + tab.i1[n]));
          else c4[kq] = -3.0e38f; }
        asm volatile("" : "+v"(c4[0]), "+v"(c4[1]), "+v"(c4[2]), "+v"(c4[3]));
        cand[sl] = sel4f(kgrp, c4[0], c4[1], c4[2], c4[3]);
      }
      cand[13] = -3.0e38f; cand[14] = -3.0e38f; cand[15] = -3.0e38f;
    }
    bitonic_sort_desc<16>(cand);
    xlane_merge16(cand, 16); xlane_merge16(cand, 32);
    float gv[16]; int ev[16]; float gsum = 0.f;
    const float v0 = __uint_as_float(__float_as_uint(cand[0]) & ~255u);
#pragma unroll
    for (int j = 0; j < 16; ++j) {
      const unsigned bits = __float_as_uint(cand[j]); const int i0 = (bits >> 4) & 15, i1 = bits & 15;
      const unsigned ra = sel4(i0 >> 2, A4[0], A4[1], A4[2], A4[3]), rb = sel4(i1 >> 2, B4[0], B4[1], B4[2], B4[3]);
      const int k0 = (ra >> (8 * (i0 & 3))) & 127, k1 = (rb >> (8 * (i1 & 3))) & 127;
      ev[j] = k0 * 128 + k1;
      gv[j] = __expf(__uint_as_float(bits & ~255u) - v0); gsum += gv[j];
    }
    const float ginv = 1.f / gsum;
    int4 eo; float4 go;
    eo.x = (int)sel4(kgrp, ev[0], ev[4], ev[8], ev[12]); eo.y = (int)sel4(kgrp, ev[1], ev[5], ev[9], ev[13]); eo.z = (int)sel4(kgrp, ev[2], ev[6], ev[10], ev[14]); eo.w = (int)sel4(kgrp, ev[3], ev[7], ev[11], ev[15]);
    go.x = sel4f(kgrp, gv[0], gv[4], gv[8], gv[12]) * ginv; go.y = sel4f(kgrp, gv[1], gv[5], gv[9], gv[13]) * ginv; go.z = sel4f(kgrp, gv[2], gv[6], gv[10], gv[14]) * ginv; go.w = sel4f(kgrp, gv[3], gv[7], gv[11], gv[15]) * ginv;
    *(int4*)(EID + (size_t)t * 128 + h * 16 + 4 * kgrp) = eo;
    *(float4*)(GATE + (size_t)t * 128 + h * 16 + 4 * kgrp) = go;
  }
}

DEV int seq_of_tau(int tau, int d) { return d == 0 ? tau : (tau < CTX ? CTX - 1 - tau : 2 * CTX + SEQ - 1 - tau); }

DEV void phase_s5_scan(CP p, float* lds) {
  float* Y = (float*)(p.scratch + OFF_Y); bf16_t* GIN = (bf16_t*)(p.scratch + OFF_GIN);
  const int tid = TIDX, wid = __builtin_amdgcn_readfirstlane(tid >> 6), lane = tid & 63;
  float* ub = lds + wid * 2048;
  float* yb = ub + 1024;
  for (int item0 = BIDX * 8; item0 < 1024; item0 += gridDim.x * 8) {
    const int item = item0 + wid, b = item >> 6, g = item & 63;
    for (int d = 0; d < 2; ++d) {
      const int sidx = (d * 64 + g) * 64 + lane;
      const float ar = p.s5_ar[sidx], ai = p.s5_ai[sidx];
      float br[16], bi[16], cr[16], ci[16];
#pragma unroll
      for (int c = 0; c < 16; ++c) { br[c] = p.s5_br[sidx * 16 + c]; bi[c] = p.s5_bi[sidx * 16 + c];
        cr[c] = p.s5_c_re[((size_t)(d * 64 + g) * 16 + c) * 64 + lane]; ci[c] = p.s5_c_im[((size_t)(d * 64 + g) * 16 + c) * 64 + lane]; }
      float xr = 0.f, xi = 0.f;
      for (int k = 0; k < 36; ++k) {
        const int trow = b * SP + seq_of_tau(k * 64 + lane, d);
        __syncthreads();
        { const bf16_t* hp = p.h + (size_t)trow * D + g * 16;
          const uint4 w0 = *(const uint4*)hp, w1 = *(const uint4*)(hp + 8);
          const unsigned ww[8] = {w0.x, w0.y, w0.z, w0.w, w1.x, w1.y, w1.z, w1.w};
#pragma unroll
          for (int i = 0; i < 8; ++i) { ub[lane * 16 + 2 * i] = __uint_as_float(ww[i] << 16); ub[lane * 16 + 2 * i + 1] = __uint_as_float(ww[i] & 0xffff0000u); } }
        __syncthreads();
#pragma unroll 1
        for (int j = 0; j < 64; ++j) {
          float u[16];
#pragma unroll
          for (int c = 0; c < 16; c += 4) { const float4 t4 = *(const float4*)(ub + j * 16 + c); u[c] = t4.x; u[c + 1] = t4.y; u[c + 2] = t4.z; u[c + 3] = t4.w; }
          float bur = 0.f, bui = 0.f;
#pragma unroll
          for (int c = 0; c < 16; ++c) { bur += br[c] * u[c]; bui += bi[c] * u[c]; }
          const float nxr = ar * xr - ai * xi + bur, nxi = ar * xi + ai * xr + bui;
          xr = nxr; xi = nxi;
          float v[16];
#pragma unroll
          for (int c = 0; c < 16; ++c) v[c] = cr[c] * xr - ci[c] * xi;
#pragma unroll
          for (int i = 0; i < 8; ++i) { const bool hi = lane & 32; const float send = hi ? v[i] : v[i + 8], keep = hi ? v[i + 8] : v[i]; v[i] = keep + __shfl_xor(send, 32); }
#pragma unroll
          for (int i = 0; i < 4; ++i) { const bool hi = lane & 16; const float send = hi ? v[i] : v[i + 4], keep = hi ? v[i + 4] : v[i]; v[i] = keep + __shfl_xor(send, 16); }
#pragma unroll
          for (int i = 0; i < 2; ++i) { const bool hi = lane & 8; const float send = hi ? v[i] : v[i + 2], keep = hi ? v[i + 2] : v[i]; v[i] = keep + __shfl_xor(send, 8); }
          { const bool hi = lane & 4; const float send = hi ? v[0] : v[1], keep = hi ? v[1] : v[0]; v[0] = keep + __shfl_xor(send, 4); }
          v[0] += __shfl_xor(v[0], 2); v[0] += __shfl_xor(v[0], 1);
          if ((lane & 3) == 0) yb[j * 16 + (lane >> 2)] = v[0];
        }
        __syncthreads();
        if (d == 0) {
#pragma unroll
          for (int c = 0; c < 16; c += 4) *(float4*)(Y + (size_t)trow * D + g * 16 + c) = *(const float4*)(yb + lane * 16 + c);
        } else {
          unsigned ow[8];
#pragma unroll
          for (int c = 0; c < 16; c += 2) {
            const float y0 = Y[(size_t)trow * D + g * 16 + c] + yb[lane * 16 + c] + p.s5_d[g * 16 + c] * ub[lane * 16 + c];
            const float y1 = Y[(size_t)trow * D + g * 16 + c + 1] + yb[lane * 16 + c + 1] + p.s5_d[g * 16 + c + 1] * ub[lane * 16 + c + 1];
            ow[c >> 1] = cvt_pk_bf16(gelu_tanh(y0), gelu_tanh(y1));
          }
          *(uint4*)(GIN + (size_t)trow * D + g * 16) = make_uint4(ow[0], ow[1], ow[2], ow[3]);
          *(uint4*)(GIN + (size_t)trow * D + g * 16 + 8) = make_uint4(ow[4], ow[5], ow[6], ow[7]);
        }
      }
    }
  }
}

DEV void phase_s5_out(CP p, int layer) {
  const bf16_t* Z = (const bf16_t*)(p.scratch + OFF_Z);
  const int lane = TIDX & 63, gw = BIDX * (NTHR / 64) + __builtin_amdgcn_readfirstlane(TIDX >> 6), nw = gridDim.x * (NTHR / 64);
  for (int t = gw; t < T; t += nw) {
    bf16_t* xr = xrow_ptr(p, t); float xv[16]; load_row_bf(xr, lane, xv);
    const float* ad = ada_ptr(p, layer, t);
#pragma unroll
    for (int j = 0; j < 4; ++j) { const int c0 = j * 256 + lane * 4;
      const uint2 za = *(const uint2*)(Z + (size_t)t * 2048 + c0), zg = *(const uint2*)(Z + (size_t)t * 2048 + 1024 + c0);
      const float a[4] = {__uint_as_float(za.x << 16), __uint_as_float(za.x & 0xffff0000u), __uint_as_float(za.y << 16), __uint_as_float(za.y & 0xffff0000u)};
      const float gg[4] = {__uint_as_float(zg.x << 16), __uint_as_float(zg.x & 0xffff0000u), __uint_as_float(zg.y << 16), __uint_as_float(zg.y & 0xffff0000u)};
      const float4 g1 = *(const float4*)(ad + 2048 + c0); const float g1a[4] = {g1.x, g1.y, g1.z, g1.w};
#pragma unroll
      for (int e = 0; e < 4; ++e) xv[j * 4 + e] += g1a[e] * a[e] * sigm(gg[e]); }
    store_row_bf(xr, lane, xv);
    norm_mod_store(xv, p.norm_g + (layer * 2 + 1) * D, ad + 4096, ad + 3072, p.h + (size_t)t * D, lane);
  }
}


typedef unsigned short us16;
DEV void phase_s5_scan_mfma(CP p, LAS char* shm) {
  bf16_t* KT = (bf16_t*)(p.scratch + OFF_KT); bf16_t* W4 = (bf16_t*)(p.scratch + OFF_W4); bf16_t* XIN = (bf16_t*)(p.scratch + OFF_XIN);
  const int tid = TIDX, wid = __builtin_amdgcn_readfirstlane(tid >> 6), lane = tid & 63, n = lane & 15, kgrp = lane >> 4, par = kgrp >> 1, chalf = kgrp & 1;
  for (int unit = BIDX; unit < 256; unit += gridDim.x) {
    __syncthreads();
    if (unit < 128) {
      const int d = unit >> 6, g = unit & 63, ri = n >> 3, pp = n & 7, pidx = (d * 64 + g) * 64 + 8 * wid + pp;
      const float ar = p.s5_ar[pidx], ai = p.s5_ai[pidx];
      float brv[8], biv[8];
#pragma unroll
      for (int j = 0; j < 8; ++j) { brv[j] = p.s5_br[pidx * 16 + 8 * chalf + j]; biv[j] = p.s5_bi[pidx * 16 + 8 * chalf + j]; }
      const float a2r = ar * ar - ai * ai, a2i = 2.f * ar * ai;
      float pr = par ? 1.f : ar, pi = par ? 0.f : ai;
      bf16x8 bfrag[16];
#pragma unroll
      for (int ks = 15; ks >= 0; --ks) {
        unsigned o[4];
#pragma unroll
        for (int j = 0; j < 8; j += 2) {
          const float v0 = ri ? (pr * biv[j] + pi * brv[j]) : (pr * brv[j] - pi * biv[j]);
          const float v1 = ri ? (pr * biv[j + 1] + pi * brv[j + 1]) : (pr * brv[j + 1] - pi * biv[j + 1]);
          o[j >> 1] = cvt_pk_bf16(v0, v1);
        }
        bfrag[ks] = __builtin_bit_cast(bf16x8, (u32x4){o[0], o[1], o[2], o[3]});
        const float npr = pr * a2r - pi * a2i, npi = pr * a2i + pi * a2r; pr = npr; pi = npi;
      }
      float a32r = ar, a32i = ai;
#pragma unroll
      for (int q = 0; q < 5; ++q) { const float tr = a32r * a32r - a32i * a32i, ti = 2.f * a32r * a32i; a32r = tr; a32i = ti; }
      f32x4 xs = (f32x4){0.f, 0.f, 0.f, 0.f};
      const int sb = tid >> 5, ssig = tid & 31;
      const bf16_t* hb = p.h + (size_t)sb * SP * D + g * 16;
      uint4 r0, r1;
      { const bf16_t* hp = hb + (size_t)seq_of_tau(ssig, d) * D; r0 = *(const uint4*)hp; r1 = *(const uint4*)(hp + 8); }
      { LAS char* ub = shm + sb * 1040 + ssig * 32; *(LAS u32x4*)ub = (u32x4){r0.x, r0.y, r0.z, r0.w}; *(LAS u32x4*)(ub + 16) = (u32x4){r1.x, r1.y, r1.z, r1.w}; }
      __syncthreads();
      bf16_t* xin = XIN + (size_t)unit * 72 * 16 * 128;
      for (int k = 0; k < 72; ++k) {
        if (k + 1 < 72) { const bf16_t* hp = hb + (size_t)seq_of_tau((k + 1) * 32 + ssig, d) * D; r0 = *(const uint4*)hp; r1 = *(const uint4*)(hp + 8); }
#pragma unroll
        for (int j = 0; j < 4; ++j) xin[((size_t)k * 16 + 4 * kgrp + j) * 128 + 16 * wid + n] = f2bf(xs[j]);
        const LAS char* ub = shm + (k & 1) * 16640 + n * 1040 + kgrp * 16;
        f32x4 acq[4];
#pragma unroll
        for (int q = 0; q < 4; ++q) acq[q] = (f32x4){0.f, 0.f, 0.f, 0.f};
#pragma unroll
        for (int ks = 0; ks < 16; ++ks) acq[ks & 3] = __builtin_amdgcn_mfma_f32_16x16x32_bf16(ld_frag_lds(ub + ks * 64), bfrag[ks], acq[ks & 3], 0, 0, 0);
        const f32x4 acc = (acq[0] + acq[1]) + (acq[2] + acq[3]);
#pragma unroll
        for (int j = 0; j < 4; ++j) { const float other = __shfl_xor(xs[j], 8);
          xs[j] = (ri ? (a32r * xs[j] + a32i * other) : (a32r * xs[j] - a32i * other)) + acc[j]; }
        if (k + 1 < 72) { LAS char* uw = shm + ((k + 1) & 1) * 16640 + sb * 1040 + ssig * 32; *(LAS u32x4*)uw = (u32x4){r0.x, r0.y, r0.z, r0.w}; *(LAS u32x4*)(uw + 16) = (u32x4){r1.x, r1.y, r1.z, r1.w}; }
        __syncthreads();
      }
    } else {
      const int u2 = unit - 128, d = u2 >> 6, g = u2 & 63;
      float* pw = (float*)shm;
      float* Bb = pw + 64 * 66;
      float* Ct = Bb + 64 * 32;
      if (tid < 64) { const int pidx = (d * 64 + g) * 64 + tid; const float ar = p.s5_ar[pidx], ai = p.s5_ai[pidx]; float pr = 1.f, pi = 0.f; asm volatile("" : "+v"(pr), "+v"(pi));
        for (int e = 0; e < 33; ++e) { pw[(tid * 33 + e) * 2] = pr; pw[(tid * 33 + e) * 2 + 1] = pi; const float nr = pr * ar - pi * ai, ni = pr * ai + pi * ar; pr = nr; pi = ni; } }
      for (int idx = tid; idx < 1024; idx += NTHR) { const int pp = idx >> 4, c = idx & 15; const int pidx = (d * 64 + g) * 64 + pp;
        Bb[idx * 2] = p.s5_br[pidx * 16 + c]; Bb[idx * 2 + 1] = p.s5_bi[pidx * 16 + c];
        Ct[idx * 2] = p.s5_c_re[((size_t)(d * 64 + g) * 16 + c) * 64 + pp]; Ct[idx * 2 + 1] = p.s5_c_im[((size_t)(d * 64 + g) * 16 + c) * 64 + pp]; }
      __syncthreads();
      { const int dl = tid >> 4, cc = tid & 15;
        float acc[16];
#pragma unroll
        for (int c = 0; c < 16; ++c) acc[c] = 0.f;
        for (int pp = 0; pp < 64; ++pp) {
          const float pr = pw[(pp * 33 + dl) * 2], pi = pw[(pp * 33 + dl) * 2 + 1], cr = Ct[(pp * 16 + cc) * 2], ci = Ct[(pp * 16 + cc) * 2 + 1];
          const float gr = cr * pr - ci * pi, gi = cr * pi + ci * pr;
#pragma unroll
          for (int c = 0; c < 16; ++c) acc[c] += gr * Bb[(pp * 16 + c) * 2] - gi * Bb[(pp * 16 + c) * 2 + 1];
        }
        bf16_t* kt = KT + ((size_t)u2 * 33 + 1 + dl) * 256 + cc * 16;
        unsigned o[8];
#pragma unroll
        for (int c = 0; c < 16; c += 2) o[c >> 1] = cvt_pk_bf16(acc[c], acc[c + 1]);
        *(uint4*)kt = make_uint4(o[0], o[1], o[2], o[3]); *(uint4*)(kt + 8) = make_uint4(o[4], o[5], o[6], o[7]);
        if (tid < 128) *(unsigned*)(KT + (size_t)u2 * 33 * 256 + tid * 2) = 0u;
      }
      for (int idx = tid; idx < 65536; idx += NTHR) {
        const int j = idx & 7, cc = (idx >> 3) & 15, kg2 = (idx >> 7) & 3, ks = (idx >> 9) & 3, tau = idx >> 11;
        const int kidx = 32 * ks + 8 * kg2 + j, wv = kidx >> 4, nn = kidx & 15, ri = nn >> 3, pp = 8 * wv + (nn & 7);
        const float pr = pw[(pp * 33 + tau + 1) * 2], pi = pw[(pp * 33 + tau + 1) * 2 + 1], cr = Ct[(pp * 16 + cc) * 2], ci = Ct[(pp * 16 + cc) * 2 + 1];
        W4[(size_t)u2 * 65536 + idx] = f2bf(ri ? -(cr * pi + ci * pr) : (cr * pr - ci * pi));
      }
    }
  }
}

DEV void phase_s5_out_mfma(CP p, LAS char* shm) {
  const bf16_t* KT = (const bf16_t*)(p.scratch + OFF_KT); const bf16_t* W4 = (const bf16_t*)(p.scratch + OFF_W4); const bf16_t* XIN = (const bf16_t*)(p.scratch + OFF_XIN);
  bf16_t* GIN = (bf16_t*)(p.scratch + OFF_GIN);
  const int tid = TIDX, wid = __builtin_amdgcn_readfirstlane(tid >> 6), lane = tid & 63, cc = lane & 15, kgrp = lane >> 4, par = kgrp >> 1, chalf = kgrp & 1;
  constexpr int KT0_OFF = 0, KT1_OFF = 17408, U_OFF = 34816, XSTR = 272, X0_OFF = U_OFF + 2 * 16640, X1_OFF = X0_OFF + 2 * 16 * XSTR;
  for (int unit = BIDX; unit < 256; unit += gridDim.x) {
    const int g = unit >> 2, q = unit & 3, u0 = g, u1 = 64 + g;
    __syncthreads();
    for (int idx = tid; idx < 33 * 32; idx += NTHR) { *(LAS u32x4*)(shm + KT0_OFF + idx * 16) = *(const u32x4*)(KT + (size_t)u0 * 33 * 256 + idx * 8);
      *(LAS u32x4*)(shm + KT1_OFF + idx * 16) = *(const u32x4*)(KT + (size_t)u1 * 33 * 256 + idx * 8); }
    bf16x8 w4a[4][4];
#pragma unroll
    for (int i = 0; i < 4; ++i)
#pragma unroll
      for (int ks = 0; ks < 4; ++ks) w4a[i][ks] = *(const bf16x8*)(W4 + ((((size_t)u0 * 32 + (wid + 8 * i)) * 4 + ks) * 4 + kgrp) * 128 + cc * 8);
    const float dsk = p.s5_d[g * 16 + cc];
    const int sb = tid >> 5, ssig = tid & 31, xrow = (tid & 255) >> 4, xpc = tid & 15;
    const bf16_t* hb = p.h + (size_t)sb * SP * D + g * 16;
    const bf16_t* xin0 = XIN + (size_t)u0 * 72 * 16 * 128; const bf16_t* xin1 = XIN + (size_t)u1 * 72 * 16 * 128;
    uint4 r0, r1, rx;
#define S5_K1(c_) ((c_) < 8 ? 7 - (c_) : 79 - (c_))
#define S5_LOAD(c_) do { const bf16_t* hp = hb + (size_t)((c_) * 32 + ssig) * D; r0 = *(const uint4*)hp; r1 = *(const uint4*)(hp + 8); \
      rx = tid < 256 ? *(const uint4*)(xin0 + ((size_t)(c_) * 16 + xrow) * 128 + xpc * 8) : *(const uint4*)(xin1 + ((size_t)S5_K1(c_) * 16 + xrow) * 128 + xpc * 8); } while (0)
#define S5_WRITE(buf_) do { LAS char* uw = shm + U_OFF + (buf_) * 16640 + sb * 1040 + ssig * 32; *(LAS u32x4*)uw = (u32x4){r0.x, r0.y, r0.z, r0.w}; *(LAS u32x4*)(uw + 16) = (u32x4){r1.x, r1.y, r1.z, r1.w}; \
      *(LAS u32x4*)(shm + (tid < 256 ? X0_OFF : X1_OFF) + (buf_) * (16 * XSTR) + xrow * XSTR + xpc * 16) = (u32x4){rx.x, rx.y, rx.z, rx.w}; } while (0)
    S5_LOAD(18 * q); S5_WRITE(0);
    __syncthreads();
    for (int ci = 0; ci < 18; ++ci) {
      const int c = 18 * q + ci, buf = ci & 1;
      if (ci + 1 < 18) S5_LOAD(c + 1);
      bf16x8 w4b[4][4];
      int zz = 0; asm volatile("" : "+s"(zz));
#pragma unroll
      for (int i = 0; i < 4; ++i)
#pragma unroll
        for (int ks = 0; ks < 4; ++ks) w4b[i][ks] = *(const bf16x8*)(W4 + zz + ((((size_t)u1 * 32 + (31 - wid - 8 * i)) * 4 + ks) * 4 + kgrp) * 128 + cc * 8);
      const LAS char* ub = shm + U_OFF + buf * 16640 + cc * 1040;
      const LAS char* x0b = shm + X0_OFF + buf * (16 * XSTR) + cc * XSTR + kgrp * 16;
      const LAS char* x1b = shm + X1_OFF + buf * (16 * XSTR) + cc * XSTR + kgrp * 16;
      f32x4 acc0[4], acc1[4];
#pragma unroll
      for (int i = 0; i < 4; ++i) { acc0[i] = (f32x4){0.f, 0.f, 0.f, 0.f}; acc1[i] = (f32x4){0.f, 0.f, 0.f, 0.f}; }
#pragma unroll
      for (int ks = 0; ks < 4; ++ks) { const bf16x8 ax0 = ld_frag_lds(x0b + ks * 64), ax1 = ld_frag_lds(x1b + ks * 64);
#pragma unroll
        for (int i = 0; i < 4; ++i) { acc0[i] = __builtin_amdgcn_mfma_f32_16x16x32_bf16(ax0, w4a[i][ks], acc0[i], 0, 0, 0); acc1[i] = __builtin_amdgcn_mfma_f32_16x16x32_bf16(ax1, w4b[i][ks], acc1[i], 0, 0, 0); } }
      asm volatile("" ::: "memory");
      { const LAS char* ua = ub + kgrp * 16;
        const LAS char* kb = shm + KT0_OFF + (wid - par + 1) * 512 + cc * 32 + chalf * 16;
#pragma unroll 2
        for (int ks = 0; ks < 16; ++ks) { const bf16x8 au = ld_frag_lds(ua + ks * 64);
#pragma unroll
          for (int i = 0; i < 4; ++i) if (2 * ks <= wid + 8 * i) acc0[i] = __builtin_amdgcn_mfma_f32_16x16x32_bf16(au, ld_frag_lds(kb + (8 * i - 2 * ks) * 512), acc0[i], 0, 0, 0); } }
      { const LAS char* ua = ub + (31 - par) * 32 + chalf * 16;
        const LAS char* kb = shm + KT1_OFF + (31 - wid - par + 1) * 512 + cc * 32 + chalf * 16;
#pragma unroll 2
        for (int ks = 0; ks < 16; ++ks) { const bf16x8 au = ld_frag_lds(ua - ks * 64);
#pragma unroll
          for (int i = 0; i < 4; ++i) if (2 * ks <= 31 - wid - 8 * i) acc1[i] = __builtin_amdgcn_mfma_f32_16x16x32_bf16(au, ld_frag_lds(kb - (8 * i + 2 * ks) * 512), acc1[i], 0, 0, 0); } }
#pragma unroll
      for (int i = 0; i < 4; ++i) {
        const int slot = wid + 8 * i, sq = c * 32 + slot;
#pragma unroll
        for (int j = 0; j < 4; ++j) {
          const float uval = bf2f(*(const LAS us16*)(ub + (4 * kgrp + j - cc) * 1040 + slot * 32 + cc * 2));
          GIN[((size_t)g * T + (size_t)(4 * kgrp + j) * SP + sq) * 16 + cc] = f2bf(gelu_tanh(acc0[i][j] + acc1[i][j] + dsk * uval));
        }
      }
      if (ci + 1 < 18) S5_WRITE((ci + 1) & 1);
      __syncthreads();
    }
#undef S5_K1
#undef S5_LOAD
#undef S5_WRITE
  }
}

DEV void phase_gla_scan(CP p, float* lds) {
  const bf16_t* QKVG = (const bf16_t*)(p.scratch + OFF_QKVG); const bf16_t* LG = (const bf16_t*)(p.scratch + OFF_LG); bf16_t* OD = (bf16_t*)(p.scratch + OFF_OD);
  float* qs = lds; float* ks = lds + 16 * 128; float* es = lds + 32 * 128; float* vs = lds + 48 * 128; float* op = vs + 16 * 256;
  const int tid = TIDX, col = tid & 255, kh = tid >> 8;
  for (int item = BIDX; item < 128; item += gridDim.x) {
    const int b = item >> 3, hd = (item >> 1) & 3, d = item & 1;
    float S[64];
#pragma unroll
    for (int i = 0; i < 64; ++i) S[i] = 0.f;
    for (int st = 0; st < SP / 16; ++st) {
      __syncthreads();
      for (int idx = tid; idx < 16 * 128; idx += NTHR) { const int j = idx >> 7, k = idx & 127; const size_t trow = (size_t)b * SP + seq_of_tau(st * 16 + j, d);
        qs[idx] = bf2f(QKVG[trow * 3072 + hd * 128 + k]); ks[idx] = bf2f(QKVG[trow * 3072 + 512 + hd * 128 + k]); es[idx] = __expf(bf2f(LG[((size_t)d * T + trow) * 512 + hd * 128 + k])); }
      for (int idx = tid; idx < 16 * 256; idx += NTHR) { const int j = idx >> 8, c = idx & 255; const size_t trow = (size_t)b * SP + seq_of_tau(st * 16 + j, d);
        vs[idx] = bf2f(QKVG[trow * 3072 + 1024 + hd * 256 + c]); }
      __syncthreads();
#pragma unroll 1
      for (int j = 0; j < 16; ++j) {
        const float vv = vs[j * 256 + col]; float acc = 0.f;
#pragma unroll
        for (int kk = 0; kk < 64; kk += 4) {
          const float4 e4 = *(const float4*)(es + j * 128 + kh * 64 + kk), k4 = *(const float4*)(ks + j * 128 + kh * 64 + kk), q4 = *(const float4*)(qs + j * 128 + kh * 64 + kk);
          S[kk] = e4.x * S[kk] + k4.x * vv; acc += q4.x * S[kk];
          S[kk + 1] = e4.y * S[kk + 1] + k4.y * vv; acc += q4.y * S[kk + 1];
          S[kk + 2] = e4.z * S[kk + 2] + k4.z * vv; acc += q4.z * S[kk + 2];
          S[kk + 3] = e4.w * S[kk + 3] + k4.w * vv; acc += q4.w * S[kk + 3];
        }
        op[kh * 16 * 256 + j * 256 + col] = acc;
      }
      __syncthreads();
      for (int idx = tid; idx < 16 * 256; idx += NTHR) { const int j = idx >> 8, c = idx & 255; const size_t trow = (size_t)b * SP + seq_of_tau(st * 16 + j, d);
        OD[((size_t)d * T + trow) * D + hd * 256 + c] = f2bf(op[idx] + op[16 * 256 + idx]); }
    }
  }
}


DEV bf16x8 ld_frag2x64(const LAS char* p) { const u32x2 a = *(const LAS u32x2*)p, b = *(const LAS u32x2*)(p + 8); return __builtin_bit_cast(bf16x8, (u32x4){a.x, a.y, b.x, b.y}); }
DEV void phase_gla_scan_mfma(CP p, LAS char* shm) {
  const bf16_t* QKVG = (const bf16_t*)(p.scratch + OFF_QKVG); const bf16_t* LG = (const bf16_t*)(p.scratch + OFF_LG); const bf16_t* VTG = (const bf16_t*)(p.scratch + OFF_VTG);
  bf16_t* OD = (bf16_t*)(p.scratch + OFF_OD);
  constexpr int QG_O = 0, KG_O = 17408, KDT_O = 34816, VT_O = 52224, ATT_O = 69632, ST_O = 78336, GS_O = 113152, EB_O = 115200;
  const int tid = TIDX, wid = __builtin_amdgcn_readfirstlane(tid >> 6), lane = tid & 63, ln = lane & 15, kgrp = lane >> 4;
  const int kcol = tid & 127, grp = tid >> 7;
  for (int unit = BIDX; unit < 256; unit += gridDim.x) {
    const int b = unit >> 4, head = (unit >> 2) & 3, d = (unit >> 1) & 1, dvh = unit & 1;
    __syncthreads();
    for (int idx = tid; idx < 34816 / 16; idx += NTHR) *(LAS u32x4*)(shm + ST_O + idx * 16) = (u32x4){0u, 0u, 0u, 0u};
    f32x4 accS[8];
#pragma unroll
    for (int i = 0; i < 8; ++i) accS[i] = (f32x4){0.f, 0.f, 0.f, 0.f};
    const bf16_t* vtg = VTG + ((size_t)(b * 4 + head) * 256 + dvh * 128 + (tid >> 2)) * SP + (tid & 3) * 16;
    us16 rl[16], rq[16], rk[16]; uint4 pv0, pv1;
#define GLA_FETCH(ci_) do { const int c_ = d == 0 ? (ci_) : ((ci_) < 4 ? 3 - (ci_) : 39 - (ci_)); const size_t t0_ = (size_t)b * SP + c_ * 64; \
      _Pragma("unroll") for (int j = 0; j < 16; ++j) { const size_t t = t0_ + grp * 16 + j; \
        rl[j] = LG[((size_t)d * T + t) * 512 + head * 128 + kcol]; rq[j] = QKVG[t * 3072 + head * 128 + kcol]; rk[j] = QKVG[t * 3072 + 512 + head * 128 + kcol]; } \
      pv0 = *(const uint4*)(vtg + c_ * 64); pv1 = *(const uint4*)(vtg + c_ * 64 + 8); } while (0)
    GLA_FETCH(0);
    for (int ci = 0; ci < 36; ++ci) {
      const int c = d == 0 ? ci : (ci < 4 ? 3 - ci : 39 - ci);
      const size_t t0 = (size_t)b * SP + c * 64;
      { float lgv[16], qv[16], kv[16];
#pragma unroll
        for (int j = 0; j < 16; ++j) { lgv[j] = bf2f(rl[j]); qv[j] = bf2f(rq[j]); kv[j] = bf2f(rk[j]); }
        const uint4 v0 = pv0, v1 = pv1;
        if (ci + 1 < 36) GLA_FETCH(ci + 1);
        float run = 0.f;
        if (d == 0) {
#pragma unroll
          for (int j = 0; j < 16; ++j) { run += lgv[j]; lgv[j] = run; }
        } else {
#pragma unroll
          for (int j = 15; j >= 0; --j) { run += lgv[j]; lgv[j] = run; }
        }
        float* GS = (float*)0; (void)GS;
        *(LAS float*)(shm + GS_O + (grp * 128 + kcol) * 4) = run;
        { LAS char* vw = shm + VT_O + (tid >> 2) * 136 + (tid & 3) * 32;
          *(LAS u32x2*)vw = (u32x2){v0.x, v0.y}; *(LAS u32x2*)(vw + 8) = (u32x2){v0.z, v0.w}; *(LAS u32x2*)(vw + 16) = (u32x2){v1.x, v1.y}; *(LAS u32x2*)(vw + 24) = (u32x2){v1.z, v1.w}; }
        __syncthreads();
        float g0 = *(const LAS float*)(shm + GS_O + (0 * 128 + kcol) * 4), g1 = *(const LAS float*)(shm + GS_O + (1 * 128 + kcol) * 4);
        float g2 = *(const LAS float*)(shm + GS_O + (2 * 128 + kcol) * 4), g3 = *(const LAS float*)(shm + GS_O + (3 * 128 + kcol) * 4);
        const float blast = (g0 + g1) + (g2 + g3);
        float off;
        if (d == 0) off = (grp > 0 ? g0 : 0.f) + (grp > 1 ? g1 : 0.f) + (grp > 2 ? g2 : 0.f);
        else off = (grp < 3 ? g3 : 0.f) + (grp < 2 ? g2 : 0.f) + (grp < 1 ? g1 : 0.f);
        unsigned kd[8];
#pragma unroll
        for (int j = 0; j < 16; j += 2) {
          const float bc0 = off + lgv[j], bc1 = off + lgv[j + 1];
          const float e0 = __expf(bc0), e1 = __expf(bc1);
          *(LAS us16*)(shm + QG_O + (grp * 16 + j) * 272 + kcol * 2) = f2bf(qv[j] * e0);
          *(LAS us16*)(shm + QG_O + (grp * 16 + j + 1) * 272 + kcol * 2) = f2bf(qv[j + 1] * e1);
          *(LAS us16*)(shm + KG_O + (grp * 16 + j) * 272 + kcol * 2) = f2bf(kv[j] * __expf(-bc0));
          *(LAS us16*)(shm + KG_O + (grp * 16 + j + 1) * 272 + kcol * 2) = f2bf(kv[j + 1] * __expf(-bc1));
          kd[j >> 1] = cvt_pk_bf16(kv[j] * __expf(blast - bc0), kv[j + 1] * __expf(blast - bc1));
        }
        { LAS char* kw = shm + KDT_O + kcol * 136 + grp * 32;
          *(LAS u32x2*)kw = (u32x2){kd[0], kd[1]}; *(LAS u32x2*)(kw + 8) = (u32x2){kd[2], kd[3]}; *(LAS u32x2*)(kw + 16) = (u32x2){kd[4], kd[5]}; *(LAS u32x2*)(kw + 24) = (u32x2){kd[6], kd[7]}; }
        if (grp == 0) *(LAS float*)(shm + EB_O + kcol * 4) = __expf(blast);
      }
      __syncthreads();
      { const int it = wid >> 1;
#pragma unroll
        for (int jj = 0; jj < 2; ++jj) {
          const int jt = 2 * (wid & 1) + jj;
          f32x4 a = (f32x4){0.f, 0.f, 0.f, 0.f};
          const bool dead = d == 0 ? (jt > it) : (jt < it);
          if (!dead) {
#pragma unroll
            for (int ks = 0; ks < 4; ++ks) a = __builtin_amdgcn_mfma_f32_16x16x32_bf16(ld_frag_lds(shm + QG_O + (16 * it + ln) * 272 + ks * 64 + kgrp * 16), ld_frag_lds(shm + KG_O + (16 * jt + ln) * 272 + ks * 64 + kgrp * 16), a, 0, 0, 0);
          }
          const int jc = 16 * jt + ln;
#pragma unroll
          for (int r = 0; r < 4; ++r) { const int ir = 16 * it + 4 * kgrp + r; const bool keep = d == 0 ? (jc <= ir) : (jc >= ir);
            *(LAS us16*)(shm + ATT_O + ir * 136 + jc * 2) = f2bf(keep ? a[r] : 0.f); }
        } }
      __syncthreads();
      { bf16x8 vtf[2], stf[4];
#pragma unroll
        for (int ks = 0; ks < 2; ++ks) vtf[ks] = ld_frag2x64(shm + VT_O + (16 * wid + ln) * 136 + ks * 64 + kgrp * 16);
#pragma unroll
        for (int ks = 0; ks < 4; ++ks) stf[ks] = ld_frag_lds(shm + ST_O + (16 * wid + ln) * 272 + ks * 64 + kgrp * 16);
#pragma unroll
        for (int it = 0; it < 4; ++it) {
          f32x4 o = (f32x4){0.f, 0.f, 0.f, 0.f};
#pragma unroll
          for (int ks = 0; ks < 2; ++ks) o = __builtin_amdgcn_mfma_f32_16x16x32_bf16(ld_frag2x64(shm + ATT_O + (16 * it + ln) * 136 + ks * 64 + kgrp * 16), vtf[ks], o, 0, 0, 0);
#pragma unroll
          for (int ks = 0; ks < 4; ++ks) o = __builtin_amdgcn_mfma_f32_16x16x32_bf16(ld_frag_lds(shm + QG_O + (16 * it + ln) * 272 + ks * 64 + kgrp * 16), stf[ks], o, 0, 0, 0);
#pragma unroll
          for (int r = 0; r < 4; ++r) OD[((size_t)d * T + t0 + 16 * it + 4 * kgrp + r) * D + head * 256 + dvh * 128 + 16 * wid + ln] = f2bf(o[r]);
        }
#pragma unroll
        for (int dkt = 0; dkt < 8; ++dkt) {
          const float eb = *(const LAS float*)(shm + EB_O + (16 * dkt + ln) * 4);
          f32x4 a = accS[dkt] * eb;
#pragma unroll
          for (int ks = 0; ks < 2; ++ks) a = __builtin_amdgcn_mfma_f32_16x16x32_bf16(vtf[ks], ld_frag2x64(shm + KDT_O + (16 * dkt + ln) * 136 + ks * 64 + kgrp * 16), a, 0, 0, 0);
          accS[dkt] = a;
        }
      }
      __syncthreads();
#pragma unroll
      for (int dkt = 0; dkt < 8; ++dkt)
#pragma unroll
        for (int r = 0; r < 4; ++r) *(LAS us16*)(shm + ST_O + (16 * wid + 4 * kgrp + r) * 272 + (16 * dkt + ln) * 2) = f2bf(accS[dkt][r]);
      __syncthreads();
    }
  }
#undef GLA_FETCH
}

DEV void phase_gla_out(CP p) {
  const bf16_t* QKVG = (const bf16_t*)(p.scratch + OFF_QKVG); const bf16_t* OD = (const bf16_t*)(p.scratch + OFF_OD); bf16_t* GO = (bf16_t*)(p.scratch + OFF_GO);
  const int lane = TIDX & 63, gw = BIDX * (NTHR / 64) + __builtin_amdgcn_readfirstlane(TIDX >> 6), nw = gridDim.x * (NTHR / 64);
  const float4 on = *(const float4*)(p.gla_o_norm + lane * 4); const float ona[4] = {on.x, on.y, on.z, on.w};
  for (int t0 = gw; t0 < T; t0 += 2 * nw) {
    uint2 a[2][4], bq[2][4], gg[2][4];
#pragma unroll
    for (int u = 0; u < 2; ++u) { const int t = t0 + u * nw; if (t < T) {
#pragma unroll
      for (int hd = 0; hd < 4; ++hd) { const int c0 = hd * 256 + lane * 4;
        a[u][hd] = *(const uint2*)(OD + (size_t)t * D + c0); bq[u][hd] = *(const uint2*)(OD + ((size_t)T + t) * D + c0); gg[u][hd] = *(const uint2*)(QKVG + (size_t)t * 3072 + 2048 + c0); } } }
#pragma unroll
    for (int u = 0; u < 2; ++u) { const int t = t0 + u * nw; if (t < T) {
#pragma unroll
      for (int hd = 0; hd < 4; ++hd) {
        const int c0 = hd * 256 + lane * 4;
        const uint2 av = a[u][hd], bv = bq[u][hd], gv2 = gg[u][hd];
        float o[4] = {__uint_as_float(av.x << 16) + __uint_as_float(bv.x << 16), __uint_as_float(av.x & 0xffff0000u) + __uint_as_float(bv.x & 0xffff0000u),
                      __uint_as_float(av.y << 16) + __uint_as_float(bv.y << 16), __uint_as_float(av.y & 0xffff0000u) + __uint_as_float(bv.y & 0xffff0000u)};
        const float gv[4] = {__uint_as_float(gv2.x << 16), __uint_as_float(gv2.x & 0xffff0000u), __uint_as_float(gv2.y << 16), __uint_as_float(gv2.y & 0xffff0000u)};
        float ss = o[0] * o[0] + o[1] * o[1] + o[2] * o[2] + o[3] * o[3];
        ss = wave_sum(ss); const float rstd = rsqrtf(ss * (1.0f / 256.0f) + 1e-6f);
        unsigned w[2];
#pragma unroll
        for (int e = 0; e < 4; e += 2) w[e >> 1] = cvt_pk_bf16(o[e] * rstd * ona[e] * silu(gv[e]), o[e + 1] * rstd * ona[e + 1] * silu(gv[e + 1]));
        *(uint2*)(GO + (size_t)t * D + c0) = make_uint2(w[0], w[1]);
      }
    } }
  }
}


#define XB_TMO      128
#define XB_XCNT(j)  (256  + 64 * (j))
#define XB_XSUB(j)  (1280 + 64 * (j))
#define XB_XGEN(j)  (2304 + 64 * (j))
#define XB_TOP      3328
#define XB_TOPGEN   3392
#define XCD_BAR_WORDS 3456
#define XB_SPIN_CAP (1u << 22)
DEV unsigned xb_ld(unsigned* p)              { return __hip_atomic_load(p, __ATOMIC_RELAXED, __HIP_MEMORY_SCOPE_AGENT); }
DEV unsigned xb_add(unsigned* p, unsigned v) { return __hip_atomic_fetch_add(p, v, __ATOMIC_RELAXED, __HIP_MEMORY_SCOPE_AGENT); }
DEV unsigned xb_xcc_id() { return (unsigned)__builtin_amdgcn_s_getreg((3 << 11) | 20) & 0xFu; }
#define XB_SPIN(cond, bar) do { unsigned _sp = 0; while (cond) { __builtin_amdgcn_s_sleep(1); \
    if ((++_sp & 255u) == 0u) { if (xb_ld(&(bar)[XB_TMO])) break; if (_sp > XB_SPIN_CAP) { atomicAdd(&(bar)[XB_TMO], 1u); break; } } } } while (0)
struct XcdBarrier { unsigned* bar; unsigned x; volatile LAS unsigned* st; };
DEV XcdBarrier xcd_barrier_post(unsigned* bar, volatile LAS unsigned* st) {
  XcdBarrier b; b.bar = bar; b.x = xb_xcc_id(); b.st = st;
  if (threadIdx.x == 0) (void)xb_add(&bar[XB_XCNT(b.x)], 1u);
  return b;
}
DEV void xcd_barrier_complete(unsigned* bar, unsigned x, unsigned& nloc, unsigned& nx) {
  const unsigned G = gridDim.x * gridDim.y * gridDim.z;
  unsigned sum, cnt, mine, sp = 0u;
  for (;;) {
    sum = 0u; cnt = 0u; mine = 0u;
#pragma unroll
    for (unsigned j = 0; j < 16; ++j) { const unsigned c = xb_ld(&bar[XB_XCNT(j)]); sum += c; cnt += (c > 0u) ? 1u : 0u; mine = (j == x) ? c : mine; }
    if (sum == G) break;
    __builtin_amdgcn_s_sleep(1);
    if ((++sp & 255u) == 0u) { if (xb_ld(&bar[XB_TMO])) break; if (sp > XB_SPIN_CAP) { atomicAdd(&bar[XB_TMO], 1u); break; } }
  }
  nloc = mine > 0u ? mine : 1u; nx = cnt > 0u ? cnt : 1u;
}
DEV void xcd_barrier(const XcdBarrier& b) {
  asm volatile("s_waitcnt vmcnt(0)" ::: "memory");
  __syncthreads();
  if (threadIdx.x == 0) {
    unsigned* bar = b.bar; asm volatile("" : "+s"(bar)); unsigned bx = b.x; asm volatile("" : "+s"(bx));
    __builtin_amdgcn_s_waitcnt(0);
    unsigned nloc = b.st[0], nx = b.st[1];
    if (nloc == 0u) { xcd_barrier_complete(bar, bx, nloc, nx); b.st[0] = nloc; b.st[1] = nx; }
    const unsigned old = xb_add(&bar[XB_XSUB(bx)], 1u);
    const unsigned gen = old / nloc;
    if (old + 1u == (gen + 1u) * nloc) {
      __builtin_amdgcn_fence(__ATOMIC_RELEASE, "agent");
      asm volatile("s_waitcnt vmcnt(0)" ::: "memory");
      const unsigned og = xb_add(&bar[XB_TOP], 1u);
      const unsigned tg = og / nx;
      if (og + 1u == (tg + 1u) * nx) xb_add(&bar[XB_TOPGEN], 1u);
      else XB_SPIN(xb_ld(&bar[XB_TOPGEN]) == tg, bar);
      __builtin_amdgcn_fence(__ATOMIC_ACQUIRE, "agent");
      xb_add(&bar[XB_XGEN(bx)], 1u);
      asm volatile("s_waitcnt vmcnt(0)" ::: "memory");
    } else {
      XB_SPIN(xb_ld(&bar[XB_XGEN(bx)]) == gen, bar);
      __builtin_amdgcn_fence(__ATOMIC_ACQUIRE, "agent");
      asm volatile("s_waitcnt vmcnt(0)" ::: "memory");
    }
  }
  __syncthreads();
}

__global__ void __launch_bounds__(NTHR) fwd_megakernel(Params p_arg) {
#define KP (*params_now())
  cg::grid_group grid = cg::this_grid();
  __shared__ __attribute__((aligned(1024))) char shm_raw[144 * 1024];
  float* lds = (float*)shm_raw; LAS char* shm = (LAS char*)shm_raw;
  __shared__ uint4 xb_words;
  if (threadIdx.x == 0) xb_words = make_uint4(0u, 0u, 0u, 0u);
  __syncthreads();
  const XcdBarrier xb = xcd_barrier_post(KP.bar, (volatile LAS unsigned*)&xb_words);
  phase_prologue(KP, lds);
  grid.sync();
#define GSYNC() xcd_barrier(xb)
#ifndef PROBE
#define PROBE 0
#endif
#define PH(grp, ...) do { unsigned long long t0_ = 0; if (PROBE == (grp)) t0_ = __builtin_amdgcn_s_memrealtime(); __VA_ARGS__; GSYNC(); \
    if (PROBE == (grp)) { const unsigned long long d_ = __builtin_amdgcn_s_memrealtime() - t0_, t1_ = __builtin_amdgcn_s_memrealtime(); \
      while (__builtin_amdgcn_s_memrealtime() - t1_ < d_) __builtin_amdgcn_s_sleep(8); GSYNC(); } } while (0)
  PH(8, phase_norm1_first(KP));
  for (int layer = 0; layer < 4; ++layer) {
    const int kind = layer % 3, j = layer / 3; const bool last = layer == 3;
    if (kind == 0) {
      PH(2, gemm_pg8(KP.h, KP.w_mla_in + (size_t)j * 768 * 1024, T, 768, 1024, EpiStoreBf16R{(bf16_t*)(KP.scratch + OFF_A1), 768, 672}, shm));
      PH(7, phase_mla_norm(KP, j));
      PH(2, gemm_pg8((const bf16_t*)(KP.scratch + OFF_CQN), KP.w_uq + (size_t)j * 1536 * 384, T, 1536, 384, EpiQR{(bf16_t*)(KP.scratch + OFF_QF)}, shm, false, last);
            gemm_pg8((const bf16_t*)(KP.scratch + OFF_CKVN), KP.w_ukv + (size_t)j * 2048 * 256, T, 2048, 256, EpiKVR{(bf16_t*)(KP.scratch + OFF_KF), (bf16_t*)(KP.scratch + OFF_VF)}, shm, true));
      PH(6, phase_attn_mfma(KP, last, shm));
      if (last) { PH(2, gemm_pg8((const bf16_t*)(KP.scratch + OFF_O), KP.w_mla_o + (size_t)j * 1024 * 1024, T, 1024, 1024, EpiResR{KP.xc, KP.xl, KP.ada, layer, 2048, last}, shm, false, true)); }
      else { PH(2, gemm256s_t<192>((const bf16_t*)(KP.scratch + OFF_O), D, KP.w_mla_o + (size_t)j * 1024 * 1024, 1024, T, 1024, 1024, EpiResR{KP.xc, KP.xl, KP.ada, layer, 2048, last}, shm)); }
      PH(7, phase_norm2(KP, layer));
    } else if (kind == 1) {
      PH(4, phase_s5_scan_mfma(KP, shm));
      PH(4, phase_s5_out_mfma(KP, shm));
      PH(2, gemm256s_t<192, EpiGluResR, true>((const bf16_t*)(KP.scratch + OFF_GIN), D, KP.w_glu, 1024, T, 2048, 1024, EpiGluResR{KP.xc, KP.xl, KP.ada, layer}, shm));
      PH(7, phase_norm2(KP, layer));
    } else {
      PH(2, gemm_pg8(KP.h, KP.w_gla_in, T, 4096, 1024, EpiGlaR{(bf16_t*)(KP.scratch + OFF_QKVG), (bf16_t*)(KP.scratch + OFF_LG), KP.gla_gk_b, (bf16_t*)(KP.scratch + OFF_VTG)}, shm));
      PH(4, phase_gla_scan_mfma(KP, shm));
      PH(7, phase_gla_out(KP));
      PH(2, gemm256s_t<192>((const bf16_t*)(KP.scratch + OFF_GO), D, KP.w_gla_o, 1024, T, 1024, 1024, EpiResR{KP.xc, KP.xl, KP.ada, layer, 2048, false}, shm));
      PH(7, phase_norm2(KP, layer));
    }
    if (last) { PH(2, gemm_pg8(KP.h, KP.w_pq + (size_t)layer * 1024 * 1024, T, 1024, 1024, EpiStoreBf16R{(bf16_t*)(KP.scratch + OFF_PQ), 1024, 1024}, shm, false, true);
          phase_peer_tables(KP, layer)); } else { PH(2, gemm256s_t<192>(KP.h, D, KP.w_pq + (size_t)layer * 1024 * 1024, 1024, T, 1024, 1024, EpiStoreBf16R{(bf16_t*)(KP.scratch + OFF_PQ), 1024, 1024}, shm);
          phase_peer_tables(KP, layer)); }
    PH(3, phase_peer_route(KP, layer, shm));
    if (layer < 3) { PH(1, phase_peer_gather8(KP, layer, shm)); } else phase_peer_gather8(KP, layer, shm);
  }
}

extern "C" void kernel_launch(void* const* d_in, const int* in_sizes, int n_in, void* d_out,
                              int out_size, void* d_ws, size_t ws_size, hipStream_t stream) {
  static int grid_blocks = 0;
  if (!grid_blocks) {
    int dev = 0, cus = 0, per_cu = 0;
    (void)hipGetDevice(&dev);
    (void)hipDeviceGetAttribute(&cus, hipDeviceAttributeMultiprocessorCount, dev);
    (void)hipOccupancyMaxActiveBlocksPerMultiprocessor(&per_cu, fwd_megakernel, NTHR, 0);
    if (per_cu > 1) per_cu = 1;
    grid_blocks = cus * per_cu;
  }
  Params p{};
  const float* const* in = (const float* const*)d_in;
  p.x = in[0]; p.c = in[1]; p.ctx = in[2]; p.c_ctx = in[3]; p.norm_g = in[4]; p.ada_w = in[5]; p.ada_b = in[6];
  p.mla_w_in = in[7]; p.mla_q_norm = in[8]; p.mla_w_uq = in[9]; p.mla_kv_norm = in[10]; p.mla_w_ukv = in[11]; p.mla_w_o = in[12];
  p.s5_lam_re = in[13]; p.s5_lam_im = in[14]; p.s5_b_re = in[15]; p.s5_b_im = in[16]; p.s5_c_re = in[17]; p.s5_c_im = in[18]; p.s5_log_step = in[19]; p.s5_d = in[20]; p.s5_w_glu = in[21];
  p.gla_w_in = in[22]; p.gla_gk_w1 = in[23]; p.gla_gk_w2 = in[24]; p.gla_gk_b = in[25]; p.gla_o_norm = in[26]; p.gla_w_o = in[27];
  p.peer_w_q = in[28]; p.peer_keys = in[29]; p.peer_u = in[30]; p.peer_v = in[31]; p.final_g = in[32];
  p.out = (float*)d_out;
  char* w = (char*)d_ws; size_t off = 0;
  auto take = [&](size_t bytes) { char* r = w + off; off += (bytes + 255) & ~(size_t)255; return r; };
  p.xc = (bf16_t*)take((size_t)NB * CTX * D * 2);
  p.xl = (bf16_t*)take((size_t)NB * SEQ * D * 2);
  p.ada = (float*)take((size_t)4 * 17 * 6144 * 4);
  p.rope = (float*)take((size_t)2048 * 32 * 4);
  p.h = (bf16_t*)take((size_t)T * D * 2);
  p.w_mla_in = (bf16_t*)take((size_t)2 * 768 * 1024 * 2);
  p.w_uq = (bf16_t*)take((size_t)2 * 1536 * 384 * 2);
  p.w_ukv = (bf16_t*)take((size_t)2 * 2048 * 256 * 2);
  p.w_mla_o = (bf16_t*)take((size_t)2 * 1024 * 1024 * 2);
  p.w_glu = (bf16_t*)take((size_t)2048 * 1024 * 2);
  p.w_gla_in = (bf16_t*)take((size_t)4096 * 1024 * 2);
  p.w_gla_o = (bf16_t*)take((size_t)1024 * 1024 * 2);
  p.w_pq = (bf16_t*)take((size_t)4 * 1024 * 1024 * 2);
  p.s5_ar = (float*)take(2 * 64 * 64 * 4); p.s5_ai = (float*)take(2 * 64 * 64 * 4);
  p.s5_br = (float*)take(2 * 64 * 64 * 16 * 4); p.s5_bi = (float*)take(2 * 64 * 64 * 16 * 4);
  p.scratch = take(SCRATCH_BYTES);
  p.bar = (unsigned*)take(XCD_BAR_WORDS * 4);
  if (off > ws_size) { fprintf(stderr, "workspace too small: need %zu have %zu\n", off, ws_size); return; }
  (void)hipMemsetAsync(p.bar, 0, XCD_BAR_WORDS * 4, stream);
  void* args[] = {&p};
  hipError_t e = hipLaunchCooperativeKernel((void*)fwd_megakernel, dim3(grid_blocks), dim3(NTHR), args, 0, stream);
  if (e != hipSuccess) fprintf(stderr, "cooperative launch failed: %s (grid %d)\n", hipGetErrorString(e), grid_blocks);
}
```
